# Optimizing an MI355X kernel written in HIP

```python
import math
import jax, jax.numpy as jnp
from jax import lax
import numpy as np

D_MODEL = 2048
BATCH = 16
SEQ = 2048
DEPTH = 2

CHUNK = 64
EPS = 1e-6
NEG_INF = -1e30
ROPE_THETA = 500000.0

N_HEADS_A = 8
HEAD_DIM = 128
ROT_DIM = HEAD_DIM // 4
N_IDX_HEADS = 8
IDX_DIM = 64
IDX_ROT_DIM = IDX_DIM // 4
TOPK_MAX = 256
Q_BLOCK = 128
WIDTH_A = N_HEADS_A * HEAD_DIM

WIDTH_B = D_MODEL // 4
SSM_GROUP = 16
N_SSM_GROUPS = WIDTH_B // SSM_GROUP
SSM_STATE = 64

WIDTH_C = D_MODEL // 4
POOL_WINDOWS = (2, 4, 8, 16)
POOL_GROUP = WIDTH_C // 4

N_BRANCH = 3

D_FF = 5504
CONV_WIDTH = 3

Q_W = WIDTH_A
K_W = HEAD_DIM
V_W = HEAD_DIM
QI_W = N_IDX_HEADS * IDX_DIM
KI_W = IDX_DIM
WI_W = N_IDX_HEADS
U_W = WIDTH_B
P_W = WIDTH_C
IN_SPLITS = (Q_W, Q_W + K_W, Q_W + K_W + V_W, Q_W + K_W + V_W + QI_W,
             Q_W + K_W + V_W + QI_W + KI_W, Q_W + K_W + V_W + QI_W + KI_W + WI_W,
             Q_W + K_W + V_W + QI_W + KI_W + WI_W + U_W)
D_IN = Q_W + K_W + V_W + QI_W + KI_W + WI_W + U_W + P_W

kernel_name = "chunk_causal_hybrid_dsa_s5_pool_convffn"


def rms_norm(x, g):
    xf = x.astype(jnp.float32)
    y = xf * lax.rsqrt(jnp.mean(xf * xf, axis=-1, keepdims=True) + EPS)
    return (y * g.astype(jnp.float32)).astype(x.dtype)


def partial_rope(x, pos, rot_dim):
    half = rot_dim // 2
    inv_freq = ROPE_THETA ** (-jnp.arange(half, dtype=jnp.float32) * (2.0 / rot_dim))
    ang = pos.astype(jnp.float32)[..., None] * inv_freq
    cos = jnp.cos(ang)[:, :, None, :]
    sin = jnp.sin(ang)[:, :, None, :]
    xf = x.astype(jnp.float32)
    x1 = xf[..., :half]
    x2 = xf[..., half:rot_dim]
    out = jnp.concatenate([x1 * cos - x2 * sin, x2 * cos + x1 * sin, xf[..., rot_dim:]], axis=-1)
    return out.astype(x.dtype)


def dsa_attention(q, k, v, qi, ki, wi, n_topk):
    B, L, H, dh = q.shape
    nb = L // Q_BLOCK
    key_pos = jnp.arange(L)
    kf = k.astype(jnp.float32)
    vf = v.astype(jnp.float32)
    kif = ki.astype(jnp.float32)

    def block(args):
        bi, qb, qib, wib = args
        qpos = bi * Q_BLOCK + jnp.arange(Q_BLOCK)
        limit = (qpos // CHUNK + 1) * CHUNK
        admissible = key_pos[None, :] < limit[:, None]
        s = jnp.einsum('bqhd,bsd->bqhs', qib.astype(jnp.float32), kif) * (IDX_DIM ** -0.5)
        idx_score = jnp.einsum('bqhs,bqh->bqs', jax.nn.relu(s), wib.astype(jnp.float32))
        idx_score = jnp.where(admissible[None], idx_score, NEG_INF)
        top_val, top_idx = lax.top_k(idx_score, n_topk)
        valid = top_val > NEG_INF * 0.5
        kg = jax.vmap(lambda kk, ii: kk[ii])(kf, top_idx)
        vg = jax.vmap(lambda vv, ii: vv[ii])(vf, top_idx)
        logits = jnp.einsum('bqhd,bqkd->bqhk', qb.astype(jnp.float32), kg) * (dh ** -0.5)
        logits = jnp.where(valid[:, :, None, :], logits, NEG_INF)
        probs = jax.nn.softmax(logits, axis=-1)
        o = jnp.einsum('bqhk,bqkd->bqhd', probs, vg)
        return o.astype(q.dtype)

    qs = q.reshape(B, nb, Q_BLOCK, H, dh).transpose(1, 0, 2, 3, 4)
    qis = qi.reshape(B, nb, Q_BLOCK, N_IDX_HEADS, IDX_DIM).transpose(1, 0, 2, 3, 4)
    wis = wi.reshape(B, nb, Q_BLOCK, N_IDX_HEADS).transpose(1, 0, 2, 3)
    out = lax.map(block, (jnp.arange(nb), qs, qis, wis))
    return out.transpose(1, 0, 2, 3, 4).reshape(B, L, H * dh)


def s5_mixer(u, a_re, a_im, b_re, b_im, c_re, c_im, d_skip, log_dt, w_glu):
    B, L, _ = u.shape
    G, P, I = N_SSM_GROUPS, SSM_STATE, SSM_GROUP
    f32 = jnp.float32
    uf = u.astype(f32).reshape(B, L, G, I)
    lam = lax.complex(a_re.astype(f32), a_im.astype(f32))
    dt = jnp.exp(log_dt.astype(f32))[:, None]
    lam_bar = jnp.exp(lam * dt)
    b_bar = ((lam_bar - 1.0) / lam)[..., None] * lax.complex(b_re.astype(f32), b_im.astype(f32))
    bu = jnp.einsum('gpi,blgi->blgp', b_bar, uf.astype(jnp.complex64))
    a_elems = jnp.broadcast_to(lam_bar, (1, L, G, P))

    def combine(left, right):
        a_l, b_l = left
        a_r, b_r = right
        return a_r * a_l, a_r * b_l + b_r

    _, states = lax.associative_scan(combine, (a_elems, bu), axis=1)
    c_t = lax.complex(c_re.astype(f32), c_im.astype(f32))
    y = jnp.einsum('gip,blgp->blgi', c_t, states).real + d_skip.astype(f32).reshape(G, I) * uf
    y = jax.nn.gelu(y.reshape(B, L, WIDTH_B))
    y = y * jax.nn.sigmoid(y @ w_glu.astype(f32))
    return y.astype(u.dtype)


def pool_mixer(p, w_pool, pool_scale):
    B, L, _ = p.shape
    pf = p.astype(jnp.float32)
    cs = jnp.pad(jnp.cumsum(pf, axis=1), ((0, 0), (1, 0), (0, 0)))
    t1 = jnp.arange(1, L + 1, dtype=jnp.float32)
    outs = []
    for g, w in enumerate(POOL_WINDOWS):
        sl = slice(g * POOL_GROUP, (g + 1) * POOL_GROUP)
        upper = cs[:, 1:, sl]
        lower = jnp.pad(cs[:, :L + 1 - w, sl], ((0, 0), (w - 1, 0), (0, 0)))
        mean = (upper - lower) / jnp.minimum(t1, float(w))[None, :, None]
        outs.append(mean - pf[:, :, sl])
    pooled = jnp.stack(outs, axis=2)
    y = jnp.einsum('blgi,gio->blgo', pooled, w_pool.astype(jnp.float32)).reshape(B, L, WIDTH_C)
    return (y * pool_scale.astype(jnp.float32)).astype(p.dtype)


def hybrid_mixer(h, positions, n_topk, w_in, g_q, g_k, a_re, a_im, b_re, b_im, c_re, c_im,
                 d_skip, log_dt, w_glu, w_pool, pool_scale, p_a, p_b, p_c, w_gate, b_gate, w_out):
    B, L, _ = h.shape
    proj = h @ w_in
    q, k, v, qi, ki, wi, u, p = jnp.split(proj, IN_SPLITS, axis=-1)
    q = partial_rope(rms_norm(q.reshape(B, L, N_HEADS_A, HEAD_DIM), g_q), positions, ROT_DIM)
    k = partial_rope(rms_norm(k, g_k)[:, :, None, :], positions, ROT_DIM)[:, :, 0]
    qi = partial_rope(qi.reshape(B, L, N_IDX_HEADS, IDX_DIM), positions, IDX_ROT_DIM)
    ki = partial_rope(ki[:, :, None, :], positions, IDX_ROT_DIM)[:, :, 0]
    o_a = dsa_attention(q, k, v, qi, ki, wi * (N_IDX_HEADS ** -0.5), n_topk)
    o_b = s5_mixer(u, a_re, a_im, b_re, b_im, c_re, c_im, d_skip, log_dt, w_glu)
    o_c = pool_mixer(p, w_pool, pool_scale)
    merged = jax.nn.sigmoid(h @ w_gate[0] + b_gate[0]) * (o_a @ p_a)
    merged = merged + jax.nn.sigmoid(h @ w_gate[1] + b_gate[1]) * (o_b @ p_b)
    merged = merged + jax.nn.sigmoid(h @ w_gate[2] + b_gate[2]) * (o_c @ p_c)
    return merged @ w_out


def conv_ffn(h, w_up, conv_w, conv_b, w_down):
    L = h.shape[1]
    a, b = jnp.split(h @ w_up, 2, axis=-1)
    a_pad = jnp.pad(a, ((0, 0), (CONV_WIDTH - 1, 0), (0, 0)))
    a_conv = conv_b + a_pad[:, 0:L] * conv_w[0]
    for j in range(1, CONV_WIDTH):
        a_conv = a_conv + a_pad[:, j:j + L] * conv_w[j]
    return (jax.nn.silu(a_conv) * b) @ w_down


def setup_inputs(seed: int = 0) -> dict:
    key = jax.random.key(seed)
    ks = jax.random.split(key, 40)
    f32 = jnp.float32
    G, P, I = N_SSM_GROUPS, SSM_STATE, SSM_GROUP

    def nrm(k, shape, scale):
        return jax.random.normal(k, shape, f32) * scale

    x = nrm(ks[0], (BATCH, SEQ, D_MODEL), 1.0)
    c = nrm(ks[1], (BATCH, D_MODEL), 1.0)
    offsets = jax.random.randint(ks[2], (BATCH, 1), 0, 64) * CHUNK
    positions = (offsets + jnp.arange(SEQ, dtype=jnp.int32)[None, :]).astype(jnp.int32)
    return {
        "x": x,
        "c": c,
        "positions": positions,
        "w_ada": nrm(ks[3], (DEPTH, D_MODEL, 6 * D_MODEL), 0.5 * D_MODEL ** -0.5),
        "b_ada": nrm(ks[4], (DEPTH, 6 * D_MODEL), 0.02),
        "g_norm1": 1.0 + nrm(ks[5], (DEPTH, D_MODEL), 0.02),
        "g_norm2": 1.0 + nrm(ks[6], (DEPTH, D_MODEL), 0.02),
        "w_in": nrm(ks[7], (DEPTH, D_MODEL, D_IN), D_MODEL ** -0.5),
        "g_q": 1.0 + nrm(ks[8], (DEPTH, HEAD_DIM), 0.02),
        "g_k": 1.0 + nrm(ks[9], (DEPTH, HEAD_DIM), 0.02),
        "a_re": -0.5 * (1.0 + nrm(ks[10], (DEPTH, G, P), 0.01)),
        "a_im": math.pi * jnp.arange(P, dtype=f32)[None, None, :] + nrm(ks[11], (DEPTH, G, P), 0.01),
        "b_re": nrm(ks[12], (DEPTH, G, P, I), (2.0 * I) ** -0.5),
        "b_im": nrm(ks[13], (DEPTH, G, P, I), (2.0 * I) ** -0.5),
        "c_re": nrm(ks[14], (DEPTH, G, I, P), (2.0 * P) ** -0.5),
        "c_im": nrm(ks[15], (DEPTH, G, I, P), (2.0 * P) ** -0.5),
        "d_skip": nrm(ks[16], (DEPTH, WIDTH_B), 1.0),
        "log_dt": jax.random.uniform(ks[17], (DEPTH, G), f32, math.log(1e-3), math.log(1e-1)),
        "w_glu": nrm(ks[18], (DEPTH, WIDTH_B, WIDTH_B), WIDTH_B ** -0.5),
        "w_pool": nrm(ks[19], (DEPTH, 4, POOL_GROUP, POOL_GROUP), POOL_GROUP ** -0.5),
        "pool_scale": 1.0 + nrm(ks[20], (DEPTH, WIDTH_C), 0.02),
        "p_a": nrm(ks[21], (DEPTH, WIDTH_A, D_MODEL), WIDTH_A ** -0.5),
        "p_b": nrm(ks[22], (DEPTH, WIDTH_B, D_MODEL), WIDTH_B ** -0.5),
        "p_c": nrm(ks[23], (DEPTH, WIDTH_C, D_MODEL), WIDTH_C ** -0.5),
        "w_gate": nrm(ks[24], (DEPTH, N_BRANCH, D_MODEL, D_MODEL), D_MODEL ** -0.5),
        "b_gate": nrm(ks[25], (DEPTH, N_BRANCH, D_MODEL), 0.02),
        "w_out": nrm(ks[26], (DEPTH, D_MODEL, D_MODEL), D_MODEL ** -0.5),
        "w_up": nrm(ks[27], (DEPTH, D_MODEL, 2 * D_FF), D_MODEL ** -0.5),
        "conv_w": nrm(ks[28], (DEPTH, CONV_WIDTH, D_FF), CONV_WIDTH ** -0.5),
        "conv_b": nrm(ks[29], (DEPTH, D_FF), 0.02),
        "w_down": nrm(ks[30], (DEPTH, D_FF, D_MODEL), D_FF ** -0.5),
    }


def reference(x, c, positions, w_ada, b_ada, g_norm1, g_norm2, w_in, g_q, g_k, a_re, a_im,
              b_re, b_im, c_re, c_im, d_skip, log_dt, w_glu, w_pool, pool_scale, p_a, p_b, p_c,
              w_gate, b_gate, w_out, w_up, conv_w, conv_b, w_down):
    L = x.shape[1]
    n_topk = min(TOPK_MAX, L // 4)
    c_act = jax.nn.silu(c)
    for l in range(DEPTH):
        mod = c_act @ w_ada[l] + b_ada[l]
        sh1, sc1, gt1, sh2, sc2, gt2 = [m[:, None, :] for m in jnp.split(mod, 6, axis=-1)]
        h = rms_norm(x, g_norm1[l]) * (1.0 + sc1) + sh1
        mix = hybrid_mixer(h, positions, n_topk, w_in[l], g_q[l], g_k[l], a_re[l], a_im[l],
                           b_re[l], b_im[l], c_re[l], c_im[l], d_skip[l], log_dt[l], w_glu[l],
                           w_pool[l], pool_scale[l], p_a[l], p_b[l], p_c[l], w_gate[l],
                           b_gate[l], w_out[l])
        x = x + gt1 * mix
        h = rms_norm(x, g_norm2[l]) * (1.0 + sc2) + sh2
        x = x + gt2 * conv_ffn(h, w_up[l], conv_w[l], conv_b[l], w_down[l])
    return x
```

```cpp
#include <hip/hip_runtime.h>
#include <hip/hip_cooperative_groups.h>
#include <cstdio>
#include <cstdint>
namespace cg = cooperative_groups;

#ifndef MK_PER_PHASE
#define MK_PER_PHASE 0
#endif

typedef unsigned short bf16_t;
typedef short bf16x8 __attribute__((ext_vector_type(8)));
typedef float f32x4 __attribute__((ext_vector_type(4)));
typedef float f32x16 __attribute__((ext_vector_type(16)));
#define LAS __attribute__((address_space(3)))

constexpr int BATCH = 16, SEQ = 2048, DM = 2048, MROWS = BATCH * SEQ, DIN = 2888, DFF = 5504;
constexpr int N1 = 9216;
constexpr float EPS = 1e-6f;
constexpr int NPHASE = 21;

constexpr size_t MiB = 1u << 20;
constexpr size_t WS_MOD = 1 * MiB;
constexpr size_t WS_WI = 3 * MiB;
constexpr size_t WS_W = 4 * MiB;
constexpr size_t W_1CAT = WS_W, W_P = WS_W + 36 * MiB, W_OUT = WS_W + 44 * MiB, W_UP = WS_W + 52 * MiB, W_DOWN = WS_W + 95 * MiB,
                 W_GLU = WS_W + 116 * MiB + MiB / 2, W_POOL = WS_W + 117 * MiB;
constexpr size_t WS_R1 = 122 * MiB;
constexpr size_t WS_Y = WS_R1, WS_POOLED = WS_R1 + 32 * MiB;
constexpr size_t WS_R2 = 250 * MiB;
constexpr size_t WS_OCAT = 634 * MiB;
constexpr size_t WS_SA = WS_OCAT, WS_SB = WS_OCAT + 44 * MiB;
constexpr size_t WS_KN = 762 * MiB, WS_V = 770 * MiB, WS_QI = 778 * MiB, WS_KI = 810 * MiB, WS_U = 814 * MiB, WS_P = 846 * MiB, WS_END = 878 * MiB;
constexpr int LDS_BYTES = 147456;

__device__ __forceinline__ unsigned f2bf(float f) { unsigned u = __float_as_uint(f); return (u + 0x7fffu + ((u >> 16) & 1u)) >> 16; }
__device__ __forceinline__ unsigned pk2(float lo, float hi) { return f2bf(lo) | (f2bf(hi) << 16); }
__device__ __forceinline__ float bflo(unsigned u) { return __uint_as_float(u << 16); }
__device__ __forceinline__ float bfhi(unsigned u) { return __uint_as_float(u & 0xffff0000u); }
__device__ __forceinline__ float bf1(bf16_t b) { return __uint_as_float(((unsigned)b) << 16); }
__device__ __forceinline__ float sigmoidf_(float x) { return 1.f / (1.f + __expf(-x)); }
__device__ __forceinline__ float siluf_(float x) { return x / (1.f + __expf(-x)); }
__device__ __forceinline__ float gelu_tanh(float x) { const float z = 0.7978845608028654f * (x + 0.044715f * x * x * x); const float t = 1.f - 2.f / (1.f + __expf(2.f * z)); return 0.5f * x * (1.f + t); }
__device__ __forceinline__ uint4 pack8(f32x4 a, f32x4 b) { uint4 r; r.x = pk2(a[0], a[1]); r.y = pk2(a[2], a[3]); r.z = pk2(b[0], b[1]); r.w = pk2(b[2], b[3]); return r; }
__device__ __forceinline__ void unpack8(uint4 v, float* f) { f[0] = bflo(v.x); f[1] = bfhi(v.x); f[2] = bflo(v.y); f[3] = bfhi(v.y); f[4] = bflo(v.z); f[5] = bfhi(v.z); f[6] = bflo(v.w); f[7] = bfhi(v.w); }
#define LDS_FENCE() asm volatile("s_waitcnt lgkmcnt(0)" ::: "memory")

namespace pg8 {
constexpr int BM = 256, BK = 64, HALF = 128, HTB = HALF * BK * 2, STAGE_BYTES = 8 * HTB, NXCD = 8, WGM = 8;
__host__ __device__ __forceinline__ int lds_byte(int r, int c) { const int st = (r >> 4) * 2 + (c >> 5), rr = r & 15, cc = c & 31, ob = rr * 64 + cc * 2; return st * 1024 + (ob ^ (((ob >> 9) & 1) << 5)); }
__host__ __device__ __forceinline__ void stage_rc(int b, int& R, int& C) { const int st = b / 1024, sb = b % 1024, swz = sb ^ (((sb >> 9) & 1) << 5); R = (st >> 1) * 16 + swz / 64; C = (st & 1) * 32 + (swz % 64) / 2; }
__host__ __device__ __forceinline__ int perm32(int rho) { const int n = rho >> 4, i = rho & 15; return 8 * (i >> 2) + 4 * n + (i & 3); }
struct Unit { int pm, pn; };
struct Gemm { const bf16_t* A; const bf16_t* Bt; int M, N, K, lda, ldb; int asplit; size_t aoff; };
struct StaticOrder {
    int nM, nN, nwg, G, c;
    __device__ void init(int M, int N, int G_, int c_) { nM = M / BM; nN = N / BM; nwg = nM * nN; G = G_; c = c_; }
    __device__ bool next(int i, Unit& u) const {
        const long L = (long)i * G + c; if (L >= nwg) return false;
        int wgid = (int)L; { const int q = nwg / NXCD, r = nwg % NXCD, xcd = wgid % NXCD, off = wgid / NXCD; wgid = (xcd < r ? xcd * (q + 1) : r * (q + 1) + (xcd - r) * q) + off; }
        const int nig = WGM * nN, gid = wgid / nig, fm = gid * WGM, gsz = (nM - fm) < WGM ? (nM - fm) : WGM;
        u.pm = fm + ((wgid % nig) % gsz); u.pn = (wgid % nig) / gsz; return true;
    }
};
template <class Epi, class Sched>
__device__ __forceinline__ void gemm_phase(LAS unsigned char* lds, const Gemm g, const Sched& S, const Epi& E, const int TI) {
    const int tid = TI, wid = __builtin_amdgcn_readfirstlane(tid >> 6), lane = tid & 63, wr = wid >> 2, wc = wid & 3, fr = lane & 15, fq = lane >> 4;
    const int K = g.K, nt = K / BK;
    unsigned voffA[2], voffB[2];
#pragma unroll
    for (int i = 0; i < 2; ++i) { int R, C; stage_rc(tid * 16 + i * 8192, R, C); const int Rb = Epi::PERM ? ((R & ~31) + perm32(R & 31)) : R;
        voffA[i] = (unsigned)(R * g.lda + C) * 2u; voffB[i] = (unsigned)(Rb * g.ldb + C) * 2u; }
    const size_t kstep = (size_t)(BK * 2);
    const size_t hstepA = (size_t)HALF * g.lda * 2, hstepB = (size_t)HALF * g.ldb * 2;
    const size_t tstepA = 2 * hstepA, tstepB = 2 * hstepB;
    const unsigned ldsw = (unsigned)wid * 1024u;
    const int aoff = lds_byte(wr * 64 + fr, fq * 8), boff = lds_byte(wc * 32 + fr, fq * 8);
#define PG8_SA(b, h) (((b) * 2 + (h)) * HTB)
#define PG8_SB(b, h) ((4 + (b) * 2 + (h)) * HTB)
#define PG8_STAGE(bufoff, gbase, voff) do { _Pragma("unroll") for (int _i = 0; _i < 2; ++_i) \
        __builtin_amdgcn_global_load_lds((const unsigned*)((const char*)(gbase) + (voff)[_i]), (LAS unsigned*)(lds + (bufoff) + ldsw + _i * 8192), 16, 0, 0); } while (0)
#define PG8_LDA(dst, b, h) do { _Pragma("unroll") for (int m = 0; m < 4; ++m) _Pragma("unroll") for (int k = 0; k < 2; ++k) dst[m][k] = *(const LAS bf16x8*)(lds + PG8_SA(b, h) + aoff + m * 2048 + k * 1024); } while (0)
#define PG8_LDB(dst, b, h) do { _Pragma("unroll") for (int n = 0; n < 2; ++n) _Pragma("unroll") for (int k = 0; k < 2; ++k) dst[n][k] = *(const LAS bf16x8*)(lds + PG8_SB(b, h) + boff + n * 2048 + k * 1024); } while (0)
#define PG8_MMA(ai, bj, At, Bt) do { __builtin_amdgcn_s_setprio(1); _Pragma("unroll") for (int m = 0; m < 4; ++m) _Pragma("unroll") for (int n = 0; n < 2; ++n) _Pragma("unroll") for (int k = 0; k < 2; ++k) \
        acc[ai][bj][m][n] = __builtin_amdgcn_mfma_f32_16x16x32_bf16(Bt[n][k], At[m][k], acc[ai][bj][m][n], 0, 0, 0); __builtin_amdgcn_s_setprio(0); } while (0)
#define PG8_WAIT_V(n) asm volatile("s_waitcnt vmcnt(" #n ")" ::: "memory")
#define PG8_WAIT_L(n) asm volatile("s_waitcnt lgkmcnt(" #n ")" ::: "memory")
#define PG8_BAR __builtin_amdgcn_s_barrier()
#define PG8_SCHED __builtin_amdgcn_sched_barrier(0)
#define PG8_ZERO() do { _Pragma("unroll") for (int a_ = 0; a_ < 2; ++a_) _Pragma("unroll") for (int b_ = 0; b_ < 2; ++b_) _Pragma("unroll") for (int m_ = 0; m_ < 4; ++m_) _Pragma("unroll") for (int n_ = 0; n_ < 2; ++n_) acc[a_][b_][m_][n_] = (f32x4){0.f, 0.f, 0.f, 0.f}; } while (0)
    Unit cur, nxt; int ui = 0;
    if (!S.next(0, cur)) return;
    f32x4 acc[2][2][4][2];
    PG8_ZERO();
    bf16x8 At[4][2], B0[2][2], B1[2][2];
    const char* cA = (const char*)g.A + (size_t)cur.pm * tstepA + (cur.pn >= g.asplit ? g.aoff : (size_t)0); const char* cB = (const char*)g.Bt + (size_t)cur.pn * tstepB;
    PG8_STAGE(PG8_SB(0, 0), cB, voffB); PG8_STAGE(PG8_SA(0, 0), cA, voffA); PG8_STAGE(PG8_SB(0, 1), cB + hstepB, voffB); PG8_STAGE(PG8_SA(0, 1), cA + hstepA, voffA);
    if (wr == 1) PG8_BAR;
    PG8_WAIT_V(4); PG8_BAR;
    PG8_STAGE(PG8_SB(1, 0), cB + kstep, voffB); PG8_STAGE(PG8_SA(1, 0), cA + kstep, voffA); PG8_STAGE(PG8_SB(1, 1), cB + hstepB + kstep, voffB);
    PG8_WAIT_V(6); PG8_BAR;
    for (;;) {
        const bool has_next = S.next(ui + 1, nxt);
        const char* nA = has_next ? (const char*)g.A + (size_t)nxt.pm * tstepA + (nxt.pn >= g.asplit ? g.aoff : (size_t)0) : cA; const char* nB = has_next ? (const char*)g.Bt + (size_t)nxt.pn * tstepB : cB;
        for (int t = 0; t < nt; t += 2) {
            const bool last = (t == nt - 2);
            const char* a1 = cA + (size_t)(t + 1) * kstep;
            const char* a2 = last ? nA : cA + (size_t)(t + 2) * kstep; const char* b2 = last ? nB : cB + (size_t)(t + 2) * kstep;
            const char* a3 = a2 + kstep; const char* b3 = b2 + kstep;
            PG8_LDB(B0, 0, 0); PG8_SCHED; PG8_LDA(At, 0, 0); PG8_STAGE(PG8_SA(1, 1), a1 + hstepA, voffA);
            PG8_WAIT_L(8); PG8_BAR; PG8_WAIT_L(0); PG8_MMA(0, 0, At, B0); PG8_BAR; PG8_SCHED;
            PG8_LDB(B1, 0, 1); PG8_STAGE(PG8_SB(0, 0), b2, voffB);
            PG8_BAR; PG8_WAIT_L(0); PG8_MMA(0, 1, At, B1); PG8_BAR;
            PG8_LDA(At, 0, 1); PG8_STAGE(PG8_SA(0, 0), a2, voffA);
            PG8_BAR; PG8_WAIT_L(0); PG8_MMA(1, 0, At, B0); PG8_BAR; PG8_SCHED;
            PG8_STAGE(PG8_SB(0, 1), b2 + hstepB, voffB);
            PG8_WAIT_V(6); PG8_BAR; PG8_MMA(1, 1, At, B1); PG8_BAR;
            PG8_LDB(B0, 1, 0); PG8_SCHED; PG8_LDA(At, 1, 0); PG8_STAGE(PG8_SA(0, 1), a2 + hstepA, voffA);
            PG8_WAIT_L(8); PG8_BAR; PG8_WAIT_L(0); PG8_MMA(0, 0, At, B0); PG8_BAR; PG8_SCHED;
            PG8_LDB(B1, 1, 1); PG8_STAGE(PG8_SB(1, 0), b3, voffB);
            PG8_BAR; PG8_WAIT_L(0); PG8_MMA(0, 1, At, B1); PG8_BAR;
            PG8_LDA(At, 1, 1); PG8_STAGE(PG8_SA(1, 0), a3, voffA);
            PG8_BAR; PG8_WAIT_L(0); PG8_MMA(1, 0, At, B0); PG8_BAR; PG8_SCHED;
            PG8_STAGE(PG8_SB(1, 1), b3 + hstepB, voffB);
            PG8_WAIT_V(6); PG8_BAR; PG8_MMA(1, 1, At, B1); PG8_BAR;
            if constexpr (Epi::SEG) { if (t + 2 == 16 || t + 2 == 24) { E.flush(acc, cur, (t + 2 == 16) ? 0 : 1, wr, wc, fr, fq); PG8_ZERO(); } }
        }
        if constexpr (Epi::SEG) E.flush(acc, cur, 2, wr, wc, fr, fq); else E(acc, cur, wr, wc, fr, fq);
        if (!has_next) break;
        PG8_ZERO();
        cur = nxt; cA = nA; cB = nB; ++ui;
    }
    PG8_WAIT_V(0);
    if (wr == 0) PG8_BAR;
    PG8_BAR;
#undef PG8_SA
#undef PG8_SB
#undef PG8_STAGE
#undef PG8_LDA
#undef PG8_LDB
#undef PG8_MMA
#undef PG8_WAIT_V
#undef PG8_WAIT_L
#undef PG8_BAR
#undef PG8_SCHED
#undef PG8_ZERO
}
}
using pg8::Unit;
typedef const f32x4 (&AccRef)[2][2][4][2];

struct Epi1 {
    static constexpr bool PERM = true, SEG = false;
    bf16_t *ocat, *kn, *vv, *qi, *ki, *u, *p, *gates; float* wi; const float* bgate;
    __device__ __forceinline__ void operator()(AccRef acc, const Unit& un, int wr, int wc, int fr, int fq) const {
        asm volatile("" : "+v"(fr), "+v"(fq));
        const int pn = un.pn, row0 = un.pm * 256 + wr * 64 + fr;
#pragma unroll
        for (int bj = 0; bj < 2; ++bj) {
            const int cit = bj * 128 + wc * 32 + 8 * fq;
            bf16_t* base; int ld; int mode = 0;
            if (pn < 4) { base = ocat + pn * 256 + cit; ld = 2048; }
            else if (pn == 4) { base = (bj == 0 ? kn : vv) + (cit & 127); ld = 128; }
            else if (pn < 7) { base = qi + (pn - 5) * 256 + cit; ld = 512; }
            else if (pn == 7) { base = ki + cit; ld = 64; mode = (cit < 64) ? 0 : ((cit == 64) ? 2 : 3); }
            else if (pn < 10) { base = u + (pn - 8) * 256 + cit; ld = 512; }
            else if (pn < 12) { base = p + (pn - 10) * 256 + cit; ld = 512; }
            else { base = gates + (pn - 12) * 256 + cit; ld = 6144; mode = 1; }
            f32x4 b0 = {0.f, 0.f, 0.f, 0.f}, b1 = {0.f, 0.f, 0.f, 0.f};
            if (mode == 1) { b0 = *(const f32x4*)(bgate + (pn - 12) * 256 + cit); b1 = *(const f32x4*)(bgate + (pn - 12) * 256 + cit + 4); }
#pragma unroll
            for (int ai = 0; ai < 2; ++ai)
#pragma unroll
                for (int m = 0; m < 4; ++m) {
                    const size_t row = (size_t)(row0 + ai * 128 + m * 16);
                    f32x4 v0 = acc[ai][bj][m][0], v1 = acc[ai][bj][m][1];
                    if (mode == 1) {
#pragma unroll
                        for (int e = 0; e < 4; ++e) { v0[e] = sigmoidf_(v0[e] + b0[e]); v1[e] = sigmoidf_(v1[e] + b1[e]); }
                    }
                    if (mode == 2) {
                        const float s = 0.35355339059327373f * 0.125f;
                        *(f32x4*)(wi + row * 8) = v0 * s; *(f32x4*)(wi + row * 8 + 4) = v1 * s;
                    } else if (mode != 3) {
                        *(uint4*)(base + row * ld) = pack8(v0, v1);
                    }
                    asm volatile("" ::: "memory");
                }
        }
    }
};
struct EpiGluPool {
    static constexpr bool PERM = true, SEG = false;
    const bf16_t* y; const float* scale; bf16_t* ocat;
    __device__ __forceinline__ void operator()(AccRef acc, const Unit& un, int wr, int wc, int fr, int fq) const {
        asm volatile("" : "+v"(fr), "+v"(fq));
        const int row0 = un.pm * 256 + wr * 64 + fr; const bool glu = un.pn < 2;
#pragma unroll
        for (int bj = 0; bj < 2; ++bj) { const int col = (un.pn & 1) * 256 + bj * 128 + wc * 32 + 8 * fq;
            f32x4 s0 = {0.f, 0.f, 0.f, 0.f}, s1 = {0.f, 0.f, 0.f, 0.f};
            if (!glu) { s0 = *(const f32x4*)(scale + col); s1 = *(const f32x4*)(scale + col + 4); }
#pragma unroll
            for (int ai = 0; ai < 2; ++ai)
#pragma unroll
                for (int m = 0; m < 4; ++m) { const size_t row = (size_t)(row0 + ai * 128 + m * 16);
                    f32x4 v0 = acc[ai][bj][m][0], v1 = acc[ai][bj][m][1];
                    if (glu) { float yv[8]; unpack8(*(const uint4*)(y + row * 512 + col), yv);
#pragma unroll
                        for (int e = 0; e < 4; ++e) { v0[e] = yv[e] * sigmoidf_(v0[e]); v1[e] = yv[4 + e] * sigmoidf_(v1[e]); }
                        *(uint4*)(ocat + row * 2048 + 1024 + col) = pack8(v0, v1);
                    } else *(uint4*)(ocat + row * 2048 + 1536 + col) = pack8(v0 * s0, v1 * s1);
                    asm volatile("" ::: "memory"); } }
    }
};
struct EpiMerge {
    static constexpr bool PERM = true, SEG = true;
    const bf16_t* gates; bf16_t* merged;
    __device__ __forceinline__ void flush(AccRef acc, const Unit& un, int seg, int wr, int wc, int fr, int fq) const {
        asm volatile("" : "+v"(fr), "+v"(fq));
        const int row0 = un.pm * 256 + wr * 64 + fr;
#pragma unroll
        for (int bj = 0; bj < 2; ++bj) { const int col = un.pn * 256 + bj * 128 + wc * 32 + 8 * fq;
#pragma unroll
            for (int ai = 0; ai < 2; ++ai)
#pragma unroll
                for (int m = 0; m < 4; ++m) { const size_t row = (size_t)(row0 + ai * 128 + m * 16);
                    float gv[8]; unpack8(*(const uint4*)(gates + row * 6144 + seg * 2048 + col), gv);
                    float pv[8];
                    if (seg > 0) unpack8(*(const uint4*)(merged + row * 2048 + col), pv);
                    else {
#pragma unroll
                        for (int e = 0; e < 8; ++e) pv[e] = 0.f; }
                    f32x4 v0 = acc[ai][bj][m][0], v1 = acc[ai][bj][m][1];
#pragma unroll
                    for (int e = 0; e < 4; ++e) { v0[e] = pv[e] + gv[e] * v0[e]; v1[e] = pv[4 + e] + gv[4 + e] * v1[e]; }
                    *(uint4*)(merged + row * 2048 + col) = pack8(v0, v1); asm volatile("" ::: "memory"); } }
    }
};
struct EpiRes {
    static constexpr bool PERM = false, SEG = false;
    const float* xin; float* out; const float* gt;
    __device__ __forceinline__ void operator()(AccRef acc, const Unit& un, int wr, int wc, int fr, int fq) const {
        asm volatile("" : "+v"(fr), "+v"(fq));
        const int row0 = un.pm * 256 + wr * 64 + fr; const float* g = gt + (size_t)(un.pm >> 3) * 12288;
#pragma unroll
        for (int bj = 0; bj < 2; ++bj)
#pragma unroll
            for (int n = 0; n < 2; ++n) { const int col = un.pn * 256 + bj * 128 + wc * 32 + 16 * n + 4 * fq;
                const f32x4 gv = *(const f32x4*)(g + col);
#pragma unroll
                for (int ai = 0; ai < 2; ++ai)
#pragma unroll
                    for (int m = 0; m < 4; ++m) { const size_t o = (size_t)(row0 + ai * 128 + m * 16) * 2048 + col;
                        const f32x4 xv = *(const f32x4*)(xin + o);
                        *(f32x4*)(out + o) = xv + gv * acc[ai][bj][m][n]; asm volatile("" ::: "memory"); } }
    }
};
struct EpiUp {
    static constexpr bool PERM = true, SEG = false;
    bf16_t* act; float* SA; float* SB; const float* cw; const float* cb;
    __device__ __forceinline__ void operator()(AccRef acc, const Unit& un, int wr, int wc, int fr, int fq) const {
        asm volatile("" : "+v"(fr), "+v"(fq));
        const int lg = fq << 4;
        const int src1 = lg | ((fr + 15) & 15), src2 = lg | ((fr + 14) & 15);
#pragma unroll
        for (int n = 0; n < 2; ++n) {
            const int ch0 = un.pn * 128 + wc * 32 + 8 * fq + 4 * n;
            const f32x4 w0 = *(const f32x4*)(cw + ch0), w1 = *(const f32x4*)(cw + DFF + ch0), w2 = *(const f32x4*)(cw + 2 * DFF + ch0), bb = *(const f32x4*)(cb + ch0);
#pragma unroll
            for (int ai = 0; ai < 2; ++ai) {
                const int rowb = un.pm * 256 + ai * 128 + wr * 64; const int blk = rowb >> 6;
#pragma unroll
                for (int m = 0; m < 4; ++m) {
                    f32x4 res;
#pragma unroll
                    for (int e = 0; e < 4; ++e) {
                        const float cur = acc[ai][0][m][n][e];
                        const float prv = (m > 0) ? acc[ai][0][m > 0 ? m - 1 : 0][n][e] : 0.f;
                        const float p1 = __shfl((fr + 1 >= 16) ? prv : cur, src1);
                        const float p2 = __shfl((fr + 2 >= 16) ? prv : cur, src2);
                        const float cv = bb[e] + w0[e] * p2 + w1[e] * p1 + w2[e] * cur;
                        res[e] = siluf_(cv) * acc[ai][1][m][n][e];
                    }
                    const size_t row = (size_t)(rowb + m * 16 + fr);
                    if (m == 0 && fr < 2) {
                        *(f32x4*)(SA + ((size_t)(blk * 4 + 2 + fr)) * DFF + ch0) = acc[ai][0][0][n];
                        *(f32x4*)(SB + ((size_t)(blk * 2 + fr)) * DFF + ch0) = acc[ai][1][0][n];
                    } else {
                        uint2 o; o.x = pk2(res[0], res[1]); o.y = pk2(res[2], res[3]);
                        *(uint2*)(act + row * DFF + ch0) = o;
                    }
                    if (m == 3 && fr >= 14) *(f32x4*)(SA + ((size_t)(blk * 4 + (fr - 14))) * DFF + ch0) = acc[ai][0][3][n];
                    asm volatile("" ::: "memory");
                }
            }
        }
    }
};

struct Args { const float* in[31]; float* out; unsigned char* ws; int ph_lo, ph_hi; };
enum { I_X = 0, I_C, I_POS, I_WADA, I_BADA, I_GN1, I_GN2, I_WIN, I_GQ, I_GK, I_ARE, I_AIM, I_BRE, I_BIM, I_CRE, I_CIM, I_DSKIP, I_LOGDT, I_WGLU, I_WPOOL, I_PSCALE, I_PA, I_PB, I_PC, I_WGATE, I_BGATE, I_WOUT, I_WUP, I_CONVW, I_CONVB, I_WDOWN };

__device__ __forceinline__ float wave_sum(float v) {
#pragma unroll
    for (int o = 32; o > 0; o >>= 1) v += __shfl_xor(v, o);
    return v;
}

__device__ __forceinline__ void phase_ada(const Args& a, unsigned char* lds, const int TI) {
    const int tid = TI;
    float* cact = (float*)lds;
    float* mod = (float*)(a.ws + WS_MOD);
    for (int w = blockIdx.x; w < 256; w += gridDim.x) {
        for (int i = tid; i < 16 * 2048; i += 512) { const int b = i >> 11, k = i & 2047; const float v = a.in[I_C][i]; cact[k * 16 + b] = siluf_(v); }
        __syncthreads();
        const int l = w >> 7, n0 = (w & 127) * 96;
        float acc[16][4];
#pragma unroll
        for (int b = 0; b < 16; ++b)
#pragma unroll
            for (int j = 0; j < 4; ++j) acc[b][j] = 0.f;
        const int cg4 = tid % 24, ks = tid / 24;
        if (tid < 384) {
            const float* wp = a.in[I_WADA] + ((size_t)l * 2048 + ks * 128) * 12288 + n0 + cg4 * 4;
#pragma unroll 4
            for (int k = 0; k < 128; ++k) {
                const f32x4 wv = *(const f32x4*)(wp + (size_t)k * 12288);
                const f32x4* cp = (const f32x4*)(cact + (ks * 128 + k) * 16);
#pragma unroll
                for (int q = 0; q < 4; ++q) { const f32x4 cv = cp[q];
#pragma unroll
                    for (int e = 0; e < 4; ++e)
#pragma unroll
                        for (int j = 0; j < 4; ++j) acc[q * 4 + e][j] += cv[e] * wv[j]; }
            }
        }
        __syncthreads();
        float* part = (float*)lds;
        if (tid < 384) {
#pragma unroll
            for (int b = 0; b < 16; ++b)
#pragma unroll
                for (int j = 0; j < 4; ++j) part[(ks * 16 + b) * 96 + cg4 * 4 + j] = acc[b][j];
        }
        __syncthreads();
        for (int o = tid; o < 1536; o += 512) { const int b = o / 96, cc = o % 96; float s = 0.f;
#pragma unroll
            for (int k2 = 0; k2 < 16; ++k2) s += part[(k2 * 16 + b) * 96 + cc];
            mod[((size_t)l * 16 + b) * 12288 + n0 + cc] = s + a.in[I_BADA][l * 12288 + n0 + cc]; }
        __syncthreads();
    }
}

__device__ __forceinline__ void cvt_tile(const float* src, int ldS, int cbase, int cend, int kbase, bf16_t* dst, int ldD, int mode, int r0, int cs0, int kd0, float* T, const int TI) {
    const int tid = TI, ty = tid >> 4, tx = tid & 15;
#pragma unroll
    for (int ps = 0; ps < 2; ++ps) { const int k = ty + ps * 32, c = cbase + tx * 4;
        f32x4 v = {0.f, 0.f, 0.f, 0.f};
        if (c < cend) v = *(const f32x4*)(src + (size_t)(kbase + k) * ldS + c);
        float* tp = T + k * 65 + tx * 4; tp[0] = v[0]; tp[1] = v[1]; tp[2] = v[2]; tp[3] = v[3]; }
    __syncthreads();
    const int n = tid >> 3, kq = tid & 7, c = cbase + n;
    if (c < cend) {
        float f[8];
#pragma unroll
        for (int j = 0; j < 8; ++j) f[j] = T[(kq * 8 + j) * 65 + n];
        int row;
        if (mode == 0) row = r0 + (c - cs0);
        else { const int bj = c >= DFF ? 1 : 0, ch = c - bj * DFF; row = (ch >> 7) * 256 + bj * 128 + (ch & 127); }
        uint4 o; o.x = pk2(f[0], f[1]); o.y = pk2(f[2], f[3]); o.z = pk2(f[4], f[5]); o.w = pk2(f[6], f[7]);
        *(uint4*)(dst + (size_t)row * ldD + kd0 + kbase + kq * 8) = o;
    }
    __syncthreads();
}
__device__ __forceinline__ void phase_cvt(const Args& a, int l, unsigned char* lds, const int TI) {
    float* T = (float*)lds;
    unsigned char* ws = a.ws;
    for (int t = blockIdx.x; t < 14912; t += gridDim.x) {
        const float* src; int ldS, cs0, ncols, nkt, ldD, mode = 0, r0 = 0, kd0 = 0, idx; bf16_t* dst;
        if (t < 960) { idx = t; src = a.in[I_WIN] + (size_t)l * DM * DIN; ldS = DIN; cs0 = 0; ncols = 1864; nkt = 32; dst = (bf16_t*)(ws + W_1CAT); ldD = 2048; r0 = 0; }
        else if (t < 1472) { idx = t - 960; src = a.in[I_WIN] + (size_t)l * DM * DIN; ldS = DIN; cs0 = 1864; ncols = 1024; nkt = 32; dst = (bf16_t*)(ws + W_1CAT); ldD = 2048; r0 = 2048; }
        else if (t < 4544) { idx = t - 1472; const int gi = idx >> 10; idx &= 1023; src = a.in[I_WGATE] + ((size_t)l * 3 + gi) * DM * DM; ldS = DM; cs0 = 0; ncols = 2048; nkt = 32; dst = (bf16_t*)(ws + W_1CAT); ldD = 2048; r0 = 3072 + 2048 * gi; }
        else if (t < 5056) { idx = t - 4544; src = a.in[I_PA] + (size_t)l * 1024 * DM; ldS = DM; cs0 = 0; ncols = 2048; nkt = 16; dst = (bf16_t*)(ws + W_P); ldD = 2048; kd0 = 0; }
        else if (t < 5312) { idx = t - 5056; src = a.in[I_PB] + (size_t)l * 512 * DM; ldS = DM; cs0 = 0; ncols = 2048; nkt = 8; dst = (bf16_t*)(ws + W_P); ldD = 2048; kd0 = 1024; }
        else if (t < 5568) { idx = t - 5312; src = a.in[I_PC] + (size_t)l * 512 * DM; ldS = DM; cs0 = 0; ncols = 2048; nkt = 8; dst = (bf16_t*)(ws + W_P); ldD = 2048; kd0 = 1536; }
        else if (t < 6592) { idx = t - 5568; src = a.in[I_WOUT] + (size_t)l * DM * DM; ldS = DM; cs0 = 0; ncols = 2048; nkt = 32; dst = (bf16_t*)(ws + W_OUT); ldD = 2048; }
        else if (t < 12096) { idx = t - 6592; src = a.in[I_WUP] + (size_t)l * DM * 2 * DFF; ldS = 2 * DFF; cs0 = 0; ncols = 2 * DFF; nkt = 32; dst = (bf16_t*)(ws + W_UP); ldD = 2048; mode = 1; }
        else if (t < 14848) { idx = t - 12096; src = a.in[I_WDOWN] + (size_t)l * DFF * DM; ldS = DM; cs0 = 0; ncols = 2048; nkt = 86; dst = (bf16_t*)(ws + W_DOWN); ldD = DFF; }
        else { idx = t - 14848; src = a.in[I_WGLU] + (size_t)l * 512 * 512; ldS = 512; cs0 = 0; ncols = 512; nkt = 8; dst = (bf16_t*)(ws + W_GLU); ldD = 512; }
        const int tn = idx / nkt, tk = idx - tn * nkt;
        cvt_tile(src, ldS, cs0 + tn * 64, cs0 + ncols, tk * 64, dst, ldD, mode, r0, cs0, kd0, T, TI);
    }
    bf16_t* wp = (bf16_t*)(ws + W_POOL); const float* wsrc = a.in[I_WPOOL] + (size_t)l * 4 * 128 * 128;
    for (int i = blockIdx.x * 512 + TI; i < 512 * 512; i += gridDim.x * 512) { const int n = i >> 9, k = i & 511, g = n >> 7;
        const float v = ((k >> 7) == g) ? wsrc[(g * 128 + (k & 127)) * 128 + (n & 127)] : 0.f; wp[i] = (bf16_t)f2bf(v); }
}

__device__ __forceinline__ void phase_norm(const float* xin, const float* g, const float* modl, int shoff, int scoff, bf16_t* out, const int TI) {
    const int lane = TI & 63, wave = TI >> 6;
    for (int r = blockIdx.x * 8 + wave; r < MROWS; r += gridDim.x * 8) {
        const f32x4* xp = (const f32x4*)(xin + (size_t)r * DM); f32x4 v[8]; float ssq = 0.f;
#pragma unroll
        for (int j = 0; j < 8; ++j) { v[j] = xp[j * 64 + lane]; ssq += v[j][0] * v[j][0] + v[j][1] * v[j][1] + v[j][2] * v[j][2] + v[j][3] * v[j][3]; }
        ssq = wave_sum(ssq);
        const float rinv = rsqrtf(ssq * (1.f / DM) + EPS);
        const float* mb = modl + (size_t)(r >> 11) * 12288;
#pragma unroll
        for (int j = 0; j < 8; ++j) { const int col = j * 256 + lane * 4;
            const f32x4 g4 = *(const f32x4*)(g + col), sc = *(const f32x4*)(mb + scoff + col), sh = *(const f32x4*)(mb + shoff + col);
            f32x4 y;
#pragma unroll
            for (int e = 0; e < 4; ++e) y[e] = (v[j][e] * rinv * g4[e]) * (1.f + sc[e]) + sh[e];
            uint2 o; o.x = pk2(y[0], y[1]); o.y = pk2(y[2], y[3]);
            *(uint2*)(out + (size_t)r * DM + col) = o; }
    }
}

__constant__ double kRevPerPos[24] = {0.15915494309189535, 0.0700865215877985, 0.03086376340470123, 0.013591370636193905, 0.005985185712713705, 0.002635675898667414, 0.001160663641240061, 0.0005111175045375439, 0.00022507907903927653, 9.911730936901935e-05, 4.364795279280289e-05, 1.9221100684944863e-05, 8.464330808241401e-06, 3.727408601915352e-06, 1.6414262627950345e-06, 7.228293068832865e-07, 0.15915494309189535, 0.03086376340470123, 0.005985185712713705, 0.001160663641240061, 0.00022507907903927653, 4.364795279280289e-05, 8.464330808241401e-06, 1.6414262627950345e-06};
__device__ __forceinline__ void rmsrope128(bf16_t* p, bool active, const float* g16, int sub, const float* cs) {
    float v[16];
    if (active) { unpack8(*(const uint4*)p, v); unpack8(*(const uint4*)(p + 8), v + 8); }
    else {
#pragma unroll
        for (int i = 0; i < 16; ++i) v[i] = 0.f; }
    float ssq = 0.f;
#pragma unroll
    for (int i = 0; i < 16; ++i) ssq += v[i] * v[i];
    ssq += __shfl_xor(ssq, 1); ssq += __shfl_xor(ssq, 2); ssq += __shfl_xor(ssq, 4);
    const float rinv = rsqrtf(ssq * (1.f / 128.f) + EPS);
#pragma unroll
    for (int i = 0; i < 16; ++i) v[i] = v[i] * rinv * g16[i];
#pragma unroll
    for (int i = 0; i < 16; ++i) { const float o = __shfl_xor(v[i], 1); const float c = cs[2 * i], s = cs[2 * i + 1];
        if (sub == 0) v[i] = v[i] * c - o * s; else if (sub == 1) v[i] = v[i] * c + o * s; }
    if (active) { uint4 o0, o1; o0.x = pk2(v[0], v[1]); o0.y = pk2(v[2], v[3]); o0.z = pk2(v[4], v[5]); o0.w = pk2(v[6], v[7]);
        o1.x = pk2(v[8], v[9]); o1.y = pk2(v[10], v[11]); o1.z = pk2(v[12], v[13]); o1.w = pk2(v[14], v[15]);
        *(uint4*)p = o0; *(uint4*)(p + 8) = o1; }
}
__device__ __forceinline__ void rope64(bf16_t* p, bool active, int sub, const float* cs) {
    float v[8];
    if (active) unpack8(*(const uint4*)p, v);
    else {
#pragma unroll
        for (int i = 0; i < 8; ++i) v[i] = 0.f; }
#pragma unroll
    for (int i = 0; i < 8; ++i) { const float o = __shfl_xor(v[i], 1); const float c = cs[2 * i], s = cs[2 * i + 1];
        if (sub == 0) v[i] = v[i] * c - o * s; else if (sub == 1) v[i] = v[i] * c + o * s; }
    if (active) { uint4 o0; o0.x = pk2(v[0], v[1]); o0.y = pk2(v[2], v[3]); o0.z = pk2(v[4], v[5]); o0.w = pk2(v[6], v[7]); *(uint4*)p = o0; }
}
__device__ __forceinline__ void phase_post(const Args& a, int l, unsigned char* lds, const int TI) {
    const int lane = TI & 63, wave = TI >> 6;
    float* cs = (float*)lds + wave * 64;
    bf16_t* ocat = (bf16_t*)(a.ws + WS_OCAT); bf16_t* kn = (bf16_t*)(a.ws + WS_KN); bf16_t* qi = (bf16_t*)(a.ws + WS_QI); bf16_t* ki = (bf16_t*)(a.ws + WS_KI);
    const int* pos = (const int*)a.in[I_POS];
    const int sub = lane & 7, hd = lane >> 3;
    float gq[16], gk[16];
#pragma unroll
    for (int i = 0; i < 16; ++i) { gq[i] = a.in[I_GQ][l * 128 + sub * 16 + i]; gk[i] = a.in[I_GK][l * 128 + sub * 16 + i]; }
    for (int r = blockIdx.x * 8 + wave; r < MROWS; r += gridDim.x * 8) {
        const int ps = pos[r];
        if (lane < 24) {
            double rev = (double)ps * kRevPerPos[lane]; rev -= rint(rev); const float fr = (float)rev;
            cs[lane * 2] = __builtin_amdgcn_cosf(fr); cs[lane * 2 + 1] = __builtin_amdgcn_sinf(fr); }
        LDS_FENCE();
        rmsrope128(ocat + (size_t)r * 2048 + hd * 128 + sub * 16, true, gq, sub, cs);
        rmsrope128(kn + (size_t)r * 128 + sub * 16, lane < 8, gk, sub, cs);
        rope64(qi + (size_t)r * 512 + hd * 64 + sub * 8, true, sub, cs + 32);
        rope64(ki + (size_t)r * 64 + sub * 8, lane < 8, sub, cs + 32);
        LDS_FENCE();
    }
}

__device__ __forceinline__ void s5_unit(const Args& a, int l, int b, int g, unsigned char* lds, const int TI) {
    const int lane = TI & 63, wave = TI >> 6, p = lane;
    float* E = (float*)lds;
    float* ust = (float*)(lds + 16384 + wave * 4096);
    bf16_t* sst = (bf16_t*)(lds + 49152 + wave * 4352);
    const bf16_t* U = (const bf16_t*)(a.ws + WS_U); bf16_t* Y = (bf16_t*)(a.ws + WS_Y);
    const int gp = (l * 32 + g) * 64 + p;
    const float are = a.in[I_ARE][gp], aim = a.in[I_AIM][gp], dt = expf(a.in[I_LOGDT][l * 32 + g]);
    const float mag = expf(are * dt);
    float ang = aim * dt; { const float n = rintf(ang * 0.15915494309189535f); ang = fmaf(-n, 6.28318548202514648f, ang); ang = fmaf(n, 1.7484555e-7f, ang); }
    const float lre = mag * cosf(ang), lim = mag * sinf(ang);
    float Bre[16], Bim[16];
    { const float nr = lre - 1.f, ni = lim, den = 1.f / (are * are + aim * aim); const float cr = (nr * are + ni * aim) * den, ci = (ni * are - nr * aim) * den;
#pragma unroll
        for (int j = 0; j < 16; ++j) { const float br = a.in[I_BRE][(size_t)gp * 16 + j], bi = a.in[I_BIM][(size_t)gp * 16 + j]; Bre[j] = cr * br - ci * bi; Bim[j] = cr * bi + ci * br; } }
    bf16x8 Cf[4];
    { const int i = lane & 15;
#pragma unroll
        for (int ks = 0; ks < 4; ++ks)
#pragma unroll
            for (int j = 0; j < 8; ++j) { const int k = ks * 32 + (lane >> 4) * 8 + j, pp = k >> 1; const size_t ci = ((size_t)(l * 32 + g) * 16 + i) * 64 + pp;
                const float v = (k & 1) ? -a.in[I_CIM][ci] : a.in[I_CRE][ci]; Cf[ks][j] = (short)f2bf(v); } }
    const float dsk = a.in[I_DSKIP][l * 512 + g * 16 + (lane & 15)];
#pragma unroll 1
    for (int cc = 0; cc < 4; ++cc) {
        const int chunk = wave * 4 + cc, t0 = chunk * 64;
        { const bf16_t* up = U + (size_t)(b * 2048 + t0 + lane) * 512 + g * 16; float f[16]; unpack8(*(const uint4*)up, f); unpack8(*(const uint4*)(up + 8), f + 8);
#pragma unroll
            for (int q = 0; q < 4; ++q) *(f32x4*)(ust + lane * 16 + q * 4) = (f32x4){f[q * 4], f[q * 4 + 1], f[q * 4 + 2], f[q * 4 + 3]}; }
        LDS_FENCE();
        float sre = 0.f, sim = 0.f;
#pragma unroll 2
        for (int t = 0; t < 64; ++t) {
            float bur = 0.f, bui = 0.f;
#pragma unroll
            for (int q = 0; q < 4; ++q) { const f32x4 u4 = *(const f32x4*)(ust + t * 16 + q * 4);
#pragma unroll
                for (int e = 0; e < 4; ++e) { bur = fmaf(Bre[q * 4 + e], u4[e], bur); bui = fmaf(Bim[q * 4 + e], u4[e], bui); } }
            const float nre = lre * sre - lim * sim + bur, nim = lre * sim + lim * sre + bui; sre = nre; sim = nim;
        }
        E[(chunk * 64 + p) * 2] = sre; E[(chunk * 64 + p) * 2 + 1] = sim;
        LDS_FENCE();
    }
    __syncthreads();
    if (wave == 0) {
        float pr = lre, pi = lim;
#pragma unroll
        for (int q = 0; q < 6; ++q) { const float nr = pr * pr - pi * pi, ni = 2.f * pr * pi; pr = nr; pi = ni; }
        float sr = 0.f, si = 0.f;
        for (int c = 0; c < 32; ++c) { const float er = E[(c * 64 + p) * 2], ei = E[(c * 64 + p) * 2 + 1]; E[(c * 64 + p) * 2] = sr; E[(c * 64 + p) * 2 + 1] = si;
            const float nr = pr * sr - pi * si + er, ni = pr * si + pi * sr + ei; sr = nr; si = ni; }
    }
    __syncthreads();
#pragma unroll 1
    for (int cc = 0; cc < 4; ++cc) {
        const int chunk = wave * 4 + cc, t0 = chunk * 64;
        { const bf16_t* up = U + (size_t)(b * 2048 + t0 + lane) * 512 + g * 16; float f[16]; unpack8(*(const uint4*)up, f); unpack8(*(const uint4*)(up + 8), f + 8);
#pragma unroll
            for (int q = 0; q < 4; ++q) *(f32x4*)(ust + lane * 16 + q * 4) = (f32x4){f[q * 4], f[q * 4 + 1], f[q * 4 + 2], f[q * 4 + 3]}; }
        LDS_FENCE();
        float sre = E[(chunk * 64 + p) * 2], sim = E[(chunk * 64 + p) * 2 + 1];
#pragma unroll 1
        for (int sb = 0; sb < 4; ++sb) {
#pragma unroll 2
            for (int tt = 0; tt < 16; ++tt) { const int t = sb * 16 + tt;
                float bur = 0.f, bui = 0.f;
#pragma unroll
                for (int q = 0; q < 4; ++q) { const f32x4 u4 = *(const f32x4*)(ust + t * 16 + q * 4);
#pragma unroll
                    for (int e = 0; e < 4; ++e) { bur = fmaf(Bre[q * 4 + e], u4[e], bur); bui = fmaf(Bim[q * 4 + e], u4[e], bui); } }
                const float nre = lre * sre - lim * sim + bur, nim = lre * sim + lim * sre + bui; sre = nre; sim = nim;
                *(unsigned*)(sst + tt * 136 + 2 * p) = pk2(sre, sim);
            }
            LDS_FENCE();
            f32x4 acc = {0.f, 0.f, 0.f, 0.f};
#pragma unroll
            for (int ks = 0; ks < 4; ++ks) { const bf16x8 af = *(const bf16x8*)(sst + (lane & 15) * 136 + ks * 32 + (lane >> 4) * 8);
                acc = __builtin_amdgcn_mfma_f32_16x16x32_bf16(af, Cf[ks], acc, 0, 0, 0); }
#pragma unroll
            for (int r = 0; r < 4; ++r) { const int t = sb * 16 + (lane >> 4) * 4 + r, i = lane & 15;
                const float y = gelu_tanh(acc[r] + dsk * ust[t * 16 + i]);
                Y[(size_t)(b * 2048 + t0 + t) * 512 + g * 16 + i] = (bf16_t)f2bf(y); }
            LDS_FENCE();
        }
    }
    __syncthreads();
}

__device__ __forceinline__ void pool_unit(const Args& a, int b, int chunk, const int TI) {
    const int c = TI, w = 2 << (c >> 7), t0 = chunk * 64;
    const bf16_t* P = (const bf16_t*)(a.ws + WS_P) + (size_t)b * 2048 * 512 + c; bf16_t* O = (bf16_t*)(a.ws + WS_POOLED) + (size_t)b * 2048 * 512 + c;
    float s = 0.f;
    for (int tau = (t0 - w > 0 ? t0 - w : 0); tau < t0; ++tau) s += bf1(P[(size_t)tau * 512]);
#pragma unroll 4
    for (int t = t0; t < t0 + 64; ++t) { const float pv = bf1(P[(size_t)t * 512]); s += pv; if (t >= w) s -= bf1(P[(size_t)(t - w) * 512]);
        const float mean = s / (float)(t + 1 < w ? t + 1 : w); O[(size_t)t * 512] = (bf16_t)f2bf(mean - pv); }
}

__device__ __forceinline__ unsigned sortkey(float x) { const unsigned u = __float_as_uint(x); return (u & 0x80000000u) ? ~u : (u | 0x80000000u); }
__device__ __forceinline__ void dsa_unit(const Args& a, int b, int tq, unsigned char* lds, const int TI) {
    const int tid = TI, lane = tid & 63, wave = tid >> 6;
    float* sc = (float*)lds;
    unsigned short* sel = (unsigned short*)(lds + 131072);
    float* wis = (float*)(lds + 131072 + 8192);
    bf16_t* ocat = (bf16_t*)(a.ws + WS_OCAT); const bf16_t* Kn = (const bf16_t*)(a.ws + WS_KN); const bf16_t* V = (const bf16_t*)(a.ws + WS_V);
    const bf16_t* QI = (const bf16_t*)(a.ws + WS_QI); const bf16_t* KI = (const bf16_t*)(a.ws + WS_KI); const float* WI = (const float*)(a.ws + WS_WI);
    const int t0 = tq * 16, row0 = b * 2048 + t0, limit = ((t0 >> 6) + 1) << 6, nkt = limit >> 5, nsel = limit < 256 ? limit : 256;
    __syncthreads();
    if (tid < 128) wis[tid] = WI[(size_t)row0 * 8 + tid];
    __syncthreads();
    {
        const int g = lane >> 5, c32 = lane & 31;
        bf16x8 Af[4][4];
#pragma unroll
        for (int rb = 0; rb < 4; ++rb) { const int R = rb * 32 + c32; const bf16_t* qp = QI + (size_t)(row0 + (R >> 3)) * 512 + (R & 7) * 64 + g * 32;
#pragma unroll
            for (int s = 0; s < 4; ++s) Af[rb][s] = *(const bf16x8*)(qp + s * 8); }
        for (int kt = wave; kt < nkt; kt += 8) {
            const bf16_t* kp = KI + (size_t)(b * 2048 + kt * 32 + c32) * 64 + g * 32;
            bf16x8 Bf[4];
#pragma unroll
            for (int s = 0; s < 4; ++s) Bf[s] = *(const bf16x8*)(kp + s * 8);
#pragma unroll
            for (int rb = 0; rb < 4; ++rb) {
                f32x16 acc;
#pragma unroll
                for (int i = 0; i < 16; ++i) acc[i] = 0.f;
#pragma unroll
                for (int s = 0; s < 4; ++s) acc = __builtin_amdgcn_mfma_f32_32x32x16_bf16(Af[rb][s], Bf[s], acc, 0, 0, 0);
#pragma unroll
                for (int j = 0; j < 4; ++j) { const int q = rb * 4 + j; const f32x4 w4 = *(const f32x4*)(wis + q * 8 + 4 * g);
                    float sp = fmaxf(acc[4 * j], 0.f) * w4[0] + fmaxf(acc[4 * j + 1], 0.f) * w4[1] + fmaxf(acc[4 * j + 2], 0.f) * w4[2] + fmaxf(acc[4 * j + 3], 0.f) * w4[3];
                    sp += __shfl_xor(sp, 32);
                    if (g == 0) sc[q * 2048 + kt * 32 + c32] = sp; }
            }
        }
    }
    __syncthreads();
    const unsigned long long ltmask = (1ull << lane) - 1ull;
    for (int qq = 0; qq < 2; ++qq) {
        const int q = wave * 2 + qq; unsigned short* sq = sel + q * 256;
        if (limit <= 256) { for (int j = lane; j < limit; j += 64) sq[j] = (unsigned short)j; }
        else {
            unsigned key[32];
#pragma unroll
            for (int j = 0; j < 32; ++j) { const int idx = j * 64 + lane; key[j] = (idx < limit) ? sortkey(sc[q * 2048 + idx]) : 0u; }
            unsigned T = 0u;
            for (int bit = 31; bit >= 0; --bit) { const unsigned cand = T | (1u << bit); int cnt = 0;
#pragma unroll
                for (int j = 0; j < 32; ++j) cnt += __popcll(__ballot(key[j] >= cand));
                if (cnt >= 256) T = cand; }
            int cgt = 0;
#pragma unroll
            for (int j = 0; j < 32; ++j) cgt += __popcll(__ballot(key[j] > T));
            const int need = 256 - cgt; int ob = 0, tb = 0;
#pragma unroll
            for (int j = 0; j < 32; ++j) { const bool gt = key[j] > T, eq = key[j] == T; const unsigned long long me = __ballot(eq);
                const int pe = tb + __popcll(me & ltmask); const bool take = gt || (eq && pe < need); const unsigned long long mt = __ballot(take);
                if (take) sq[ob + __popcll(mt & ltmask)] = (unsigned short)(j * 64 + lane);
                ob += __popcll(mt); tb += __popcll(me); }
        }
    }
    __syncthreads();
    float* Pw = (float*)lds + wave * 2048;
    const int g4 = lane >> 4, hh = lane & 15;
    for (int qq = 0; qq < 2; ++qq) {
        const int q = wave * 2 + qq; const size_t row = (size_t)(row0 + q); const unsigned short* sq = sel + q * 256;
        bf16x8 Qf[4];
#pragma unroll
        for (int s = 0; s < 4; ++s) Qf[s] = *(const bf16x8*)(ocat + row * 2048 + (hh & 7) * 128 + g4 * 32 + s * 8);
        float lg[16][4];
#pragma unroll
        for (int kb = 0; kb < 16; ++kb) {
            if (kb * 16 < nsel) {
                const int idx = sq[kb * 16 + hh]; const bf16_t* kp = Kn + (size_t)(b * 2048 + idx) * 128 + g4 * 32;
                f32x4 c = {0.f, 0.f, 0.f, 0.f};
#pragma unroll
                for (int s = 0; s < 4; ++s) c = __builtin_amdgcn_mfma_f32_16x16x32_bf16(*(const bf16x8*)(kp + s * 8), Qf[s], c, 0, 0, 0);
#pragma unroll
                for (int r = 0; r < 4; ++r) lg[kb][r] = c[r] * 0.08838834764831845f;
                if (kb & 1) asm volatile("" ::: "memory");
            } else {
#pragma unroll
                for (int r = 0; r < 4; ++r) lg[kb][r] = -1e30f;
            }
        }
        float mx = -1e30f;
#pragma unroll
        for (int kb = 0; kb < 16; ++kb)
#pragma unroll
            for (int r = 0; r < 4; ++r) mx = fmaxf(mx, lg[kb][r]);
        mx = fmaxf(mx, __shfl_xor(mx, 16)); mx = fmaxf(mx, __shfl_xor(mx, 32));
        float sum = 0.f;
#pragma unroll
        for (int kb = 0; kb < 16; ++kb)
#pragma unroll
            for (int r = 0; r < 4; ++r) { const float e = (kb * 16 < nsel) ? __expf(lg[kb][r] - mx) : 0.f; lg[kb][r] = e; sum += e; }
        sum += __shfl_xor(sum, 16); sum += __shfl_xor(sum, 32);
        const float inv = 1.f / sum;
        if (hh < 8) {
#pragma unroll
            for (int kb = 0; kb < 16; ++kb)
                if (kb * 16 < nsel) {
#pragma unroll
                    for (int r = 0; r < 4; ++r) Pw[(kb * 16 + g4 * 4 + r) * 8 + hh] = lg[kb][r] * inv; }
        }
        LDS_FENCE();
        float o[8][2];
#pragma unroll
        for (int h = 0; h < 8; ++h) { o[h][0] = 0.f; o[h][1] = 0.f; }
        for (int j0 = 0; j0 < nsel; j0 += 8) {
            const uint4 i8 = *(const uint4*)(sq + j0);
            unsigned vv[8];
            const unsigned iw[4] = {i8.x, i8.y, i8.z, i8.w};
#pragma unroll
            for (int jj = 0; jj < 8; ++jj) { const int idx = (jj & 1) ? (int)(iw[jj >> 1] >> 16) : (int)(iw[jj >> 1] & 0xffffu);
                vv[jj] = *(const unsigned*)(V + (size_t)(b * 2048 + idx) * 128 + 2 * lane); }
#pragma unroll
            for (int jj = 0; jj < 8; ++jj) { const f32x4 pa = *(const f32x4*)(Pw + (j0 + jj) * 8), pb = *(const f32x4*)(Pw + (j0 + jj) * 8 + 4);
                const float v0 = bflo(vv[jj]), v1 = bfhi(vv[jj]);
#pragma unroll
                for (int h = 0; h < 4; ++h) { o[h][0] = fmaf(pa[h], v0, o[h][0]); o[h][1] = fmaf(pa[h], v1, o[h][1]); o[4 + h][0] = fmaf(pb[h], v0, o[4 + h][0]); o[4 + h][1] = fmaf(pb[h], v1, o[4 + h][1]); } }
        }
#pragma unroll
        for (int h = 0; h < 8; ++h) *(unsigned*)(ocat + row * 2048 + h * 128 + 2 * lane) = pk2(o[h][0], o[h][1]);
        LDS_FENCE();
    }
}

__device__ __forceinline__ void phase_fix(const Args& a, int l, const int TI) {
    const float* SA = (const float*)(a.ws + WS_SA); const float* SB = (const float*)(a.ws + WS_SB); bf16_t* act = (bf16_t*)(a.ws + WS_R2);
    const float* cw = a.in[I_CONVW] + (size_t)l * 3 * DFF; const float* cb = a.in[I_CONVB] + (size_t)l * DFF;
    const int total = 512 * 2 * DFF;
    for (int i = blockIdx.x * 512 + TI; i < total; i += gridDim.x * 512) {
        const int ch = i % DFF, rb = i / DFF, rr = rb & 1, blk = rb >> 1, r = blk * 64 + rr, t = r & 2047;
        const float a0 = SA[((size_t)blk * 4 + 2 + rr) * DFF + ch];
        float am1, am2;
        if (rr == 0) { am1 = (t >= 1) ? SA[((size_t)(blk - 1) * 4 + 1) * DFF + ch] : 0.f; am2 = (t >= 2) ? SA[((size_t)(blk - 1) * 4 + 0) * DFF + ch] : 0.f; }
        else { am1 = SA[((size_t)blk * 4 + 2) * DFF + ch]; am2 = (t >= 2) ? SA[((size_t)(blk - 1) * 4 + 1) * DFF + ch] : 0.f; }
        const float cv = cb[ch] + cw[ch] * am2 + cw[DFF + ch] * am1 + cw[2 * DFF + ch] * a0;
        act[(size_t)r * DFF + ch] = (bf16_t)f2bf(siluf_(cv) * SB[((size_t)blk * 2 + rr) * DFF + ch]);
    }
}

__device__ __forceinline__ void run_phase(const Args& a, int ph, unsigned char* lds, const int TI) {
    unsigned char* ws = a.ws;
    LAS unsigned char* ldsl = (LAS unsigned char*)lds;
    const int G = gridDim.x, bx = blockIdx.x;
#ifndef DBG_NOADA
    if (ph == 0) { phase_ada(a, lds, TI); return; }
#else
    if (ph == 0) return;
#endif
    const int l = (ph - 1) / 10, sp = (ph - 1) % 10;
    const float* modl = (const float*)(ws + WS_MOD) + (size_t)l * 16 * 12288;
    const float* xin = (l == 0) ? a.in[I_X] : a.out;
#ifdef DBG_SP
    if (sp != DBG_SP) return;
#endif
    switch (sp) {
    case 0: phase_cvt(a, l, lds, TI); phase_norm(xin, a.in[I_GN1] + l * DM, modl, 0, 2048, (bf16_t*)(ws + WS_R1), TI); break;
    case 1: {
        pg8::Gemm g{(const bf16_t*)(ws + WS_R1), (const bf16_t*)(ws + W_1CAT), MROWS, N1, DM, DM, DM, 1 << 30, 0}; pg8::StaticOrder S; S.init(MROWS, N1, G, bx);
        Epi1 E{(bf16_t*)(ws + WS_OCAT), (bf16_t*)(ws + WS_KN), (bf16_t*)(ws + WS_V), (bf16_t*)(ws + WS_QI), (bf16_t*)(ws + WS_KI), (bf16_t*)(ws + WS_U), (bf16_t*)(ws + WS_P), (bf16_t*)(ws + WS_R2),
               (float*)(ws + WS_WI), a.in[I_BGATE] + (size_t)l * 3 * DM};
        pg8::gemm_phase<Epi1, pg8::StaticOrder>(ldsl, g, S, E, TI); } break;
    case 2:
        phase_post(a, l, lds, TI);
        __syncthreads();
        for (int u = bx; u < 512; u += G) s5_unit(a, l, u >> 5, u & 31, lds, TI);
        for (int u = bx; u < 512; u += G) pool_unit(a, u >> 5, u & 31, TI);
        break;
    case 3: {
#ifndef DBG_NO_DSA
        for (int u = bx; u < 2048; u += G) { const int w = u & 255, i = u >> 8, b = w & 15, s = w >> 4; const int tq = (i & 1) ? (i * 16 + 15 - s) : (i * 16 + s); dsa_unit(a, b, tq, lds, TI); }
        __syncthreads();
#endif
#ifndef DBG_DSA_ONLY
        { pg8::Gemm g{(const bf16_t*)(ws + WS_Y), (const bf16_t*)(ws + W_GLU), MROWS, 1024, 512, 512, 512, 2, WS_POOLED - WS_Y}; pg8::StaticOrder S; S.init(MROWS, 1024, G, bx);
          EpiGluPool E{(const bf16_t*)(ws + WS_Y), a.in[I_PSCALE] + l * 512, (bf16_t*)(ws + WS_OCAT)}; pg8::gemm_phase<EpiGluPool, pg8::StaticOrder>(ldsl, g, S, E, TI); }
#endif
        } break;
    case 4: {
        pg8::Gemm g{(const bf16_t*)(ws + WS_OCAT), (const bf16_t*)(ws + W_P), MROWS, DM, DM, DM, DM, 1 << 30, 0}; pg8::StaticOrder S; S.init(MROWS, DM, G, bx);
        EpiMerge E{(const bf16_t*)(ws + WS_R2), (bf16_t*)(ws + WS_R1)}; pg8::gemm_phase<EpiMerge, pg8::StaticOrder>(ldsl, g, S, E, TI); } break;
    case 5: {
        pg8::Gemm g{(const bf16_t*)(ws + WS_R1), (const bf16_t*)(ws + W_OUT), MROWS, DM, DM, DM, DM, 1 << 30, 0}; pg8::StaticOrder S; S.init(MROWS, DM, G, bx);
        EpiRes E{xin, a.out, modl + 4096}; pg8::gemm_phase<EpiRes, pg8::StaticOrder>(ldsl, g, S, E, TI); } break;
    case 6: phase_norm(a.out, a.in[I_GN2] + l * DM, modl, 6144, 8192, (bf16_t*)(ws + WS_R1), TI); break;
    case 7: {
        pg8::Gemm g{(const bf16_t*)(ws + WS_R1), (const bf16_t*)(ws + W_UP), MROWS, 2 * DFF, DM, DM, DM, 1 << 30, 0}; pg8::StaticOrder S; S.init(MROWS, 2 * DFF, G, bx);
        EpiUp E{(bf16_t*)(ws + WS_R2), (float*)(ws + WS_SA), (float*)(ws + WS_SB), a.in[I_CONVW] + (size_t)l * 3 * DFF, a.in[I_CONVB] + (size_t)l * DFF};
        pg8::gemm_phase<EpiUp, pg8::StaticOrder>(ldsl, g, S, E, TI); } break;
    case 8: phase_fix(a, l, TI); break;
    case 9: {
        pg8::Gemm g{(const bf16_t*)(ws + WS_R2), (const bf16_t*)(ws + W_DOWN), MROWS, DM, DFF, DFF, DFF, 1 << 30, 0}; pg8::StaticOrder S; S.init(MROWS, DM, G, bx);
        EpiRes E{a.out, a.out, modl + 10240}; pg8::gemm_phase<EpiRes, pg8::StaticOrder>(ldsl, g, S, E, TI); } break;
    }
}

__global__ void __launch_bounds__(512, 2) mega_fwd(Args a) {
    extern __shared__ __attribute__((aligned(16))) unsigned char lds[];
    cg::grid_group grid = cg::this_grid();
    for (int ph = a.ph_lo; ph < a.ph_hi; ++ph) {
        int TI = threadIdx.x; asm volatile("" : "+v"(TI));
        Args la = a; asm volatile("" : "+s"(la.ws)); asm volatile("" : "+s"(la.out));
        run_phase(la, ph, lds, TI);
        if (ph + 1 < a.ph_hi) grid.sync();
    }
}

extern "C" void kernel_launch(void* const* d_in, const int* in_sizes, int n_in, void* d_out, int out_size, void* d_ws, size_t ws_size, hipStream_t stream) {
    static int grid = 0;
    if (grid == 0) {
        int dev = 0, cus = 0, per_cu = 0;
        if (n_in != 31 || ws_size < WS_END) { fprintf(stderr, "kernel_launch: unexpected n_in %d / ws %zu\n", n_in, ws_size); grid = -1; return; }
        hipGetDevice(&dev); hipDeviceGetAttribute(&cus, hipDeviceAttributeMultiprocessorCount, dev);
        if (hipFuncSetAttribute((const void*)mega_fwd, hipFuncAttributeMaxDynamicSharedMemorySize, LDS_BYTES) != hipSuccess) { fprintf(stderr, "kernel_launch: hipFuncSetAttribute failed\n"); grid = -1; return; }
        if (hipOccupancyMaxActiveBlocksPerMultiprocessor(&per_cu, (const void*)mega_fwd, 512, LDS_BYTES) != hipSuccess || per_cu < 1) { fprintf(stderr, "kernel_launch: occupancy query says %d blocks/CU\n", per_cu); per_cu = 1; }
        (void)hipGetLastError();
        grid = cus > 0 ? cus : 256;
    }
    if (grid < 0) return;
    Args a{};
    for (int i = 0; i < 31; ++i) a.in[i] = (const float*)d_in[i];
    a.out = (float*)d_out; a.ws = (unsigned char*)d_ws;
#if MK_PER_PHASE
    for (int ph = 0; ph < NPHASE; ++ph) {
        a.ph_lo = ph; a.ph_hi = ph + 1;
        void* args[] = {&a};
        hipError_t e = hipLaunchCooperativeKernel((const void*)mega_fwd, dim3(grid), dim3(512), args, LDS_BYTES, stream);
        if (e != hipSuccess) { fprintf(stderr, "kernel_launch: launch of phase %d failed: %s\n", ph, hipGetErrorString(e)); break; }
    }
#else
    a.ph_lo = 0; a.ph_hi = NPHASE;
    void* args[] = {&a};
    hipError_t e = hipLaunchCooperativeKernel((const void*)mega_fwd, dim3(grid), dim3(512), args, LDS_BYTES, stream);
    if (e != hipSuccess) fprintf(stderr, "kernel_launch: cooperative launch failed: %s (grid %d)\n", hipGetErrorString(e), grid);
#endif
}
```

```cpp
#include <hip/hip_runtime.h>
#include <hip/hip_cooperative_groups.h>
#include <cstdio>
#include <cstdint>
namespace cg = cooperative_groups;

#ifndef MK_PER_PHASE
#define MK_PER_PHASE 0
#endif

typedef unsigned short bf16_t;
typedef short bf16x8 __attribute__((ext_vector_type(8)));
typedef float f32x4 __attribute__((ext_vector_type(4)));
typedef float f32x16 __attribute__((ext_vector_type(16)));
#define LAS __attribute__((address_space(3)))

constexpr int BATCH = 16, SEQ = 2048, DM = 2048, MROWS = BATCH * SEQ, DIN = 2888, DFF = 5504;
constexpr int N1 = 9216;
constexpr float EPS = 1e-6f;
constexpr int NPHASE = 21;

constexpr size_t MiB = 1u << 20;
constexpr size_t WS_MOD = 1 * MiB;
constexpr size_t WS_WI = 3 * MiB;
constexpr size_t WS_W = 4 * MiB;
constexpr size_t W_1CAT = WS_W, W_P = WS_W + 36 * MiB, W_OUT = WS_W + 44 * MiB, W_UP = WS_W + 52 * MiB, W_DOWN = WS_W + 95 * MiB,
                 W_GLU = WS_W + 116 * MiB + MiB / 2, W_POOL = WS_W + 117 * MiB;
constexpr size_t WS_R1 = 122 * MiB;
constexpr size_t WS_Y = WS_R1, WS_POOLED = WS_R1 + 32 * MiB;
constexpr size_t WS_R2 = 250 * MiB;
constexpr size_t WS_OCAT = 634 * MiB;
constexpr size_t WS_SA = WS_OCAT, WS_SB = WS_OCAT + 44 * MiB;
constexpr size_t WS_KN = 762 * MiB, WS_V = 770 * MiB, WS_QI = 778 * MiB, WS_KI = 810 * MiB, WS_U = 814 * MiB, WS_P = 846 * MiB, WS_END = 878 * MiB;
constexpr int LDS_BYTES = 147456;

__device__ __forceinline__ unsigned f2bf(float f) { unsigned u = __float_as_uint(f); return (u + 0x7fffu + ((u >> 16) & 1u)) >> 16; }
__device__ __forceinline__ unsigned pk2(float lo, float hi) { return f2bf(lo) | (f2bf(hi) << 16); }
__device__ __forceinline__ float bflo(unsigned u) { return __uint_as_float(u << 16); }
__device__ __forceinline__ float bfhi(unsigned u) { return __uint_as_float(u & 0xffff0000u); }
__device__ __forceinline__ float bf1(bf16_t b) { return __uint_as_float(((unsigned)b) << 16); }
__device__ __forceinline__ float sigmoidf_(float x) { return 1.f / (1.f + __expf(-x)); }
__device__ __forceinline__ float siluf_(float x) { return x / (1.f + __expf(-x)); }
__device__ __forceinline__ float gelu_tanh(float x) { const float z = 0.7978845608028654f * (x + 0.044715f * x * x * x); const float t = 1.f - 2.f / (1.f + __expf(2.f * z)); return 0.5f * x * (1.f + t); }
__device__ __forceinline__ uint4 pack8(f32x4 a, f32x4 b) { uint4 r; r.x = pk2(a[0], a[1]); r.y = pk2(a[2], a[3]); r.z = pk2(b[0], b[1]); r.w = pk2(b[2], b[3]); return r; }
__device__ __forceinline__ void unpack8(uint4 v, float* f) { f[0] = bflo(v.x); f[1] = bfhi(v.x); f[2] = bflo(v.y); f[3] = bfhi(v.y); f[4] = bflo(v.z); f[5] = bfhi(v.z); f[6] = bflo(v.w); f[7] = bfhi(v.w); }
#define LDS_FENCE() asm volatile("s_waitcnt lgkmcnt(0)" ::: "memory")
__device__ __forceinline__ int fresh_tid(int wv) { int l = (int)__builtin_amdgcn_mbcnt_hi(~0u, __builtin_amdgcn_mbcnt_lo(~0u, 0u)); asm volatile("" : "+v"(l)); return (wv << 6) | l; }

namespace pg8 {
constexpr int BM = 256, BK = 64, HALF = 128, HTB = HALF * BK * 2, STAGE_BYTES = 8 * HTB, NXCD = 8, WGM = 8;
__host__ __device__ __forceinline__ int lds_byte(int r, int c) { const int st = (r >> 4) * 2 + (c >> 5), rr = r & 15, cc = c & 31, ob = rr * 64 + cc * 2; return st * 1024 + (ob ^ (((ob >> 9) & 1) << 5)); }
__host__ __device__ __forceinline__ void stage_rc(int b, int& R, int& C) { const int st = b / 1024, sb = b % 1024, swz = sb ^ (((sb >> 9) & 1) << 5); R = (st >> 1) * 16 + swz / 64; C = (st & 1) * 32 + (swz % 64) / 2; }
__host__ __device__ __forceinline__ int perm32(int rho) { const int n = rho >> 4, i = rho & 15; return 8 * (i >> 2) + 4 * n + (i & 3); }
struct Unit { int pm, pn; };
struct Gemm { const bf16_t* A; const bf16_t* Bt; int M, N, K, lda, ldb; int asplit; size_t aoff; };
struct StaticOrder {
    int nM, nN, nwg, G, c;
    __device__ void init(int M, int N, int G_, int c_) { nM = M / BM; nN = N / BM; nwg = nM * nN; G = G_; c = c_; }
    __device__ bool next(int i, Unit& u) const {
        const long L = (long)i * G + c; if (L >= nwg) return false;
        int wgid = (int)L; { const int q = nwg / NXCD, r = nwg % NXCD, xcd = wgid % NXCD, off = wgid / NXCD; wgid = (xcd < r ? xcd * (q + 1) : r * (q + 1) + (xcd - r) * q) + off; }
        const int nig = WGM * nN, gid = wgid / nig, fm = gid * WGM, gsz = (nM - fm) < WGM ? (nM - fm) : WGM;
        u.pm = fm + ((wgid % nig) % gsz); u.pn = (wgid % nig) / gsz; return true;
    }
};
template <class Epi, class Sched>
__device__ __forceinline__ void gemm_phase(LAS unsigned char* lds, const Gemm g, const Sched& S, const Epi& E, const int WV) {
    const int TI = fresh_tid(WV);
    const int tid = TI, wid = __builtin_amdgcn_readfirstlane(tid >> 6), lane = tid & 63, wr = wid >> 2, wc = wid & 3, fr = lane & 15, fq = lane >> 4;
    const int K = g.K, nt = K / BK;
    unsigned voffA[2], voffB[2];
#pragma unroll
    for (int i = 0; i < 2; ++i) { int R, C; stage_rc(tid * 16 + i * 8192, R, C); const int Rb = Epi::PERM ? ((R & ~31) + perm32(R & 31)) : R;
        voffA[i] = (unsigned)(R * g.lda + C) * 2u; voffB[i] = (unsigned)(Rb * g.ldb + C) * 2u; }
    const size_t kstep = (size_t)(BK * 2);
    const size_t hstepA = (size_t)HALF * g.lda * 2, hstepB = (size_t)HALF * g.ldb * 2;
    const size_t tstepA = 2 * hstepA, tstepB = 2 * hstepB;
    const unsigned ldsw = (unsigned)wid * 1024u;
    const int aoff = lds_byte(wr * 64 + fr, fq * 8), boff = lds_byte(wc * 32 + fr, fq * 8);
#define PG8_SA(b, h) (((b) * 2 + (h)) * HTB)
#define PG8_SB(b, h) ((4 + (b) * 2 + (h)) * HTB)
#define PG8_STAGE(bufoff, gbase, voff) do { _Pragma("unroll") for (int _i = 0; _i < 2; ++_i) \
        __builtin_amdgcn_global_load_lds((const unsigned*)((const char*)(gbase) + (voff)[_i]), (LAS unsigned*)(lds + (bufoff) + ldsw + _i * 8192), 16, 0, 0); } while (0)
#define PG8_LDA(dst, b, h) do { _Pragma("unroll") for (int m = 0; m < 4; ++m) _Pragma("unroll") for (int k = 0; k < 2; ++k) dst[m][k] = *(const LAS bf16x8*)(lds + PG8_SA(b, h) + aoff + m * 2048 + k * 1024); } while (0)
#define PG8_LDB(dst, b, h) do { _Pragma("unroll") for (int n = 0; n < 2; ++n) _Pragma("unroll") for (int k = 0; k < 2; ++k) dst[n][k] = *(const LAS bf16x8*)(lds + PG8_SB(b, h) + boff + n * 2048 + k * 1024); } while (0)
#define PG8_MMA(ai, bj, At, Bt) do { __builtin_amdgcn_s_setprio(1); _Pragma("unroll") for (int m = 0; m < 4; ++m) _Pragma("unroll") for (int n = 0; n < 2; ++n) _Pragma("unroll") for (int k = 0; k < 2; ++k) \
        acc[ai][bj][m][n] = __builtin_amdgcn_mfma_f32_16x16x32_bf16(Bt[n][k], At[m][k], acc[ai][bj][m][n], 0, 0, 0); __builtin_amdgcn_s_setprio(0); } while (0)
#define PG8_WAIT_V(n) asm volatile("s_waitcnt vmcnt(" #n ")" ::: "memory")
#define PG8_WAIT_L(n) asm volatile("s_waitcnt lgkmcnt(" #n ")" ::: "memory")
#define PG8_BAR __builtin_amdgcn_s_barrier()
#define PG8_SCHED __builtin_amdgcn_sched_barrier(0)
#define PG8_ZERO() do { _Pragma("unroll") for (int a_ = 0; a_ < 2; ++a_) _Pragma("unroll") for (int b_ = 0; b_ < 2; ++b_) _Pragma("unroll") for (int m_ = 0; m_ < 4; ++m_) _Pragma("unroll") for (int n_ = 0; n_ < 2; ++n_) acc[a_][b_][m_][n_] = (f32x4){0.f, 0.f, 0.f, 0.f}; } while (0)
    Unit cur, nxt; int ui = 0;
    if (!S.next(0, cur)) return;
    f32x4 acc[2][2][4][2];
    PG8_ZERO();
    bf16x8 At[4][2], B0[2][2], B1[2][2];
    const char* cA = (const char*)g.A + (size_t)cur.pm * tstepA + (cur.pn >= g.asplit ? g.aoff : (size_t)0); const char* cB = (const char*)g.Bt + (size_t)cur.pn * tstepB;
    PG8_STAGE(PG8_SB(0, 0), cB, voffB); PG8_STAGE(PG8_SA(0, 0), cA, voffA); PG8_STAGE(PG8_SB(0, 1), cB + hstepB, voffB); PG8_STAGE(PG8_SA(0, 1), cA + hstepA, voffA);
    if (wr == 1) PG8_BAR;
    PG8_WAIT_V(4); PG8_BAR;
    PG8_STAGE(PG8_SB(1, 0), cB + kstep, voffB); PG8_STAGE(PG8_SA(1, 0), cA + kstep, voffA); PG8_STAGE(PG8_SB(1, 1), cB + hstepB + kstep, voffB);
    PG8_WAIT_V(6); PG8_BAR;
    for (;;) {
        const bool has_next = S.next(ui + 1, nxt);
        const char* nA = has_next ? (const char*)g.A + (size_t)nxt.pm * tstepA + (nxt.pn >= g.asplit ? g.aoff : (size_t)0) : cA; const char* nB = has_next ? (const char*)g.Bt + (size_t)nxt.pn * tstepB : cB;
        for (int t = 0; t < nt; t += 2) {
            const bool last = (t == nt - 2);
            const char* a1 = cA + (size_t)(t + 1) * kstep;
            const char* a2 = last ? nA : cA + (size_t)(t + 2) * kstep; const char* b2 = last ? nB : cB + (size_t)(t + 2) * kstep;
            const char* a3 = a2 + kstep; const char* b3 = b2 + kstep;
            PG8_LDB(B0, 0, 0); PG8_SCHED; PG8_LDA(At, 0, 0); PG8_STAGE(PG8_SA(1, 1), a1 + hstepA, voffA);
            PG8_WAIT_L(8); PG8_BAR; PG8_WAIT_L(0); PG8_MMA(0, 0, At, B0); PG8_BAR; PG8_SCHED;
            PG8_LDB(B1, 0, 1); PG8_STAGE(PG8_SB(0, 0), b2, voffB);
            PG8_BAR; PG8_WAIT_L(0); PG8_MMA(0, 1, At, B1); PG8_BAR;
            PG8_LDA(At, 0, 1); PG8_STAGE(PG8_SA(0, 0), a2, voffA);
            PG8_BAR; PG8_WAIT_L(0); PG8_MMA(1, 0, At, B0); PG8_BAR; PG8_SCHED;
            PG8_STAGE(PG8_SB(0, 1), b2 + hstepB, voffB);
            PG8_WAIT_V(6); PG8_BAR; PG8_MMA(1, 1, At, B1); PG8_BAR;
            PG8_LDB(B0, 1, 0); PG8_SCHED; PG8_LDA(At, 1, 0); PG8_STAGE(PG8_SA(0, 1), a2 + hstepA, voffA);
            PG8_WAIT_L(8); PG8_BAR; PG8_WAIT_L(0); PG8_MMA(0, 0, At, B0); PG8_BAR; PG8_SCHED;
            PG8_LDB(B1, 1, 1); PG8_STAGE(PG8_SB(1, 0), b3, voffB);
            PG8_BAR; PG8_WAIT_L(0); PG8_MMA(0, 1, At, B1); PG8_BAR;
            PG8_LDA(At, 1, 1); PG8_STAGE(PG8_SA(1, 0), a3, voffA);
            PG8_BAR; PG8_WAIT_L(0); PG8_MMA(1, 0, At, B0); PG8_BAR; PG8_SCHED;
            PG8_STAGE(PG8_SB(1, 1), b3 + hstepB, voffB);
            PG8_WAIT_V(6); PG8_BAR; PG8_MMA(1, 1, At, B1); PG8_BAR;
            if constexpr (Epi::SEG) { if (t + 2 == 16 || t + 2 == 24) { E.flush(acc, cur, (t + 2 == 16) ? 0 : 1, wr, wc, fr, fq); PG8_ZERO(); } }
        }
        if constexpr (Epi::SEG) E.flush(acc, cur, 2, wr, wc, fr, fq); else E(acc, cur, wr, wc, fr, fq);
        if (!has_next) break;
        PG8_ZERO();
        cur = nxt; cA = nA; cB = nB; ++ui;
    }
    PG8_WAIT_V(0);
    if (wr == 0) PG8_BAR;
    PG8_BAR;
#undef PG8_SA
#undef PG8_SB
#undef PG8_STAGE
#undef PG8_LDA
#undef PG8_LDB
#undef PG8_MMA
#undef PG8_WAIT_V
#undef PG8_WAIT_L
#undef PG8_BAR
#undef PG8_SCHED
#undef PG8_ZERO
}
}
using pg8::Unit;
typedef const f32x4 (&AccRef)[2][2][4][2];

struct Epi1 {
    static constexpr bool PERM = true, SEG = false;
    bf16_t *ocat, *kn, *vv, *qi, *ki, *u, *p, *gates; float* wi; const float* bgate;
    __device__ __forceinline__ void operator()(AccRef acc, const Unit& un, int wr, int wc, int fr, int fq) const {
        asm volatile("" : "+v"(fr), "+v"(fq));
        const int pn = un.pn, row0 = un.pm * 256 + wr * 64 + fr;
#pragma unroll
        for (int bj = 0; bj < 2; ++bj) {
            const int cit = bj * 128 + wc * 32 + 8 * fq;
            bf16_t* base; int ld; int mode = 0;
            if (pn < 4) { base = ocat + pn * 256 + cit; ld = 2048; }
            else if (pn == 4) { base = (bj == 0 ? kn : vv) + (cit & 127); ld = 128; }
            else if (pn < 7) { base = qi + (pn - 5) * 256 + cit; ld = 512; }
            else if (pn == 7) { base = ki + cit; ld = 64; mode = (cit < 64) ? 0 : ((cit == 64) ? 2 : 3); }
            else if (pn < 10) { base = u + (pn - 8) * 256 + cit; ld = 512; }
            else if (pn < 12) { base = p + (pn - 10) * 256 + cit; ld = 512; }
            else { base = gates + (pn - 12) * 256 + cit; ld = 6144; mode = 1; }
            f32x4 b0 = {0.f, 0.f, 0.f, 0.f}, b1 = {0.f, 0.f, 0.f, 0.f};
            if (mode == 1) { b0 = *(const f32x4*)(bgate + (pn - 12) * 256 + cit); b1 = *(const f32x4*)(bgate + (pn - 12) * 256 + cit + 4); }
#pragma unroll
            for (int ai = 0; ai < 2; ++ai)
#pragma unroll
                for (int m = 0; m < 4; ++m) {
                    const size_t row = (size_t)(row0 + ai * 128 + m * 16);
                    f32x4 v0 = acc[ai][bj][m][0], v1 = acc[ai][bj][m][1];
                    if (mode == 1) {
#pragma unroll
                        for (int e = 0; e < 4; ++e) { v0[e] = sigmoidf_(v0[e] + b0[e]); v1[e] = sigmoidf_(v1[e] + b1[e]); }
                    }
                    if (mode == 2) {
                        const float s = 0.35355339059327373f * 0.125f;
                        *(f32x4*)(wi + row * 8) = v0 * s; *(f32x4*)(wi + row * 8 + 4) = v1 * s;
                    } else if (mode != 3) {
                        *(uint4*)(base + row * ld) = pack8(v0, v1);
                    }

                }
        }
    }
};
struct EpiGluPool {
    static constexpr bool PERM = true, SEG = false;
    const bf16_t* y; const float* scale; bf16_t* ocat;
    __device__ __forceinline__ void operator()(AccRef acc, const Unit& un, int wr, int wc, int fr, int fq) const {
        asm volatile("" : "+v"(fr), "+v"(fq));
        const int row0 = un.pm * 256 + wr * 64 + fr; const bool glu = un.pn < 2;
#pragma unroll
        for (int bj = 0; bj < 2; ++bj) { const int col = (un.pn & 1) * 256 + bj * 128 + wc * 32 + 8 * fq;
            f32x4 s0 = {0.f, 0.f, 0.f, 0.f}, s1 = {0.f, 0.f, 0.f, 0.f};
            if (!glu) { s0 = *(const f32x4*)(scale + col); s1 = *(const f32x4*)(scale + col + 4); }
#pragma unroll
            for (int ai = 0; ai < 2; ++ai) {
                uint4 yq[4];
                if (glu) {
#pragma unroll
                    for (int m = 0; m < 4; ++m) yq[m] = *(const uint4*)(y + (size_t)(row0 + ai * 128 + m * 16) * 512 + col); }
#pragma unroll
                for (int m = 0; m < 4; ++m) { const size_t row = (size_t)(row0 + ai * 128 + m * 16);
                    f32x4 v0 = acc[ai][bj][m][0], v1 = acc[ai][bj][m][1];
                    if (glu) { float yv[8]; unpack8(yq[m], yv);
#pragma unroll
                        for (int e = 0; e < 4; ++e) { v0[e] = yv[e] * sigmoidf_(v0[e]); v1[e] = yv[4 + e] * sigmoidf_(v1[e]); }
                        *(uint4*)(ocat + row * 2048 + 1024 + col) = pack8(v0, v1);
                    } else *(uint4*)(ocat + row * 2048 + 1536 + col) = pack8(v0 * s0, v1 * s1); } } }
    }
};
struct EpiMerge {
    static constexpr bool PERM = true, SEG = true;
    const bf16_t* gates; bf16_t* merged;
    __device__ __forceinline__ void flush(AccRef acc, const Unit& un, int seg, int wr, int wc, int fr, int fq) const {
        asm volatile("" : "+v"(fr), "+v"(fq));
        const int row0 = un.pm * 256 + wr * 64 + fr;
#pragma unroll
        for (int bj = 0; bj < 2; ++bj) { const int col = un.pn * 256 + bj * 128 + wc * 32 + 8 * fq;
#pragma unroll
            for (int ai = 0; ai < 2; ++ai) {
                uint4 gq[4], pq[4];
#pragma unroll
                for (int m = 0; m < 4; ++m) { const size_t row = (size_t)(row0 + ai * 128 + m * 16);
                    gq[m] = *(const uint4*)(gates + row * 6144 + seg * 2048 + col);
                    if (seg > 0) pq[m] = *(const uint4*)(merged + row * 2048 + col); else pq[m] = make_uint4(0u, 0u, 0u, 0u); }
#pragma unroll
                for (int m = 0; m < 4; ++m) { const size_t row = (size_t)(row0 + ai * 128 + m * 16);
                    float gv[8], pv[8]; unpack8(gq[m], gv); unpack8(pq[m], pv);
                    f32x4 v0 = acc[ai][bj][m][0], v1 = acc[ai][bj][m][1];
#pragma unroll
                    for (int e = 0; e < 4; ++e) { v0[e] = pv[e] + gv[e] * v0[e]; v1[e] = pv[4 + e] + gv[4 + e] * v1[e]; }
                    *(uint4*)(merged + row * 2048 + col) = pack8(v0, v1); } } }
    }
};
struct EpiRes {
    static constexpr bool PERM = false, SEG = false;
    const float* xin; float* out; const float* gt;
    __device__ __forceinline__ void operator()(AccRef acc, const Unit& un, int wr, int wc, int fr, int fq) const {
        asm volatile("" : "+v"(fr), "+v"(fq));
        const int row0 = un.pm * 256 + wr * 64 + fr; const float* g = gt + (size_t)(un.pm >> 3) * 12288;
#pragma unroll
        for (int bj = 0; bj < 2; ++bj)
#pragma unroll
            for (int n = 0; n < 2; ++n) { const int col = un.pn * 256 + bj * 128 + wc * 32 + 16 * n + 4 * fq;
                const f32x4 gv = *(const f32x4*)(g + col);
                f32x4 xv[2][4];
#pragma unroll
                for (int ai = 0; ai < 2; ++ai)
#pragma unroll
                    for (int m = 0; m < 4; ++m) xv[ai][m] = *(const f32x4*)(xin + (size_t)(row0 + ai * 128 + m * 16) * 2048 + col);
#pragma unroll
                for (int ai = 0; ai < 2; ++ai)
#pragma unroll
                    for (int m = 0; m < 4; ++m) *(f32x4*)(out + (size_t)(row0 + ai * 128 + m * 16) * 2048 + col) = xv[ai][m] + gv * acc[ai][bj][m][n]; }
    }
};
struct EpiUp {
    static constexpr bool PERM = true, SEG = false;
    bf16_t* act; float* SA; float* SB; const float* cw; const float* cb;
    __device__ __forceinline__ void operator()(AccRef acc, const Unit& un, int wr, int wc, int fr, int fq) const {
        asm volatile("" : "+v"(fr), "+v"(fq));
        const int lg = fq << 4;
        const int src1 = lg | ((fr + 15) & 15), src2 = lg | ((fr + 14) & 15);
#pragma unroll
        for (int n = 0; n < 2; ++n) {
            const int ch0 = un.pn * 128 + wc * 32 + 8 * fq + 4 * n;
            const f32x4 w0 = *(const f32x4*)(cw + ch0), w1 = *(const f32x4*)(cw + DFF + ch0), w2 = *(const f32x4*)(cw + 2 * DFF + ch0), bb = *(const f32x4*)(cb + ch0);
#pragma unroll
            for (int ai = 0; ai < 2; ++ai) {
                const int rowb = un.pm * 256 + ai * 128 + wr * 64; const int blk = rowb >> 6;
#pragma unroll
                for (int m = 0; m < 4; ++m) {
                    f32x4 res;
#pragma unroll
                    for (int e = 0; e < 4; ++e) {
                        const float cur = acc[ai][0][m][n][e];
                        const float prv = (m > 0) ? acc[ai][0][m > 0 ? m - 1 : 0][n][e] : 0.f;
                        const float p1 = __shfl((fr + 1 >= 16) ? prv : cur, src1);
                        const float p2 = __shfl((fr + 2 >= 16) ? prv : cur, src2);
                        const float cv = bb[e] + w0[e] * p2 + w1[e] * p1 + w2[e] * cur;
                        res[e] = siluf_(cv) * acc[ai][1][m][n][e];
                    }
                    const size_t row = (size_t)(rowb + m * 16 + fr);
                    if (m == 0 && fr < 2) {
                        *(f32x4*)(SA + ((size_t)(blk * 4 + 2 + fr)) * DFF + ch0) = acc[ai][0][0][n];
                        *(f32x4*)(SB + ((size_t)(blk * 2 + fr)) * DFF + ch0) = acc[ai][1][0][n];
                    } else {
                        uint2 o; o.x = pk2(res[0], res[1]); o.y = pk2(res[2], res[3]);
                        *(uint2*)(act + row * DFF + ch0) = o;
                    }
                    if (m == 3 && fr >= 14) *(f32x4*)(SA + ((size_t)(blk * 4 + (fr - 14))) * DFF + ch0) = acc[ai][0][3][n];

                }
            }
        }
    }
};

struct Args { const float* in[31]; float* out; unsigned char* ws; int ph_lo, ph_hi; };
enum { I_X = 0, I_C, I_POS, I_WADA, I_BADA, I_GN1, I_GN2, I_WIN, I_GQ, I_GK, I_ARE, I_AIM, I_BRE, I_BIM, I_CRE, I_CIM, I_DSKIP, I_LOGDT, I_WGLU, I_WPOOL, I_PSCALE, I_PA, I_PB, I_PC, I_WGATE, I_BGATE, I_WOUT, I_WUP, I_CONVW, I_CONVB, I_WDOWN };

__device__ __forceinline__ float wave_sum(float v) {
#pragma unroll
    for (int o = 32; o > 0; o >>= 1) v += __shfl_xor(v, o);
    return v;
}

__device__ __forceinline__ void phase_ada(const Args& a, unsigned char* lds, const int WV) {
    const int TI = fresh_tid(WV);
    const int tid = TI;
    float* cact = (float*)lds;
    float* mod = (float*)(a.ws + WS_MOD);
    for (int w = blockIdx.x; w < 256; w += gridDim.x) {
        for (int i = tid; i < 16 * 2048; i += 512) { const int b = i >> 11, k = i & 2047; const float v = a.in[I_C][i]; cact[k * 16 + b] = siluf_(v); }
        __syncthreads();
        const int l = w >> 7, n0 = (w & 127) * 96;
        float acc[16][4];
#pragma unroll
        for (int b = 0; b < 16; ++b)
#pragma unroll
            for (int j = 0; j < 4; ++j) acc[b][j] = 0.f;
        const int cg4 = tid % 24, ks = tid / 24;
        if (tid < 384) {
            const float* wp = a.in[I_WADA] + ((size_t)l * 2048 + ks * 128) * 12288 + n0 + cg4 * 4;
#pragma unroll 4
            for (int k = 0; k < 128; ++k) {
                const f32x4 wv = *(const f32x4*)(wp + (size_t)k * 12288);
                const f32x4* cp = (const f32x4*)(cact + (ks * 128 + k) * 16);
#pragma unroll
                for (int q = 0; q < 4; ++q) { const f32x4 cv = cp[q];
#pragma unroll
                    for (int e = 0; e < 4; ++e)
#pragma unroll
                        for (int j = 0; j < 4; ++j) acc[q * 4 + e][j] += cv[e] * wv[j]; }
            }
        }
        __syncthreads();
        float* part = (float*)lds;
        if (tid < 384) {
#pragma unroll
            for (int b = 0; b < 16; ++b)
#pragma unroll
                for (int j = 0; j < 4; ++j) part[(ks * 16 + b) * 96 + cg4 * 4 + j] = acc[b][j];
        }
        __syncthreads();
        for (int o = tid; o < 1536; o += 512) { const int b = o / 96, cc = o % 96; float s = 0.f;
#pragma unroll
            for (int k2 = 0; k2 < 16; ++k2) s += part[(k2 * 16 + b) * 96 + cc];
            mod[((size_t)l * 16 + b) * 12288 + n0 + cc] = s + a.in[I_BADA][l * 12288 + n0 + cc]; }
        __syncthreads();
    }
}

struct CvtJob { const float* src; bf16_t* dst; int ldS, cbase, cend, kbase, ldD, mode, r0, cs0, kd0; };
__device__ __forceinline__ CvtJob cvt_decode(const Args& a, int l, int t) {
    unsigned char* ws = a.ws; CvtJob J; int ncols, nkt, idx; J.mode = 0; J.r0 = 0; J.kd0 = 0; J.cs0 = 0;
    if (t < 960) { idx = t; J.src = a.in[I_WIN] + (size_t)l * DM * DIN; J.ldS = DIN; ncols = 1864; nkt = 32; J.dst = (bf16_t*)(ws + W_1CAT); J.ldD = 2048; }
    else if (t < 1472) { idx = t - 960; J.src = a.in[I_WIN] + (size_t)l * DM * DIN; J.ldS = DIN; J.cs0 = 1864; ncols = 1024; nkt = 32; J.dst = (bf16_t*)(ws + W_1CAT); J.ldD = 2048; J.r0 = 2048; }
    else if (t < 4544) { idx = t - 1472; const int gi = idx >> 10; idx &= 1023; J.src = a.in[I_WGATE] + ((size_t)l * 3 + gi) * DM * DM; J.ldS = DM; ncols = 2048; nkt = 32; J.dst = (bf16_t*)(ws + W_1CAT); J.ldD = 2048; J.r0 = 3072 + 2048 * gi; }
    else if (t < 5056) { idx = t - 4544; J.src = a.in[I_PA] + (size_t)l * 1024 * DM; J.ldS = DM; ncols = 2048; nkt = 16; J.dst = (bf16_t*)(ws + W_P); J.ldD = 2048; }
    else if (t < 5312) { idx = t - 5056; J.src = a.in[I_PB] + (size_t)l * 512 * DM; J.ldS = DM; ncols = 2048; nkt = 8; J.dst = (bf16_t*)(ws + W_P); J.ldD = 2048; J.kd0 = 1024; }
    else if (t < 5568) { idx = t - 5312; J.src = a.in[I_PC] + (size_t)l * 512 * DM; J.ldS = DM; ncols = 2048; nkt = 8; J.dst = (bf16_t*)(ws + W_P); J.ldD = 2048; J.kd0 = 1536; }
    else if (t < 6592) { idx = t - 5568; J.src = a.in[I_WOUT] + (size_t)l * DM * DM; J.ldS = DM; ncols = 2048; nkt = 32; J.dst = (bf16_t*)(ws + W_OUT); J.ldD = 2048; }
    else if (t < 12096) { idx = t - 6592; J.src = a.in[I_WUP] + (size_t)l * DM * 2 * DFF; J.ldS = 2 * DFF; ncols = 2 * DFF; nkt = 32; J.dst = (bf16_t*)(ws + W_UP); J.ldD = 2048; J.mode = 1; }
    else if (t < 14848) { idx = t - 12096; J.src = a.in[I_WDOWN] + (size_t)l * DFF * DM; J.ldS = DM; ncols = 2048; nkt = 86; J.dst = (bf16_t*)(ws + W_DOWN); J.ldD = DFF; }
    else { idx = t - 14848; J.src = a.in[I_WGLU] + (size_t)l * 512 * 512; J.ldS = 512; ncols = 512; nkt = 8; J.dst = (bf16_t*)(ws + W_GLU); J.ldD = 512; }
    const int tn = idx / nkt, tk = idx - tn * nkt;
    J.cbase = J.cs0 + tn * 64; J.cend = J.cs0 + ncols; J.kbase = tk * 64; return J;
}
__device__ __forceinline__ void phase_cvt(const Args& a, int l, unsigned char* lds, const int WV) {
    const int TI = fresh_tid(WV);
    float* T = (float*)lds;
    const int tid = TI, ty = tid >> 4, tx = tid & 15;
    for (int t4 = blockIdx.x * 4; t4 < 14912; t4 += gridDim.x * 4) {
        f32x4 v[4][2];
#pragma unroll
        for (int q = 0; q < 4; ++q) { const CvtJob J = cvt_decode(a, l, t4 + q);
#pragma unroll
            for (int ps = 0; ps < 2; ++ps) { const int k = ty + ps * 32, c = J.cbase + tx * 4;
                v[q][ps] = (f32x4){0.f, 0.f, 0.f, 0.f};
                if (c < J.cend) v[q][ps] = *(const f32x4*)(J.src + (size_t)(J.kbase + k) * J.ldS + c); } }
#pragma unroll
        for (int q = 0; q < 4; ++q)
#pragma unroll
            for (int ps = 0; ps < 2; ++ps) { float* tp = T + q * (64 * 65) + (ty + ps * 32) * 65 + tx * 4; tp[0] = v[q][ps][0]; tp[1] = v[q][ps][1]; tp[2] = v[q][ps][2]; tp[3] = v[q][ps][3]; }
        __syncthreads();
#pragma unroll
        for (int q = 0; q < 4; ++q) { const CvtJob J = cvt_decode(a, l, t4 + q);
            const int n = tid >> 3, kq = tid & 7, c = J.cbase + n;
            if (c < J.cend) {
                float f[8];
#pragma unroll
                for (int j = 0; j < 8; ++j) f[j] = T[q * (64 * 65) + (kq * 8 + j) * 65 + n];
                int row;
                if (J.mode == 0) row = J.r0 + (c - J.cs0);
                else { const int bj = c >= DFF ? 1 : 0, ch = c - bj * DFF; row = (ch >> 7) * 256 + bj * 128 + (ch & 127); }
                uint4 o; o.x = pk2(f[0], f[1]); o.y = pk2(f[2], f[3]); o.z = pk2(f[4], f[5]); o.w = pk2(f[6], f[7]);
                *(uint4*)(J.dst + (size_t)row * J.ldD + J.kd0 + J.kbase + kq * 8) = o;
            } }
        __syncthreads();
    }
    bf16_t* wp = (bf16_t*)(a.ws + W_POOL); const float* wsrc = a.in[I_WPOOL] + (size_t)l * 4 * 128 * 128;
    for (int i = blockIdx.x * 512 + TI; i < 512 * 512; i += gridDim.x * 512) { const int n = i >> 9, k = i & 511, g = n >> 7;
        const float v = ((k >> 7) == g) ? wsrc[(g * 128 + (k & 127)) * 128 + (n & 127)] : 0.f; wp[i] = (bf16_t)f2bf(v); }
}

__device__ __forceinline__ void phase_norm(const float* xin, const float* g, const float* modl, int shoff, int scoff, bf16_t* out, const int WV) {
    const int TI = fresh_tid(WV);
    const int lane = TI & 63, wave = TI >> 6;
    for (int r = blockIdx.x * 8 + wave; r < MROWS; r += gridDim.x * 8) {
        const f32x4* xp = (const f32x4*)(xin + (size_t)r * DM); f32x4 v[8]; float ssq = 0.f;
#pragma unroll
        for (int j = 0; j < 8; ++j) { v[j] = xp[j * 64 + lane]; ssq += v[j][0] * v[j][0] + v[j][1] * v[j][1] + v[j][2] * v[j][2] + v[j][3] * v[j][3]; }
        ssq = wave_sum(ssq);
        const float rinv = rsqrtf(ssq * (1.f / DM) + EPS);
        const float* mb = modl + (size_t)(r >> 11) * 12288;
#pragma unroll
        for (int j = 0; j < 8; ++j) { const int col = j * 256 + lane * 4;
            const f32x4 g4 = *(const f32x4*)(g + col), sc = *(const f32x4*)(mb + scoff + col), sh = *(const f32x4*)(mb + shoff + col);
            f32x4 y;
#pragma unroll
            for (int e = 0; e < 4; ++e) y[e] = (v[j][e] * rinv * g4[e]) * (1.f + sc[e]) + sh[e];
            uint2 o; o.x = pk2(y[0], y[1]); o.y = pk2(y[2], y[3]);
            *(uint2*)(out + (size_t)r * DM + col) = o; }
    }
}

__constant__ double kRevPerPos[24] = {0.15915494309189535, 0.0700865215877985, 0.03086376340470123, 0.013591370636193905, 0.005985185712713705, 0.002635675898667414, 0.001160663641240061, 0.0005111175045375439, 0.00022507907903927653, 9.911730936901935e-05, 4.364795279280289e-05, 1.9221100684944863e-05, 8.464330808241401e-06, 3.727408601915352e-06, 1.6414262627950345e-06, 7.228293068832865e-07, 0.15915494309189535, 0.03086376340470123, 0.005985185712713705, 0.001160663641240061, 0.00022507907903927653, 4.364795279280289e-05, 8.464330808241401e-06, 1.6414262627950345e-06};
__device__ __forceinline__ void rmsrope128(bf16_t* p, bool active, const float* g16, int sub, const float* cs) {
    float v[16];
    if (active) { unpack8(*(const uint4*)p, v); unpack8(*(const uint4*)(p + 8), v + 8); }
    else {
#pragma unroll
        for (int i = 0; i < 16; ++i) v[i] = 0.f; }
    float ssq = 0.f;
#pragma unroll
    for (int i = 0; i < 16; ++i) ssq += v[i] * v[i];
    ssq += __shfl_xor(ssq, 1); ssq += __shfl_xor(ssq, 2); ssq += __shfl_xor(ssq, 4);
    const float rinv = rsqrtf(ssq * (1.f / 128.f) + EPS);
#pragma unroll
    for (int i = 0; i < 16; ++i) v[i] = v[i] * rinv * g16[i];
#pragma unroll
    for (int i = 0; i < 16; ++i) { const float o = __shfl_xor(v[i], 1); const float c = cs[2 * i], s = cs[2 * i + 1];
        if (sub == 0) v[i] = v[i] * c - o * s; else if (sub == 1) v[i] = v[i] * c + o * s; }
    if (active) { uint4 o0, o1; o0.x = pk2(v[0], v[1]); o0.y = pk2(v[2], v[3]); o0.z = pk2(v[4], v[5]); o0.w = pk2(v[6], v[7]);
        o1.x = pk2(v[8], v[9]); o1.y = pk2(v[10], v[11]); o1.z = pk2(v[12], v[13]); o1.w = pk2(v[14], v[15]);
        *(uint4*)p = o0; *(uint4*)(p + 8) = o1; }
}
__device__ __forceinline__ void rope64(bf16_t* p, bool active, int sub, const float* cs) {
    float v[8];
    if (active) unpack8(*(const uint4*)p, v);
    else {
#pragma unroll
        for (int i = 0; i < 8; ++i) v[i] = 0.f; }
#pragma unroll
    for (int i = 0; i < 8; ++i) { const float o = __shfl_xor(v[i], 1); const float c = cs[2 * i], s = cs[2 * i + 1];
        if (sub == 0) v[i] = v[i] * c - o * s; else if (sub == 1) v[i] = v[i] * c + o * s; }
    if (active) { uint4 o0; o0.x = pk2(v[0], v[1]); o0.y = pk2(v[2], v[3]); o0.z = pk2(v[4], v[5]); o0.w = pk2(v[6], v[7]); *(uint4*)p = o0; }
}
__device__ __forceinline__ void phase_post(const Args& a, int l, unsigned char* lds, const int WV) {
    const int TI = fresh_tid(WV);
    const int lane = TI & 63, wave = TI >> 6;
    float* cs = (float*)lds + wave * 64;
    bf16_t* ocat = (bf16_t*)(a.ws + WS_OCAT); bf16_t* kn = (bf16_t*)(a.ws + WS_KN); bf16_t* qi = (bf16_t*)(a.ws + WS_QI); bf16_t* ki = (bf16_t*)(a.ws + WS_KI);
    const int* pos = (const int*)a.in[I_POS];
    const int sub = lane & 7, hd = lane >> 3;
    float gq[16], gk[16];
#pragma unroll
    for (int i = 0; i < 16; ++i) { gq[i] = a.in[I_GQ][l * 128 + sub * 16 + i]; gk[i] = a.in[I_GK][l * 128 + sub * 16 + i]; }
    for (int r = blockIdx.x * 8 + wave; r < MROWS; r += gridDim.x * 8) {
        const int ps = pos[r];
        if (lane < 24) {
            double rev = (double)ps * kRevPerPos[lane]; rev -= rint(rev); const float fr = (float)rev;
            cs[lane * 2] = __builtin_amdgcn_cosf(fr); cs[lane * 2 + 1] = __builtin_amdgcn_sinf(fr); }
        LDS_FENCE();
        rmsrope128(ocat + (size_t)r * 2048 + hd * 128 + sub * 16, true, gq, sub, cs);
        rmsrope128(kn + (size_t)r * 128 + sub * 16, lane < 8, gk, sub, cs);
        rope64(qi + (size_t)r * 512 + hd * 64 + sub * 8, true, sub, cs + 32);
        rope64(ki + (size_t)r * 64 + sub * 8, lane < 8, sub, cs + 32);
        LDS_FENCE();
    }
}

__device__ __forceinline__ void s5_unit(const Args& a, int l, int b, int g, unsigned char* lds, const int WV) {
    const int TI = fresh_tid(WV);
    const int lane = TI & 63, wave = __builtin_amdgcn_readfirstlane(TI >> 6), p = lane;
    float* E = (float*)lds;
    float* ust = (float*)(lds + 16384 + wave * 4096);
    bf16_t* sst = (bf16_t*)(lds + 49152 + wave * 4352);
    const bf16_t* U = (const bf16_t*)(a.ws + WS_U); bf16_t* Y = (bf16_t*)(a.ws + WS_Y);
    const int gp = (l * 32 + g) * 64 + p;
    const float are = a.in[I_ARE][gp], aim = a.in[I_AIM][gp], dt = expf(a.in[I_LOGDT][l * 32 + g]);
    const float mag = expf(are * dt);
    float ang = aim * dt; { const float n = rintf(ang * 0.15915494309189535f); ang = fmaf(-n, 6.28318548202514648f, ang); ang = fmaf(n, 1.7484555e-7f, ang); }
    const float lre = mag * cosf(ang), lim = mag * sinf(ang);
    float Bre[16], Bim[16];
    { const float nr = lre - 1.f, ni = lim, den = 1.f / (are * are + aim * aim); const float cr = (nr * are + ni * aim) * den, ci = (ni * are - nr * aim) * den;
#pragma unroll
        for (int j = 0; j < 16; ++j) { const float br = a.in[I_BRE][(size_t)gp * 16 + j], bi = a.in[I_BIM][(size_t)gp * 16 + j]; Bre[j] = cr * br - ci * bi; Bim[j] = cr * bi + ci * br; } }
    bf16x8 Cf[4];
    { const int i = lane & 15;
#pragma unroll
        for (int ks = 0; ks < 4; ++ks)
#pragma unroll
            for (int j = 0; j < 8; ++j) { const int k = ks * 32 + (lane >> 4) * 8 + j, pp = k >> 1; const size_t ci = ((size_t)(l * 32 + g) * 16 + i) * 64 + pp;
                const float v = (k & 1) ? -a.in[I_CIM][ci] : a.in[I_CRE][ci]; Cf[ks][j] = (short)f2bf(v); } }
    const float dsk = a.in[I_DSKIP][l * 512 + g * 16 + (lane & 15)];
#define S5_STEP(t_) do { float br0 = 0.f, br1 = 0.f, bi0 = 0.f, bi1 = 0.f; \
        _Pragma("unroll") for (int k_ = 0; k_ < 8; ++k_) { const unsigned w_ = (unsigned)__builtin_amdgcn_readlane((int)upk[k_], (t_)); \
            const float ul_ = __uint_as_float(w_ << 16), uh_ = __uint_as_float(w_ & 0xffff0000u); \
            br0 = fmaf(Bre[2 * k_], ul_, br0); bi0 = fmaf(Bim[2 * k_], ul_, bi0); br1 = fmaf(Bre[2 * k_ + 1], uh_, br1); bi1 = fmaf(Bim[2 * k_ + 1], uh_, bi1); } \
        const float nre_ = lre * sre - lim * sim + (br0 + br1), nim_ = lre * sim + lim * sre + (bi0 + bi1); sre = nre_; sim = nim_; } while (0)
#pragma unroll 1
    for (int cc = 0; cc < 4; ++cc) {
        const int chunk = wave * 4 + cc, t0 = chunk * 64;
        unsigned upk[8];
        { const bf16_t* up = U + (size_t)(b * 2048 + t0 + lane) * 512 + g * 16; const uint4 q0 = *(const uint4*)up, q1 = *(const uint4*)(up + 8);
            upk[0] = q0.x; upk[1] = q0.y; upk[2] = q0.z; upk[3] = q0.w; upk[4] = q1.x; upk[5] = q1.y; upk[6] = q1.z; upk[7] = q1.w; }
        float sre = 0.f, sim = 0.f;
#pragma unroll 4
        for (int t = 0; t < 64; ++t) S5_STEP(t);
        E[(chunk * 64 + p) * 2] = sre; E[(chunk * 64 + p) * 2 + 1] = sim;
    }
    __syncthreads();
    if (wave == 0) {
        float pr = lre, pi = lim;
#pragma unroll
        for (int q = 0; q < 6; ++q) { const float nr = pr * pr - pi * pi, pp_ = pr * pi, ni = pp_ + pp_; pr = nr; pi = ni; }
        float sr = 0.f, si = 0.f;
        for (int c = 0; c < 32; ++c) { const float er = E[(c * 64 + p) * 2], ei = E[(c * 64 + p) * 2 + 1]; E[(c * 64 + p) * 2] = sr; E[(c * 64 + p) * 2 + 1] = si;
            const float nr = pr * sr - pi * si + er, ni = pr * si + pi * sr + ei; sr = nr; si = ni; }
    }
    __syncthreads();
#pragma unroll 1
    for (int cc = 0; cc < 4; ++cc) {
        const int chunk = wave * 4 + cc, t0 = chunk * 64;
        unsigned upk[8];
        { const bf16_t* up = U + (size_t)(b * 2048 + t0 + lane) * 512 + g * 16; const uint4 q0 = *(const uint4*)up, q1 = *(const uint4*)(up + 8);
            upk[0] = q0.x; upk[1] = q0.y; upk[2] = q0.z; upk[3] = q0.w; upk[4] = q1.x; upk[5] = q1.y; upk[6] = q1.z; upk[7] = q1.w;
            float f[16]; unpack8(q0, f); unpack8(q1, f + 8);
#pragma unroll
            for (int q = 0; q < 4; ++q) *(f32x4*)(ust + lane * 16 + q * 4) = (f32x4){f[q * 4], f[q * 4 + 1], f[q * 4 + 2], f[q * 4 + 3]}; }
        float sre = E[(chunk * 64 + p) * 2], sim = E[(chunk * 64 + p) * 2 + 1];
#pragma unroll 1
        for (int sb = 0; sb < 4; ++sb) {
#pragma unroll 4
            for (int tt = 0; tt < 16; ++tt) { S5_STEP(sb * 16 + tt);
                *(unsigned*)(sst + tt * 136 + 2 * p) = pk2(sre, sim);
            }
            LDS_FENCE();
            f32x4 acc = {0.f, 0.f, 0.f, 0.f};
#pragma unroll
            for (int ks = 0; ks < 4; ++ks) { const bf16x8 af = *(const bf16x8*)(sst + (lane & 15) * 136 + ks * 32 + (lane >> 4) * 8);
                acc = __builtin_amdgcn_mfma_f32_16x16x32_bf16(af, Cf[ks], acc, 0, 0, 0); }
#pragma unroll
            for (int r = 0; r < 4; ++r) { const int t = sb * 16 + (lane >> 4) * 4 + r, i = lane & 15;
                const float y = gelu_tanh(acc[r] + dsk * ust[t * 16 + i]);
                Y[(size_t)(b * 2048 + t0 + t) * 512 + g * 16 + i] = (bf16_t)f2bf(y); }
            LDS_FENCE();
        }
    }
    __syncthreads();
#undef S5_STEP
}

__device__ __forceinline__ void pool_unit(const Args& a, int b, int chunk, unsigned char* lds, const int WV) {
    const int TI = fresh_tid(WV);
    bf16_t* T = (bf16_t*)lds;
    const int t0 = chunk * 64;
    const bf16_t* P = (const bf16_t*)(a.ws + WS_P) + (size_t)b * 2048 * 512; bf16_t* O = (bf16_t*)(a.ws + WS_POOLED) + (size_t)b * 2048 * 512;
    __syncthreads();
    for (int i = TI; i < 80 * 64; i += 512) { const int r = i >> 6, c8 = i & 63, t = t0 - 16 + r;
        uint4 v = make_uint4(0u, 0u, 0u, 0u); if (t >= 0) v = *(const uint4*)(P + (size_t)t * 512 + c8 * 8);
        *(uint4*)(T + r * 512 + c8 * 8) = v; }
    __syncthreads();
    const int c = TI, w = 2 << (c >> 7);
    float s = 0.f;
    for (int k = 1; k <= w; ++k) s += bf1(T[(16 - k) * 512 + c]);
#pragma unroll 4
    for (int t = 0; t < 64; ++t) { const float pv = bf1(T[(16 + t) * 512 + c]); s += pv; s -= bf1(T[(16 + t - w) * 512 + c]);
        const int tt = t0 + t + 1; const float mean = s / (float)(tt < w ? tt : w); O[(size_t)(t0 + t) * 512 + c] = (bf16_t)f2bf(mean - pv); }
}

__device__ __forceinline__ unsigned sortkey(float x) { const unsigned u = __float_as_uint(x); return (u & 0x80000000u) ? ~u : (u | 0x80000000u); }
__device__ __forceinline__ void dsa_unit(const Args& a, int b, int tq, unsigned char* lds, const int WV, bf16_t* obase, const int ostride) {
    const int TI = fresh_tid(WV);
    int tid = TI;
    int lane = tid & 63; const int wave = WV;
    float* sc = (float*)lds;
    unsigned short* sel = (unsigned short*)(lds + 131072);
    float* wis = (float*)(lds + 131072 + 8192);
    bf16_t* ocat = (bf16_t*)(a.ws + WS_OCAT); const bf16_t* Kn = (const bf16_t*)(a.ws + WS_KN); const bf16_t* V = (const bf16_t*)(a.ws + WS_V);
    const bf16_t* QI = (const bf16_t*)(a.ws + WS_QI); const bf16_t* KI = (const bf16_t*)(a.ws + WS_KI); const float* WI = (const float*)(a.ws + WS_WI);
    const int t0 = tq * 16, row0 = b * 2048 + t0, limit = ((t0 >> 6) + 1) << 6, nkt = limit >> 5, nsel = limit < 256 ? limit : 256;
    __syncthreads();
    if (tid < 128) wis[tid] = WI[(size_t)row0 * 8 + tid];
    __syncthreads();
    {
        const int g = lane >> 5, c32 = lane & 31;
        bf16x8 Af[4][4];
#pragma unroll
        for (int rb = 0; rb < 4; ++rb) { const int R = rb * 32 + c32; const bf16_t* qp = QI + (size_t)(row0 + (R >> 3)) * 512 + (R & 7) * 64 + g * 8;
#pragma unroll
            for (int s = 0; s < 4; ++s) Af[rb][s] = *(const bf16x8*)(qp + s * 16); }
        bf16x8 Bn[4];
        { const bf16_t* kp0 = KI + (size_t)(b * 2048 + wave * 32 + c32) * 64 + g * 8;
#pragma unroll
            for (int s = 0; s < 4; ++s) Bn[s] = *(const bf16x8*)(kp0 + s * 16); }
#pragma unroll 1
        for (int kt = wave; kt < nkt; kt += 8) {
            bf16x8 Bf[4];
#pragma unroll
            for (int s = 0; s < 4; ++s) Bf[s] = Bn[s];
            if (kt + 8 < nkt) { const bf16_t* kp = KI + (size_t)(b * 2048 + (kt + 8) * 32 + c32) * 64 + g * 8;
#pragma unroll
                for (int s = 0; s < 4; ++s) Bn[s] = *(const bf16x8*)(kp + s * 16); }
#pragma unroll
            for (int rb = 0; rb < 4; ++rb) {
                f32x16 acc;
#pragma unroll
                for (int i = 0; i < 16; ++i) acc[i] = 0.f;
#pragma unroll
                for (int s = 0; s < 4; ++s) acc = __builtin_amdgcn_mfma_f32_32x32x16_bf16(Af[rb][s], Bf[s], acc, 0, 0, 0);
#pragma unroll
                for (int j = 0; j < 4; ++j) { const int q = rb * 4 + j; const f32x4 w4 = *(const f32x4*)(wis + q * 8 + 4 * g);
                    float sp = fmaxf(acc[4 * j], 0.f) * w4[0] + fmaxf(acc[4 * j + 1], 0.f) * w4[1] + fmaxf(acc[4 * j + 2], 0.f) * w4[2] + fmaxf(acc[4 * j + 3], 0.f) * w4[3];
                    sp += __shfl_xor(sp, 32);
                    if (g == 0) sc[q * 2048 + kt * 32 + c32] = sp; }
            }
        }
    }
    __syncthreads();
    lane = fresh_tid(WV) & 63;
    const unsigned long long ltmask = (1ull << lane) - 1ull;
    for (int qq = 0; qq < 2; ++qq) {
        const int q = wave * 2 + qq; unsigned short* sq = sel + q * 256;
        if (limit <= 256) { for (int j = lane; j < limit; j += 64) sq[j] = (unsigned short)j; }
        else {
            unsigned key[32];
#pragma unroll
            for (int j = 0; j < 32; ++j) { const int idx = j * 64 + lane; key[j] = (idx < limit) ? sortkey(sc[q * 2048 + idx]) : 0u; }
            unsigned T = 0u;
            for (int bit = 31; bit >= 0; --bit) { const unsigned cand = T | (1u << bit); int cnt = 0;
#pragma unroll
                for (int j = 0; j < 32; ++j) cnt += __popcll(__ballot(key[j] >= cand));
                if (cnt >= 256) T = cand; }
            int cgt = 0;
#pragma unroll
            for (int j = 0; j < 32; ++j) cgt += __popcll(__ballot(key[j] > T));
            const int need = 256 - cgt; int ob = 0, tb = 0;
#pragma unroll
            for (int j = 0; j < 32; ++j) { const bool gt = key[j] > T, eq = key[j] == T; const unsigned long long me = __ballot(eq);
                const int pe = tb + __popcll(me & ltmask); const bool take = gt || (eq && pe < need); const unsigned long long mt = __ballot(take);
                if (take) sq[ob + __popcll(mt & ltmask)] = (unsigned short)(j * 64 + lane);
                ob += __popcll(mt); tb += __popcll(me); }
        }
    }
    __syncthreads();
    lane = fresh_tid(WV) & 63;
    float* Pw = (float*)lds + wave * 2048;
    const int g4 = lane >> 4, hh = lane & 15;
#pragma unroll 1
    for (int qq = 0; qq < 2; ++qq) {
        const int q = wave * 2 + qq; const size_t row = (size_t)(row0 + q); const unsigned short* sq = sel + q * 256;
        bf16x8 Qf[4];
#pragma unroll
        for (int s = 0; s < 4; ++s) Qf[s] = *(const bf16x8*)(ocat + row * 2048 + (hh & 7) * 128 + g4 * 8 + s * 32);
        float lg[16][4];
#pragma unroll
        for (int kb = 0; kb < 16; ++kb) {
            if (kb * 16 < nsel) {
                const int idx = sq[kb * 16 + hh]; const bf16_t* kp = Kn + (size_t)(b * 2048 + idx) * 128 + g4 * 8;
                f32x4 c = {0.f, 0.f, 0.f, 0.f};
#pragma unroll
                for (int s = 0; s < 4; ++s) c = __builtin_amdgcn_mfma_f32_16x16x32_bf16(*(const bf16x8*)(kp + s * 32), Qf[s], c, 0, 0, 0);
#pragma unroll
                for (int r = 0; r < 4; ++r) lg[kb][r] = c[r] * 0.08838834764831845f;
                if ((kb & 3) == 3) __builtin_amdgcn_sched_barrier(0);
            } else {
#pragma unroll
                for (int r = 0; r < 4; ++r) lg[kb][r] = -1e30f;
            }
        }
        float mx = -1e30f;
#pragma unroll
        for (int kb = 0; kb < 16; ++kb)
#pragma unroll
            for (int r = 0; r < 4; ++r) mx = fmaxf(mx, lg[kb][r]);
        mx = fmaxf(mx, __shfl_xor(mx, 16)); mx = fmaxf(mx, __shfl_xor(mx, 32));
        float sum = 0.f;
#pragma unroll
        for (int kb = 0; kb < 16; ++kb)
#pragma unroll
            for (int r = 0; r < 4; ++r) { const float e = (kb * 16 < nsel) ? __expf(lg[kb][r] - mx) : 0.f; lg[kb][r] = e; sum += e; }
        sum += __shfl_xor(sum, 16); sum += __shfl_xor(sum, 32);
        const float inv = 1.f / sum;
        if (hh < 8) {
#pragma unroll
            for (int kb = 0; kb < 16; ++kb)
                if (kb * 16 < nsel) {
#pragma unroll
                    for (int r = 0; r < 4; ++r) Pw[(kb * 16 + g4 * 4 + r) * 8 + hh] = lg[kb][r] * inv; }
        }
        LDS_FENCE();
        float o[8][8];
#pragma unroll
        for (int h = 0; h < 8; ++h)
#pragma unroll
            for (int d = 0; d < 8; ++d) o[h][d] = 0.f;
        const bf16_t* Vb = V + (size_t)b * 2048 * 128 + hh * 8;
        uint4 vq[8], vn[8];
#pragma unroll
        for (int jj = 0; jj < 8; ++jj) { const int idx = sq[jj * 4 + g4]; vq[jj] = *(const uint4*)(Vb + (size_t)idx * 128); }
#pragma unroll 1
        for (int j0 = 0; j0 < nsel; j0 += 32) {
            if (j0 + 32 < nsel) {
#pragma unroll
                for (int jj = 0; jj < 8; ++jj) { const int idx = sq[j0 + 32 + jj * 4 + g4]; vn[jj] = *(const uint4*)(Vb + (size_t)idx * 128); }
            }
#pragma unroll
            for (int jj = 0; jj < 8; ++jj) { const int slot = j0 + jj * 4 + g4;
                const f32x4 pa = *(const f32x4*)(Pw + slot * 8), pb = *(const f32x4*)(Pw + slot * 8 + 4);
                float v[8]; unpack8(vq[jj], v);
#pragma unroll
                for (int h = 0; h < 4; ++h)
#pragma unroll
                    for (int d = 0; d < 8; ++d) { o[h][d] = fmaf(pa[h], v[d], o[h][d]); o[4 + h][d] = fmaf(pb[h], v[d], o[4 + h][d]); } }
#pragma unroll
            for (int jj = 0; jj < 8; ++jj) vq[jj] = vn[jj];
        }
        { const bool b4 = (lane & 16) != 0, b5 = (lane & 32) != 0;
            float kp[4][8];
#pragma unroll
            for (int i = 0; i < 4; ++i)
#pragma unroll
                for (int d = 0; d < 8; ++d) { const float snd = b4 ? o[i][d] : o[4 + i][d]; const float rcv = __shfl_xor(snd, 16); kp[i][d] = (b4 ? o[4 + i][d] : o[i][d]) + rcv; }
#pragma unroll
            for (int i = 0; i < 2; ++i) { float fin[8];
#pragma unroll
                for (int d = 0; d < 8; ++d) { const float snd = b5 ? kp[i][d] : kp[2 + i][d]; const float rcv = __shfl_xor(snd, 32); fin[d] = (b5 ? kp[2 + i][d] : kp[i][d]) + rcv; }
                const int head = (b4 ? 4 : 0) + (b5 ? 2 : 0) + i;
                uint4 ov; ov.x = pk2(fin[0], fin[1]); ov.y = pk2(fin[2], fin[3]); ov.z = pk2(fin[4], fin[5]); ov.w = pk2(fin[6], fin[7]);
                *(uint4*)(obase + row * ostride + head * 128 + hh * 8) = ov; }
        }
        LDS_FENCE();
    }
}

__device__ __forceinline__ void phase_fix(const Args& a, int l, const int WV) {
    const int TI = fresh_tid(WV);
    const float* SA = (const float*)(a.ws + WS_SA); const float* SB = (const float*)(a.ws + WS_SB); bf16_t* act = (bf16_t*)(a.ws + WS_R2);
    const float* cw = a.in[I_CONVW] + (size_t)l * 3 * DFF; const float* cb = a.in[I_CONVB] + (size_t)l * DFF;
    const int total = 512 * 2 * DFF;
    for (int i = blockIdx.x * 512 + TI; i < total; i += gridDim.x * 512) {
        const int ch = i % DFF, rb = i / DFF, rr = rb & 1, blk = rb >> 1, r = blk * 64 + rr, t = r & 2047;
        const float a0 = SA[((size_t)blk * 4 + 2 + rr) * DFF + ch];
        float am1, am2;
        if (rr == 0) { am1 = (t >= 1) ? SA[((size_t)(blk - 1) * 4 + 1) * DFF + ch] : 0.f; am2 = (t >= 2) ? SA[((size_t)(blk - 1) * 4 + 0) * DFF + ch] : 0.f; }
        else { am1 = SA[((size_t)blk * 4 + 2) * DFF + ch]; am2 = (t >= 2) ? SA[((size_t)(blk - 1) * 4 + 1) * DFF + ch] : 0.f; }
        const float cv = cb[ch] + cw[ch] * am2 + cw[DFF + ch] * am1 + cw[2 * DFF + ch] * a0;
        act[(size_t)r * DFF + ch] = (bf16_t)f2bf(siluf_(cv) * SB[((size_t)blk * 2 + rr) * DFF + ch]);
    }
}

__device__ __forceinline__ void run_phase(const Args& a, int ph, unsigned char* lds, const int WV, const bool dummy) {
    unsigned char* ws = a.ws;
    LAS unsigned char* ldsl = (LAS unsigned char*)lds;
    const int G = gridDim.x, bx = blockIdx.x;
#ifndef DBG_NOADA
    if (ph == 0) { phase_ada(a, lds, WV); return; }
#else
    if (ph == 0) return;
#endif
    const int l = (ph - 1) / 10, sp = (ph - 1) % 10;
    const float* modl = (const float*)(ws + WS_MOD) + (size_t)l * 16 * 12288;
    const float* xin = (l == 0) ? a.in[I_X] : a.out;
#ifdef DBG_SP
    if (sp != DBG_SP) return;
#endif
    switch (sp) {
    case 0: phase_cvt(a, l, lds, WV); phase_norm(xin, a.in[I_GN1] + l * DM, modl, 0, 2048, (bf16_t*)(ws + WS_R1), WV); break;
    case 1: {
        pg8::Gemm g{(const bf16_t*)(ws + WS_R1), (const bf16_t*)(ws + W_1CAT), MROWS, N1, DM, DM, DM, 1 << 30, 0}; pg8::StaticOrder S; S.init(MROWS, N1, G, bx);
        Epi1 E{(bf16_t*)(ws + WS_OCAT), (bf16_t*)(ws + WS_KN), (bf16_t*)(ws + WS_V), (bf16_t*)(ws + WS_QI), (bf16_t*)(ws + WS_KI), (bf16_t*)(ws + WS_U), (bf16_t*)(ws + WS_P), (bf16_t*)(ws + WS_R2),
               (float*)(ws + WS_WI), a.in[I_BGATE] + (size_t)l * 3 * DM};
        pg8::gemm_phase<Epi1, pg8::StaticOrder>(ldsl, g, S, E, WV); } break;
    case 2:
        if (!dummy) phase_post(a, l, lds, WV);
        __syncthreads();
        for (int u = bx; u < 512; u += G) s5_unit(a, l, u >> 5, u & 31, lds, WV);
        for (int u = bx; u < 512; u += G) pool_unit(a, u >> 5, u & 31, lds, WV);
        break;
    case 3: {
#ifndef DBG_NO_DSA
        for (int u = bx; u < 2048; u += G) { const int w = u & 255, i = u >> 8, b = w & 15, s = w >> 4; const int tq = (i & 1) ? (i * 16 + 15 - s) : (i * 16 + s); dsa_unit(a, b, tq, lds, WV, dummy ? (bf16_t*)(ws + WS_R1 + 64 * MiB) : (bf16_t*)(ws + WS_OCAT), dummy ? 1024 : 2048); }
        __syncthreads();
#endif
#ifndef DBG_DSA_ONLY
        { pg8::Gemm g{(const bf16_t*)(ws + WS_Y), (const bf16_t*)(ws + W_GLU), MROWS, 1024, 512, 512, 512, 2, WS_POOLED - WS_Y}; pg8::StaticOrder S; S.init(MROWS, 1024, G, bx);
          EpiGluPool E{(const bf16_t*)(ws + WS_Y), a.in[I_PSCALE] + l * 512, (bf16_t*)(ws + WS_OCAT)}; pg8::gemm_phase<EpiGluPool, pg8::StaticOrder>(ldsl, g, S, E, WV); }
#endif
        } break;
    case 4: {
        pg8::Gemm g{(const bf16_t*)(ws + WS_OCAT), (const bf16_t*)(ws + W_P), MROWS, DM, DM, DM, DM, 1 << 30, 0}; pg8::StaticOrder S; S.init(MROWS, DM, G, bx);
        EpiMerge E{(const bf16_t*)(ws + WS_R2), (bf16_t*)(ws + WS_R1)}; pg8::gemm_phase<EpiMerge, pg8::StaticOrder>(ldsl, g, S, E, WV); } break;
    case 5: {
        pg8::Gemm g{(const bf16_t*)(ws + WS_R1), (const bf16_t*)(ws + W_OUT), MROWS, DM, DM, DM, DM, 1 << 30, 0}; pg8::StaticOrder S; S.init(MROWS, DM, G, bx);
        EpiRes E{xin, dummy ? (float*)(ws + WS_OCAT) : a.out, modl + 4096}; pg8::gemm_phase<EpiRes, pg8::StaticOrder>(ldsl, g, S, E, WV); } break;
    case 6: phase_norm(a.out, a.in[I_GN2] + l * DM, modl, 6144, 8192, (bf16_t*)(ws + WS_R1), WV); break;
    case 7: {
        pg8::Gemm g{(const bf16_t*)(ws + WS_R1), (const bf16_t*)(ws + W_UP), MROWS, 2 * DFF, DM, DM, DM, 1 << 30, 0}; pg8::StaticOrder S; S.init(MROWS, 2 * DFF, G, bx);
        EpiUp E{(bf16_t*)(ws + WS_R2), (float*)(ws + WS_SA), (float*)(ws + WS_SB), a.in[I_CONVW] + (size_t)l * 3 * DFF, a.in[I_CONVB] + (size_t)l * DFF};
        pg8::gemm_phase<EpiUp, pg8::StaticOrder>(ldsl, g, S, E, WV); } break;
    case 8: phase_fix(a, l, WV); break;
    case 9: {
        pg8::Gemm g{(const bf16_t*)(ws + WS_R2), (const bf16_t*)(ws + W_DOWN), MROWS, DM, DFF, DFF, DFF, 1 << 30, 0}; pg8::StaticOrder S; S.init(MROWS, DM, G, bx);
        EpiRes E{a.out, dummy ? (float*)(ws + WS_OCAT) : a.out, modl + 10240}; pg8::gemm_phase<EpiRes, pg8::StaticOrder>(ldsl, g, S, E, WV); } break;
    }
}

__device__ __forceinline__ void grid_bar(unsigned* ctr, unsigned target, int wave_id) {
    asm volatile("s_waitcnt vmcnt(0) lgkmcnt(0)" ::: "memory");
    __syncthreads();
    if (wave_id == 0) {
        const int l = (int)__builtin_amdgcn_mbcnt_hi(~0u, __builtin_amdgcn_mbcnt_lo(~0u, 0u));
        if (l == 0) {
            __builtin_amdgcn_fence(__ATOMIC_RELEASE, "agent");
            asm volatile("s_waitcnt vmcnt(0)" ::: "memory");
            (void)__hip_atomic_fetch_add(ctr, 1u, __ATOMIC_RELAXED, __HIP_MEMORY_SCOPE_AGENT);
            unsigned sp = 0u;
            while (__hip_atomic_load(ctr, __ATOMIC_RELAXED, __HIP_MEMORY_SCOPE_AGENT) < target) { __builtin_amdgcn_s_sleep(1); if (++sp > (1u << 22)) break; }
            __builtin_amdgcn_fence(__ATOMIC_ACQUIRE, "agent");
            asm volatile("s_waitcnt vmcnt(0)" ::: "memory");
        }
    }
    __syncthreads();
}

__global__ void __launch_bounds__(512, 2) mega_fwd(Args a) {
    extern __shared__ __attribute__((aligned(16))) unsigned char lds[];
    cg::grid_group grid = cg::this_grid();
    const int wave_id = __builtin_amdgcn_readfirstlane((int)(threadIdx.x >> 6));
    const int ph_lo = a.ph_lo, ph_hi = a.ph_hi;
    unsigned nbar = 0u;
    for (int ph = ph_lo; ph < ph_hi; ++ph) {
        const __attribute__((address_space(4))) Args* kp = (const __attribute__((address_space(4))) Args*)__builtin_amdgcn_kernarg_segment_ptr();
        asm volatile("" : "+s"(kp));
        Args la;
#pragma unroll
        for (int i = 0; i < 31; ++i) la.in[i] = (const float*)(const __attribute__((address_space(1))) float*)kp->in[i];
        la.ws = (unsigned char*)(__attribute__((address_space(1))) unsigned char*)kp->ws;
        la.out = (float*)(__attribute__((address_space(1))) float*)kp->out;
        la.ph_lo = ph_lo; la.ph_hi = ph_hi;
#ifdef REP_MASK
        if (ph > 0 && ((REP_MASK >> ((ph - 1) % 10)) & 1)) { run_phase(la, ph, lds, wave_id, true); grid.sync(); }
#endif
        run_phase(la, ph, lds, wave_id, false);
        if (ph + 1 < ph_hi) {
            if (ph == ph_lo) grid.sync();
            else { ++nbar; grid_bar((unsigned*)la.ws, nbar * gridDim.x, wave_id); }
        }
    }
}

extern "C" void kernel_launch(void* const* d_in, const int* in_sizes, int n_in, void* d_out, int out_size, void* d_ws, size_t ws_size, hipStream_t stream) {
    static int grid = 0;
    if (grid == 0) {
        int dev = 0, cus = 0, per_cu = 0;
        if (n_in != 31 || ws_size < WS_END) { fprintf(stderr, "kernel_launch: unexpected n_in %d / ws %zu\n", n_in, ws_size); grid = -1; return; }
        hipGetDevice(&dev); hipDeviceGetAttribute(&cus, hipDeviceAttributeMultiprocessorCount, dev);
        if (hipFuncSetAttribute((const void*)mega_fwd, hipFuncAttributeMaxDynamicSharedMemorySize, LDS_BYTES) != hipSuccess) { fprintf(stderr, "kernel_launch: hipFuncSetAttribute failed\n"); grid = -1; return; }
        if (hipOccupancyMaxActiveBlocksPerMultiprocessor(&per_cu, (const void*)mega_fwd, 512, LDS_BYTES) != hipSuccess || per_cu < 1) { fprintf(stderr, "kernel_launch: occupancy query says %d blocks/CU\n", per_cu); per_cu = 1; }
        (void)hipGetLastError();
        grid = cus > 0 ? cus : 256;
    }
    if (grid < 0) return;
    if (hipMemsetAsync(d_ws, 0, 256, stream) != hipSuccess) { fprintf(stderr, "kernel_launch: memset of the barrier word failed\n"); return; }
    Args a{};
    for (int i = 0; i < 31; ++i) a.in[i] = (const float*)d_in[i];
    a.out = (float*)d_out; a.ws = (unsigned char*)d_ws;
#if MK_PER_PHASE
    for (int ph = 0; ph < NPHASE; ++ph) {
        a.ph_lo = ph; a.ph_hi = ph + 1;
        void* args[] = {&a};
        hipError_t e = hipLaunchCooperativeKernel((const void*)mega_fwd, dim3(grid), dim3(512), args, LDS_BYTES, stream);
        if (e != hipSuccess) { fprintf(stderr, "kernel_launch: launch of phase %d failed: %s\n", ph, hipGetErrorString(e)); break; }
    }
#else
    a.ph_lo = 0; a.ph_hi = NPHASE;
    void* args[] = {&a};
    hipError_t e = hipLaunchCooperativeKernel((const void*)mega_fwd, dim3(grid), dim3(512), args, LDS_BYTES, stream);
    if (e != hipSuccess) fprintf(stderr, "kernel_launch: cooperative launch failed: %s (grid %d)\n", hipGetErrorString(e), grid);
#endif
}
```

```cpp
#include <hip/hip_runtime.h>
#include <hip/hip_cooperative_groups.h>
#include <cstdio>
#include <cstdint>
namespace cg = cooperative_groups;

#ifndef MK_PER_PHASE
#define MK_PER_PHASE 0
#endif

typedef unsigned short bf16_t;
typedef short bf16x8 __attribute__((ext_vector_type(8)));
typedef float f32x4 __attribute__((ext_vector_type(4)));
typedef float f32x2 __attribute__((ext_vector_type(2)));
typedef float f32x16 __attribute__((ext_vector_type(16)));
#define LAS __attribute__((address_space(3)))

constexpr int BATCH = 16, SEQ = 2048, DM = 2048, MROWS = BATCH * SEQ, DIN = 2888, DFF = 5504;
constexpr int N1 = 9216;
constexpr float EPS = 1e-6f;
constexpr int NPHASE = 21;

constexpr size_t MiB = 1u << 20;
constexpr size_t WS_MOD = 1 * MiB;
constexpr size_t WS_WI = 3 * MiB;
constexpr size_t WS_W = 4 * MiB;
constexpr size_t W_1CAT = WS_W, W_P = WS_W + 36 * MiB, W_OUT = WS_W + 44 * MiB, W_UP = WS_W + 52 * MiB, W_DOWN = WS_W + 95 * MiB,
                 W_GLU = WS_W + 116 * MiB + MiB / 2, W_POOL = WS_W + 117 * MiB;
constexpr size_t WS_R1 = 122 * MiB;
constexpr size_t WS_Y = WS_R1, WS_POOLED = WS_R1 + 32 * MiB;
constexpr size_t WS_R2 = 250 * MiB;
constexpr size_t WS_OCAT = 634 * MiB;
constexpr size_t WS_SA = WS_OCAT, WS_SB = WS_OCAT + 44 * MiB;
constexpr size_t WS_KN = 762 * MiB, WS_V = 770 * MiB, WS_QI = 778 * MiB, WS_KI = 810 * MiB, WS_U = 814 * MiB, WS_P = 846 * MiB, WS_END = 878 * MiB;
constexpr int LDS_BYTES = 147456;

__device__ __forceinline__ unsigned f2bf(float f) { unsigned u = __float_as_uint(f); return (u + 0x7fffu + ((u >> 16) & 1u)) >> 16; }
__device__ __forceinline__ unsigned pk2(float lo, float hi) { return f2bf(lo) | (f2bf(hi) << 16); }
__device__ __forceinline__ float bflo(unsigned u) { return __uint_as_float(u << 16); }
__device__ __forceinline__ float bfhi(unsigned u) { return __uint_as_float(u & 0xffff0000u); }
__device__ __forceinline__ float bf1(bf16_t b) { return __uint_as_float(((unsigned)b) << 16); }
__device__ __forceinline__ float sigmoidf_(float x) { return 1.f / (1.f + __expf(-x)); }
__device__ __forceinline__ float siluf_(float x) { return x / (1.f + __expf(-x)); }
__device__ __forceinline__ float gelu_tanh(float x) { const float z = 0.7978845608028654f * (x + 0.044715f * x * x * x); const float t = 1.f - 2.f / (1.f + __expf(2.f * z)); return 0.5f * x * (1.f + t); }
__device__ __forceinline__ uint4 pack8(f32x4 a, f32x4 b) { uint4 r; r.x = pk2(a[0], a[1]); r.y = pk2(a[2], a[3]); r.z = pk2(b[0], b[1]); r.w = pk2(b[2], b[3]); return r; }
__device__ __forceinline__ void unpack8(uint4 v, float* f) { f[0] = bflo(v.x); f[1] = bfhi(v.x); f[2] = bflo(v.y); f[3] = bfhi(v.y); f[4] = bflo(v.z); f[5] = bfhi(v.z); f[6] = bflo(v.w); f[7] = bfhi(v.w); }
#define LDS_FENCE() asm volatile("s_waitcnt lgkmcnt(0)" ::: "memory")
__device__ __forceinline__ int fresh_tid(int wv) { int l = (int)__builtin_amdgcn_mbcnt_hi(~0u, __builtin_amdgcn_mbcnt_lo(~0u, 0u)); asm volatile("" : "+v"(l)); return (wv << 6) | l; }

namespace pg8 {
constexpr int BM = 256, BK = 64, HALF = 128, HTB = HALF * BK * 2, STAGE_BYTES = 8 * HTB, NXCD = 8, WGM = 8;
__host__ __device__ __forceinline__ int lds_byte(int r, int c) { const int st = (r >> 4) * 2 + (c >> 5), rr = r & 15, cc = c & 31, ob = rr * 64 + cc * 2; return st * 1024 + (ob ^ (((ob >> 9) & 1) << 5)); }
__host__ __device__ __forceinline__ void stage_rc(int b, int& R, int& C) { const int st = b / 1024, sb = b % 1024, swz = sb ^ (((sb >> 9) & 1) << 5); R = (st >> 1) * 16 + swz / 64; C = (st & 1) * 32 + (swz % 64) / 2; }
__host__ __device__ __forceinline__ int perm32(int rho) { const int n = rho >> 4, i = rho & 15; return 8 * (i >> 2) + 4 * n + (i & 3); }
struct Unit { int pm, pn; };
struct Gemm { const bf16_t* A; const bf16_t* Bt; int M, N, K, lda, ldb; int asplit; size_t aoff; };
struct StaticOrder {
    int nM, nN, nwg, G, c;
    __device__ void init(int M, int N, int G_, int c_) { nM = M / BM; nN = N / BM; nwg = nM * nN; G = G_; c = c_; }
    __device__ bool next(int i, Unit& u) const {
        const long L = (long)i * G + c; if (L >= nwg) return false;
        int wgid = (int)L; { const int q = nwg / NXCD, r = nwg % NXCD, xcd = wgid % NXCD, off = wgid / NXCD; wgid = (xcd < r ? xcd * (q + 1) : r * (q + 1) + (xcd - r) * q) + off; }
        const int nig = WGM * nN, gid = wgid / nig, fm = gid * WGM, gsz = (nM - fm) < WGM ? (nM - fm) : WGM;
        u.pm = fm + ((wgid % nig) % gsz); u.pn = (wgid % nig) / gsz; return true;
    }
};
template <class Epi, class Sched>
__device__ __forceinline__ void gemm_phase(LAS unsigned char* lds, const Gemm g, const Sched& S, const Epi& E, const int WV) {
    const int TI = fresh_tid(WV);
    const int tid = TI, wid = __builtin_amdgcn_readfirstlane(tid >> 6), lane = tid & 63, wr = wid >> 2, wc = wid & 3, fr = lane & 15, fq = lane >> 4;
    const int K = g.K, nt = K / BK;
    unsigned voffA[2], voffB[2];
#pragma unroll
    for (int i = 0; i < 2; ++i) { int R, C; stage_rc(tid * 16 + i * 8192, R, C); const int Rb = Epi::PERM ? ((R & ~31) + perm32(R & 31)) : R;
        voffA[i] = (unsigned)(R * g.lda + C) * 2u; voffB[i] = (unsigned)(Rb * g.ldb + C) * 2u; }
    const size_t kstep = (size_t)(BK * 2);
    const size_t hstepA = (size_t)HALF * g.lda * 2, hstepB = (size_t)HALF * g.ldb * 2;
    const size_t tstepA = 2 * hstepA, tstepB = 2 * hstepB;
    const unsigned ldsw = (unsigned)wid * 1024u;
    const int aoff = lds_byte(wr * 64 + fr, fq * 8), boff = lds_byte(wc * 32 + fr, fq * 8);
#define PG8_SA(b, h) (((b) * 2 + (h)) * HTB)
#define PG8_SB(b, h) ((4 + (b) * 2 + (h)) * HTB)
#define PG8_STAGE(bufoff, gbase, voff) do { _Pragma("unroll") for (int _i = 0; _i < 2; ++_i) \
        __builtin_amdgcn_global_load_lds((const unsigned*)((const char*)(gbase) + (voff)[_i]), (LAS unsigned*)(lds + (bufoff) + ldsw + _i * 8192), 16, 0, 0); } while (0)
#define PG8_LDA(dst, b, h) do { _Pragma("unroll") for (int m = 0; m < 4; ++m) _Pragma("unroll") for (int k = 0; k < 2; ++k) dst[m][k] = *(const LAS bf16x8*)(lds + PG8_SA(b, h) + aoff + m * 2048 + k * 1024); } while (0)
#define PG8_LDB(dst, b, h) do { _Pragma("unroll") for (int n = 0; n < 2; ++n) _Pragma("unroll") for (int k = 0; k < 2; ++k) dst[n][k] = *(const LAS bf16x8*)(lds + PG8_SB(b, h) + boff + n * 2048 + k * 1024); } while (0)
#define PG8_MMA(ai, bj, At, Bt) do { __builtin_amdgcn_s_setprio(1); _Pragma("unroll") for (int m = 0; m < 4; ++m) _Pragma("unroll") for (int n = 0; n < 2; ++n) _Pragma("unroll") for (int k = 0; k < 2; ++k) \
        acc[ai][bj][m][n] = __builtin_amdgcn_mfma_f32_16x16x32_bf16(Bt[n][k], At[m][k], acc[ai][bj][m][n], 0, 0, 0); __builtin_amdgcn_s_setprio(0); } while (0)
#define PG8_WAIT_V(n) asm volatile("s_waitcnt vmcnt(" #n ")" ::: "memory")
#define PG8_WAIT_L(n) asm volatile("s_waitcnt lgkmcnt(" #n ")" ::: "memory")
#define PG8_BAR __builtin_amdgcn_s_barrier()
#define PG8_SCHED __builtin_amdgcn_sched_barrier(0)
#define PG8_ZERO() do { _Pragma("unroll") for (int a_ = 0; a_ < 2; ++a_) _Pragma("unroll") for (int b_ = 0; b_ < 2; ++b_) _Pragma("unroll") for (int m_ = 0; m_ < 4; ++m_) _Pragma("unroll") for (int n_ = 0; n_ < 2; ++n_) acc[a_][b_][m_][n_] = (f32x4){0.f, 0.f, 0.f, 0.f}; } while (0)
    Unit cur, nxt; int ui = 0;
    if (!S.next(0, cur)) return;
    f32x4 acc[2][2][4][2];
    PG8_ZERO();
    bf16x8 At[4][2], B0[2][2], B1[2][2];
    const char* cA = (const char*)g.A + (size_t)cur.pm * tstepA + (cur.pn >= g.asplit ? g.aoff : (size_t)0); const char* cB = (const char*)g.Bt + (size_t)cur.pn * tstepB;
    PG8_STAGE(PG8_SB(0, 0), cB, voffB); PG8_STAGE(PG8_SA(0, 0), cA, voffA); PG8_STAGE(PG8_SB(0, 1), cB + hstepB, voffB); PG8_STAGE(PG8_SA(0, 1), cA + hstepA, voffA);
    if (wr == 1) PG8_BAR;
    PG8_WAIT_V(4); PG8_BAR;
    PG8_STAGE(PG8_SB(1, 0), cB + kstep, voffB); PG8_STAGE(PG8_SA(1, 0), cA + kstep, voffA); PG8_STAGE(PG8_SB(1, 1), cB + hstepB + kstep, voffB);
    PG8_WAIT_V(6); PG8_BAR;
    for (;;) {
        const bool has_next = S.next(ui + 1, nxt);
        const char* nA = has_next ? (const char*)g.A + (size_t)nxt.pm * tstepA + (nxt.pn >= g.asplit ? g.aoff : (size_t)0) : cA; const char* nB = has_next ? (const char*)g.Bt + (size_t)nxt.pn * tstepB : cB;
        for (int t = 0; t < nt; t += 2) {
            const bool last = (t == nt - 2);
            const char* a1 = cA + (size_t)(t + 1) * kstep;
            const char* a2 = last ? nA : cA + (size_t)(t + 2) * kstep; const char* b2 = last ? nB : cB + (size_t)(t + 2) * kstep;
            const char* a3 = a2 + kstep; const char* b3 = b2 + kstep;
            PG8_LDB(B0, 0, 0); PG8_SCHED; PG8_LDA(At, 0, 0); PG8_STAGE(PG8_SA(1, 1), a1 + hstepA, voffA);
            PG8_WAIT_L(8); PG8_BAR; PG8_WAIT_L(0); PG8_MMA(0, 0, At, B0); PG8_BAR; PG8_SCHED;
            PG8_LDB(B1, 0, 1); PG8_STAGE(PG8_SB(0, 0), b2, voffB);
            PG8_BAR; PG8_WAIT_L(0); PG8_MMA(0, 1, At, B1); PG8_BAR;
            PG8_LDA(At, 0, 1); PG8_STAGE(PG8_SA(0, 0), a2, voffA);
            PG8_BAR; PG8_WAIT_L(0); PG8_MMA(1, 0, At, B0); PG8_BAR; PG8_SCHED;
            PG8_STAGE(PG8_SB(0, 1), b2 + hstepB, voffB);
            PG8_WAIT_V(6); PG8_BAR; PG8_MMA(1, 1, At, B1); PG8_BAR;
            PG8_LDB(B0, 1, 0); PG8_SCHED; PG8_LDA(At, 1, 0); PG8_STAGE(PG8_SA(0, 1), a2 + hstepA, voffA);
            PG8_WAIT_L(8); PG8_BAR; PG8_WAIT_L(0); PG8_MMA(0, 0, At, B0); PG8_BAR; PG8_SCHED;
            PG8_LDB(B1, 1, 1); PG8_STAGE(PG8_SB(1, 0), b3, voffB);
            PG8_BAR; PG8_WAIT_L(0); PG8_MMA(0, 1, At, B1); PG8_BAR;
            PG8_LDA(At, 1, 1); PG8_STAGE(PG8_SA(1, 0), a3, voffA);
            PG8_BAR; PG8_WAIT_L(0); PG8_MMA(1, 0, At, B0); PG8_BAR; PG8_SCHED;
            PG8_STAGE(PG8_SB(1, 1), b3 + hstepB, voffB);
            PG8_WAIT_V(6); PG8_BAR; PG8_MMA(1, 1, At, B1); PG8_BAR;
            if constexpr (Epi::SEG) { if (t + 2 == 16 || t + 2 == 24) { E.flush(acc, cur, (t + 2 == 16) ? 0 : 1, wr, wc, fr, fq); PG8_ZERO(); } }
        }
        if constexpr (Epi::SEG) E.flush(acc, cur, 2, wr, wc, fr, fq); else E(acc, cur, wr, wc, fr, fq);
        if (!has_next) break;
        PG8_ZERO();
        cur = nxt; cA = nA; cB = nB; ++ui;
    }
    PG8_WAIT_V(0);
    if (wr == 0) PG8_BAR;
    PG8_BAR;
#undef PG8_SA
#undef PG8_SB
#undef PG8_STAGE
#undef PG8_LDA
#undef PG8_LDB
#undef PG8_MMA
#undef PG8_WAIT_V
#undef PG8_WAIT_L
#undef PG8_BAR
#undef PG8_SCHED
#undef PG8_ZERO
}
}
using pg8::Unit;
typedef const f32x4 (&AccRef)[2][2][4][2];

struct Epi1 {
    static constexpr bool PERM = true, SEG = false;
    bf16_t *ocat, *kn, *vv, *qi, *ki, *u, *p, *gates; float* wi; const float* bgate;
    __device__ __forceinline__ void operator()(AccRef acc, const Unit& un, int wr, int wc, int fr, int fq) const {
        asm volatile("" : "+v"(fr), "+v"(fq));
        const int pn = un.pn, row0 = un.pm * 256 + wr * 64 + fr;
#pragma unroll
        for (int bj = 0; bj < 2; ++bj) {
            const int cit = bj * 128 + wc * 32 + 8 * fq;
            bf16_t* base; int ld; int mode = 0;
            if (pn < 4) { base = ocat + pn * 256 + cit; ld = 2048; }
            else if (pn == 4) { base = (bj == 0 ? kn : vv) + (cit & 127); ld = 128; }
            else if (pn < 7) { base = qi + (pn - 5) * 256 + cit; ld = 512; }
            else if (pn == 7) { base = ki + cit; ld = 64; mode = (cit < 64) ? 0 : ((cit == 64) ? 2 : 3); }
            else if (pn < 10) { base = u + (pn - 8) * 256 + cit; ld = 512; }
            else if (pn < 12) { base = p + (pn - 10) * 256 + cit; ld = 512; }
            else { base = gates; ld = 0; mode = 1; }
            f32x4 b0 = {0.f, 0.f, 0.f, 0.f}, b1 = {0.f, 0.f, 0.f, 0.f};
            if (mode == 1) { b0 = *(const f32x4*)(bgate + (pn - 12) * 256 + cit); b1 = *(const f32x4*)(bgate + (pn - 12) * 256 + cit + 4); }
#pragma unroll
            for (int ai = 0; ai < 2; ++ai)
#pragma unroll
                for (int m = 0; m < 4; ++m) {
                    const size_t row = (size_t)(row0 + ai * 128 + m * 16);
                    f32x4 v0 = acc[ai][bj][m][0], v1 = acc[ai][bj][m][1];
                    if (mode == 1) {
#pragma unroll
                        for (int e = 0; e < 4; ++e) { v0[e] = sigmoidf_(v0[e] + b0[e]); v1[e] = sigmoidf_(v1[e] + b1[e]); }
                    }
                    if (mode == 2) {
                        const float s = 0.35355339059327373f * 0.125f;
                        *(f32x4*)(wi + row * 8) = v0 * s; *(f32x4*)(wi + row * 8 + 4) = v1 * s;
                    } else if (mode == 1) {
                        uint2 q;
                        q.x = (unsigned)(v0[0] * 255.f + 0.5f) | ((unsigned)(v0[1] * 255.f + 0.5f) << 8) | ((unsigned)(v0[2] * 255.f + 0.5f) << 16) | ((unsigned)(v0[3] * 255.f + 0.5f) << 24);
                        q.y = (unsigned)(v1[0] * 255.f + 0.5f) | ((unsigned)(v1[1] * 255.f + 0.5f) << 8) | ((unsigned)(v1[2] * 255.f + 0.5f) << 16) | ((unsigned)(v1[3] * 255.f + 0.5f) << 24);
                        *(uint2*)((unsigned char*)gates + row * 6144 + (pn - 12) * 256 + cit) = q;
                    } else if (mode != 3) {
                        *(uint4*)(base + row * ld) = pack8(v0, v1);
                    }

                }
        }
    }
};
struct EpiGluPool {
    static constexpr bool PERM = true, SEG = false;
    const bf16_t* y; const float* scale; bf16_t* ocat;
    __device__ __forceinline__ void operator()(AccRef acc, const Unit& un, int wr, int wc, int fr, int fq) const {
        asm volatile("" : "+v"(fr), "+v"(fq));
        const int row0 = un.pm * 256 + wr * 64 + fr; const bool glu = un.pn < 2;
#pragma unroll
        for (int bj = 0; bj < 2; ++bj) { const int col = (un.pn & 1) * 256 + bj * 128 + wc * 32 + 8 * fq;
            f32x4 s0 = {0.f, 0.f, 0.f, 0.f}, s1 = {0.f, 0.f, 0.f, 0.f};
            if (!glu) { s0 = *(const f32x4*)(scale + col); s1 = *(const f32x4*)(scale + col + 4); }
#pragma unroll
            for (int ai = 0; ai < 2; ++ai) {
                uint4 yq[4];
                if (glu) {
#pragma unroll
                    for (int m = 0; m < 4; ++m) yq[m] = *(const uint4*)(y + (size_t)(row0 + ai * 128 + m * 16) * 512 + col); }
#pragma unroll
                for (int m = 0; m < 4; ++m) { const size_t row = (size_t)(row0 + ai * 128 + m * 16);
                    f32x4 v0 = acc[ai][bj][m][0], v1 = acc[ai][bj][m][1];
                    if (glu) { float yv[8]; unpack8(yq[m], yv);
#pragma unroll
                        for (int e = 0; e < 4; ++e) { v0[e] = yv[e] * sigmoidf_(v0[e]); v1[e] = yv[4 + e] * sigmoidf_(v1[e]); }
                        *(uint4*)(ocat + row * 2048 + 1024 + col) = pack8(v0, v1);
                    } else *(uint4*)(ocat + row * 2048 + 1536 + col) = pack8(v0 * s0, v1 * s1); } } }
    }
};
struct EpiMerge {
    static constexpr bool PERM = true, SEG = true;
    const bf16_t* gates; bf16_t* merged;
    __device__ __forceinline__ void flush(AccRef acc, const Unit& un, int seg, int wr, int wc, int fr, int fq) const {
        asm volatile("" : "+v"(fr), "+v"(fq));
        const int row0 = un.pm * 256 + wr * 64 + fr;
#pragma unroll
        for (int bj = 0; bj < 2; ++bj) { const int col = un.pn * 256 + bj * 128 + wc * 32 + 8 * fq;
#pragma unroll
            for (int ai = 0; ai < 2; ++ai) {
                uint2 gq[4]; uint4 pq[4];
#pragma unroll
                for (int m = 0; m < 4; ++m) { const size_t row = (size_t)(row0 + ai * 128 + m * 16);
                    gq[m] = *(const uint2*)((const unsigned char*)gates + row * 6144 + seg * 2048 + col);
                    if (seg > 0) pq[m] = *(const uint4*)(merged + row * 2048 + col); else pq[m] = make_uint4(0u, 0u, 0u, 0u); }
#pragma unroll
                for (int m = 0; m < 4; ++m) { const size_t row = (size_t)(row0 + ai * 128 + m * 16);
                    float gv[8], pv[8]; unpack8(pq[m], pv);
#pragma unroll
                    for (int e = 0; e < 4; ++e) { gv[e] = (float)((gq[m].x >> (8 * e)) & 0xffu) * (1.f / 255.f); gv[4 + e] = (float)((gq[m].y >> (8 * e)) & 0xffu) * (1.f / 255.f); }
                    f32x4 v0 = acc[ai][bj][m][0], v1 = acc[ai][bj][m][1];
#pragma unroll
                    for (int e = 0; e < 4; ++e) { v0[e] = pv[e] + gv[e] * v0[e]; v1[e] = pv[4 + e] + gv[4 + e] * v1[e]; }
                    *(uint4*)(merged + row * 2048 + col) = pack8(v0, v1); } } }
    }
};
struct EpiRes {
    static constexpr bool PERM = false, SEG = false;
    const float* xin; float* out; const float* gt;
    __device__ __forceinline__ void operator()(AccRef acc, const Unit& un, int wr, int wc, int fr, int fq) const {
        asm volatile("" : "+v"(fr), "+v"(fq));
        const int row0 = un.pm * 256 + wr * 64 + fr; const float* g = gt + (size_t)(un.pm >> 3) * 12288;
#pragma unroll
        for (int bj = 0; bj < 2; ++bj)
#pragma unroll
            for (int n = 0; n < 2; ++n) { const int col = un.pn * 256 + bj * 128 + wc * 32 + 16 * n + 4 * fq;
                const f32x4 gv = *(const f32x4*)(g + col);
                f32x4 xv[2][4];
#pragma unroll
                for (int ai = 0; ai < 2; ++ai)
#pragma unroll
                    for (int m = 0; m < 4; ++m) xv[ai][m] = *(const f32x4*)(xin + (size_t)(row0 + ai * 128 + m * 16) * 2048 + col);
#pragma unroll
                for (int ai = 0; ai < 2; ++ai)
#pragma unroll
                    for (int m = 0; m < 4; ++m) *(f32x4*)(out + (size_t)(row0 + ai * 128 + m * 16) * 2048 + col) = xv[ai][m] + gv * acc[ai][bj][m][n]; }
    }
};
struct EpiUp {
    static constexpr bool PERM = true, SEG = false;
    bf16_t* act; float* SA; float* SB; const float* cw; const float* cb;
    __device__ __forceinline__ void operator()(AccRef acc, const Unit& un, int wr, int wc, int fr, int fq) const {
        asm volatile("" : "+v"(fr), "+v"(fq));
        const int lg = fq << 4;
        const int src1 = lg | ((fr + 15) & 15), src2 = lg | ((fr + 14) & 15);
#pragma unroll
        for (int n = 0; n < 2; ++n) {
            const int ch0 = un.pn * 128 + wc * 32 + 8 * fq + 4 * n;
            const f32x4 w0 = *(const f32x4*)(cw + ch0), w1 = *(const f32x4*)(cw + DFF + ch0), w2 = *(const f32x4*)(cw + 2 * DFF + ch0), bb = *(const f32x4*)(cb + ch0);
#pragma unroll
            for (int ai = 0; ai < 2; ++ai) {
                const int rowb = un.pm * 256 + ai * 128 + wr * 64; const int blk = rowb >> 6;
#pragma unroll
                for (int m = 0; m < 4; ++m) {
                    f32x4 res;
#pragma unroll
                    for (int e = 0; e < 4; ++e) {
                        const float cur = acc[ai][0][m][n][e];
                        const float prv = (m > 0) ? acc[ai][0][m > 0 ? m - 1 : 0][n][e] : 0.f;
                        const float p1 = __shfl((fr + 1 >= 16) ? prv : cur, src1);
                        const float p2 = __shfl((fr + 2 >= 16) ? prv : cur, src2);
                        const float cv = bb[e] + w0[e] * p2 + w1[e] * p1 + w2[e] * cur;
                        res[e] = siluf_(cv) * acc[ai][1][m][n][e];
                    }
                    const size_t row = (size_t)(rowb + m * 16 + fr);
                    if (m == 0 && fr < 2) {
                        *(f32x4*)(SA + ((size_t)(blk * 4 + 2 + fr)) * DFF + ch0) = acc[ai][0][0][n];
                        *(f32x4*)(SB + ((size_t)(blk * 2 + fr)) * DFF + ch0) = acc[ai][1][0][n];
                    } else {
                        uint2 o; o.x = pk2(res[0], res[1]); o.y = pk2(res[2], res[3]);
                        *(uint2*)(act + row * DFF + ch0) = o;
                    }
                    if (m == 3 && fr >= 14) *(f32x4*)(SA + ((size_t)(blk * 4 + (fr - 14))) * DFF + ch0) = acc[ai][0][3][n];

                }
            }
        }
    }
};

struct Args { const float* in[31]; float* out; unsigned char* ws; int ph_lo, ph_hi; };
enum { I_X = 0, I_C, I_POS, I_WADA, I_BADA, I_GN1, I_GN2, I_WIN, I_GQ, I_GK, I_ARE, I_AIM, I_BRE, I_BIM, I_CRE, I_CIM, I_DSKIP, I_LOGDT, I_WGLU, I_WPOOL, I_PSCALE, I_PA, I_PB, I_PC, I_WGATE, I_BGATE, I_WOUT, I_WUP, I_CONVW, I_CONVB, I_WDOWN };

__device__ __forceinline__ float wave_sum(float v) {
#pragma unroll
    for (int o = 32; o > 0; o >>= 1) v += __shfl_xor(v, o);
    return v;
}

__device__ __forceinline__ void phase_ada(const Args& a, unsigned char* lds, const int WV) {
    const int TI = fresh_tid(WV);
    const int tid = TI;
    float* cact = (float*)lds;
    float* mod = (float*)(a.ws + WS_MOD);
    for (int w = blockIdx.x; w < 256; w += gridDim.x) {
        for (int i = tid; i < 16 * 2048; i += 512) { const int b = i >> 11, k = i & 2047; const float v = a.in[I_C][i]; cact[k * 16 + b] = siluf_(v); }
        __syncthreads();
        const int l = w >> 7, n0 = (w & 127) * 96;
        float acc[16][4];
#pragma unroll
        for (int b = 0; b < 16; ++b)
#pragma unroll
            for (int j = 0; j < 4; ++j) acc[b][j] = 0.f;
        const int cg4 = tid % 24, ks = tid / 24;
        if (tid < 384) {
            const float* wp = a.in[I_WADA] + ((size_t)l * 2048 + ks * 128) * 12288 + n0 + cg4 * 4;
#pragma unroll 4
            for (int k = 0; k < 128; ++k) {
                const f32x4 wv = *(const f32x4*)(wp + (size_t)k * 12288);
                const f32x4* cp = (const f32x4*)(cact + (ks * 128 + k) * 16);
#pragma unroll
                for (int q = 0; q < 4; ++q) { const f32x4 cv = cp[q];
#pragma unroll
                    for (int e = 0; e < 4; ++e)
#pragma unroll
                        for (int j = 0; j < 4; ++j) acc[q * 4 + e][j] += cv[e] * wv[j]; }
            }
        }
        __syncthreads();
        float* part = (float*)lds;
        if (tid < 384) {
#pragma unroll
            for (int b = 0; b < 16; ++b)
#pragma unroll
                for (int j = 0; j < 4; ++j) part[(ks * 16 + b) * 96 + cg4 * 4 + j] = acc[b][j];
        }
        __syncthreads();
        for (int o = tid; o < 1536; o += 512) { const int b = o / 96, cc = o % 96; float s = 0.f;
#pragma unroll
            for (int k2 = 0; k2 < 16; ++k2) s += part[(k2 * 16 + b) * 96 + cc];
            mod[((size_t)l * 16 + b) * 12288 + n0 + cc] = s + a.in[I_BADA][l * 12288 + n0 + cc]; }
        __syncthreads();
    }
}

struct CvtJob { const float* src; bf16_t* dst; int ldS, cbase, cend, kbase, ldD, mode, r0, cs0, kd0; };
__device__ __forceinline__ CvtJob cvt_decode(const Args& a, int l, int t) {
    unsigned char* ws = a.ws; CvtJob J; int ncols, nkt, idx; J.mode = 0; J.r0 = 0; J.kd0 = 0; J.cs0 = 0;
    if (t < 960) { idx = t; J.src = a.in[I_WIN] + (size_t)l * DM * DIN; J.ldS = DIN; ncols = 1864; nkt = 32; J.dst = (bf16_t*)(ws + W_1CAT); J.ldD = 2048; }
    else if (t < 1472) { idx = t - 960; J.src = a.in[I_WIN] + (size_t)l * DM * DIN; J.ldS = DIN; J.cs0 = 1864; ncols = 1024; nkt = 32; J.dst = (bf16_t*)(ws + W_1CAT); J.ldD = 2048; J.r0 = 2048; }
    else if (t < 4544) { idx = t - 1472; const int gi = idx >> 10; idx &= 1023; J.src = a.in[I_WGATE] + ((size_t)l * 3 + gi) * DM * DM; J.ldS = DM; ncols = 2048; nkt = 32; J.dst = (bf16_t*)(ws + W_1CAT); J.ldD = 2048; J.r0 = 3072 + 2048 * gi; }
    else if (t < 5056) { idx = t - 4544; J.src = a.in[I_PA] + (size_t)l * 1024 * DM; J.ldS = DM; ncols = 2048; nkt = 16; J.dst = (bf16_t*)(ws + W_P); J.ldD = 2048; }
    else if (t < 5312) { idx = t - 5056; J.src = a.in[I_PB] + (size_t)l * 512 * DM; J.ldS = DM; ncols = 2048; nkt = 8; J.dst = (bf16_t*)(ws + W_P); J.ldD = 2048; J.kd0 = 1024; }
    else if (t < 5568) { idx = t - 5312; J.src = a.in[I_PC] + (size_t)l * 512 * DM; J.ldS = DM; ncols = 2048; nkt = 8; J.dst = (bf16_t*)(ws + W_P); J.ldD = 2048; J.kd0 = 1536; }
    else if (t < 6592) { idx = t - 5568; J.src = a.in[I_WOUT] + (size_t)l * DM * DM; J.ldS = DM; ncols = 2048; nkt = 32; J.dst = (bf16_t*)(ws + W_OUT); J.ldD = 2048; }
    else if (t < 12096) { idx = t - 6592; J.src = a.in[I_WUP] + (size_t)l * DM * 2 * DFF; J.ldS = 2 * DFF; ncols = 2 * DFF; nkt = 32; J.dst = (bf16_t*)(ws + W_UP); J.ldD = 2048; J.mode = 1; }
    else if (t < 14848) { idx = t - 12096; J.src = a.in[I_WDOWN] + (size_t)l * DFF * DM; J.ldS = DM; ncols = 2048; nkt = 86; J.dst = (bf16_t*)(ws + W_DOWN); J.ldD = DFF; }
    else { idx = t - 14848; J.src = a.in[I_WGLU] + (size_t)l * 512 * 512; J.ldS = 512; ncols = 512; nkt = 8; J.dst = (bf16_t*)(ws + W_GLU); J.ldD = 512; }
    const int tn = idx / nkt, tk = idx - tn * nkt;
    J.cbase = J.cs0 + tn * 64; J.cend = J.cs0 + ncols; J.kbase = tk * 64; return J;
}
__device__ __forceinline__ void phase_cvt(const Args& a, int l, unsigned char* lds, const int WV) {
    const int TI = fresh_tid(WV);
    float* T = (float*)lds;
    const int tid = TI, ty = tid >> 4, tx = tid & 15;
    for (int t4 = blockIdx.x * 4; t4 < 14912; t4 += gridDim.x * 4) {
        f32x4 v[4][2];
#pragma unroll
        for (int q = 0; q < 4; ++q) { const CvtJob J = cvt_decode(a, l, t4 + q);
#pragma unroll
            for (int ps = 0; ps < 2; ++ps) { const int k = ty + ps * 32, c = J.cbase + tx * 4;
                v[q][ps] = (f32x4){0.f, 0.f, 0.f, 0.f};
                if (c < J.cend) v[q][ps] = *(const f32x4*)(J.src + (size_t)(J.kbase + k) * J.ldS + c); } }
#pragma unroll
        for (int q = 0; q < 4; ++q)
#pragma unroll
            for (int ps = 0; ps < 2; ++ps) { float* tp = T + q * (64 * 65) + (ty + ps * 32) * 65 + tx * 4; tp[0] = v[q][ps][0]; tp[1] = v[q][ps][1]; tp[2] = v[q][ps][2]; tp[3] = v[q][ps][3]; }
        __syncthreads();
#pragma unroll
        for (int q = 0; q < 4; ++q) { const CvtJob J = cvt_decode(a, l, t4 + q);
            const int n = tid >> 3, kq = tid & 7, c = J.cbase + n;
            if (c < J.cend) {
                float f[8];
#pragma unroll
                for (int j = 0; j < 8; ++j) f[j] = T[q * (64 * 65) + (kq * 8 + j) * 65 + n];
                int row;
                if (J.mode == 0) row = J.r0 + (c - J.cs0);
                else { const int bj = c >= DFF ? 1 : 0, ch = c - bj * DFF; row = (ch >> 7) * 256 + bj * 128 + (ch & 127); }
                uint4 o; o.x = pk2(f[0], f[1]); o.y = pk2(f[2], f[3]); o.z = pk2(f[4], f[5]); o.w = pk2(f[6], f[7]);
                *(uint4*)(J.dst + (size_t)row * J.ldD + J.kd0 + J.kbase + kq * 8) = o;
            } }
        __syncthreads();
    }
    bf16_t* wp = (bf16_t*)(a.ws + W_POOL); const float* wsrc = a.in[I_WPOOL] + (size_t)l * 4 * 128 * 128;
    for (int i = blockIdx.x * 512 + TI; i < 512 * 512; i += gridDim.x * 512) { const int n = i >> 9, k = i & 511, g = n >> 7;
        const float v = ((k >> 7) == g) ? wsrc[(g * 128 + (k & 127)) * 128 + (n & 127)] : 0.f; wp[i] = (bf16_t)f2bf(v); }
}

__device__ __forceinline__ void phase_norm(const float* xin, const float* g, const float* modl, int shoff, int scoff, bf16_t* out, const int WV) {
    const int TI = fresh_tid(WV);
    const int lane = TI & 63, wave = TI >> 6;
    for (int r = blockIdx.x * 8 + wave; r < MROWS; r += gridDim.x * 8) {
        const f32x4* xp = (const f32x4*)(xin + (size_t)r * DM); f32x4 v[8]; float ssq = 0.f;
#pragma unroll
        for (int j = 0; j < 8; ++j) { v[j] = xp[j * 64 + lane]; ssq += v[j][0] * v[j][0] + v[j][1] * v[j][1] + v[j][2] * v[j][2] + v[j][3] * v[j][3]; }
        ssq = wave_sum(ssq);
        const float rinv = rsqrtf(ssq * (1.f / DM) + EPS);
        const float* mb = modl + (size_t)(r >> 11) * 12288;
#pragma unroll
        for (int j = 0; j < 8; ++j) { const int col = j * 256 + lane * 4;
            const f32x4 g4 = *(const f32x4*)(g + col), sc = *(const f32x4*)(mb + scoff + col), sh = *(const f32x4*)(mb + shoff + col);
            f32x4 y;
#pragma unroll
            for (int e = 0; e < 4; ++e) y[e] = (v[j][e] * rinv * g4[e]) * (1.f + sc[e]) + sh[e];
            uint2 o; o.x = pk2(y[0], y[1]); o.y = pk2(y[2], y[3]);
            *(uint2*)(out + (size_t)r * DM + col) = o; }
    }
}

__constant__ double kRevPerPos[24] = {0.15915494309189535, 0.0700865215877985, 0.03086376340470123, 0.013591370636193905, 0.005985185712713705, 0.002635675898667414, 0.001160663641240061, 0.0005111175045375439, 0.00022507907903927653, 9.911730936901935e-05, 4.364795279280289e-05, 1.9221100684944863e-05, 8.464330808241401e-06, 3.727408601915352e-06, 1.6414262627950345e-06, 7.228293068832865e-07, 0.15915494309189535, 0.03086376340470123, 0.005985185712713705, 0.001160663641240061, 0.00022507907903927653, 4.364795279280289e-05, 8.464330808241401e-06, 1.6414262627950345e-06};
__device__ __forceinline__ void rmsrope128(bf16_t* p, bool active, const float* g16, int sub, const float* cs) {
    float v[16];
    if (active) { unpack8(*(const uint4*)p, v); unpack8(*(const uint4*)(p + 8), v + 8); }
    else {
#pragma unroll
        for (int i = 0; i < 16; ++i) v[i] = 0.f; }
    float ssq = 0.f;
#pragma unroll
    for (int i = 0; i < 16; ++i) ssq += v[i] * v[i];
    ssq += __shfl_xor(ssq, 1); ssq += __shfl_xor(ssq, 2); ssq += __shfl_xor(ssq, 4);
    const float rinv = rsqrtf(ssq * (1.f / 128.f) + EPS);
#pragma unroll
    for (int i = 0; i < 16; ++i) v[i] = v[i] * rinv * g16[i];
#pragma unroll
    for (int i = 0; i < 16; ++i) { const float o = __shfl_xor(v[i], 1); const float c = cs[2 * i], s = cs[2 * i + 1];
        if (sub == 0) v[i] = v[i] * c - o * s; else if (sub == 1) v[i] = v[i] * c + o * s; }
    if (active) { uint4 o0, o1; o0.x = pk2(v[0], v[1]); o0.y = pk2(v[2], v[3]); o0.z = pk2(v[4], v[5]); o0.w = pk2(v[6], v[7]);
        o1.x = pk2(v[8], v[9]); o1.y = pk2(v[10], v[11]); o1.z = pk2(v[12], v[13]); o1.w = pk2(v[14], v[15]);
        *(uint4*)p = o0; *(uint4*)(p + 8) = o1; }
}
__device__ __forceinline__ void rope64(bf16_t* p, bool active, int sub, const float* cs) {
    float v[8];
    if (active) unpack8(*(const uint4*)p, v);
    else {
#pragma unroll
        for (int i = 0; i < 8; ++i) v[i] = 0.f; }
#pragma unroll
    for (int i = 0; i < 8; ++i) { const float o = __shfl_xor(v[i], 1); const float c = cs[2 * i], s = cs[2 * i + 1];
        if (sub == 0) v[i] = v[i] * c - o * s; else if (sub == 1) v[i] = v[i] * c + o * s; }
    if (active) { uint4 o0; o0.x = pk2(v[0], v[1]); o0.y = pk2(v[2], v[3]); o0.z = pk2(v[4], v[5]); o0.w = pk2(v[6], v[7]); *(uint4*)p = o0; }
}
__device__ __forceinline__ void phase_post(const Args& a, int l, unsigned char* lds, const int WV) {
    const int TI = fresh_tid(WV);
    const int lane = TI & 63, wave = TI >> 6;
    float* cs = (float*)lds + wave * 64;
    bf16_t* ocat = (bf16_t*)(a.ws + WS_OCAT); bf16_t* kn = (bf16_t*)(a.ws + WS_KN); bf16_t* qi = (bf16_t*)(a.ws + WS_QI); bf16_t* ki = (bf16_t*)(a.ws + WS_KI);
    const int* pos = (const int*)a.in[I_POS];
    const int sub = lane & 7, hd = lane >> 3;
    float gq[16], gk[16];
#pragma unroll
    for (int i = 0; i < 16; ++i) { gq[i] = a.in[I_GQ][l * 128 + sub * 16 + i]; gk[i] = a.in[I_GK][l * 128 + sub * 16 + i]; }
    for (int r = blockIdx.x * 8 + wave; r < MROWS; r += gridDim.x * 8) {
        const int ps = pos[r];
        if (lane < 24) {
            double rev = (double)ps * kRevPerPos[lane]; rev -= rint(rev); const float fr = (float)rev;
            cs[lane * 2] = __builtin_amdgcn_cosf(fr); cs[lane * 2 + 1] = __builtin_amdgcn_sinf(fr); }
        LDS_FENCE();
        rmsrope128(ocat + (size_t)r * 2048 + hd * 128 + sub * 16, true, gq, sub, cs);
        rmsrope128(kn + (size_t)r * 128 + sub * 16, lane < 8, gk, sub, cs);
        rope64(qi + (size_t)r * 512 + hd * 64 + sub * 8, true, sub, cs + 32);
        rope64(ki + (size_t)r * 64 + sub * 8, lane < 8, sub, cs + 32);
        LDS_FENCE();
    }
}

__device__ __forceinline__ void s5_unit(const Args& a, int l, int b, int g, unsigned char* lds, const int WV) {
    const int TI = fresh_tid(WV);
    const int lane = TI & 63, wave = __builtin_amdgcn_readfirstlane(TI >> 6), p = lane;
    float* E = (float*)lds;
    float* ust = (float*)(lds + 16384 + wave * 4096);
    bf16_t* sst = (bf16_t*)(lds + 49152 + wave * 4352);
    const bf16_t* U = (const bf16_t*)(a.ws + WS_U); bf16_t* Y = (bf16_t*)(a.ws + WS_Y);
    const int gp = (l * 32 + g) * 64 + p;
    const float are = a.in[I_ARE][gp], aim = a.in[I_AIM][gp], dt = expf(a.in[I_LOGDT][l * 32 + g]);
    const float mag = expf(are * dt);
    float ang = aim * dt; { const float n = rintf(ang * 0.15915494309189535f); ang = fmaf(-n, 6.28318548202514648f, ang); ang = fmaf(n, 1.7484555e-7f, ang); }
    const float lre = mag * cosf(ang), lim = mag * sinf(ang);
    float Bre[16], Bim[16];
    { const float nr = lre - 1.f, ni = lim, den = 1.f / (are * are + aim * aim); const float cr = (nr * are + ni * aim) * den, ci = (ni * are - nr * aim) * den;
#pragma unroll
        for (int j = 0; j < 16; ++j) { const float br = a.in[I_BRE][(size_t)gp * 16 + j], bi = a.in[I_BIM][(size_t)gp * 16 + j]; Bre[j] = cr * br - ci * bi; Bim[j] = cr * bi + ci * br; } }
    bf16x8 Cf[4];
    { const int i = lane & 15;
#pragma unroll
        for (int ks = 0; ks < 4; ++ks)
#pragma unroll
            for (int j = 0; j < 8; ++j) { const int k = ks * 32 + (lane >> 4) * 8 + j, pp = k >> 1; const size_t ci = ((size_t)(l * 32 + g) * 16 + i) * 64 + pp;
                const float v = (k & 1) ? -a.in[I_CIM][ci] : a.in[I_CRE][ci]; Cf[ks][j] = (short)f2bf(v); } }
    const float dsk = a.in[I_DSKIP][l * 512 + g * 16 + (lane & 15)];
    f32x2 Bv[16];
#pragma unroll
    for (int j = 0; j < 16; ++j) Bv[j] = (f32x2){Bre[j], Bim[j]};
    const f32x2 lre2 = {lre, lre}, lim2 = {lim, lim};
#define S5_STEP(t_) do { f32x2 bu0 = {0.f, 0.f}, bu1 = {0.f, 0.f}; \
        _Pragma("unroll") for (int k_ = 0; k_ < 8; ++k_) { const unsigned w_ = (unsigned)__builtin_amdgcn_readlane((int)upk[k_], (t_)); \
            const float ul_ = __uint_as_float(w_ << 16), uh_ = __uint_as_float(w_ & 0xffff0000u); \
            bu0 = __builtin_elementwise_fma(Bv[2 * k_], (f32x2){ul_, ul_}, bu0); bu1 = __builtin_elementwise_fma(Bv[2 * k_ + 1], (f32x2){uh_, uh_}, bu1); } \
        const f32x2 sw_ = {-st[1], st[0]}; \
        st = __builtin_elementwise_fma(st, lre2, __builtin_elementwise_fma(sw_, lim2, bu0 + bu1)); } while (0)
#pragma unroll 1
    for (int cc = 0; cc < 4; ++cc) {
        const int chunk = wave * 4 + cc, t0 = chunk * 64;
        unsigned upk[8];
        { const bf16_t* up = U + (size_t)(b * 2048 + t0 + lane) * 512 + g * 16; const uint4 q0 = *(const uint4*)up, q1 = *(const uint4*)(up + 8);
            upk[0] = q0.x; upk[1] = q0.y; upk[2] = q0.z; upk[3] = q0.w; upk[4] = q1.x; upk[5] = q1.y; upk[6] = q1.z; upk[7] = q1.w; }
        f32x2 st = {0.f, 0.f};
#pragma unroll 4
        for (int t = 0; t < 64; ++t) S5_STEP(t);
        E[(chunk * 64 + p) * 2] = st[0]; E[(chunk * 64 + p) * 2 + 1] = st[1];
    }
    __syncthreads();
    if (wave == 0) {
        float pr = lre, pi = lim;
#pragma unroll
        for (int q = 0; q < 6; ++q) { const float nr = pr * pr - pi * pi, pp_ = pr * pi, ni = pp_ + pp_; pr = nr; pi = ni; }
        float sr = 0.f, si = 0.f;
        for (int c = 0; c < 32; ++c) { const float er = E[(c * 64 + p) * 2], ei = E[(c * 64 + p) * 2 + 1]; E[(c * 64 + p) * 2] = sr; E[(c * 64 + p) * 2 + 1] = si;
            const float nr = pr * sr - pi * si + er, ni = pr * si + pi * sr + ei; sr = nr; si = ni; }
    }
    __syncthreads();
#pragma unroll 1
    for (int cc = 0; cc < 4; ++cc) {
        const int chunk = wave * 4 + cc, t0 = chunk * 64;
        unsigned upk[8];
        { const bf16_t* up = U + (size_t)(b * 2048 + t0 + lane) * 512 + g * 16; const uint4 q0 = *(const uint4*)up, q1 = *(const uint4*)(up + 8);
            upk[0] = q0.x; upk[1] = q0.y; upk[2] = q0.z; upk[3] = q0.w; upk[4] = q1.x; upk[5] = q1.y; upk[6] = q1.z; upk[7] = q1.w;
            float f[16]; unpack8(q0, f); unpack8(q1, f + 8);
#pragma unroll
            for (int q = 0; q < 4; ++q) *(f32x4*)(ust + lane * 16 + q * 4) = (f32x4){f[q * 4], f[q * 4 + 1], f[q * 4 + 2], f[q * 4 + 3]}; }
        f32x2 st = {E[(chunk * 64 + p) * 2], E[(chunk * 64 + p) * 2 + 1]};
#pragma unroll 1
        for (int sb = 0; sb < 4; ++sb) {
#pragma unroll 4
            for (int tt = 0; tt < 16; ++tt) { S5_STEP(sb * 16 + tt);
                *(unsigned*)(sst + tt * 136 + 2 * p) = pk2(st[0], st[1]);
            }
            LDS_FENCE();
            f32x4 acc = {0.f, 0.f, 0.f, 0.f};
#pragma unroll
            for (int ks = 0; ks < 4; ++ks) { const bf16x8 af = *(const bf16x8*)(sst + (lane & 15) * 136 + ks * 32 + (lane >> 4) * 8);
                acc = __builtin_amdgcn_mfma_f32_16x16x32_bf16(af, Cf[ks], acc, 0, 0, 0); }
#pragma unroll
            for (int r = 0; r < 4; ++r) { const int t = sb * 16 + (lane >> 4) * 4 + r, i = lane & 15;
                const float y = gelu_tanh(acc[r] + dsk * ust[t * 16 + i]);
                Y[(size_t)(b * 2048 + t0 + t) * 512 + g * 16 + i] = (bf16_t)f2bf(y); }
            LDS_FENCE();
        }
    }
    __syncthreads();
#undef S5_STEP
}

__device__ __forceinline__ void pool_unit(const Args& a, int b, int chunk, unsigned char* lds, const int WV) {
    const int TI = fresh_tid(WV);
    bf16_t* T = (bf16_t*)lds;
    const int t0 = chunk * 64;
    const bf16_t* P = (const bf16_t*)(a.ws + WS_P) + (size_t)b * 2048 * 512; bf16_t* O = (bf16_t*)(a.ws + WS_POOLED) + (size_t)b * 2048 * 512;
    __syncthreads();
    for (int i = TI; i < 80 * 64; i += 512) { const int r = i >> 6, c8 = i & 63, t = t0 - 16 + r;
        uint4 v = make_uint4(0u, 0u, 0u, 0u); if (t >= 0) v = *(const uint4*)(P + (size_t)t * 512 + c8 * 8);
        *(uint4*)(T + r * 512 + c8 * 8) = v; }
    __syncthreads();
    const int c = TI, w = 2 << (c >> 7);
    float s = 0.f;
    for (int k = 1; k <= w; ++k) s += bf1(T[(16 - k) * 512 + c]);
#pragma unroll 4
    for (int t = 0; t < 64; ++t) { const float pv = bf1(T[(16 + t) * 512 + c]); s += pv; s -= bf1(T[(16 + t - w) * 512 + c]);
        const int tt = t0 + t + 1; const float mean = s / (float)(tt < w ? tt : w); O[(size_t)(t0 + t) * 512 + c] = (bf16_t)f2bf(mean - pv); }
}

__device__ __forceinline__ unsigned sortkey(float x) { const unsigned u = __float_as_uint(x); return (u & 0x80000000u) ? ~u : (u | 0x80000000u); }
__device__ __forceinline__ void dsa_unit(const Args& a, int b, int tq, unsigned char* lds, const int WV, bf16_t* obase, const int ostride, const int parts) {
    const int TI = fresh_tid(WV);
    int tid = TI;
    int lane = tid & 63; const int wave = WV;
    float* sc = (float*)lds;
    unsigned short* sel = (unsigned short*)(lds + 131072);
    float* wis = (float*)(lds + 131072 + 8192);
    bf16_t* ocat = (bf16_t*)(a.ws + WS_OCAT); const bf16_t* Kn = (const bf16_t*)(a.ws + WS_KN); const bf16_t* V = (const bf16_t*)(a.ws + WS_V);
    const bf16_t* QI = (const bf16_t*)(a.ws + WS_QI); const bf16_t* KI = (const bf16_t*)(a.ws + WS_KI); const float* WI = (const float*)(a.ws + WS_WI);
    const int t0 = tq * 16, row0 = b * 2048 + t0, limit = ((t0 >> 6) + 1) << 6, nkt = limit >> 5, nsel = limit < 256 ? limit : 256;
    __syncthreads();
    if (tid < 128) wis[tid] = WI[(size_t)row0 * 8 + tid];
    __syncthreads();
    if (parts & 1)
    {
        const int g = lane >> 5, c32 = lane & 31;
        bf16x8 Af[4][4];
#pragma unroll
        for (int rb = 0; rb < 4; ++rb) { const int R = rb * 32 + c32; const bf16_t* qp = QI + (size_t)(row0 + (R >> 3)) * 512 + (R & 7) * 64 + g * 8;
#pragma unroll
            for (int s = 0; s < 4; ++s) Af[rb][s] = *(const bf16x8*)(qp + s * 16); }
        bf16x8 Bn[4];
        { const bf16_t* kp0 = KI + (size_t)(b * 2048 + wave * 32 + c32) * 64 + g * 8;
#pragma unroll
            for (int s = 0; s < 4; ++s) Bn[s] = *(const bf16x8*)(kp0 + s * 16); }
#pragma unroll 1
        for (int kt = wave; kt < nkt; kt += 8) {
            bf16x8 Bf[4];
#pragma unroll
            for (int s = 0; s < 4; ++s) Bf[s] = Bn[s];
            if (kt + 8 < nkt) { const bf16_t* kp = KI + (size_t)(b * 2048 + (kt + 8) * 32 + c32) * 64 + g * 8;
#pragma unroll
                for (int s = 0; s < 4; ++s) Bn[s] = *(const bf16x8*)(kp + s * 16); }
#pragma unroll
            for (int rb = 0; rb < 4; ++rb) {
                f32x16 acc;
#pragma unroll
                for (int i = 0; i < 16; ++i) acc[i] = 0.f;
#pragma unroll
                for (int s = 0; s < 4; ++s) acc = __builtin_amdgcn_mfma_f32_32x32x16_bf16(Af[rb][s], Bf[s], acc, 0, 0, 0);
#pragma unroll
                for (int j = 0; j < 4; ++j) { const int q = rb * 4 + j; const f32x4 w4 = *(const f32x4*)(wis + q * 8 + 4 * g);
                    float sp = fmaxf(acc[4 * j], 0.f) * w4[0] + fmaxf(acc[4 * j + 1], 0.f) * w4[1] + fmaxf(acc[4 * j + 2], 0.f) * w4[2] + fmaxf(acc[4 * j + 3], 0.f) * w4[3];
                    sp += __shfl_xor(sp, 32);
                    if (g == 0) sc[q * 2048 + kt * 32 + c32] = sp; }
            }
        }
    }
    __syncthreads();
    lane = fresh_tid(WV) & 63;
    const unsigned long long ltmask = (1ull << lane) - 1ull;
    for (int qq = 0; qq < 2; ++qq) {
        const int q = wave * 2 + qq; unsigned short* sq = sel + q * 256;
        if (limit <= 256 || !(parts & 2)) { for (int j = lane; j < nsel; j += 64) sq[j] = (unsigned short)j; }
        else {
            unsigned key[32];
#pragma unroll
            for (int j = 0; j < 32; ++j) { const int idx = j * 64 + lane; key[j] = (idx < limit) ? sortkey(sc[q * 2048 + idx]) : 0u; }
            unsigned T = 0u;
            for (int bit = 31; bit >= 0; --bit) { const unsigned cand = T | (1u << bit); int cnt = 0;
#pragma unroll
                for (int j = 0; j < 32; ++j) cnt += __popcll(__ballot(key[j] >= cand));
                if (cnt >= 256) { T = cand; if (cnt == 256) break; } }
            int cgt = 0;
#pragma unroll
            for (int j = 0; j < 32; ++j) cgt += __popcll(__ballot(key[j] > T));
            const int need = 256 - cgt; int ob = 0, tb = 0;
#pragma unroll
            for (int j = 0; j < 32; ++j) { const bool gt = key[j] > T, eq = key[j] == T; const unsigned long long me = __ballot(eq);
                const int pe = tb + __popcll(me & ltmask); const bool take = gt || (eq && pe < need); const unsigned long long mt = __ballot(take);
                if (take) sq[ob + __popcll(mt & ltmask)] = (unsigned short)(j * 64 + lane);
                ob += __popcll(mt); tb += __popcll(me); }
        }
    }
    __syncthreads();
    lane = fresh_tid(WV) & 63;
    float* Pw = (float*)lds + wave * 2048;
    const int g4 = lane >> 4, hh = lane & 15;
#pragma unroll 1
    for (int qq = 0; qq < 2; ++qq) {
        const int q = wave * 2 + qq; const size_t row = (size_t)(row0 + q); const unsigned short* sq = sel + q * 256;
        if (parts & 4) {
        bf16x8 Qf[4];
#pragma unroll
        for (int s = 0; s < 4; ++s) Qf[s] = *(const bf16x8*)(ocat + row * 2048 + (hh & 7) * 128 + g4 * 8 + s * 32);
        float lg[16][4];
#pragma unroll
        for (int kg = 0; kg < 4; ++kg) {
            if (kg * 64 < nsel) {
                bf16x8 kf[4][4];
#pragma unroll
                for (int k4 = 0; k4 < 4; ++k4) { const int idx = sq[(kg * 4 + k4) * 16 + hh]; const bf16_t* kp = Kn + (size_t)(b * 2048 + idx) * 128 + g4 * 8;
#pragma unroll
                    for (int s = 0; s < 4; ++s) kf[k4][s] = *(const bf16x8*)(kp + s * 32); }
#pragma unroll
                for (int k4 = 0; k4 < 4; ++k4) { f32x4 c = {0.f, 0.f, 0.f, 0.f};
#pragma unroll
                    for (int s = 0; s < 4; ++s) c = __builtin_amdgcn_mfma_f32_16x16x32_bf16(kf[k4][s], Qf[s], c, 0, 0, 0);
#pragma unroll
                    for (int r = 0; r < 4; ++r) lg[kg * 4 + k4][r] = c[r] * 0.08838834764831845f; }
            } else {
#pragma unroll
                for (int k4 = 0; k4 < 4; ++k4)
#pragma unroll
                    for (int r = 0; r < 4; ++r) lg[kg * 4 + k4][r] = -1e30f;
            }
        }
        float mx = -1e30f;
#pragma unroll
        for (int kb = 0; kb < 16; ++kb)
#pragma unroll
            for (int r = 0; r < 4; ++r) mx = fmaxf(mx, lg[kb][r]);
        mx = fmaxf(mx, __shfl_xor(mx, 16)); mx = fmaxf(mx, __shfl_xor(mx, 32));
        float sum = 0.f;
#pragma unroll
        for (int kb = 0; kb < 16; ++kb)
#pragma unroll
            for (int r = 0; r < 4; ++r) { const float e = (kb * 16 < nsel) ? __expf(lg[kb][r] - mx) : 0.f; lg[kb][r] = e; sum += e; }
        sum += __shfl_xor(sum, 16); sum += __shfl_xor(sum, 32);
        const float inv = 1.f / sum;
        if (hh < 8) {
#pragma unroll
            for (int kb = 0; kb < 16; ++kb)
                if (kb * 16 < nsel) {
#pragma unroll
                    for (int r = 0; r < 4; ++r) Pw[(kb * 16 + g4 * 4 + r) * 8 + hh] = lg[kb][r] * inv; }
        }
        }
        LDS_FENCE();
        if (!(parts & 8)) continue;
        float o[8][8];
#pragma unroll
        for (int h = 0; h < 8; ++h)
#pragma unroll
            for (int d = 0; d < 8; ++d) o[h][d] = 0.f;
        const bf16_t* Vb = V + (size_t)b * 2048 * 128 + hh * 8;
        uint4 vq[8], vn[8];
#pragma unroll
        for (int jj = 0; jj < 8; ++jj) { const int idx = sq[jj * 4 + g4]; vq[jj] = *(const uint4*)(Vb + (size_t)idx * 128); }
#pragma unroll 1
        for (int j0 = 0; j0 < nsel; j0 += 32) {
            if (j0 + 32 < nsel) {
#pragma unroll
                for (int jj = 0; jj < 8; ++jj) { const int idx = sq[j0 + 32 + jj * 4 + g4]; vn[jj] = *(const uint4*)(Vb + (size_t)idx * 128); }
            }
#pragma unroll
            for (int jj = 0; jj < 8; ++jj) { const int slot = j0 + jj * 4 + g4;
                const f32x4 pa = *(const f32x4*)(Pw + slot * 8), pb = *(const f32x4*)(Pw + slot * 8 + 4);
                float v[8]; unpack8(vq[jj], v);
#pragma unroll
                for (int h = 0; h < 4; ++h)
#pragma unroll
                    for (int d = 0; d < 8; ++d) { o[h][d] = fmaf(pa[h], v[d], o[h][d]); o[4 + h][d] = fmaf(pb[h], v[d], o[4 + h][d]); } }
#pragma unroll
            for (int jj = 0; jj < 8; ++jj) vq[jj] = vn[jj];
        }
        { const bool b4 = (lane & 16) != 0, b5 = (lane & 32) != 0;
            float kp[4][8];
#pragma unroll
            for (int i = 0; i < 4; ++i)
#pragma unroll
                for (int d = 0; d < 8; ++d) { const float snd = b4 ? o[i][d] : o[4 + i][d]; const float rcv = __shfl_xor(snd, 16); kp[i][d] = (b4 ? o[4 + i][d] : o[i][d]) + rcv; }
#pragma unroll
            for (int i = 0; i < 2; ++i) { float fin[8];
#pragma unroll
                for (int d = 0; d < 8; ++d) { const float snd = b5 ? kp[i][d] : kp[2 + i][d]; const float rcv = __shfl_xor(snd, 32); fin[d] = (b5 ? kp[2 + i][d] : kp[i][d]) + rcv; }
                const int head = (b4 ? 4 : 0) + (b5 ? 2 : 0) + i;
                uint4 ov; ov.x = pk2(fin[0], fin[1]); ov.y = pk2(fin[2], fin[3]); ov.z = pk2(fin[4], fin[5]); ov.w = pk2(fin[6], fin[7]);
                *(uint4*)(obase + row * ostride + head * 128 + hh * 8) = ov; }
        }
        LDS_FENCE();
    }
}

__device__ __forceinline__ void phase_fix(const Args& a, int l, const int WV) {
    const int TI = fresh_tid(WV);
    const float* SA = (const float*)(a.ws + WS_SA); const float* SB = (const float*)(a.ws + WS_SB); bf16_t* act = (bf16_t*)(a.ws + WS_R2);
    const float* cw = a.in[I_CONVW] + (size_t)l * 3 * DFF; const float* cb = a.in[I_CONVB] + (size_t)l * DFF;
    const int total = 512 * 2 * DFF;
    for (int i = blockIdx.x * 512 + TI; i < total; i += gridDim.x * 512) {
        const int ch = i % DFF, rb = i / DFF, rr = rb & 1, blk = rb >> 1, r = blk * 64 + rr, t = r & 2047;
        const float a0 = SA[((size_t)blk * 4 + 2 + rr) * DFF + ch];
        float am1, am2;
        if (rr == 0) { am1 = (t >= 1) ? SA[((size_t)(blk - 1) * 4 + 1) * DFF + ch] : 0.f; am2 = (t >= 2) ? SA[((size_t)(blk - 1) * 4 + 0) * DFF + ch] : 0.f; }
        else { am1 = SA[((size_t)blk * 4 + 2) * DFF + ch]; am2 = (t >= 2) ? SA[((size_t)(blk - 1) * 4 + 1) * DFF + ch] : 0.f; }
        const float cv = cb[ch] + cw[ch] * am2 + cw[DFF + ch] * am1 + cw[2 * DFF + ch] * a0;
        act[(size_t)r * DFF + ch] = (bf16_t)f2bf(siluf_(cv) * SB[((size_t)blk * 2 + rr) * DFF + ch]);
    }
}

__device__ __forceinline__ void run_phase(const Args& a, int ph, unsigned char* lds, const int WV, const bool dummy) {
    unsigned char* ws = a.ws;
    LAS unsigned char* ldsl = (LAS unsigned char*)lds;
    const int G = gridDim.x, bx = blockIdx.x;
#ifndef DBG_NOADA
    if (ph == 0) { phase_ada(a, lds, WV); return; }
#else
    if (ph == 0) return;
#endif
    const int l = (ph - 1) / 10, sp = (ph - 1) % 10;
    const float* modl = (const float*)(ws + WS_MOD) + (size_t)l * 16 * 12288;
    const float* xin = (l == 0) ? a.in[I_X] : a.out;
#ifdef DBG_SP
    if (sp != DBG_SP) return;
#endif
    switch (sp) {
    case 0: phase_cvt(a, l, lds, WV); phase_norm(xin, a.in[I_GN1] + l * DM, modl, 0, 2048, (bf16_t*)(ws + WS_R1), WV); break;
    case 1: {
        pg8::Gemm g{(const bf16_t*)(ws + WS_R1), (const bf16_t*)(ws + W_1CAT), MROWS, N1, DM, DM, DM, 1 << 30, 0}; pg8::StaticOrder S; S.init(MROWS, N1, G, bx);
        Epi1 E{(bf16_t*)(ws + WS_OCAT), (bf16_t*)(ws + WS_KN), (bf16_t*)(ws + WS_V), (bf16_t*)(ws + WS_QI), (bf16_t*)(ws + WS_KI), (bf16_t*)(ws + WS_U), (bf16_t*)(ws + WS_P), (bf16_t*)(ws + WS_R2),
               (float*)(ws + WS_WI), a.in[I_BGATE] + (size_t)l * 3 * DM};
        pg8::gemm_phase<Epi1, pg8::StaticOrder>(ldsl, g, S, E, WV); } break;
    case 2:
        if (!dummy) phase_post(a, l, lds, WV);
        __syncthreads();
        for (int u = bx; u < 512; u += G) s5_unit(a, l, u >> 5, u & 31, lds, WV);
        for (int u = bx; u < 512; u += G) pool_unit(a, u >> 5, u & 31, lds, WV);
        break;
    case 3: {
#ifndef DBG_NO_DSA
#ifdef DSA_PROBE
        for (int rep = 0; rep < 2; ++rep) { const bool dm = (rep == 0); const int parts = dm ? (DSA_PROBE) : 15;
#else
        { const bool dm = dummy; const int parts = 15;
#endif
            for (int u = bx; u < 2048; u += G) { const int w = u & 255, i = u >> 8, b = w & 15, s = w >> 4; const int tq = (i & 1) ? (i * 16 + 15 - s) : (i * 16 + s);
                dsa_unit(a, b, tq, lds, WV, dm ? (bf16_t*)(ws + WS_R1 + 64 * MiB) : (bf16_t*)(ws + WS_OCAT), dm ? 1024 : 2048, parts); }
        }
        __syncthreads();
#endif
#ifndef DBG_DSA_ONLY
        { pg8::Gemm g{(const bf16_t*)(ws + WS_Y), (const bf16_t*)(ws + W_GLU), MROWS, 1024, 512, 512, 512, 2, WS_POOLED - WS_Y}; pg8::StaticOrder S; S.init(MROWS, 1024, G, bx);
          EpiGluPool E{(const bf16_t*)(ws + WS_Y), a.in[I_PSCALE] + l * 512, (bf16_t*)(ws + WS_OCAT)}; pg8::gemm_phase<EpiGluPool, pg8::StaticOrder>(ldsl, g, S, E, WV); }
#endif
        } break;
    case 4: {
        pg8::Gemm g{(const bf16_t*)(ws + WS_OCAT), (const bf16_t*)(ws + W_P), MROWS, DM, DM, DM, DM, 1 << 30, 0}; pg8::StaticOrder S; S.init(MROWS, DM, G, bx);
        EpiMerge E{(const bf16_t*)(ws + WS_R2), (bf16_t*)(ws + WS_R1)}; pg8::gemm_phase<EpiMerge, pg8::StaticOrder>(ldsl, g, S, E, WV); } break;
    case 5: {
        pg8::Gemm g{(const bf16_t*)(ws + WS_R1), (const bf16_t*)(ws + W_OUT), MROWS, DM, DM, DM, DM, 1 << 30, 0}; pg8::StaticOrder S; S.init(MROWS, DM, G, bx);
        EpiRes E{xin, dummy ? (float*)(ws + WS_OCAT) : a.out, modl + 4096}; pg8::gemm_phase<EpiRes, pg8::StaticOrder>(ldsl, g, S, E, WV); } break;
    case 6: phase_norm(a.out, a.in[I_GN2] + l * DM, modl, 6144, 8192, (bf16_t*)(ws + WS_R1), WV); break;
    case 7: {
        pg8::Gemm g{(const bf16_t*)(ws + WS_R1), (const bf16_t*)(ws + W_UP), MROWS, 2 * DFF, DM, DM, DM, 1 << 30, 0}; pg8::StaticOrder S; S.init(MROWS, 2 * DFF, G, bx);
        EpiUp E{(bf16_t*)(ws + WS_R2), (float*)(ws + WS_SA), (float*)(ws + WS_SB), a.in[I_CONVW] + (size_t)l * 3 * DFF, a.in[I_CONVB] + (size_t)l * DFF};
        pg8::gemm_phase<EpiUp, pg8::StaticOrder>(ldsl, g, S, E, WV); } break;
    case 8: phase_fix(a, l, WV); break;
    case 9: {
        pg8::Gemm g{(const bf16_t*)(ws + WS_R2), (const bf16_t*)(ws + W_DOWN), MROWS, DM, DFF, DFF, DFF, 1 << 30, 0}; pg8::StaticOrder S; S.init(MROWS, DM, G, bx);
        EpiRes E{a.out, dummy ? (float*)(ws + WS_OCAT) : a.out, modl + 10240}; pg8::gemm_phase<EpiRes, pg8::StaticOrder>(ldsl, g, S, E, WV); } break;
    }
}

__device__ __forceinline__ void grid_bar(unsigned* ctr, unsigned target, int wave_id) {
    asm volatile("s_waitcnt vmcnt(0) lgkmcnt(0)" ::: "memory");
    __syncthreads();
    if (wave_id == 0) {
        const int l = (int)__builtin_amdgcn_mbcnt_hi(~0u, __builtin_amdgcn_mbcnt_lo(~0u, 0u));
        if (l == 0) {
            __builtin_amdgcn_fence(__ATOMIC_RELEASE, "agent");
            asm volatile("s_waitcnt vmcnt(0)" ::: "memory");
            (void)__hip_atomic_fetch_add(ctr, 1u, __ATOMIC_RELAXED, __HIP_MEMORY_SCOPE_AGENT);
            unsigned sp = 0u;
            while (__hip_atomic_load(ctr, __ATOMIC_RELAXED, __HIP_MEMORY_SCOPE_AGENT) < target) { __builtin_amdgcn_s_sleep(1); if (++sp > (1u << 22)) break; }
            __builtin_amdgcn_fence(__ATOMIC_ACQUIRE, "agent");
            asm volatile("s_waitcnt vmcnt(0)" ::: "memory");
        }
    }
    __syncthreads();
}

__global__ void __launch_bounds__(512, 2) mega_fwd(Args a) {
    extern __shared__ __attribute__((aligned(16))) unsigned char lds[];
    cg::grid_group grid = cg::this_grid();
    const int wave_id = __builtin_amdgcn_readfirstlane((int)(threadIdx.x >> 6));
    const int ph_lo = a.ph_lo, ph_hi = a.ph_hi;
    unsigned nbar = 0u;
    for (int ph = ph_lo; ph < ph_hi; ++ph) {
        const __attribute__((address_space(4))) Args* kp = (const __attribute__((address_space(4))) Args*)__builtin_amdgcn_kernarg_segment_ptr();
        asm volatile("" : "+s"(kp));
        Args la;
#pragma unroll
        for (int i = 0; i < 31; ++i) la.in[i] = (const float*)(const __attribute__((address_space(1))) float*)kp->in[i];
        la.ws = (unsigned char*)(__attribute__((address_space(1))) unsigned char*)kp->ws;
        la.out = (float*)(__attribute__((address_space(1))) float*)kp->out;
        la.ph_lo = ph_lo; la.ph_hi = ph_hi;
#ifdef REP_MASK
        if (ph > 0 && ((REP_MASK >> ((ph - 1) % 10)) & 1)) { run_phase(la, ph, lds, wave_id, true); grid.sync(); }
#endif
        run_phase(la, ph, lds, wave_id, false);
        if (ph + 1 < ph_hi) {
            if (ph == ph_lo) grid.sync();
            else { ++nbar; grid_bar((unsigned*)la.ws, nbar * gridDim.x, wave_id); }
        }
    }
}

extern "C" void kernel_launch(void* const* d_in, const int* in_sizes, int n_in, void* d_out, int out_size, void* d_ws, size_t ws_size, hipStream_t stream) {
    static int grid = 0;
    if (grid == 0) {
        int dev = 0, cus = 0, per_cu = 0;
        if (n_in != 31 || ws_size < WS_END) { fprintf(stderr, "kernel_launch: unexpected n_in %d / ws %zu\n", n_in, ws_size); grid = -1; return; }
        hipGetDevice(&dev); hipDeviceGetAttribute(&cus, hipDeviceAttributeMultiprocessorCount, dev);
        if (hipFuncSetAttribute((const void*)mega_fwd, hipFuncAttributeMaxDynamicSharedMemorySize, LDS_BYTES) != hipSuccess) { fprintf(stderr, "kernel_launch: hipFuncSetAttribute failed\n"); grid = -1; return; }
        if (hipOccupancyMaxActiveBlocksPerMultiprocessor(&per_cu, (const void*)mega_fwd, 512, LDS_BYTES) != hipSuccess || per_cu < 1) { fprintf(stderr, "kernel_launch: occupancy query says %d blocks/CU\n", per_cu); per_cu = 1; }
        (void)hipGetLastError();
        grid = cus > 0 ? cus : 256;
    }
    if (grid < 0) return;
    if (hipMemsetAsync(d_ws, 0, 256, stream) != hipSuccess) { fprintf(stderr, "kernel_launch: memset of the barrier word failed\n"); return; }
    Args a{};
    for (int i = 0; i < 31; ++i) a.in[i] = (const float*)d_in[i];
    a.out = (float*)d_out; a.ws = (unsigned char*)d_ws;
#if MK_PER_PHASE
    for (int ph = 0; ph < NPHASE; ++ph) {
        a.ph_lo = ph; a.ph_hi = ph + 1;
        void* args[] = {&a};
        hipError_t e = hipLaunchCooperativeKernel((const void*)mega_fwd, dim3(grid), dim3(512), args, LDS_BYTES, stream);
        if (e != hipSuccess) { fprintf(stderr, "kernel_launch: launch of phase %d failed: %s\n", ph, hipGetErrorString(e)); break; }
    }
#else
    a.ph_lo = 0; a.ph_hi = NPHASE;
    void* args[] = {&a};
    hipError_t e = hipLaunchCooperativeKernel((const void*)mega_fwd, dim3(grid), dim3(512), args, LDS_BYTES, stream);
    if (e != hipSuccess) fprintf(stderr, "kernel_launch: cooperative launch failed: %s (grid %d)\n", hipGetErrorString(e), grid);
#endif
}
```

```cpp
#include <hip/hip_runtime.h>
#include <hip/hip_cooperative_groups.h>
#include <cstdio>
#include <cstdint>
namespace cg = cooperative_groups;

#ifndef MK_PER_PHASE
#define MK_PER_PHASE 0
#endif

typedef unsigned short bf16_t;
typedef short bf16x8 __attribute__((ext_vector_type(8)));
typedef float f32x4 __attribute__((ext_vector_type(4)));
typedef float f32x2 __attribute__((ext_vector_type(2)));
typedef float f32x16 __attribute__((ext_vector_type(16)));
typedef unsigned u32x4 __attribute__((ext_vector_type(4)));
typedef unsigned u32x2 __attribute__((ext_vector_type(2)));
#define LAS __attribute__((address_space(3)))

constexpr int BATCH = 16, SEQ = 2048, DM = 2048, MROWS = BATCH * SEQ, DIN = 2888, DFF = 5504;
constexpr int N1 = 9216;
constexpr float EPS = 1e-6f;
constexpr int NPHASE = 21;

constexpr size_t MiB = 1u << 20;
constexpr size_t WS_MOD = 1 * MiB;
constexpr size_t WS_WI = 3 * MiB;
constexpr size_t WS_W = 4 * MiB;
constexpr size_t W_1CAT = WS_W, W_P = WS_W + 36 * MiB, W_OUT = WS_W + 44 * MiB, W_UP = WS_W + 52 * MiB, W_DOWN = WS_W + 95 * MiB,
                 W_GLU = WS_W + 116 * MiB + MiB / 2, W_POOL = WS_W + 117 * MiB;
constexpr size_t WS_R1 = 122 * MiB;
constexpr size_t WS_Y = WS_R1, WS_POOLED = WS_R1 + 32 * MiB;
constexpr size_t WS_R2 = 250 * MiB;
constexpr size_t WS_OCAT = 634 * MiB;
constexpr size_t WS_SA = WS_OCAT, WS_SB = WS_OCAT + 44 * MiB;
constexpr size_t WS_KN = 762 * MiB, WS_V = 770 * MiB, WS_QI = 778 * MiB, WS_KI = 810 * MiB, WS_U = 814 * MiB, WS_P = 846 * MiB, WS_END = 878 * MiB;
constexpr int LDS_BYTES = 155648;

__device__ __forceinline__ unsigned f2bf(float f) { unsigned u = __float_as_uint(f); return (u + 0x7fffu + ((u >> 16) & 1u)) >> 16; }
__device__ __forceinline__ unsigned pk2(float lo, float hi) { return f2bf(lo) | (f2bf(hi) << 16); }
__device__ __forceinline__ float bflo(unsigned u) { return __uint_as_float(u << 16); }
__device__ __forceinline__ float bfhi(unsigned u) { return __uint_as_float(u & 0xffff0000u); }
__device__ __forceinline__ float bf1(bf16_t b) { return __uint_as_float(((unsigned)b) << 16); }
__device__ __forceinline__ float sigmoidf_(float x) { return 1.f / (1.f + __expf(-x)); }
__device__ __forceinline__ float siluf_(float x) { return x / (1.f + __expf(-x)); }
__device__ __forceinline__ float gelu_tanh(float x) { const float z = 0.7978845608028654f * (x + 0.044715f * x * x * x); const float t = 1.f - 2.f / (1.f + __expf(2.f * z)); return 0.5f * x * (1.f + t); }
__device__ __forceinline__ uint4 pack8(f32x4 a, f32x4 b) { uint4 r; r.x = pk2(a[0], a[1]); r.y = pk2(a[2], a[3]); r.z = pk2(b[0], b[1]); r.w = pk2(b[2], b[3]); return r; }
__device__ __forceinline__ void unpack8(uint4 v, float* f) { f[0] = bflo(v.x); f[1] = bfhi(v.x); f[2] = bflo(v.y); f[3] = bfhi(v.y); f[4] = bflo(v.z); f[5] = bfhi(v.z); f[6] = bflo(v.w); f[7] = bfhi(v.w); }
#define LDS_FENCE() asm volatile("s_waitcnt lgkmcnt(0)" ::: "memory")
__device__ __forceinline__ int fresh_tid(int wv) { int l = (int)__builtin_amdgcn_mbcnt_hi(~0u, __builtin_amdgcn_mbcnt_lo(~0u, 0u)); asm volatile("" : "+v"(l)); return (wv << 6) | l; }

namespace pg8 {
constexpr int BM = 256, BK = 64, HALF = 128, HTB = HALF * BK * 2, STAGE_BYTES = 8 * HTB, NXCD = 8, WGM = 8;
__host__ __device__ __forceinline__ int lds_byte(int r, int c) { const int st = (r >> 4) * 2 + (c >> 5), rr = r & 15, cc = c & 31, ob = rr * 64 + cc * 2; return st * 1024 + (ob ^ (((ob >> 9) & 1) << 5)); }
__host__ __device__ __forceinline__ void stage_rc(int b, int& R, int& C) { const int st = b / 1024, sb = b % 1024, swz = sb ^ (((sb >> 9) & 1) << 5); R = (st >> 1) * 16 + swz / 64; C = (st & 1) * 32 + (swz % 64) / 2; }
__host__ __device__ __forceinline__ int perm32(int rho) { const int n = rho >> 4, i = rho & 15; return 8 * (i >> 2) + 4 * n + (i & 3); }
struct Unit { int pm, pn; };
struct Gemm { const bf16_t* A; const bf16_t* Bt; int M, N, K, lda, ldb; int asplit; size_t aoff; };
struct StaticOrder {
    int nM, nN, nwg, G, c;
    __device__ void init(int M, int N, int G_, int c_) { nM = M / BM; nN = N / BM; nwg = nM * nN; G = G_; c = c_; }
    __device__ bool next(int i, Unit& u) const {
        const long L = (long)i * G + c; if (L >= nwg) return false;
        int wgid = (int)L; { const int q = nwg / NXCD, r = nwg % NXCD, xcd = wgid % NXCD, off = wgid / NXCD; wgid = (xcd < r ? xcd * (q + 1) : r * (q + 1) + (xcd - r) * q) + off; }
        const int nig = WGM * nN, gid = wgid / nig, fm = gid * WGM, gsz = (nM - fm) < WGM ? (nM - fm) : WGM;
        u.pm = fm + ((wgid % nig) % gsz); u.pn = (wgid % nig) / gsz; return true;
    }
};
template <class Epi, class Sched>
__device__ __forceinline__ void gemm_phase(LAS unsigned char* lds, const Gemm g, const Sched& S, const Epi& E, const int WV) {
    const int TI = fresh_tid(WV);
    const int tid = TI, wid = __builtin_amdgcn_readfirstlane(tid >> 6), lane = tid & 63, wr = wid >> 2, wc = wid & 3, fr = lane & 15, fq = lane >> 4;
    const int K = g.K, nt = K / BK;
    unsigned voffA[2], voffB[2];
#pragma unroll
    for (int i = 0; i < 2; ++i) { int R, C; stage_rc(tid * 16 + i * 8192, R, C); const int Rb = Epi::PERM ? ((R & ~31) + perm32(R & 31)) : R;
        voffA[i] = (unsigned)(R * g.lda + C) * 2u; voffB[i] = (unsigned)(Rb * g.ldb + C) * 2u; }
    const size_t kstep = (size_t)(BK * 2);
    const size_t hstepA = (size_t)HALF * g.lda * 2, hstepB = (size_t)HALF * g.ldb * 2;
    const size_t tstepA = 2 * hstepA, tstepB = 2 * hstepB;
    const unsigned ldsw = (unsigned)wid * 1024u;
    const int aoff = lds_byte(wr * 64 + fr, fq * 8), boff = lds_byte(wc * 32 + fr, fq * 8);
#define PG8_SA(b, h) (((b) * 2 + (h)) * HTB)
#define PG8_SB(b, h) ((4 + (b) * 2 + (h)) * HTB)
#define PG8_STAGE(bufoff, gbase, voff) do { _Pragma("unroll") for (int _i = 0; _i < 2; ++_i) \
        __builtin_amdgcn_global_load_lds((const unsigned*)((const char*)(gbase) + (voff)[_i]), (LAS unsigned*)(lds + (bufoff) + ldsw + _i * 8192), 16, 0, 0); } while (0)
#define PG8_LDA(dst, b, h) do { _Pragma("unroll") for (int m = 0; m < 4; ++m) _Pragma("unroll") for (int k = 0; k < 2; ++k) dst[m][k] = *(const LAS bf16x8*)(lds + PG8_SA(b, h) + aoff + m * 2048 + k * 1024); } while (0)
#define PG8_LDB(dst, b, h) do { _Pragma("unroll") for (int n = 0; n < 2; ++n) _Pragma("unroll") for (int k = 0; k < 2; ++k) dst[n][k] = *(const LAS bf16x8*)(lds + PG8_SB(b, h) + boff + n * 2048 + k * 1024); } while (0)
#define PG8_MMA(ai, bj, At, Bt) do { __builtin_amdgcn_s_setprio(1); _Pragma("unroll") for (int m = 0; m < 4; ++m) _Pragma("unroll") for (int n = 0; n < 2; ++n) _Pragma("unroll") for (int k = 0; k < 2; ++k) \
        acc[ai][bj][m][n] = __builtin_amdgcn_mfma_f32_16x16x32_bf16(Bt[n][k], At[m][k], acc[ai][bj][m][n], 0, 0, 0); __builtin_amdgcn_s_setprio(0); } while (0)
#define PG8_WAIT_V(n) asm volatile("s_waitcnt vmcnt(" #n ")" ::: "memory")
#define PG8_WAIT_L(n) asm volatile("s_waitcnt lgkmcnt(" #n ")" ::: "memory")
#define PG8_BAR __builtin_amdgcn_s_barrier()
#define PG8_SCHED __builtin_amdgcn_sched_barrier(0)
#define PG8_ZERO() do { _Pragma("unroll") for (int a_ = 0; a_ < 2; ++a_) _Pragma("unroll") for (int b_ = 0; b_ < 2; ++b_) _Pragma("unroll") for (int m_ = 0; m_ < 4; ++m_) _Pragma("unroll") for (int n_ = 0; n_ < 2; ++n_) acc[a_][b_][m_][n_] = (f32x4){0.f, 0.f, 0.f, 0.f}; } while (0)
    Unit cur, nxt; int ui = 0;
    if (!S.next(0, cur)) return;
    f32x4 acc[2][2][4][2];
    PG8_ZERO();
    bf16x8 At[4][2], B0[2][2], B1[2][2];
    const char* cA = (const char*)g.A + (size_t)cur.pm * tstepA + (cur.pn >= g.asplit ? g.aoff : (size_t)0); const char* cB = (const char*)g.Bt + (size_t)cur.pn * tstepB;
    PG8_STAGE(PG8_SB(0, 0), cB, voffB); PG8_STAGE(PG8_SA(0, 0), cA, voffA); PG8_STAGE(PG8_SB(0, 1), cB + hstepB, voffB); PG8_STAGE(PG8_SA(0, 1), cA + hstepA, voffA);
    if (wr == 1) PG8_BAR;
    PG8_WAIT_V(4); PG8_BAR;
    PG8_STAGE(PG8_SB(1, 0), cB + kstep, voffB); PG8_STAGE(PG8_SA(1, 0), cA + kstep, voffA); PG8_STAGE(PG8_SB(1, 1), cB + hstepB + kstep, voffB);
    PG8_WAIT_V(6); PG8_BAR;
    for (;;) {
        const bool has_next = S.next(ui + 1, nxt);
        const char* nA = has_next ? (const char*)g.A + (size_t)nxt.pm * tstepA + (nxt.pn >= g.asplit ? g.aoff : (size_t)0) : cA; const char* nB = has_next ? (const char*)g.Bt + (size_t)nxt.pn * tstepB : cB;
        for (int t = 0; t < nt; t += 2) {
            const bool last = (t == nt - 2);
            const char* a1 = cA + (size_t)(t + 1) * kstep;
            const char* a2 = last ? nA : cA + (size_t)(t + 2) * kstep; const char* b2 = last ? nB : cB + (size_t)(t + 2) * kstep;
            const char* a3 = a2 + kstep; const char* b3 = b2 + kstep;
            PG8_LDB(B0, 0, 0); PG8_SCHED; PG8_LDA(At, 0, 0); PG8_STAGE(PG8_SA(1, 1), a1 + hstepA, voffA);
            PG8_WAIT_L(8); PG8_BAR; PG8_WAIT_L(0); PG8_MMA(0, 0, At, B0); PG8_BAR; PG8_SCHED;
            PG8_LDB(B1, 0, 1); PG8_STAGE(PG8_SB(0, 0), b2, voffB);
            PG8_BAR; PG8_WAIT_L(0); PG8_MMA(0, 1, At, B1); PG8_BAR;
            PG8_LDA(At, 0, 1); PG8_STAGE(PG8_SA(0, 0), a2, voffA);
            PG8_BAR; PG8_WAIT_L(0); PG8_MMA(1, 0, At, B0); PG8_BAR; PG8_SCHED;
            PG8_STAGE(PG8_SB(0, 1), b2 + hstepB, voffB);
            PG8_WAIT_V(6); PG8_BAR; PG8_MMA(1, 1, At, B1); PG8_BAR;
            PG8_LDB(B0, 1, 0); PG8_SCHED; PG8_LDA(At, 1, 0); PG8_STAGE(PG8_SA(0, 1), a2 + hstepA, voffA);
            PG8_WAIT_L(8); PG8_BAR; PG8_WAIT_L(0); PG8_MMA(0, 0, At, B0); PG8_BAR; PG8_SCHED;
            PG8_LDB(B1, 1, 1); PG8_STAGE(PG8_SB(1, 0), b3, voffB);
            PG8_BAR; PG8_WAIT_L(0); PG8_MMA(0, 1, At, B1); PG8_BAR;
            PG8_LDA(At, 1, 1); PG8_STAGE(PG8_SA(1, 0), a3, voffA);
            PG8_BAR; PG8_WAIT_L(0); PG8_MMA(1, 0, At, B0); PG8_BAR; PG8_SCHED;
            PG8_STAGE(PG8_SB(1, 1), b3 + hstepB, voffB);
            PG8_WAIT_V(6); PG8_BAR; PG8_MMA(1, 1, At, B1); PG8_BAR;
            if constexpr (Epi::SEG) { if (t + 2 == 16 || t + 2 == 24) { E.flush(acc, cur, (t + 2 == 16) ? 0 : 1, wr, wc, fr, fq); PG8_ZERO(); } }
        }
        if constexpr (Epi::SEG) E.flush(acc, cur, 2, wr, wc, fr, fq); else E(acc, cur, wr, wc, fr, fq);
        if (!has_next) break;
        PG8_ZERO();
        cur = nxt; cA = nA; cB = nB; ++ui;
    }
    PG8_WAIT_V(0);
    if (wr == 0) PG8_BAR;
    PG8_BAR;
#undef PG8_SA
#undef PG8_SB
#undef PG8_STAGE
#undef PG8_LDA
#undef PG8_LDB
#undef PG8_MMA
#undef PG8_WAIT_V
#undef PG8_WAIT_L
#undef PG8_BAR
#undef PG8_SCHED
#undef PG8_ZERO
}
}
using pg8::Unit;
typedef const f32x4 (&AccRef)[2][2][4][2];

struct Epi1 {
    static constexpr bool PERM = true, SEG = false;
    bf16_t *ocat, *kn, *vv, *qi, *ki, *u, *p, *gates; float* wi; const float* bgate; LAS unsigned char* stg;
    __device__ __forceinline__ void operator()(AccRef acc, const Unit& un, int wr, int wc, int fr, int fq) const {
        asm volatile("" : "+v"(fr), "+v"(fq));
        const int pn = un.pn, rowb = un.pm * 256 + wr * 64, lane = fq * 16 + fr;
        LAS unsigned char* sb = stg + (wr * 4 + wc) * 2304;
        if (pn == 7 && wc >= 1) {
            if (wc == 1 && fq == 0) {
                const float s = 0.35355339059327373f * 0.125f;
#pragma unroll
                for (int ai = 0; ai < 2; ++ai)
#pragma unroll
                    for (int m = 0; m < 4; ++m) { const size_t row = (size_t)(rowb + ai * 128 + m * 16 + fr);
                        *(f32x4*)(wi + row * 8) = acc[ai][0][m][0] * s; *(f32x4*)(wi + row * 8 + 4) = acc[ai][0][m][1] * s; }
            }
            return;
        }
        if (pn >= 12) {
            const int c0 = (pn - 12) * 256 + 64 * wc;
            f32x4 bz[2][2];
#pragma unroll
            for (int bj = 0; bj < 2; ++bj) { bz[bj][0] = *(const f32x4*)(bgate + c0 + 32 * bj + 8 * fq); bz[bj][1] = *(const f32x4*)(bgate + c0 + 32 * bj + 8 * fq + 4); }
            unsigned char* gb = (unsigned char*)gates + c0;
#pragma unroll
            for (int ai = 0; ai < 2; ++ai)
#pragma unroll
                for (int m = 0; m < 4; ++m) {
#pragma unroll
                    for (int bj = 0; bj < 2; ++bj) { uint2 q; unsigned w[2];
#pragma unroll
                        for (int n = 0; n < 2; ++n) { unsigned t = 0u;
#pragma unroll
                            for (int e = 0; e < 4; ++e) t |= (unsigned)(sigmoidf_(acc[ai][bj][m][n][e] + bz[bj][n][e]) * 255.f + 0.5f) << (8 * e);
                            w[n] = t; }
                        q.x = w[0]; q.y = w[1];
                        *(LAS u32x2*)(sb + fr * 80 + 32 * bj + 8 * fq) = (u32x2){q.x, q.y}; }
                    LDS_FENCE();
                    { const int r = lane >> 2, sg = lane & 3; const u32x4 v = *(const LAS u32x4*)(sb + r * 80 + sg * 16);
                      *(u32x4*)(gb + (size_t)(rowb + ai * 128 + m * 16 + r) * 6144 + sg * 16) = v; }
                    LDS_FENCE();
                }
            return;
        }
        bf16_t* base; int ld;
        if (pn < 4) { base = ocat + pn * 256 + 64 * wc; ld = 2048; }
        else if (pn == 4) { base = (wc < 2 ? kn : vv) + 64 * (wc & 1); ld = 128; }
        else if (pn < 7) { base = qi + (pn - 5) * 256 + 64 * wc; ld = 512; }
        else if (pn == 7) { base = ki; ld = 64; }
        else if (pn < 10) { base = u + (pn - 8) * 256 + 64 * wc; ld = 512; }
        else { base = p + (pn - 10) * 256 + 64 * wc; ld = 512; }
#pragma unroll
        for (int ai = 0; ai < 2; ++ai)
#pragma unroll
            for (int m = 0; m < 4; ++m) {
#pragma unroll
                for (int bj = 0; bj < 2; ++bj) { const uint4 pk_ = pack8(acc[ai][bj][m][0], acc[ai][bj][m][1]); *(LAS u32x4*)(sb + fr * 144 + 64 * bj + 16 * fq) = (u32x4){pk_.x, pk_.y, pk_.z, pk_.w}; }
                LDS_FENCE();
#pragma unroll
                for (int h = 0; h < 2; ++h) { const int r = h * 8 + (lane >> 3), sg = lane & 7; const u32x4 v = *(const LAS u32x4*)(sb + r * 144 + sg * 16);
                    *(u32x4*)(base + (size_t)(rowb + ai * 128 + m * 16 + r) * ld + sg * 8) = v; }
                LDS_FENCE();
            }
    }
};
struct EpiGluPool {
    static constexpr bool PERM = true, SEG = false;
    const bf16_t* y; const float* scale; bf16_t* ocat;
    __device__ __forceinline__ void operator()(AccRef acc, const Unit& un, int wr, int wc, int fr, int fq) const {
        asm volatile("" : "+v"(fr), "+v"(fq));
        const int row0 = un.pm * 256 + wr * 64 + fr; const bool glu = un.pn < 2;
#pragma unroll
        for (int bj = 0; bj < 2; ++bj) { const int col = (un.pn & 1) * 256 + bj * 128 + wc * 32 + 8 * fq;
            f32x4 s0 = {0.f, 0.f, 0.f, 0.f}, s1 = {0.f, 0.f, 0.f, 0.f};
            if (!glu) { s0 = *(const f32x4*)(scale + col); s1 = *(const f32x4*)(scale + col + 4); }
#pragma unroll
            for (int ai = 0; ai < 2; ++ai) {
                uint4 yq[4];
                if (glu) {
#pragma unroll
                    for (int m = 0; m < 4; ++m) yq[m] = *(const uint4*)(y + (size_t)(row0 + ai * 128 + m * 16) * 512 + col); }
#pragma unroll
                for (int m = 0; m < 4; ++m) { const size_t row = (size_t)(row0 + ai * 128 + m * 16);
                    f32x4 v0 = acc[ai][bj][m][0], v1 = acc[ai][bj][m][1];
                    if (glu) { float yv[8]; unpack8(yq[m], yv);
#pragma unroll
                        for (int e = 0; e < 4; ++e) { v0[e] = yv[e] * sigmoidf_(v0[e]); v1[e] = yv[4 + e] * sigmoidf_(v1[e]); }
                        *(uint4*)(ocat + row * 2048 + 1024 + col) = pack8(v0, v1);
                    } else *(uint4*)(ocat + row * 2048 + 1536 + col) = pack8(v0 * s0, v1 * s1); } } }
    }
};
struct EpiMerge {
    static constexpr bool PERM = true, SEG = true;
    const bf16_t* gates; bf16_t* merged;
    __device__ __forceinline__ void flush(AccRef acc, const Unit& un, int seg, int wr, int wc, int fr, int fq) const {
        asm volatile("" : "+v"(fr), "+v"(fq));
        const int row0 = un.pm * 256 + wr * 64 + fr;
#pragma unroll
        for (int bj = 0; bj < 2; ++bj) { const int col = un.pn * 256 + bj * 128 + wc * 32 + 8 * fq;
#pragma unroll
            for (int ai = 0; ai < 2; ++ai) {
                uint2 gq[4]; uint4 pq[4];
#pragma unroll
                for (int m = 0; m < 4; ++m) { const size_t row = (size_t)(row0 + ai * 128 + m * 16);
                    gq[m] = *(const uint2*)((const unsigned char*)gates + row * 6144 + seg * 2048 + col);
                    if (seg > 0) pq[m] = *(const uint4*)(merged + row * 2048 + col); else pq[m] = make_uint4(0u, 0u, 0u, 0u); }
#pragma unroll
                for (int m = 0; m < 4; ++m) { const size_t row = (size_t)(row0 + ai * 128 + m * 16);
                    float gv[8], pv[8]; unpack8(pq[m], pv);
#pragma unroll
                    for (int e = 0; e < 4; ++e) { gv[e] = (float)((gq[m].x >> (8 * e)) & 0xffu) * (1.f / 255.f); gv[4 + e] = (float)((gq[m].y >> (8 * e)) & 0xffu) * (1.f / 255.f); }
                    f32x4 v0 = acc[ai][bj][m][0], v1 = acc[ai][bj][m][1];
#pragma unroll
                    for (int e = 0; e < 4; ++e) { v0[e] = pv[e] + gv[e] * v0[e]; v1[e] = pv[4 + e] + gv[4 + e] * v1[e]; }
                    *(uint4*)(merged + row * 2048 + col) = pack8(v0, v1); } } }
    }
};
struct EpiRes {
    static constexpr bool PERM = false, SEG = false;
    const float* xin; float* out; const float* gt;
    __device__ __forceinline__ void operator()(AccRef acc, const Unit& un, int wr, int wc, int fr, int fq) const {
        asm volatile("" : "+v"(fr), "+v"(fq));
        const int row0 = un.pm * 256 + wr * 64 + fr; const float* g = gt + (size_t)(un.pm >> 3) * 12288;
#pragma unroll
        for (int bj = 0; bj < 2; ++bj) { const int col = un.pn * 256 + bj * 128 + wc * 32 + 4 * fq;
            f32x4 gv[2], xv[2][2][4];
#pragma unroll
            for (int n = 0; n < 2; ++n) gv[n] = *(const f32x4*)(g + col + 16 * n);
#pragma unroll
            for (int n = 0; n < 2; ++n)
#pragma unroll
                for (int ai = 0; ai < 2; ++ai)
#pragma unroll
                    for (int m = 0; m < 4; ++m) xv[n][ai][m] = *(const f32x4*)(xin + (size_t)(row0 + ai * 128 + m * 16) * 2048 + col + 16 * n);
#pragma unroll
            for (int n = 0; n < 2; ++n)
#pragma unroll
                for (int ai = 0; ai < 2; ++ai)
#pragma unroll
                    for (int m = 0; m < 4; ++m) *(f32x4*)(out + (size_t)(row0 + ai * 128 + m * 16) * 2048 + col + 16 * n) = xv[n][ai][m] + gv[n] * acc[ai][bj][m][n]; }
    }
};
struct EpiUp {
    static constexpr bool PERM = true, SEG = false;
    bf16_t* act; float* SA; float* SB; const float* cw; const float* cb; LAS unsigned char* stg;
    __device__ __forceinline__ void operator()(AccRef acc, const Unit& un, int wr, int wc, int fr, int fq) const {
        asm volatile("" : "+v"(fr), "+v"(fq));
        const int lg = fq << 4, lane = lg | fr;
        const int src1 = lg | ((fr + 15) & 15), src2 = lg | ((fr + 14) & 15);
        const int ch0 = un.pn * 128 + wc * 32 + 8 * fq;
        LAS unsigned char* sb = stg + (wr * 4 + wc) * 2304;
        f32x4 w0[2], w1[2], w2[2], bb[2];
#pragma unroll
        for (int n = 0; n < 2; ++n) { w0[n] = *(const f32x4*)(cw + ch0 + 4 * n); w1[n] = *(const f32x4*)(cw + DFF + ch0 + 4 * n); w2[n] = *(const f32x4*)(cw + 2 * DFF + ch0 + 4 * n); bb[n] = *(const f32x4*)(cb + ch0 + 4 * n); }
#pragma unroll
        for (int ai = 0; ai < 2; ++ai) {
            const int rowb = un.pm * 256 + ai * 128 + wr * 64; const int blk = rowb >> 6;
#pragma unroll
            for (int m = 0; m < 4; ++m) {
                f32x4 res[2];
#pragma unroll
                for (int n = 0; n < 2; ++n)
#pragma unroll
                    for (int e = 0; e < 4; ++e) {
                        const float cur = acc[ai][0][m][n][e];
                        const float prv = (m > 0) ? acc[ai][0][m > 0 ? m - 1 : 0][n][e] : 0.f;
                        const float p1 = __shfl((fr + 1 >= 16) ? prv : cur, src1);
                        const float p2 = __shfl((fr + 2 >= 16) ? prv : cur, src2);
                        const float cv = bb[n][e] + w0[n][e] * p2 + w1[n][e] * p1 + w2[n][e] * cur;
                        res[n][e] = siluf_(cv) * acc[ai][1][m][n][e];
                    }
                if (m == 0 && fr < 2) {
                    float* sa = SA + ((size_t)(blk * 4 + 2 + fr)) * DFF + ch0; float* sbp = SB + ((size_t)(blk * 2 + fr)) * DFF + ch0;
                    *(f32x4*)sa = acc[ai][0][0][0]; *(f32x4*)(sa + 4) = acc[ai][0][0][1];
                    *(f32x4*)sbp = acc[ai][1][0][0]; *(f32x4*)(sbp + 4) = acc[ai][1][0][1];
                }
                if (m == 3 && fr >= 14) { float* sa = SA + ((size_t)(blk * 4 + (fr - 14))) * DFF + ch0; *(f32x4*)sa = acc[ai][0][3][0]; *(f32x4*)(sa + 4) = acc[ai][0][3][1]; }
                { const uint4 pk_ = pack8(res[0], res[1]); *(LAS u32x4*)(sb + fr * 80 + 16 * fq) = (u32x4){pk_.x, pk_.y, pk_.z, pk_.w}; }
                LDS_FENCE();
                { const int r = lane >> 2, sg = lane & 3; const u32x4 v = *(const LAS u32x4*)(sb + r * 80 + sg * 16);
                  if (!(m == 0 && r < 2)) *(u32x4*)(act + (size_t)(rowb + m * 16 + r) * DFF + un.pn * 128 + wc * 32 + sg * 8) = v; }
                LDS_FENCE();
            }
        }
    }
};

struct Args { const float* in[31]; float* out; unsigned char* ws; int ph_lo, ph_hi; };
enum { I_X = 0, I_C, I_POS, I_WADA, I_BADA, I_GN1, I_GN2, I_WIN, I_GQ, I_GK, I_ARE, I_AIM, I_BRE, I_BIM, I_CRE, I_CIM, I_DSKIP, I_LOGDT, I_WGLU, I_WPOOL, I_PSCALE, I_PA, I_PB, I_PC, I_WGATE, I_BGATE, I_WOUT, I_WUP, I_CONVW, I_CONVB, I_WDOWN };

__device__ __forceinline__ float wave_sum(float v) {
#pragma unroll
    for (int o = 32; o > 0; o >>= 1) v += __shfl_xor(v, o);
    return v;
}

__device__ __forceinline__ void phase_ada(const Args& a, unsigned char* lds, const int WV) {
    const int TI = fresh_tid(WV);
    const int tid = TI;
    float* cact = (float*)lds;
    float* mod = (float*)(a.ws + WS_MOD);
    for (int w = blockIdx.x; w < 256; w += gridDim.x) {
        for (int i = tid; i < 16 * 2048; i += 512) { const int b = i >> 11, k = i & 2047; const float v = a.in[I_C][i]; cact[k * 16 + b] = siluf_(v); }
        __syncthreads();
        const int l = w >> 7, n0 = (w & 127) * 96;
        float acc[16][4];
#pragma unroll
        for (int b = 0; b < 16; ++b)
#pragma unroll
            for (int j = 0; j < 4; ++j) acc[b][j] = 0.f;
        const int cg4 = tid % 24, ks = tid / 24;
        if (tid < 384) {
            const float* wp = a.in[I_WADA] + ((size_t)l * 2048 + ks * 128) * 12288 + n0 + cg4 * 4;
#pragma unroll 4
            for (int k = 0; k < 128; ++k) {
                const f32x4 wv = *(const f32x4*)(wp + (size_t)k * 12288);
                const f32x4* cp = (const f32x4*)(cact + (ks * 128 + k) * 16);
#pragma unroll
                for (int q = 0; q < 4; ++q) { const f32x4 cv = cp[q];
#pragma unroll
                    for (int e = 0; e < 4; ++e)
#pragma unroll
                        for (int j = 0; j < 4; ++j) acc[q * 4 + e][j] += cv[e] * wv[j]; }
            }
        }
        __syncthreads();
        float* part = (float*)lds;
        if (tid < 384) {
#pragma unroll
            for (int b = 0; b < 16; ++b)
#pragma unroll
                for (int j = 0; j < 4; ++j) part[(ks * 16 + b) * 96 + cg4 * 4 + j] = acc[b][j];
        }
        __syncthreads();
        for (int o = tid; o < 1536; o += 512) { const int b = o / 96, cc = o % 96; float s = 0.f;
#pragma unroll
            for (int k2 = 0; k2 < 16; ++k2) s += part[(k2 * 16 + b) * 96 + cc];
            mod[((size_t)l * 16 + b) * 12288 + n0 + cc] = s + a.in[I_BADA][l * 12288 + n0 + cc]; }
        __syncthreads();
    }
}

struct CvtJob { const float* src; bf16_t* dst; int ldS, cbase, cend, kbase, ldD, mode, r0, cs0, kd0; };
__device__ __forceinline__ CvtJob cvt_decode(const Args& a, int l, int t) {
    unsigned char* ws = a.ws; CvtJob J; int ncols, nkt, idx; J.mode = 0; J.r0 = 0; J.kd0 = 0; J.cs0 = 0;
    if (t < 960) { idx = t; J.src = a.in[I_WIN] + (size_t)l * DM * DIN; J.ldS = DIN; ncols = 1864; nkt = 32; J.dst = (bf16_t*)(ws + W_1CAT); J.ldD = 2048; J.mode = 2; }
    else if (t < 1472) { idx = t - 960; J.src = a.in[I_WIN] + (size_t)l * DM * DIN; J.ldS = DIN; J.cs0 = 1864; ncols = 1024; nkt = 32; J.dst = (bf16_t*)(ws + W_1CAT); J.ldD = 2048; J.r0 = 2048; J.mode = 2; }
    else if (t < 4544) { idx = t - 1472; const int gi = idx >> 10; idx &= 1023; J.src = a.in[I_WGATE] + ((size_t)l * 3 + gi) * DM * DM; J.ldS = DM; ncols = 2048; nkt = 32; J.dst = (bf16_t*)(ws + W_1CAT); J.ldD = 2048; J.r0 = 3072 + 2048 * gi; J.mode = 2; }
    else if (t < 5056) { idx = t - 4544; J.src = a.in[I_PA] + (size_t)l * 1024 * DM; J.ldS = DM; ncols = 2048; nkt = 16; J.dst = (bf16_t*)(ws + W_P); J.ldD = 2048; }
    else if (t < 5312) { idx = t - 5056; J.src = a.in[I_PB] + (size_t)l * 512 * DM; J.ldS = DM; ncols = 2048; nkt = 8; J.dst = (bf16_t*)(ws + W_P); J.ldD = 2048; J.kd0 = 1024; }
    else if (t < 5568) { idx = t - 5312; J.src = a.in[I_PC] + (size_t)l * 512 * DM; J.ldS = DM; ncols = 2048; nkt = 8; J.dst = (bf16_t*)(ws + W_P); J.ldD = 2048; J.kd0 = 1536; }
    else if (t < 6592) { idx = t - 5568; J.src = a.in[I_WOUT] + (size_t)l * DM * DM; J.ldS = DM; ncols = 2048; nkt = 32; J.dst = (bf16_t*)(ws + W_OUT); J.ldD = 2048; }
    else if (t < 12096) { idx = t - 6592; J.src = a.in[I_WUP] + (size_t)l * DM * 2 * DFF; J.ldS = 2 * DFF; ncols = 2 * DFF; nkt = 32; J.dst = (bf16_t*)(ws + W_UP); J.ldD = 2048; J.mode = 1; }
    else if (t < 14848) { idx = t - 12096; J.src = a.in[I_WDOWN] + (size_t)l * DFF * DM; J.ldS = DM; ncols = 2048; nkt = 86; J.dst = (bf16_t*)(ws + W_DOWN); J.ldD = DFF; }
    else { idx = t - 14848; J.src = a.in[I_WGLU] + (size_t)l * 512 * 512; J.ldS = 512; ncols = 512; nkt = 8; J.dst = (bf16_t*)(ws + W_GLU); J.ldD = 512; }
    const int tn = idx / nkt, tk = idx - tn * nkt;
    J.cbase = J.cs0 + tn * 64; J.cend = J.cs0 + ncols; J.kbase = tk * 64; return J;
}
__device__ __forceinline__ void phase_cvt(const Args& a, int l, unsigned char* lds, const int WV) {
    const int TI = fresh_tid(WV);
    float* T = (float*)lds;
    const int tid = TI, ty = tid >> 4, tx = tid & 15;
    for (int t4 = blockIdx.x * 4; t4 < 14912; t4 += gridDim.x * 4) {
        f32x4 v[4][2];
#pragma unroll
        for (int q = 0; q < 4; ++q) { const CvtJob J = cvt_decode(a, l, t4 + q);
#pragma unroll
            for (int ps = 0; ps < 2; ++ps) { const int k = ty + ps * 32, c = J.cbase + tx * 4;
                v[q][ps] = (f32x4){0.f, 0.f, 0.f, 0.f};
                if (c < J.cend) v[q][ps] = *(const f32x4*)(J.src + (size_t)(J.kbase + k) * J.ldS + c); } }
#pragma unroll
        for (int q = 0; q < 4; ++q)
#pragma unroll
            for (int ps = 0; ps < 2; ++ps) { float* tp = T + q * (64 * 65) + (ty + ps * 32) * 65 + tx * 4; tp[0] = v[q][ps][0]; tp[1] = v[q][ps][1]; tp[2] = v[q][ps][2]; tp[3] = v[q][ps][3]; }
        __syncthreads();
#pragma unroll
        for (int q = 0; q < 4; ++q) { const CvtJob J = cvt_decode(a, l, t4 + q);
            const int n = tid >> 3, kq = tid & 7, c = J.cbase + n;
            if (c < J.cend) {
                float f[8];
#pragma unroll
                for (int j = 0; j < 8; ++j) f[j] = T[q * (64 * 65) + (kq * 8 + j) * 65 + n];
                int row;
                if (J.mode == 0) row = J.r0 + (c - J.cs0);
                else if (J.mode == 2) { const int r_ = J.r0 + (c - J.cs0), ct = r_ & 255; row = (r_ & ~255) | (((ct >> 5) & 1) << 7) | ((ct >> 6) << 5) | (ct & 31); }
                else { const int bj = c >= DFF ? 1 : 0, ch = c - bj * DFF; row = (ch >> 7) * 256 + bj * 128 + (ch & 127); }
                uint4 o; o.x = pk2(f[0], f[1]); o.y = pk2(f[2], f[3]); o.z = pk2(f[4], f[5]); o.w = pk2(f[6], f[7]);
                *(uint4*)(J.dst + (size_t)row * J.ldD + J.kd0 + J.kbase + kq * 8) = o;
            } }
        __syncthreads();
    }
    bf16_t* wp = (bf16_t*)(a.ws + W_POOL); const float* wsrc = a.in[I_WPOOL] + (size_t)l * 4 * 128 * 128;
    for (int i = blockIdx.x * 512 + TI; i < 512 * 512; i += gridDim.x * 512) { const int n = i >> 9, k = i & 511, g = n >> 7;
        const float v = ((k >> 7) == g) ? wsrc[(g * 128 + (k & 127)) * 128 + (n & 127)] : 0.f; wp[i] = (bf16_t)f2bf(v); }
}

__device__ __forceinline__ void phase_norm(const float* xin, const float* g, const float* modl, int shoff, int scoff, bf16_t* out, const int WV) {
    const int TI = fresh_tid(WV);
    const int lane = TI & 63, wave = TI >> 6;
    for (int r = blockIdx.x * 8 + wave; r < MROWS; r += gridDim.x * 8) {
        const f32x4* xp = (const f32x4*)(xin + (size_t)r * DM); f32x4 v[8]; float ssq = 0.f;
#pragma unroll
        for (int j = 0; j < 8; ++j) { v[j] = xp[j * 64 + lane]; ssq += v[j][0] * v[j][0] + v[j][1] * v[j][1] + v[j][2] * v[j][2] + v[j][3] * v[j][3]; }
        ssq = wave_sum(ssq);
        const float rinv = rsqrtf(ssq * (1.f / DM) + EPS);
        const float* mb = modl + (size_t)(r >> 11) * 12288;
#pragma unroll
        for (int j = 0; j < 8; ++j) { const int col = j * 256 + lane * 4;
            const f32x4 g4 = *(const f32x4*)(g + col), sc = *(const f32x4*)(mb + scoff + col), sh = *(const f32x4*)(mb + shoff + col);
            f32x4 y;
#pragma unroll
            for (int e = 0; e < 4; ++e) y[e] = (v[j][e] * rinv * g4[e]) * (1.f + sc[e]) + sh[e];
            uint2 o; o.x = pk2(y[0], y[1]); o.y = pk2(y[2], y[3]);
            *(uint2*)(out + (size_t)r * DM + col) = o; }
    }
}

__constant__ double kRevPerPos[24] = {0.15915494309189535, 0.0700865215877985, 0.03086376340470123, 0.013591370636193905, 0.005985185712713705, 0.002635675898667414, 0.001160663641240061, 0.0005111175045375439, 0.00022507907903927653, 9.911730936901935e-05, 4.364795279280289e-05, 1.9221100684944863e-05, 8.464330808241401e-06, 3.727408601915352e-06, 1.6414262627950345e-06, 7.228293068832865e-07, 0.15915494309189535, 0.03086376340470123, 0.005985185712713705, 0.001160663641240061, 0.00022507907903927653, 4.364795279280289e-05, 8.464330808241401e-06, 1.6414262627950345e-06};
__device__ __forceinline__ void rmsrope128(bf16_t* p, bool active, const float* g16, int sub, const float* cs) {
    float v[16];
    if (active) { unpack8(*(const uint4*)p, v); unpack8(*(const uint4*)(p + 8), v + 8); }
    else {
#pragma unroll
        for (int i = 0; i < 16; ++i) v[i] = 0.f; }
    float ssq = 0.f;
#pragma unroll
    for (int i = 0; i < 16; ++i) ssq += v[i] * v[i];
    ssq += __shfl_xor(ssq, 1); ssq += __shfl_xor(ssq, 2); ssq += __shfl_xor(ssq, 4);
    const float rinv = rsqrtf(ssq * (1.f / 128.f) + EPS);
#pragma unroll
    for (int i = 0; i < 16; ++i) v[i] = v[i] * rinv * g16[i];
#pragma unroll
    for (int i = 0; i < 16; ++i) { const float o = __shfl_xor(v[i], 1); const float c = cs[2 * i], s = cs[2 * i + 1];
        if (sub == 0) v[i] = v[i] * c - o * s; else if (sub == 1) v[i] = v[i] * c + o * s; }
    if (active) { uint4 o0, o1; o0.x = pk2(v[0], v[1]); o0.y = pk2(v[2], v[3]); o0.z = pk2(v[4], v[5]); o0.w = pk2(v[6], v[7]);
        o1.x = pk2(v[8], v[9]); o1.y = pk2(v[10], v[11]); o1.z = pk2(v[12], v[13]); o1.w = pk2(v[14], v[15]);
        *(uint4*)p = o0; *(uint4*)(p + 8) = o1; }
}
__device__ __forceinline__ void rope64(bf16_t* p, bool active, int sub, const float* cs) {
    float v[8];
    if (active) unpack8(*(const uint4*)p, v);
    else {
#pragma unroll
        for (int i = 0; i < 8; ++i) v[i] = 0.f; }
#pragma unroll
    for (int i = 0; i < 8; ++i) { const float o = __shfl_xor(v[i], 1); const float c = cs[2 * i], s = cs[2 * i + 1];
        if (sub == 0) v[i] = v[i] * c - o * s; else if (sub == 1) v[i] = v[i] * c + o * s; }
    if (active) { uint4 o0; o0.x = pk2(v[0], v[1]); o0.y = pk2(v[2], v[3]); o0.z = pk2(v[4], v[5]); o0.w = pk2(v[6], v[7]); *(uint4*)p = o0; }
}
__device__ __forceinline__ void phase_post(const Args& a, int l, unsigned char* lds, const int WV) {
    const int TI = fresh_tid(WV);
    const int lane = TI & 63, wave = TI >> 6;
    float* cs = (float*)lds + wave * 64;
    bf16_t* ocat = (bf16_t*)(a.ws + WS_OCAT); bf16_t* kn = (bf16_t*)(a.ws + WS_KN); bf16_t* qi = (bf16_t*)(a.ws + WS_QI); bf16_t* ki = (bf16_t*)(a.ws + WS_KI);
    const int* pos = (const int*)a.in[I_POS];
    const int sub = lane & 7, hd = lane >> 3;
    float gq[16], gk[16];
#pragma unroll
    for (int i = 0; i < 16; ++i) { gq[i] = a.in[I_GQ][l * 128 + sub * 16 + i]; gk[i] = a.in[I_GK][l * 128 + sub * 16 + i]; }
    for (int r = blockIdx.x * 8 + wave; r < MROWS; r += gridDim.x * 8) {
        const int ps = pos[r];
        if (lane < 24) {
            double rev = (double)ps * kRevPerPos[lane]; rev -= rint(rev); const float fr = (float)rev;
            cs[lane * 2] = __builtin_amdgcn_cosf(fr); cs[lane * 2 + 1] = __builtin_amdgcn_sinf(fr); }
        LDS_FENCE();
        rmsrope128(ocat + (size_t)r * 2048 + hd * 128 + sub * 16, true, gq, sub, cs);
        rmsrope128(kn + (size_t)r * 128 + sub * 16, lane < 8, gk, sub, cs);
        rope64(qi + (size_t)r * 512 + hd * 64 + sub * 8, true, sub, cs + 32);
        rope64(ki + (size_t)r * 64 + sub * 8, lane < 8, sub, cs + 32);
        LDS_FENCE();
    }
}

__device__ __forceinline__ void s5_unit(const Args& a, int l, int b, int g, unsigned char* lds, const int WV) {
    const int TI = fresh_tid(WV);
    const int lane = TI & 63, wave = __builtin_amdgcn_readfirstlane(TI >> 6), p = lane;
    float* E = (float*)lds;
    float* ust = (float*)(lds + 16384 + wave * 4096);
    bf16_t* sst = (bf16_t*)(lds + 49152 + wave * 4352);
    const bf16_t* U = (const bf16_t*)(a.ws + WS_U); bf16_t* Y = (bf16_t*)(a.ws + WS_Y);
    const int gp = (l * 32 + g) * 64 + p;
    const float are = a.in[I_ARE][gp], aim = a.in[I_AIM][gp], dt = expf(a.in[I_LOGDT][l * 32 + g]);
    const float mag = expf(are * dt);
    float ang = aim * dt; { const float n = rintf(ang * 0.15915494309189535f); ang = fmaf(-n, 6.28318548202514648f, ang); ang = fmaf(n, 1.7484555e-7f, ang); }
    const float lre = mag * cosf(ang), lim = mag * sinf(ang);
    float Bre[16], Bim[16];
    { const float nr = lre - 1.f, ni = lim, den = 1.f / (are * are + aim * aim); const float cr = (nr * are + ni * aim) * den, ci = (ni * are - nr * aim) * den;
#pragma unroll
        for (int j = 0; j < 16; ++j) { const float br = a.in[I_BRE][(size_t)gp * 16 + j], bi = a.in[I_BIM][(size_t)gp * 16 + j]; Bre[j] = cr * br - ci * bi; Bim[j] = cr * bi + ci * br; } }
    bf16x8 Cf[4];
    { const int i = lane & 15;
#pragma unroll
        for (int ks = 0; ks < 4; ++ks)
#pragma unroll
            for (int j = 0; j < 8; ++j) { const int k = ks * 32 + (lane >> 4) * 8 + j, pp = k >> 1; const size_t ci = ((size_t)(l * 32 + g) * 16 + i) * 64 + pp;
                const float v = (k & 1) ? -a.in[I_CIM][ci] : a.in[I_CRE][ci]; Cf[ks][j] = (short)f2bf(v); } }
    const float dsk = a.in[I_DSKIP][l * 512 + g * 16 + (lane & 15)];
    f32x2 Bv[16];
#pragma unroll
    for (int j = 0; j < 16; ++j) Bv[j] = (f32x2){Bre[j], Bim[j]};
    const f32x2 lre2 = {lre, lre}, lim2 = {lim, lim};
#define S5_STEP(t_) do { f32x2 bu0 = {0.f, 0.f}, bu1 = {0.f, 0.f}; \
        _Pragma("unroll") for (int k_ = 0; k_ < 8; ++k_) { const unsigned w_ = (unsigned)__builtin_amdgcn_readlane((int)upk[k_], (t_)); \
            const float ul_ = __uint_as_float(w_ << 16), uh_ = __uint_as_float(w_ & 0xffff0000u); \
            bu0 = __builtin_elementwise_fma(Bv[2 * k_], (f32x2){ul_, ul_}, bu0); bu1 = __builtin_elementwise_fma(Bv[2 * k_ + 1], (f32x2){uh_, uh_}, bu1); } \
        const f32x2 sw_ = {-st[1], st[0]}; \
        st = __builtin_elementwise_fma(st, lre2, __builtin_elementwise_fma(sw_, lim2, bu0 + bu1)); } while (0)
#pragma unroll 1
    for (int cc = 0; cc < 4; ++cc) {
        const int chunk = wave * 4 + cc, t0 = chunk * 64;
        unsigned upk[8];
        { const bf16_t* up = U + (size_t)(b * 2048 + t0 + lane) * 512 + g * 16; const uint4 q0 = *(const uint4*)up, q1 = *(const uint4*)(up + 8);
            upk[0] = q0.x; upk[1] = q0.y; upk[2] = q0.z; upk[3] = q0.w; upk[4] = q1.x; upk[5] = q1.y; upk[6] = q1.z; upk[7] = q1.w; }
        f32x2 st = {0.f, 0.f};
#pragma unroll 4
        for (int t = 0; t < 64; ++t) S5_STEP(t);
        E[(chunk * 64 + p) * 2] = st[0]; E[(chunk * 64 + p) * 2 + 1] = st[1];
    }
    __syncthreads();
    if (wave == 0) {
        float pr = lre, pi = lim;
#pragma unroll
        for (int q = 0; q < 6; ++q) { const float nr = pr * pr - pi * pi, pp_ = pr * pi, ni = pp_ + pp_; pr = nr; pi = ni; }
        float sr = 0.f, si = 0.f;
        for (int c = 0; c < 32; ++c) { const float er = E[(c * 64 + p) * 2], ei = E[(c * 64 + p) * 2 + 1]; E[(c * 64 + p) * 2] = sr; E[(c * 64 + p) * 2 + 1] = si;
            const float nr = pr * sr - pi * si + er, ni = pr * si + pi * sr + ei; sr = nr; si = ni; }
    }
    __syncthreads();
#pragma unroll 1
    for (int cc = 0; cc < 4; ++cc) {
        const int chunk = wave * 4 + cc, t0 = chunk * 64;
        unsigned upk[8];
        { const bf16_t* up = U + (size_t)(b * 2048 + t0 + lane) * 512 + g * 16; const uint4 q0 = *(const uint4*)up, q1 = *(const uint4*)(up + 8);
            upk[0] = q0.x; upk[1] = q0.y; upk[2] = q0.z; upk[3] = q0.w; upk[4] = q1.x; upk[5] = q1.y; upk[6] = q1.z; upk[7] = q1.w;
            float f[16]; unpack8(q0, f); unpack8(q1, f + 8);
#pragma unroll
            for (int q = 0; q < 4; ++q) *(f32x4*)(ust + lane * 16 + q * 4) = (f32x4){f[q * 4], f[q * 4 + 1], f[q * 4 + 2], f[q * 4 + 3]}; }
        f32x2 st = {E[(chunk * 64 + p) * 2], E[(chunk * 64 + p) * 2 + 1]};
#pragma unroll 1
        for (int sb = 0; sb < 4; ++sb) {
#pragma unroll 4
            for (int tt = 0; tt < 16; ++tt) { S5_STEP(sb * 16 + tt);
                *(unsigned*)(sst + tt * 136 + 2 * p) = pk2(st[0], st[1]);
            }
            LDS_FENCE();
            f32x4 acc = {0.f, 0.f, 0.f, 0.f};
#pragma unroll
            for (int ks = 0; ks < 4; ++ks) { const bf16x8 af = *(const bf16x8*)(sst + (lane & 15) * 136 + ks * 32 + (lane >> 4) * 8);
                acc = __builtin_amdgcn_mfma_f32_16x16x32_bf16(af, Cf[ks], acc, 0, 0, 0); }
#pragma unroll
            for (int r = 0; r < 4; ++r) { const int t = sb * 16 + (lane >> 4) * 4 + r, i = lane & 15;
                const float y = gelu_tanh(acc[r] + dsk * ust[t * 16 + i]);
                Y[(size_t)(b * 2048 + t0 + t) * 512 + g * 16 + i] = (bf16_t)f2bf(y); }
            LDS_FENCE();
        }
    }
    __syncthreads();
#undef S5_STEP
}

__device__ __forceinline__ void pool_unit(const Args& a, int b, int chunk, unsigned char* lds, const int WV) {
    const int TI = fresh_tid(WV);
    bf16_t* T = (bf16_t*)lds;
    const int t0 = chunk * 64;
    const bf16_t* P = (const bf16_t*)(a.ws + WS_P) + (size_t)b * 2048 * 512; bf16_t* O = (bf16_t*)(a.ws + WS_POOLED) + (size_t)b * 2048 * 512;
    __syncthreads();
    for (int i = TI; i < 80 * 64; i += 512) { const int r = i >> 6, c8 = i & 63, t = t0 - 16 + r;
        uint4 v = make_uint4(0u, 0u, 0u, 0u); if (t >= 0) v = *(const uint4*)(P + (size_t)t * 512 + c8 * 8);
        *(uint4*)(T + r * 512 + c8 * 8) = v; }
    __syncthreads();
    const int c = TI, w = 2 << (c >> 7);
    float s = 0.f;
    for (int k = 1; k <= w; ++k) s += bf1(T[(16 - k) * 512 + c]);
#pragma unroll 4
    for (int t = 0; t < 64; ++t) { const float pv = bf1(T[(16 + t) * 512 + c]); s += pv; s -= bf1(T[(16 + t - w) * 512 + c]);
        const int tt = t0 + t + 1; const float mean = s / (float)(tt < w ? tt : w); O[(size_t)(t0 + t) * 512 + c] = (bf16_t)f2bf(mean - pv); }
}

__device__ __forceinline__ unsigned sortkey(float x) { const unsigned u = __float_as_uint(x); return (u & 0x80000000u) ? ~u : (u | 0x80000000u); }
__device__ __forceinline__ void dsa_unit(const Args& a, int b, int tq, unsigned char* lds, const int WV, bf16_t* obase, const int ostride, const int parts) {
    const int TI = fresh_tid(WV);
    int tid = TI;
    int lane = tid & 63; const int wave = WV;
    float* sc = (float*)lds;
    unsigned short* sel = (unsigned short*)(lds + 131072);
    float* wis = (float*)(lds + 131072 + 8192);
    bf16_t* ocat = (bf16_t*)(a.ws + WS_OCAT); const bf16_t* Kn = (const bf16_t*)(a.ws + WS_KN); const bf16_t* V = (const bf16_t*)(a.ws + WS_V);
    const bf16_t* QI = (const bf16_t*)(a.ws + WS_QI); const bf16_t* KI = (const bf16_t*)(a.ws + WS_KI); const float* WI = (const float*)(a.ws + WS_WI);
    const int t0 = tq * 16, row0 = b * 2048 + t0, limit = ((t0 >> 6) + 1) << 6, nkt = limit >> 5, nsel = limit < 256 ? limit : 256;
    __syncthreads();
    if (tid < 128) wis[tid] = WI[(size_t)row0 * 8 + tid];
    __syncthreads();
    if (parts & 1)
    {
        const int g = lane >> 5, c32 = lane & 31;
        bf16x8 Af[4][4];
#pragma unroll
        for (int rb = 0; rb < 4; ++rb) { const int R = rb * 32 + c32; const bf16_t* qp = QI + (size_t)(row0 + (R >> 3)) * 512 + (R & 7) * 64 + g * 8;
#pragma unroll
            for (int s = 0; s < 4; ++s) Af[rb][s] = *(const bf16x8*)(qp + s * 16); }
        bf16x8 Bn[4];
        { const bf16_t* kp0 = KI + (size_t)(b * 2048 + wave * 32 + c32) * 64 + g * 8;
#pragma unroll
            for (int s = 0; s < 4; ++s) Bn[s] = *(const bf16x8*)(kp0 + s * 16); }
#pragma unroll 1
        for (int kt = wave; kt < nkt; kt += 8) {
            bf16x8 Bf[4];
#pragma unroll
            for (int s = 0; s < 4; ++s) Bf[s] = Bn[s];
            if (kt + 8 < nkt) { const bf16_t* kp = KI + (size_t)(b * 2048 + (kt + 8) * 32 + c32) * 64 + g * 8;
#pragma unroll
                for (int s = 0; s < 4; ++s) Bn[s] = *(const bf16x8*)(kp + s * 16); }
#pragma unroll
            for (int rb = 0; rb < 4; ++rb) {
                f32x16 acc;
#pragma unroll
                for (int i = 0; i < 16; ++i) acc[i] = 0.f;
#pragma unroll
                for (int s = 0; s < 4; ++s) acc = __builtin_amdgcn_mfma_f32_32x32x16_bf16(Af[rb][s], Bf[s], acc, 0, 0, 0);
#pragma unroll
                for (int j = 0; j < 4; ++j) { const int q = rb * 4 + j; const f32x4 w4 = *(const f32x4*)(wis + q * 8 + 4 * g);
                    float sp = fmaxf(acc[4 * j], 0.f) * w4[0] + fmaxf(acc[4 * j + 1], 0.f) * w4[1] + fmaxf(acc[4 * j + 2], 0.f) * w4[2] + fmaxf(acc[4 * j + 3], 0.f) * w4[3];
                    sp += __shfl_xor(sp, 32);
                    if (g == 0) sc[q * 2048 + kt * 32 + c32] = sp; }
            }
        }
    }
    __syncthreads();
    lane = fresh_tid(WV) & 63;
    const unsigned long long ltmask = (1ull << lane) - 1ull;
    for (int qq = 0; qq < 2; ++qq) {
        const int q = wave * 2 + qq; unsigned short* sq = sel + q * 256;
        if (limit <= 256 || !(parts & 2)) { for (int j = lane; j < nsel; j += 64) sq[j] = (unsigned short)j; }
        else {
            unsigned key[32];
#pragma unroll
            for (int j = 0; j < 32; ++j) { const int idx = j * 64 + lane; key[j] = (idx < limit) ? sortkey(sc[q * 2048 + idx]) : 0u; }
            unsigned T = 0u;
            for (int bit = 31; bit >= 0; --bit) { const unsigned cand = T | (1u << bit); int cnt = 0;
#pragma unroll
                for (int j = 0; j < 32; ++j) cnt += __popcll(__ballot(key[j] >= cand));
                if (cnt >= 256) { T = cand; if (cnt == 256) break; } }
            int cgt = 0;
#pragma unroll
            for (int j = 0; j < 32; ++j) cgt += __popcll(__ballot(key[j] > T));
            const int need = 256 - cgt; int ob = 0, tb = 0;
#pragma unroll
            for (int j = 0; j < 32; ++j) { const bool gt = key[j] > T, eq = key[j] == T; const unsigned long long me = __ballot(eq);
                const int pe = tb + __popcll(me & ltmask); const bool take = gt || (eq && pe < need); const unsigned long long mt = __ballot(take);
                if (take) sq[ob + __popcll(mt & ltmask)] = (unsigned short)(j * 64 + lane);
                ob += __popcll(mt); tb += __popcll(me); }
        }
    }
    __syncthreads();
    lane = fresh_tid(WV) & 63;
    float* Pw = (float*)lds + wave * 2048;
    const int g4 = lane >> 4, hh = lane & 15;
#pragma unroll 1
    for (int qq = 0; qq < 2; ++qq) {
        const int q = wave * 2 + qq; const size_t row = (size_t)(row0 + q); const unsigned short* sq = sel + q * 256;
        if (parts & 4) {
        bf16x8 Qf[4];
#pragma unroll
        for (int s = 0; s < 4; ++s) Qf[s] = *(const bf16x8*)(ocat + row * 2048 + (hh & 7) * 128 + g4 * 8 + s * 32);
        float lg[16][4];
#pragma unroll
        for (int kg = 0; kg < 4; ++kg) {
            if (kg * 64 < nsel) {
                bf16x8 kf[4][4];
#pragma unroll
                for (int k4 = 0; k4 < 4; ++k4) { const int idx = sq[(kg * 4 + k4) * 16 + hh]; const bf16_t* kp = Kn + (size_t)(b * 2048 + idx) * 128 + g4 * 8;
#pragma unroll
                    for (int s = 0; s < 4; ++s) kf[k4][s] = *(const bf16x8*)(kp + s * 32); }
#pragma unroll
                for (int k4 = 0; k4 < 4; ++k4) { f32x4 c = {0.f, 0.f, 0.f, 0.f};
#pragma unroll
                    for (int s = 0; s < 4; ++s) c = __builtin_amdgcn_mfma_f32_16x16x32_bf16(kf[k4][s], Qf[s], c, 0, 0, 0);
#pragma unroll
                    for (int r = 0; r < 4; ++r) lg[kg * 4 + k4][r] = c[r] * 0.08838834764831845f; }
            } else {
#pragma unroll
                for (int k4 = 0; k4 < 4; ++k4)
#pragma unroll
                    for (int r = 0; r < 4; ++r) lg[kg * 4 + k4][r] = -1e30f;
            }
        }
        float mx = -1e30f;
#pragma unroll
        for (int kb = 0; kb < 16; ++kb)
#pragma unroll
            for (int r = 0; r < 4; ++r) mx = fmaxf(mx, lg[kb][r]);
        mx = fmaxf(mx, __shfl_xor(mx, 16)); mx = fmaxf(mx, __shfl_xor(mx, 32));
        float sum = 0.f;
#pragma unroll
        for (int kb = 0; kb < 16; ++kb)
#pragma unroll
            for (int r = 0; r < 4; ++r) { const float e = (kb * 16 < nsel) ? __expf(lg[kb][r] - mx) : 0.f; lg[kb][r] = e; sum += e; }
        sum += __shfl_xor(sum, 16); sum += __shfl_xor(sum, 32);
        const float inv = 1.f / sum;
        if (hh < 8) {
#pragma unroll
            for (int kb = 0; kb < 16; ++kb)
                if (kb * 16 < nsel) {
#pragma unroll
                    for (int r = 0; r < 4; ++r) Pw[(kb * 16 + g4 * 4 + r) * 8 + hh] = lg[kb][r] * inv; }
        }
        }
        LDS_FENCE();
        if (!(parts & 8)) continue;
        float o[8][8];
#pragma unroll
        for (int h = 0; h < 8; ++h)
#pragma unroll
            for (int d = 0; d < 8; ++d) o[h][d] = 0.f;
        const bf16_t* Vb = V + (size_t)b * 2048 * 128 + hh * 8;
        uint4 vq[8], vn[8];
#pragma unroll
        for (int jj = 0; jj < 8; ++jj) { const int idx = sq[jj * 4 + g4]; vq[jj] = *(const uint4*)(Vb + (size_t)idx * 128); }
#pragma unroll 1
        for (int j0 = 0; j0 < nsel; j0 += 32) {
            if (j0 + 32 < nsel) {
#pragma unroll
                for (int jj = 0; jj < 8; ++jj) { const int idx = sq[j0 + 32 + jj * 4 + g4]; vn[jj] = *(const uint4*)(Vb + (size_t)idx * 128); }
            }
#pragma unroll
            for (int jj = 0; jj < 8; ++jj) { const int slot = j0 + jj * 4 + g4;
                const f32x4 pa = *(const f32x4*)(Pw + slot * 8), pb = *(const f32x4*)(Pw + slot * 8 + 4);
                float v[8]; unpack8(vq[jj], v);
#pragma unroll
                for (int h = 0; h < 4; ++h)
#pragma unroll
                    for (int d = 0; d < 8; ++d) { o[h][d] = fmaf(pa[h], v[d], o[h][d]); o[4 + h][d] = fmaf(pb[h], v[d], o[4 + h][d]); } }
#pragma unroll
            for (int jj = 0; jj < 8; ++jj) vq[jj] = vn[jj];
        }
        { const bool b4 = (lane & 16) != 0, b5 = (lane & 32) != 0;
            float kp[4][8];
#pragma unroll
            for (int i = 0; i < 4; ++i)
#pragma unroll
                for (int d = 0; d < 8; ++d) { const float snd = b4 ? o[i][d] : o[4 + i][d]; const float rcv = __shfl_xor(snd, 16); kp[i][d] = (b4 ? o[4 + i][d] : o[i][d]) + rcv; }
#pragma unroll
            for (int i = 0; i < 2; ++i) { float fin[8];
#pragma unroll
                for (int d = 0; d < 8; ++d) { const float snd = b5 ? kp[i][d] : kp[2 + i][d]; const float rcv = __shfl_xor(snd, 32); fin[d] = (b5 ? kp[2 + i][d] : kp[i][d]) + rcv; }
                const int head = (b4 ? 4 : 0) + (b5 ? 2 : 0) + i;
                uint4 ov; ov.x = pk2(fin[0], fin[1]); ov.y = pk2(fin[2], fin[3]); ov.z = pk2(fin[4], fin[5]); ov.w = pk2(fin[6], fin[7]);
                *(uint4*)(obase + row * ostride + head * 128 + hh * 8) = ov; }
        }
        LDS_FENCE();
    }
}

__device__ __forceinline__ void phase_fix(const Args& a, int l, const int WV) {
    const int TI = fresh_tid(WV);
    const float* SA = (const float*)(a.ws + WS_SA); const float* SB = (const float*)(a.ws + WS_SB); bf16_t* act = (bf16_t*)(a.ws + WS_R2);
    const float* cw = a.in[I_CONVW] + (size_t)l * 3 * DFF; const float* cb = a.in[I_CONVB] + (size_t)l * DFF;
    const int total = 512 * 2 * DFF;
    for (int i = blockIdx.x * 512 + TI; i < total; i += gridDim.x * 512) {
        const int ch = i % DFF, rb = i / DFF, rr = rb & 1, blk = rb >> 1, r = blk * 64 + rr, t = r & 2047;
        const float a0 = SA[((size_t)blk * 4 + 2 + rr) * DFF + ch];
        float am1, am2;
        if (rr == 0) { am1 = (t >= 1) ? SA[((size_t)(blk - 1) * 4 + 1) * DFF + ch] : 0.f; am2 = (t >= 2) ? SA[((size_t)(blk - 1) * 4 + 0) * DFF + ch] : 0.f; }
        else { am1 = SA[((size_t)blk * 4 + 2) * DFF + ch]; am2 = (t >= 2) ? SA[((size_t)(blk - 1) * 4 + 1) * DFF + ch] : 0.f; }
        const float cv = cb[ch] + cw[ch] * am2 + cw[DFF + ch] * am1 + cw[2 * DFF + ch] * a0;
        act[(size_t)r * DFF + ch] = (bf16_t)f2bf(siluf_(cv) * SB[((size_t)blk * 2 + rr) * DFF + ch]);
    }
}

__device__ __forceinline__ void run_phase(const Args& a, int ph, unsigned char* lds, const int WV, const bool dummy) {
    unsigned char* ws = a.ws;
    LAS unsigned char* ldsl = (LAS unsigned char*)lds;
    const int G = gridDim.x, bx = blockIdx.x;
#ifndef DBG_NOADA
    if (ph == 0) { phase_ada(a, lds, WV); return; }
#else
    if (ph == 0) return;
#endif
    const int l = (ph - 1) / 10, sp = (ph - 1) % 10;
    const float* modl = (const float*)(ws + WS_MOD) + (size_t)l * 16 * 12288;
    const float* xin = (l == 0) ? a.in[I_X] : a.out;
#ifdef DBG_SP
    if (sp != DBG_SP) return;
#endif
    switch (sp) {
    case 0: phase_cvt(a, l, lds, WV); phase_norm(xin, a.in[I_GN1] + l * DM, modl, 0, 2048, (bf16_t*)(ws + WS_R1), WV); break;
    case 1: {
        pg8::Gemm g{(const bf16_t*)(ws + WS_R1), (const bf16_t*)(ws + W_1CAT), MROWS, N1, DM, DM, DM, 1 << 30, 0}; pg8::StaticOrder S; S.init(MROWS, N1, G, bx);
        Epi1 E{(bf16_t*)(ws + WS_OCAT), (bf16_t*)(ws + WS_KN), (bf16_t*)(ws + WS_V), (bf16_t*)(ws + WS_QI), (bf16_t*)(ws + WS_KI), (bf16_t*)(ws + WS_U), (bf16_t*)(ws + WS_P), (bf16_t*)(ws + WS_R2),
               (float*)(ws + WS_WI), a.in[I_BGATE] + (size_t)l * 3 * DM, ldsl + 131072};
        pg8::gemm_phase<Epi1, pg8::StaticOrder>(ldsl, g, S, E, WV); } break;
    case 2:
        if (!dummy) phase_post(a, l, lds, WV);
        __syncthreads();
        for (int u = bx; u < 512; u += G) s5_unit(a, l, u >> 5, u & 31, lds, WV);
        for (int u = bx; u < 512; u += G) pool_unit(a, u >> 5, u & 31, lds, WV);
        break;
    case 3: {
#ifndef DBG_NO_DSA
#ifdef DSA_PROBE
        for (int rep = 0; rep < 2; ++rep) { const bool dm = (rep == 0); const int parts = dm ? (DSA_PROBE) : 15;
#else
        { const bool dm = dummy; const int parts = 15;
#endif
            for (int u = bx; u < 2048; u += G) { const int w = u & 255, i = u >> 8, b = w & 15, s = w >> 4; const int tq = (i & 1) ? (i * 16 + 15 - s) : (i * 16 + s);
                dsa_unit(a, b, tq, lds, WV, dm ? (bf16_t*)(ws + WS_R1 + 64 * MiB) : (bf16_t*)(ws + WS_OCAT), dm ? 1024 : 2048, parts); }
        }
        __syncthreads();
#endif
#ifndef DBG_DSA_ONLY
        { pg8::Gemm g{(const bf16_t*)(ws + WS_Y), (const bf16_t*)(ws + W_GLU), MROWS, 1024, 512, 512, 512, 2, WS_POOLED - WS_Y}; pg8::StaticOrder S; S.init(MROWS, 1024, G, bx);
          EpiGluPool E{(const bf16_t*)(ws + WS_Y), a.in[I_PSCALE] + l * 512, (bf16_t*)(ws + WS_OCAT)}; pg8::gemm_phase<EpiGluPool, pg8::StaticOrder>(ldsl, g, S, E, WV); }
#endif
        } break;
    case 4: {
        pg8::Gemm g{(const bf16_t*)(ws + WS_OCAT), (const bf16_t*)(ws + W_P), MROWS, DM, DM, DM, DM, 1 << 30, 0}; pg8::StaticOrder S; S.init(MROWS, DM, G, bx);
        EpiMerge E{(const bf16_t*)(ws + WS_R2), (bf16_t*)(ws + WS_R1)}; pg8::gemm_phase<EpiMerge, pg8::StaticOrder>(ldsl, g, S, E, WV); } break;
    case 5: {
        pg8::Gemm g{(const bf16_t*)(ws + WS_R1), (const bf16_t*)(ws + W_OUT), MROWS, DM, DM, DM, DM, 1 << 30, 0}; pg8::StaticOrder S; S.init(MROWS, DM, G, bx);
        EpiRes E{xin, dummy ? (float*)(ws + WS_OCAT) : a.out, modl + 4096}; pg8::gemm_phase<EpiRes, pg8::StaticOrder>(ldsl, g, S, E, WV); } break;
    case 6: phase_norm(a.out, a.in[I_GN2] + l * DM, modl, 6144, 8192, (bf16_t*)(ws + WS_R1), WV); break;
    case 7: {
        pg8::Gemm g{(const bf16_t*)(ws + WS_R1), (const bf16_t*)(ws + W_UP), MROWS, 2 * DFF, DM, DM, DM, 1 << 30, 0}; pg8::StaticOrder S; S.init(MROWS, 2 * DFF, G, bx);
        EpiUp E{(bf16_t*)(ws + WS_R2), (float*)(ws + WS_SA), (float*)(ws + WS_SB), a.in[I_CONVW] + (size_t)l * 3 * DFF, a.in[I_CONVB] + (size_t)l * DFF, ldsl + 131072};
        pg8::gemm_phase<EpiUp, pg8::StaticOrder>(ldsl, g, S, E, WV); } break;
    case 8: phase_fix(a, l, WV); break;
    case 9: {
        pg8::Gemm g{(const bf16_t*)(ws + WS_R2), (const bf16_t*)(ws + W_DOWN), MROWS, DM, DFF, DFF, DFF, 1 << 30, 0}; pg8::StaticOrder S; S.init(MROWS, DM, G, bx);
        EpiRes E{a.out, dummy ? (float*)(ws + WS_OCAT) : a.out, modl + 10240}; pg8::gemm_phase<EpiRes, pg8::StaticOrder>(ldsl, g, S, E, WV); } break;
    }
}

__device__ __forceinline__ void grid_bar(unsigned* ctr, unsigned target, int wave_id) {
    asm volatile("s_waitcnt vmcnt(0) lgkmcnt(0)" ::: "memory");
    __syncthreads();
    if (wave_id == 0) {
        const int l = (int)__builtin_amdgcn_mbcnt_hi(~0u, __builtin_amdgcn_mbcnt_lo(~0u, 0u));
        if (l == 0) {
            __builtin_amdgcn_fence(__ATOMIC_RELEASE, "agent");
            asm volatile("s_waitcnt vmcnt(0)" ::: "memory");
            (void)__hip_atomic_fetch_add(ctr, 1u, __ATOMIC_RELAXED, __HIP_MEMORY_SCOPE_AGENT);
            unsigned sp = 0u;
            while (__hip_atomic_load(ctr, __ATOMIC_RELAXED, __HIP_MEMORY_SCOPE_AGENT) < target) { __builtin_amdgcn_s_sleep(1); if (++sp > (1u << 22)) break; }
            __builtin_amdgcn_fence(__ATOMIC_ACQUIRE, "agent");
            asm volatile("s_waitcnt vmcnt(0)" ::: "memory");
        }
    }
    __syncthreads();
}

__global__ void __launch_bounds__(512, 2) mega_fwd(Args a) {
    extern __shared__ __attribute__((aligned(16))) unsigned char lds[];
    cg::grid_group grid = cg::this_grid();
    const int wave_id = __builtin_amdgcn_readfirstlane((int)(threadIdx.x >> 6));
    const int ph_lo = a.ph_lo, ph_hi = a.ph_hi;
    unsigned nbar = 0u;
    for (int ph = ph_lo; ph < ph_hi; ++ph) {
        const __attribute__((address_space(4))) Args* kp = (const __attribute__((address_space(4))) Args*)__builtin_amdgcn_kernarg_segment_ptr();
        asm volatile("" : "+s"(kp));
        Args la;
#pragma unroll
        for (int i = 0; i < 31; ++i) la.in[i] = (const float*)(const __attribute__((address_space(1))) float*)kp->in[i];
        la.ws = (unsigned char*)(__attribute__((address_space(1))) unsigned char*)kp->ws;
        la.out = (float*)(__attribute__((address_space(1))) float*)kp->out;
        la.ph_lo = ph_lo; la.ph_hi = ph_hi;
#ifdef REP_MASK
        if (ph > 0 && ((REP_MASK >> ((ph - 1) % 10)) & 1)) { run_phase(la, ph, lds, wave_id, true); grid.sync(); }
#endif
        run_phase(la, ph, lds, wave_id, false);
        if (ph + 1 < ph_hi) {
            if (ph == ph_lo) grid.sync();
            else { ++nbar; grid_bar((unsigned*)la.ws, nbar * gridDim.x, wave_id); }
        }
    }
}

extern "C" void kernel_launch(void* const* d_in, const int* in_sizes, int n_in, void* d_out, int out_size, void* d_ws, size_t ws_size, hipStream_t stream) {
    static int grid = 0;
    if (grid == 0) {
        int dev = 0, cus = 0, per_cu = 0;
        if (n_in != 31 || ws_size < WS_END) { fprintf(stderr, "kernel_launch: unexpected n_in %d / ws %zu\n", n_in, ws_size); grid = -1; return; }
        hipGetDevice(&dev); hipDeviceGetAttribute(&cus, hipDeviceAttributeMultiprocessorCount, dev);
        if (hipFuncSetAttribute((const void*)mega_fwd, hipFuncAttributeMaxDynamicSharedMemorySize, LDS_BYTES) != hipSuccess) { fprintf(stderr, "kernel_launch: hipFuncSetAttribute failed\n"); grid = -1; return; }
        if (hipOccupancyMaxActiveBlocksPerMultiprocessor(&per_cu, (const void*)mega_fwd, 512, LDS_BYTES) != hipSuccess || per_cu < 1) { fprintf(stderr, "kernel_launch: occupancy query says %d blocks/CU\n", per_cu); per_cu = 1; }
        (void)hipGetLastError();
        grid = cus > 0 ? cus : 256;
    }
    if (grid < 0) return;
    if (hipMemsetAsync(d_ws, 0, 256, stream) != hipSuccess) { fprintf(stderr, "kernel_launch: memset of the barrier word failed\n"); return; }
    Args a{};
    for (int i = 0; i < 31; ++i) a.in[i] = (const float*)d_in[i];
    a.out = (float*)d_out; a.ws = (unsigned char*)d_ws;
#if MK_PER_PHASE
    for (int ph = 0; ph < NPHASE; ++ph) {
        a.ph_lo = ph; a.ph_hi = ph + 1;
        void* args[] = {&a};
        hipError_t e = hipLaunchCooperativeKernel((const void*)mega_fwd, dim3(grid), dim3(512), args, LDS_BYTES, stream);
        if (e != hipSuccess) { fprintf(stderr, "kernel_launch: launch of phase %d failed: %s\n", ph, hipGetErrorString(e)); break; }
    }
#else
    a.ph_lo = 0; a.ph_hi = NPHASE;
    void* args[] = {&a};
    hipError_t e = hipLaunchCooperativeKernel((const void*)mega_fwd, dim3(grid), dim3(512), args, LDS_BYTES, stream);
    if (e != hipSuccess) fprintf(stderr, "kernel_launch: cooperative launch failed: %s (grid %d)\n", hipGetErrorString(e), grid);
#endif
}
```

```cpp
#include <hip/hip_runtime.h>
#include <hip/hip_cooperative_groups.h>
#include <cstdio>
#include <cstdint>
namespace cg = cooperative_groups;

#ifndef MK_PER_PHASE
#define MK_PER_PHASE 0
#endif

typedef unsigned short bf16_t;
typedef short bf16x8 __attribute__((ext_vector_type(8)));
typedef float f32x4 __attribute__((ext_vector_type(4)));
typedef float f32x2 __attribute__((ext_vector_type(2)));
typedef float f32x16 __attribute__((ext_vector_type(16)));
typedef unsigned u32x4 __attribute__((ext_vector_type(4)));
typedef unsigned u32x2 __attribute__((ext_vector_type(2)));
#define LAS __attribute__((address_space(3)))

constexpr int BATCH = 16, SEQ = 2048, DM = 2048, MROWS = BATCH * SEQ, DIN = 2888, DFF = 5504;
constexpr int N1 = 9216;
constexpr float EPS = 1e-6f;
constexpr int NPHASE = 21;

constexpr size_t MiB = 1u << 20;
constexpr size_t WS_MOD = 1 * MiB;
constexpr size_t WS_WI = 3 * MiB;
constexpr size_t WS_W = 4 * MiB;
constexpr size_t W_1CAT = WS_W, W_P = WS_W + 36 * MiB, W_OUT = WS_W + 44 * MiB, W_UP = WS_W + 52 * MiB, W_DOWN = WS_W + 95 * MiB,
                 W_GLU = WS_W + 116 * MiB + MiB / 2, W_POOL = WS_W + 117 * MiB;
constexpr size_t WS_R1 = 122 * MiB;
constexpr size_t WS_Y = WS_R1, WS_POOLED = WS_R1 + 32 * MiB;
constexpr size_t WS_R2 = 250 * MiB;
constexpr size_t WS_OCAT = 634 * MiB;
constexpr size_t WS_SA = WS_OCAT, WS_SB = WS_OCAT + 44 * MiB;
constexpr size_t WS_KN = 762 * MiB, WS_V = 770 * MiB, WS_QI = 778 * MiB, WS_KI = 810 * MiB, WS_U = 814 * MiB, WS_P = 846 * MiB, WS_END = 878 * MiB;
constexpr int LDS_BYTES = 155648;

__device__ __forceinline__ unsigned f2bf(float f) { unsigned u = __float_as_uint(f); return (u + 0x7fffu + ((u >> 16) & 1u)) >> 16; }
__device__ __forceinline__ unsigned pk2(float lo, float hi) { return f2bf(lo) | (f2bf(hi) << 16); }
__device__ __forceinline__ float bflo(unsigned u) { return __uint_as_float(u << 16); }
__device__ __forceinline__ float bfhi(unsigned u) { return __uint_as_float(u & 0xffff0000u); }
__device__ __forceinline__ float bf1(bf16_t b) { return __uint_as_float(((unsigned)b) << 16); }
__device__ __forceinline__ float sigmoidf_(float x) { return 1.f / (1.f + __expf(-x)); }
__device__ __forceinline__ float siluf_(float x) { return x / (1.f + __expf(-x)); }
__device__ __forceinline__ float gelu_tanh(float x) { const float z = 0.7978845608028654f * (x + 0.044715f * x * x * x); const float t = 1.f - 2.f / (1.f + __expf(2.f * z)); return 0.5f * x * (1.f + t); }
__device__ __forceinline__ uint4 pack8(f32x4 a, f32x4 b) { uint4 r; r.x = pk2(a[0], a[1]); r.y = pk2(a[2], a[3]); r.z = pk2(b[0], b[1]); r.w = pk2(b[2], b[3]); return r; }
__device__ __forceinline__ void unpack8(uint4 v, float* f) { f[0] = bflo(v.x); f[1] = bfhi(v.x); f[2] = bflo(v.y); f[3] = bfhi(v.y); f[4] = bflo(v.z); f[5] = bfhi(v.z); f[6] = bflo(v.w); f[7] = bfhi(v.w); }
#define LDS_FENCE() asm volatile("s_waitcnt lgkmcnt(0)" ::: "memory")
__device__ __forceinline__ int fresh_tid(int wv) { int l = (int)__builtin_amdgcn_mbcnt_hi(~0u, __builtin_amdgcn_mbcnt_lo(~0u, 0u)); asm volatile("" : "+v"(l)); return (wv << 6) | l; }

namespace pg8 {
constexpr int BM = 256, BK = 64, HALF = 128, HTB = HALF * BK * 2, STAGE_BYTES = 8 * HTB, NXCD = 8, WGM = 8;
__host__ __device__ __forceinline__ int lds_byte(int r, int c) { const int st = (r >> 4) * 2 + (c >> 5), rr = r & 15, cc = c & 31, ob = rr * 64 + cc * 2; return st * 1024 + (ob ^ (((ob >> 9) & 1) << 5)); }
__host__ __device__ __forceinline__ void stage_rc(int b, int& R, int& C) { const int st = b / 1024, sb = b % 1024, swz = sb ^ (((sb >> 9) & 1) << 5); R = (st >> 1) * 16 + swz / 64; C = (st & 1) * 32 + (swz % 64) / 2; }
__host__ __device__ __forceinline__ int perm32(int rho) { const int n = rho >> 4, i = rho & 15; return 8 * (i >> 2) + 4 * n + (i & 3); }
struct Unit { int pm, pn; };
struct Gemm { const bf16_t* A; const bf16_t* Bt; int M, N, K, lda, ldb; int asplit; size_t aoff; };
struct StaticOrder {
    int nM, nN, nwg, G, c;
    __device__ void init(int M, int N, int G_, int c_) { nM = M / BM; nN = N / BM; nwg = nM * nN; G = G_; c = c_; }
    __device__ bool next(int i, Unit& u) const {
        const long L = (long)i * G + c; if (L >= nwg) return false;
        int wgid = (int)L; { const int q = nwg / NXCD, r = nwg % NXCD, xcd = wgid % NXCD, off = wgid / NXCD; wgid = (xcd < r ? xcd * (q + 1) : r * (q + 1) + (xcd - r) * q) + off; }
        const int nig = WGM * nN, gid = wgid / nig, fm = gid * WGM, gsz = (nM - fm) < WGM ? (nM - fm) : WGM;
        u.pm = fm + ((wgid % nig) % gsz); u.pn = (wgid % nig) / gsz; return true;
    }
};
template <class Epi, class Sched>
__device__ __forceinline__ void gemm_phase(LAS unsigned char* lds, const Gemm g, const Sched& S, const Epi& E, const int WV) {
    const int TI = fresh_tid(WV);
    const int tid = TI, wid = __builtin_amdgcn_readfirstlane(tid >> 6), lane = tid & 63, wr = wid >> 2, wc = wid & 3, fr = lane & 15, fq = lane >> 4;
    const int K = g.K, nt = K / BK;
    unsigned voffA[2], voffB[2];
#pragma unroll
    for (int i = 0; i < 2; ++i) { int R, C; stage_rc(tid * 16 + i * 8192, R, C); const int Rb = Epi::PERM ? ((R & ~31) + perm32(R & 31)) : R;
        voffA[i] = (unsigned)(R * g.lda + C) * 2u; voffB[i] = (unsigned)(Rb * g.ldb + C) * 2u; }
    const size_t kstep = (size_t)(BK * 2);
    const size_t hstepA = (size_t)HALF * g.lda * 2, hstepB = (size_t)HALF * g.ldb * 2;
    const size_t tstepA = 2 * hstepA, tstepB = 2 * hstepB;
    const unsigned ldsw = (unsigned)wid * 1024u;
    const int aoff = lds_byte(wr * 64 + fr, fq * 8), boff = lds_byte(wc * 32 + fr, fq * 8);
#define PG8_SA(b, h) (((b) * 2 + (h)) * HTB)
#define PG8_SB(b, h) ((4 + (b) * 2 + (h)) * HTB)
#define PG8_STAGE(bufoff, gbase, voff) do { _Pragma("unroll") for (int _i = 0; _i < 2; ++_i) \
        __builtin_amdgcn_global_load_lds((const unsigned*)((const char*)(gbase) + (voff)[_i]), (LAS unsigned*)(lds + (bufoff) + ldsw + _i * 8192), 16, 0, 0); } while (0)
#define PG8_LDA(dst, b, h) do { _Pragma("unroll") for (int m = 0; m < 4; ++m) _Pragma("unroll") for (int k = 0; k < 2; ++k) dst[m][k] = *(const LAS bf16x8*)(lds + PG8_SA(b, h) + aoff + m * 2048 + k * 1024); } while (0)
#define PG8_LDB(dst, b, h) do { _Pragma("unroll") for (int n = 0; n < 2; ++n) _Pragma("unroll") for (int k = 0; k < 2; ++k) dst[n][k] = *(const LAS bf16x8*)(lds + PG8_SB(b, h) + boff + n * 2048 + k * 1024); } while (0)
#define PG8_MMA(ai, bj, At, Bt) do { __builtin_amdgcn_s_setprio(1); _Pragma("unroll") for (int m = 0; m < 4; ++m) _Pragma("unroll") for (int n = 0; n < 2; ++n) _Pragma("unroll") for (int k = 0; k < 2; ++k) \
        acc[ai][bj][m][n] = __builtin_amdgcn_mfma_f32_16x16x32_bf16(Bt[n][k], At[m][k], acc[ai][bj][m][n], 0, 0, 0); __builtin_amdgcn_s_setprio(0); } while (0)
#define PG8_WAIT_V(n) asm volatile("s_waitcnt vmcnt(" #n ")" ::: "memory")
#define PG8_WAIT_L(n) asm volatile("s_waitcnt lgkmcnt(" #n ")" ::: "memory")
#define PG8_BAR __builtin_amdgcn_s_barrier()
#define PG8_SCHED __builtin_amdgcn_sched_barrier(0)
#define PG8_ZERO() do { _Pragma("unroll") for (int a_ = 0; a_ < 2; ++a_) _Pragma("unroll") for (int b_ = 0; b_ < 2; ++b_) _Pragma("unroll") for (int m_ = 0; m_ < 4; ++m_) _Pragma("unroll") for (int n_ = 0; n_ < 2; ++n_) acc[a_][b_][m_][n_] = (f32x4){0.f, 0.f, 0.f, 0.f}; } while (0)
    Unit cur, nxt; int ui = 0;
    if (!S.next(0, cur)) return;
    f32x4 acc[2][2][4][2];
    PG8_ZERO();
    bf16x8 At[4][2], B0[2][2], B1[2][2];
    const char* cA = (const char*)g.A + (size_t)cur.pm * tstepA + (cur.pn >= g.asplit ? g.aoff : (size_t)0); const char* cB = (const char*)g.Bt + (size_t)cur.pn * tstepB;
    PG8_STAGE(PG8_SB(0, 0), cB, voffB); PG8_STAGE(PG8_SA(0, 0), cA, voffA); PG8_STAGE(PG8_SB(0, 1), cB + hstepB, voffB); PG8_STAGE(PG8_SA(0, 1), cA + hstepA, voffA);
    if (wr == 1) PG8_BAR;
    PG8_WAIT_V(4); PG8_BAR;
    PG8_STAGE(PG8_SB(1, 0), cB + kstep, voffB); PG8_STAGE(PG8_SA(1, 0), cA + kstep, voffA); PG8_STAGE(PG8_SB(1, 1), cB + hstepB + kstep, voffB);
    PG8_WAIT_V(6); PG8_BAR;
    for (;;) {
        const bool has_next = S.next(ui + 1, nxt);
        const char* nA = has_next ? (const char*)g.A + (size_t)nxt.pm * tstepA + (nxt.pn >= g.asplit ? g.aoff : (size_t)0) : cA; const char* nB = has_next ? (const char*)g.Bt + (size_t)nxt.pn * tstepB : cB;
        for (int t = 0; t < nt; t += 2) {
            const bool last = (t == nt - 2);
            const char* a1 = cA + (size_t)(t + 1) * kstep;
            const char* a2 = last ? nA : cA + (size_t)(t + 2) * kstep; const char* b2 = last ? nB : cB + (size_t)(t + 2) * kstep;
            const char* a3 = a2 + kstep; const char* b3 = b2 + kstep;
            PG8_LDB(B0, 0, 0); PG8_SCHED; PG8_LDA(At, 0, 0); PG8_STAGE(PG8_SA(1, 1), a1 + hstepA, voffA);
            PG8_WAIT_L(8); PG8_BAR; PG8_WAIT_L(0); PG8_MMA(0, 0, At, B0); PG8_BAR; PG8_SCHED;
            PG8_LDB(B1, 0, 1); PG8_STAGE(PG8_SB(0, 0), b2, voffB);
            PG8_BAR; PG8_WAIT_L(0); PG8_MMA(0, 1, At, B1); PG8_BAR;
            PG8_LDA(At, 0, 1); PG8_STAGE(PG8_SA(0, 0), a2, voffA);
            PG8_BAR; PG8_WAIT_L(0); PG8_MMA(1, 0, At, B0); PG8_BAR; PG8_SCHED;
            PG8_STAGE(PG8_SB(0, 1), b2 + hstepB, voffB);
            PG8_WAIT_V(6); PG8_BAR; PG8_MMA(1, 1, At, B1); PG8_BAR;
            PG8_LDB(B0, 1, 0); PG8_SCHED; PG8_LDA(At, 1, 0); PG8_STAGE(PG8_SA(0, 1), a2 + hstepA, voffA);
            PG8_WAIT_L(8); PG8_BAR; PG8_WAIT_L(0); PG8_MMA(0, 0, At, B0); PG8_BAR; PG8_SCHED;
            PG8_LDB(B1, 1, 1); PG8_STAGE(PG8_SB(1, 0), b3, voffB);
            PG8_BAR; PG8_WAIT_L(0); PG8_MMA(0, 1, At, B1); PG8_BAR;
            PG8_LDA(At, 1, 1); PG8_STAGE(PG8_SA(1, 0), a3, voffA);
            PG8_BAR; PG8_WAIT_L(0); PG8_MMA(1, 0, At, B0); PG8_BAR; PG8_SCHED;
            PG8_STAGE(PG8_SB(1, 1), b3 + hstepB, voffB);
            PG8_WAIT_V(6); PG8_BAR; PG8_MMA(1, 1, At, B1); PG8_BAR;
            if constexpr (Epi::SEG) { if (t + 2 == 16 || t + 2 == 24) { E.flush(acc, cur, (t + 2 == 16) ? 0 : 1, wr, wc, fr, fq); PG8_ZERO(); } }
        }
        if constexpr (Epi::SEG) E.flush(acc, cur, 2, wr, wc, fr, fq); else E(acc, cur, wr, wc, fr, fq);
        if (!has_next) break;
        PG8_ZERO();
        cur = nxt; cA = nA; cB = nB; ++ui;
    }
    PG8_WAIT_V(0);
    if (wr == 0) PG8_BAR;
    PG8_BAR;
#undef PG8_SA
#undef PG8_SB
#undef PG8_STAGE
#undef PG8_LDA
#undef PG8_LDB
#undef PG8_MMA
#undef PG8_WAIT_V
#undef PG8_WAIT_L
#undef PG8_BAR
#undef PG8_SCHED
#undef PG8_ZERO
}
}
using pg8::Unit;
typedef const f32x4 (&AccRef)[2][2][4][2];

struct Epi1 {
    static constexpr bool PERM = true, SEG = false;
    bf16_t *ocat, *kn, *vv, *qi, *ki, *u, *p, *gates; float* wi; const float* bgate; LAS unsigned char* stg;
    __device__ __forceinline__ void operator()(AccRef acc, const Unit& un, int wr, int wc, int fr, int fq) const {
        asm volatile("" : "+v"(fr), "+v"(fq));
        const int pn = un.pn, rowb = un.pm * 256 + wr * 64, lane = fq * 16 + fr;
        LAS unsigned char* sb = stg + (wr * 4 + wc) * 2304;
        if (pn == 7 && wc >= 1) {
            if (wc == 1 && fq == 0) {
                const float s = 0.35355339059327373f * 0.125f;
#pragma unroll
                for (int ai = 0; ai < 2; ++ai)
#pragma unroll
                    for (int m = 0; m < 4; ++m) { const size_t row = (size_t)(rowb + ai * 128 + m * 16 + fr);
                        *(f32x4*)(wi + row * 8) = acc[ai][0][m][0] * s; *(f32x4*)(wi + row * 8 + 4) = acc[ai][0][m][1] * s; }
            }
            return;
        }
        if (pn >= 12) {
            const int c0 = (pn - 12) * 256 + 64 * wc;
            f32x4 bz[2][2];
#pragma unroll
            for (int bj = 0; bj < 2; ++bj) { bz[bj][0] = *(const f32x4*)(bgate + c0 + 32 * bj + 8 * fq); bz[bj][1] = *(const f32x4*)(bgate + c0 + 32 * bj + 8 * fq + 4); }
            unsigned char* gb = (unsigned char*)gates + c0;
#pragma unroll
            for (int ai = 0; ai < 2; ++ai)
#pragma unroll
                for (int m = 0; m < 4; ++m) {
#pragma unroll
                    for (int bj = 0; bj < 2; ++bj) { uint2 q; unsigned w[2];
#pragma unroll
                        for (int n = 0; n < 2; ++n) { unsigned t = 0u;
#pragma unroll
                            for (int e = 0; e < 4; ++e) t |= (unsigned)(sigmoidf_(acc[ai][bj][m][n][e] + bz[bj][n][e]) * 255.f + 0.5f) << (8 * e);
                            w[n] = t; }
                        q.x = w[0]; q.y = w[1];
                        *(LAS u32x2*)(sb + fr * 80 + 32 * bj + 8 * fq) = (u32x2){q.x, q.y}; }
                    LDS_FENCE();
                    { const int r = lane >> 2, sg = lane & 3; const u32x4 v = *(const LAS u32x4*)(sb + r * 80 + sg * 16);
                      *(u32x4*)(gb + (size_t)(rowb + ai * 128 + m * 16 + r) * 6144 + sg * 16) = v; }
                    LDS_FENCE();
                }
            return;
        }
        bf16_t* base; int ld;
        if (pn < 4) { base = ocat + pn * 256 + 64 * wc; ld = 2048; }
        else if (pn == 4) { base = (wc < 2 ? kn : vv) + 64 * (wc & 1); ld = 128; }
        else if (pn < 7) { base = qi + (pn - 5) * 256 + 64 * wc; ld = 512; }
        else if (pn == 7) { base = ki; ld = 64; }
        else if (pn < 10) { base = u + (pn - 8) * 256 + 64 * wc; ld = 512; }
        else { base = p + (pn - 10) * 256 + 64 * wc; ld = 512; }
#pragma unroll
        for (int ai = 0; ai < 2; ++ai)
#pragma unroll
            for (int m = 0; m < 4; ++m) {
#pragma unroll
                for (int bj = 0; bj < 2; ++bj) { const uint4 pk_ = pack8(acc[ai][bj][m][0], acc[ai][bj][m][1]); *(LAS u32x4*)(sb + fr * 144 + 64 * bj + 16 * fq) = (u32x4){pk_.x, pk_.y, pk_.z, pk_.w}; }
                LDS_FENCE();
#pragma unroll
                for (int h = 0; h < 2; ++h) { const int r = h * 8 + (lane >> 3), sg = lane & 7; const u32x4 v = *(const LAS u32x4*)(sb + r * 144 + sg * 16);
                    *(u32x4*)(base + (size_t)(rowb + ai * 128 + m * 16 + r) * ld + sg * 8) = v; }
                LDS_FENCE();
            }
    }
};
struct EpiGluPool {
    static constexpr bool PERM = true, SEG = false;
    const bf16_t* y; const float* scale; bf16_t* ocat;
    __device__ __forceinline__ void operator()(AccRef acc, const Unit& un, int wr, int wc, int fr, int fq) const {
        asm volatile("" : "+v"(fr), "+v"(fq));
        const int row0 = un.pm * 256 + wr * 64 + fr; const bool glu = un.pn < 2;
#pragma unroll
        for (int bj = 0; bj < 2; ++bj) { const int col = (un.pn & 1) * 256 + bj * 128 + wc * 32 + 8 * fq;
            f32x4 s0 = {0.f, 0.f, 0.f, 0.f}, s1 = {0.f, 0.f, 0.f, 0.f};
            if (!glu) { s0 = *(const f32x4*)(scale + col); s1 = *(const f32x4*)(scale + col + 4); }
#pragma unroll
            for (int ai = 0; ai < 2; ++ai) {
                uint4 yq[4];
                if (glu) {
#pragma unroll
                    for (int m = 0; m < 4; ++m) yq[m] = *(const uint4*)(y + (size_t)(row0 + ai * 128 + m * 16) * 512 + col); }
#pragma unroll
                for (int m = 0; m < 4; ++m) { const size_t row = (size_t)(row0 + ai * 128 + m * 16);
                    f32x4 v0 = acc[ai][bj][m][0], v1 = acc[ai][bj][m][1];
                    if (glu) { float yv[8]; unpack8(yq[m], yv);
#pragma unroll
                        for (int e = 0; e < 4; ++e) { v0[e] = yv[e] * sigmoidf_(v0[e]); v1[e] = yv[4 + e] * sigmoidf_(v1[e]); }
                        *(uint4*)(ocat + row * 2048 + 1024 + col) = pack8(v0, v1);
                    } else *(uint4*)(ocat + row * 2048 + 1536 + col) = pack8(v0 * s0, v1 * s1); } } }
    }
};
struct EpiMerge {
    static constexpr bool PERM = true, SEG = true;
    const bf16_t* gates; bf16_t* merged;
    __device__ __forceinline__ void flush(AccRef acc, const Unit& un, int seg, int wr, int wc, int fr, int fq) const {
        asm volatile("" : "+v"(fr), "+v"(fq));
        const int row0 = un.pm * 256 + wr * 64 + fr;
#pragma unroll
        for (int bj = 0; bj < 2; ++bj) { const int col = un.pn * 256 + bj * 128 + wc * 32 + 8 * fq;
            uint2 gq[2][4];
#pragma unroll
            for (int ai = 0; ai < 2; ++ai)
#pragma unroll
                for (int m = 0; m < 4; ++m) gq[ai][m] = *(const uint2*)((const unsigned char*)gates + (size_t)(row0 + ai * 128 + m * 16) * 6144 + seg * 2048 + col);
#pragma unroll
            for (int ai = 0; ai < 2; ++ai) {
                uint4 pq[4];
#pragma unroll
                for (int m = 0; m < 4; ++m) { if (seg > 0) pq[m] = *(const uint4*)(merged + (size_t)(row0 + ai * 128 + m * 16) * 2048 + col); else pq[m] = make_uint4(0u, 0u, 0u, 0u); }
#pragma unroll
                for (int m = 0; m < 4; ++m) { const size_t row = (size_t)(row0 + ai * 128 + m * 16);
                    float gv[8], pv[8]; unpack8(pq[m], pv);
#pragma unroll
                    for (int e = 0; e < 4; ++e) { gv[e] = (float)((gq[ai][m].x >> (8 * e)) & 0xffu) * (1.f / 255.f); gv[4 + e] = (float)((gq[ai][m].y >> (8 * e)) & 0xffu) * (1.f / 255.f); }
                    f32x4 v0 = acc[ai][bj][m][0], v1 = acc[ai][bj][m][1];
#pragma unroll
                    for (int e = 0; e < 4; ++e) { v0[e] = pv[e] + gv[e] * v0[e]; v1[e] = pv[4 + e] + gv[4 + e] * v1[e]; }
                    *(uint4*)(merged + row * 2048 + col) = pack8(v0, v1); } } }
    }
};
struct EpiRes {
    static constexpr bool PERM = false, SEG = false;
    const float* xin; float* out; const float* gt;
    __device__ __forceinline__ void operator()(AccRef acc, const Unit& un, int wr, int wc, int fr, int fq) const {
        asm volatile("" : "+v"(fr), "+v"(fq));
        const int row0 = un.pm * 256 + wr * 64 + fr; const float* g = gt + (size_t)(un.pm >> 3) * 12288;
#pragma unroll
        for (int bj = 0; bj < 2; ++bj) { const int col = un.pn * 256 + bj * 128 + wc * 32 + 4 * fq;
            f32x4 gv[2], xv[2][2][4];
#pragma unroll
            for (int n = 0; n < 2; ++n) gv[n] = *(const f32x4*)(g + col + 16 * n);
#pragma unroll
            for (int n = 0; n < 2; ++n)
#pragma unroll
                for (int ai = 0; ai < 2; ++ai)
#pragma unroll
                    for (int m = 0; m < 4; ++m) xv[n][ai][m] = *(const f32x4*)(xin + (size_t)(row0 + ai * 128 + m * 16) * 2048 + col + 16 * n);
#pragma unroll
            for (int n = 0; n < 2; ++n)
#pragma unroll
                for (int ai = 0; ai < 2; ++ai)
#pragma unroll
                    for (int m = 0; m < 4; ++m) *(f32x4*)(out + (size_t)(row0 + ai * 128 + m * 16) * 2048 + col + 16 * n) = xv[n][ai][m] + gv[n] * acc[ai][bj][m][n]; }
    }
};
struct EpiUp {
    static constexpr bool PERM = true, SEG = false;
    bf16_t* act; float* SA; float* SB; const float* cw; const float* cb; LAS unsigned char* stg;
    __device__ __forceinline__ void operator()(AccRef acc, const Unit& un, int wr, int wc, int fr, int fq) const {
        asm volatile("" : "+v"(fr), "+v"(fq));
        const int lg = fq << 4, lane = lg | fr;
        const int src1 = lg | ((fr + 15) & 15), src2 = lg | ((fr + 14) & 15);
        const int ch0 = un.pn * 128 + wc * 32 + 8 * fq;
        LAS unsigned char* sb = stg + (wr * 4 + wc) * 2304;
        f32x4 w0[2], w1[2], w2[2], bb[2];
#pragma unroll
        for (int n = 0; n < 2; ++n) { w0[n] = *(const f32x4*)(cw + ch0 + 4 * n); w1[n] = *(const f32x4*)(cw + DFF + ch0 + 4 * n); w2[n] = *(const f32x4*)(cw + 2 * DFF + ch0 + 4 * n); bb[n] = *(const f32x4*)(cb + ch0 + 4 * n); }
#pragma unroll
        for (int ai = 0; ai < 2; ++ai) {
            const int rowb = un.pm * 256 + ai * 128 + wr * 64; const int blk = rowb >> 6;
#pragma unroll
            for (int m = 0; m < 4; ++m) {
                f32x4 res[2];
#pragma unroll
                for (int n = 0; n < 2; ++n)
#pragma unroll
                    for (int e = 0; e < 4; ++e) {
                        const float cur = acc[ai][0][m][n][e];
                        const float prv = (m > 0) ? acc[ai][0][m > 0 ? m - 1 : 0][n][e] : 0.f;
                        const float p1 = __shfl((fr + 1 >= 16) ? prv : cur, src1);
                        const float p2 = __shfl((fr + 2 >= 16) ? prv : cur, src2);
                        const float cv = bb[n][e] + w0[n][e] * p2 + w1[n][e] * p1 + w2[n][e] * cur;
                        res[n][e] = siluf_(cv) * acc[ai][1][m][n][e];
                    }
                if (m == 0 && fr < 2) {
                    float* sa = SA + ((size_t)(blk * 4 + 2 + fr)) * DFF + ch0; float* sbp = SB + ((size_t)(blk * 2 + fr)) * DFF + ch0;
                    *(f32x4*)sa = acc[ai][0][0][0]; *(f32x4*)(sa + 4) = acc[ai][0][0][1];
                    *(f32x4*)sbp = acc[ai][1][0][0]; *(f32x4*)(sbp + 4) = acc[ai][1][0][1];
                }
                if (m == 3 && fr >= 14) { float* sa = SA + ((size_t)(blk * 4 + (fr - 14))) * DFF + ch0; *(f32x4*)sa = acc[ai][0][3][0]; *(f32x4*)(sa + 4) = acc[ai][0][3][1]; }
                { const uint4 pk_ = pack8(res[0], res[1]); *(LAS u32x4*)(sb + fr * 80 + 16 * fq) = (u32x4){pk_.x, pk_.y, pk_.z, pk_.w}; }
                LDS_FENCE();
                { const int r = lane >> 2, sg = lane & 3; const u32x4 v = *(const LAS u32x4*)(sb + r * 80 + sg * 16);
                  if (!(m == 0 && r < 2)) *(u32x4*)(act + (size_t)(rowb + m * 16 + r) * DFF + un.pn * 128 + wc * 32 + sg * 8) = v; }
                LDS_FENCE();
            }
        }
    }
};

struct Args { const float* in[31]; float* out; unsigned char* ws; int ph_lo, ph_hi; };
enum { I_X = 0, I_C, I_POS, I_WADA, I_BADA, I_GN1, I_GN2, I_WIN, I_GQ, I_GK, I_ARE, I_AIM, I_BRE, I_BIM, I_CRE, I_CIM, I_DSKIP, I_LOGDT, I_WGLU, I_WPOOL, I_PSCALE, I_PA, I_PB, I_PC, I_WGATE, I_BGATE, I_WOUT, I_WUP, I_CONVW, I_CONVB, I_WDOWN };

__device__ __forceinline__ float wave_sum(float v) {
#pragma unroll
    for (int o = 32; o > 0; o >>= 1) v += __shfl_xor(v, o);
    return v;
}

__device__ __forceinline__ void phase_ada(const Args& a, unsigned char* lds, const int WV) {
    const int TI = fresh_tid(WV);
    const int tid = TI;
    float* cact = (float*)lds;
    float* mod = (float*)(a.ws + WS_MOD);
    for (int w = blockIdx.x; w < 256; w += gridDim.x) {
        for (int i = tid; i < 16 * 2048; i += 512) { const int b = i >> 11, k = i & 2047; const float v = a.in[I_C][i]; cact[k * 16 + b] = siluf_(v); }
        __syncthreads();
        const int l = w >> 7, n0 = (w & 127) * 96;
        float acc[16][4];
#pragma unroll
        for (int b = 0; b < 16; ++b)
#pragma unroll
            for (int j = 0; j < 4; ++j) acc[b][j] = 0.f;
        const int cg4 = tid % 24, ks = tid / 24;
        if (tid < 384) {
            const float* wp = a.in[I_WADA] + ((size_t)l * 2048 + ks * 128) * 12288 + n0 + cg4 * 4;
#pragma unroll 4
            for (int k = 0; k < 128; ++k) {
                const f32x4 wv = *(const f32x4*)(wp + (size_t)k * 12288);
                const f32x4* cp = (const f32x4*)(cact + (ks * 128 + k) * 16);
#pragma unroll
                for (int q = 0; q < 4; ++q) { const f32x4 cv = cp[q];
#pragma unroll
                    for (int e = 0; e < 4; ++e)
#pragma unroll
                        for (int j = 0; j < 4; ++j) acc[q * 4 + e][j] += cv[e] * wv[j]; }
            }
        }
        __syncthreads();
        float* part = (float*)lds;
        if (tid < 384) {
#pragma unroll
            for (int b = 0; b < 16; ++b)
#pragma unroll
                for (int j = 0; j < 4; ++j) part[(ks * 16 + b) * 96 + cg4 * 4 + j] = acc[b][j];
        }
        __syncthreads();
        for (int o = tid; o < 1536; o += 512) { const int b = o / 96, cc = o % 96; float s = 0.f;
#pragma unroll
            for (int k2 = 0; k2 < 16; ++k2) s += part[(k2 * 16 + b) * 96 + cc];
            mod[((size_t)l * 16 + b) * 12288 + n0 + cc] = s + a.in[I_BADA][l * 12288 + n0 + cc]; }
        __syncthreads();
    }
}

struct CvtJob { const float* src; bf16_t* dst; int ldS, cbase, cend, kbase, ldD, mode, r0, cs0, kd0; };
__device__ __forceinline__ CvtJob cvt_decode(const Args& a, int l, int t) {
    unsigned char* ws = a.ws; CvtJob J; int ncols, nkt, idx; J.mode = 0; J.r0 = 0; J.kd0 = 0; J.cs0 = 0;
    if (t < 960) { idx = t; J.src = a.in[I_WIN] + (size_t)l * DM * DIN; J.ldS = DIN; ncols = 1864; nkt = 32; J.dst = (bf16_t*)(ws + W_1CAT); J.ldD = 2048; J.mode = 2; }
    else if (t < 1472) { idx = t - 960; J.src = a.in[I_WIN] + (size_t)l * DM * DIN; J.ldS = DIN; J.cs0 = 1864; ncols = 1024; nkt = 32; J.dst = (bf16_t*)(ws + W_1CAT); J.ldD = 2048; J.r0 = 2048; J.mode = 2; }
    else if (t < 4544) { idx = t - 1472; const int gi = idx >> 10; idx &= 1023; J.src = a.in[I_WGATE] + ((size_t)l * 3 + gi) * DM * DM; J.ldS = DM; ncols = 2048; nkt = 32; J.dst = (bf16_t*)(ws + W_1CAT); J.ldD = 2048; J.r0 = 3072 + 2048 * gi; J.mode = 2; }
    else if (t < 5056) { idx = t - 4544; J.src = a.in[I_PA] + (size_t)l * 1024 * DM; J.ldS = DM; ncols = 2048; nkt = 16; J.dst = (bf16_t*)(ws + W_P); J.ldD = 2048; }
    else if (t < 5312) { idx = t - 5056; J.src = a.in[I_PB] + (size_t)l * 512 * DM; J.ldS = DM; ncols = 2048; nkt = 8; J.dst = (bf16_t*)(ws + W_P); J.ldD = 2048; J.kd0 = 1024; }
    else if (t < 5568) { idx = t - 5312; J.src = a.in[I_PC] + (size_t)l * 512 * DM; J.ldS = DM; ncols = 2048; nkt = 8; J.dst = (bf16_t*)(ws + W_P); J.ldD = 2048; J.kd0 = 1536; }
    else if (t < 6592) { idx = t - 5568; J.src = a.in[I_WOUT] + (size_t)l * DM * DM; J.ldS = DM; ncols = 2048; nkt = 32; J.dst = (bf16_t*)(ws + W_OUT); J.ldD = 2048; }
    else if (t < 12096) { idx = t - 6592; J.src = a.in[I_WUP] + (size_t)l * DM * 2 * DFF; J.ldS = 2 * DFF; ncols = 2 * DFF; nkt = 32; J.dst = (bf16_t*)(ws + W_UP); J.ldD = 2048; J.mode = 1; }
    else if (t < 14848) { idx = t - 12096; J.src = a.in[I_WDOWN] + (size_t)l * DFF * DM; J.ldS = DM; ncols = 2048; nkt = 86; J.dst = (bf16_t*)(ws + W_DOWN); J.ldD = DFF; }
    else { idx = t - 14848; J.src = a.in[I_WGLU] + (size_t)l * 512 * 512; J.ldS = 512; ncols = 512; nkt = 8; J.dst = (bf16_t*)(ws + W_GLU); J.ldD = 512; }
    const int tn = idx / nkt, tk = idx - tn * nkt;
    J.cbase = J.cs0 + tn * 64; J.cend = J.cs0 + ncols; J.kbase = tk * 64; return J;
}
__device__ __forceinline__ void phase_cvt(const Args& a, int l, unsigned char* lds, const int WV) {
    const int TI = fresh_tid(WV);
    float* T = (float*)lds;
    const int tid = TI, ty = tid >> 4, tx = tid & 15;
    for (int t4 = blockIdx.x * 4; t4 < 14912; t4 += gridDim.x * 4) {
        f32x4 v[4][2];
#pragma unroll
        for (int q = 0; q < 4; ++q) { const CvtJob J = cvt_decode(a, l, t4 + q);
#pragma unroll
            for (int ps = 0; ps < 2; ++ps) { const int k = ty + ps * 32, c = J.cbase + tx * 4;
                v[q][ps] = (f32x4){0.f, 0.f, 0.f, 0.f};
                if (c < J.cend) v[q][ps] = *(const f32x4*)(J.src + (size_t)(J.kbase + k) * J.ldS + c); } }
#pragma unroll
        for (int q = 0; q < 4; ++q)
#pragma unroll
            for (int ps = 0; ps < 2; ++ps) { float* tp = T + q * (64 * 65) + (ty + ps * 32) * 65 + tx * 4; tp[0] = v[q][ps][0]; tp[1] = v[q][ps][1]; tp[2] = v[q][ps][2]; tp[3] = v[q][ps][3]; }
        __syncthreads();
#pragma unroll
        for (int q = 0; q < 4; ++q) { const CvtJob J = cvt_decode(a, l, t4 + q);
            const int n = tid >> 3, kq = tid & 7, c = J.cbase + n;
            if (c < J.cend) {
                float f[8];
#pragma unroll
                for (int j = 0; j < 8; ++j) f[j] = T[q * (64 * 65) + (kq * 8 + j) * 65 + n];
                int row;
                if (J.mode == 0) row = J.r0 + (c - J.cs0);
                else if (J.mode == 2) { const int r_ = J.r0 + (c - J.cs0), ct = r_ & 255; row = (r_ & ~255) | (((ct >> 5) & 1) << 7) | ((ct >> 6) << 5) | (ct & 31); }
                else { const int bj = c >= DFF ? 1 : 0, ch = c - bj * DFF; row = (ch >> 7) * 256 + bj * 128 + (ch & 127); }
                uint4 o; o.x = pk2(f[0], f[1]); o.y = pk2(f[2], f[3]); o.z = pk2(f[4], f[5]); o.w = pk2(f[6], f[7]);
                *(uint4*)(J.dst + (size_t)row * J.ldD + J.kd0 + J.kbase + kq * 8) = o;
            } }
        __syncthreads();
    }
    bf16_t* wp = (bf16_t*)(a.ws + W_POOL); const float* wsrc = a.in[I_WPOOL] + (size_t)l * 4 * 128 * 128;
    for (int i = blockIdx.x * 512 + TI; i < 512 * 512; i += gridDim.x * 512) { const int n = i >> 9, k = i & 511, g = n >> 7;
        const float v = ((k >> 7) == g) ? wsrc[(g * 128 + (k & 127)) * 128 + (n & 127)] : 0.f; wp[i] = (bf16_t)f2bf(v); }
}

__device__ __forceinline__ void phase_norm(const float* xin, const float* g, const float* modl, int shoff, int scoff, bf16_t* out, const int WV) {
    const int TI = fresh_tid(WV);
    const int lane = TI & 63, wave = TI >> 6;
    for (int r = blockIdx.x * 8 + wave; r < MROWS; r += gridDim.x * 8) {
        const f32x4* xp = (const f32x4*)(xin + (size_t)r * DM); f32x4 v[8]; float ssq = 0.f;
#pragma unroll
        for (int j = 0; j < 8; ++j) { v[j] = xp[j * 64 + lane]; ssq += v[j][0] * v[j][0] + v[j][1] * v[j][1] + v[j][2] * v[j][2] + v[j][3] * v[j][3]; }
        ssq = wave_sum(ssq);
        const float rinv = rsqrtf(ssq * (1.f / DM) + EPS);
        const float* mb = modl + (size_t)(r >> 11) * 12288;
#pragma unroll
        for (int j = 0; j < 8; ++j) { const int col = j * 256 + lane * 4;
            const f32x4 g4 = *(const f32x4*)(g + col), sc = *(const f32x4*)(mb + scoff + col), sh = *(const f32x4*)(mb + shoff + col);
            f32x4 y;
#pragma unroll
            for (int e = 0; e < 4; ++e) y[e] = (v[j][e] * rinv * g4[e]) * (1.f + sc[e]) + sh[e];
            uint2 o; o.x = pk2(y[0], y[1]); o.y = pk2(y[2], y[3]);
            *(uint2*)(out + (size_t)r * DM + col) = o; }
    }
}

__constant__ double kRevPerPos[24] = {0.15915494309189535, 0.0700865215877985, 0.03086376340470123, 0.013591370636193905, 0.005985185712713705, 0.002635675898667414, 0.001160663641240061, 0.0005111175045375439, 0.00022507907903927653, 9.911730936901935e-05, 4.364795279280289e-05, 1.9221100684944863e-05, 8.464330808241401e-06, 3.727408601915352e-06, 1.6414262627950345e-06, 7.228293068832865e-07, 0.15915494309189535, 0.03086376340470123, 0.005985185712713705, 0.001160663641240061, 0.00022507907903927653, 4.364795279280289e-05, 8.464330808241401e-06, 1.6414262627950345e-06};
__device__ __forceinline__ void rmsrope128(bf16_t* p, bool active, const float* g16, int sub, const float* cs) {
    float v[16];
    if (active) { unpack8(*(const uint4*)p, v); unpack8(*(const uint4*)(p + 8), v + 8); }
    else {
#pragma unroll
        for (int i = 0; i < 16; ++i) v[i] = 0.f; }
    float ssq = 0.f;
#pragma unroll
    for (int i = 0; i < 16; ++i) ssq += v[i] * v[i];
    ssq += __shfl_xor(ssq, 1); ssq += __shfl_xor(ssq, 2); ssq += __shfl_xor(ssq, 4);
    const float rinv = rsqrtf(ssq * (1.f / 128.f) + EPS);
#pragma unroll
    for (int i = 0; i < 16; ++i) v[i] = v[i] * rinv * g16[i];
#pragma unroll
    for (int i = 0; i < 16; ++i) { const float o = __shfl_xor(v[i], 1); const float c = cs[2 * i], s = cs[2 * i + 1];
        if (sub == 0) v[i] = v[i] * c - o * s; else if (sub == 1) v[i] = v[i] * c + o * s; }
    if (active) { uint4 o0, o1; o0.x = pk2(v[0], v[1]); o0.y = pk2(v[2], v[3]); o0.z = pk2(v[4], v[5]); o0.w = pk2(v[6], v[7]);
        o1.x = pk2(v[8], v[9]); o1.y = pk2(v[10], v[11]); o1.z = pk2(v[12], v[13]); o1.w = pk2(v[14], v[15]);
        *(uint4*)p = o0; *(uint4*)(p + 8) = o1; }
}
__device__ __forceinline__ void rope64(bf16_t* p, bool active, int sub, const float* cs) {
    float v[8];
    if (active) unpack8(*(const uint4*)p, v);
    else {
#pragma unroll
        for (int i = 0; i < 8; ++i) v[i] = 0.f; }
#pragma unroll
    for (int i = 0; i < 8; ++i) { const float o = __shfl_xor(v[i], 1); const float c = cs[2 * i], s = cs[2 * i + 1];
        if (sub == 0) v[i] = v[i] * c - o * s; else if (sub == 1) v[i] = v[i] * c + o * s; }
    if (active) { uint4 o0; o0.x = pk2(v[0], v[1]); o0.y = pk2(v[2], v[3]); o0.z = pk2(v[4], v[5]); o0.w = pk2(v[6], v[7]); *(uint4*)p = o0; }
}
__device__ __forceinline__ void phase_post(const Args& a, int l, unsigned char* lds, const int WV) {
    const int TI = fresh_tid(WV);
    const int lane = TI & 63, wave = TI >> 6;
    float* cs = (float*)lds + wave * 64;
    bf16_t* ocat = (bf16_t*)(a.ws + WS_OCAT); bf16_t* kn = (bf16_t*)(a.ws + WS_KN); bf16_t* qi = (bf16_t*)(a.ws + WS_QI); bf16_t* ki = (bf16_t*)(a.ws + WS_KI);
    const int* pos = (const int*)a.in[I_POS];
    const int sub = lane & 7, hd = lane >> 3;
    float gq[16], gk[16];
#pragma unroll
    for (int i = 0; i < 16; ++i) { gq[i] = a.in[I_GQ][l * 128 + sub * 16 + i]; gk[i] = a.in[I_GK][l * 128 + sub * 16 + i]; }
    for (int r = blockIdx.x * 8 + wave; r < MROWS; r += gridDim.x * 8) {
        const int ps = pos[r];
        if (lane < 24) {
            double rev = (double)ps * kRevPerPos[lane]; rev -= rint(rev); const float fr = (float)rev;
            cs[lane * 2] = __builtin_amdgcn_cosf(fr); cs[lane * 2 + 1] = __builtin_amdgcn_sinf(fr); }
        LDS_FENCE();
        rmsrope128(ocat + (size_t)r * 2048 + hd * 128 + sub * 16, true, gq, sub, cs);
        rmsrope128(kn + (size_t)r * 128 + sub * 16, lane < 8, gk, sub, cs);
        rope64(qi + (size_t)r * 512 + hd * 64 + sub * 8, true, sub, cs + 32);
        rope64(ki + (size_t)r * 64 + sub * 8, lane < 8, sub, cs + 32);
        LDS_FENCE();
    }
}

__device__ __forceinline__ void s5_unit(const Args& a, int l, int b, int g, unsigned char* lds, const int WV) {
    const int TI = fresh_tid(WV);
    const int lane = TI & 63, wave = __builtin_amdgcn_readfirstlane(TI >> 6), p = lane;
    float* E = (float*)lds;
    float* ust = (float*)(lds + 16384 + wave * 4096);
    bf16_t* sst = (bf16_t*)(lds + 49152 + wave * 4352);
    const bf16_t* U = (const bf16_t*)(a.ws + WS_U); bf16_t* Y = (bf16_t*)(a.ws + WS_Y);
    const int gp = (l * 32 + g) * 64 + p;
    const float are = a.in[I_ARE][gp], aim = a.in[I_AIM][gp], dt = expf(a.in[I_LOGDT][l * 32 + g]);
    const float mag = expf(are * dt);
    float ang = aim * dt; { const float n = rintf(ang * 0.15915494309189535f); ang = fmaf(-n, 6.28318548202514648f, ang); ang = fmaf(n, 1.7484555e-7f, ang); }
    const float lre = mag * cosf(ang), lim = mag * sinf(ang);
    float Bre[16], Bim[16];
    { const float nr = lre - 1.f, ni = lim, den = 1.f / (are * are + aim * aim); const float cr = (nr * are + ni * aim) * den, ci = (ni * are - nr * aim) * den;
#pragma unroll
        for (int j = 0; j < 16; ++j) { const float br = a.in[I_BRE][(size_t)gp * 16 + j], bi = a.in[I_BIM][(size_t)gp * 16 + j]; Bre[j] = cr * br - ci * bi; Bim[j] = cr * bi + ci * br; } }
    bf16x8 Cf[4];
    { const int i = lane & 15;
#pragma unroll
        for (int ks = 0; ks < 4; ++ks)
#pragma unroll
            for (int j = 0; j < 8; ++j) { const int k = ks * 32 + (lane >> 4) * 8 + j, pp = k >> 1; const size_t ci = ((size_t)(l * 32 + g) * 16 + i) * 64 + pp;
                const float v = (k & 1) ? -a.in[I_CIM][ci] : a.in[I_CRE][ci]; Cf[ks][j] = (short)f2bf(v); } }
    const float dsk = a.in[I_DSKIP][l * 512 + g * 16 + (lane & 15)];
    f32x2 Bv[16];
#pragma unroll
    for (int j = 0; j < 16; ++j) Bv[j] = (f32x2){Bre[j], Bim[j]};
    const f32x2 lre2 = {lre, lre}, lim2 = {lim, lim};
#define S5_STEP(t_) do { f32x2 bu0 = {0.f, 0.f}, bu1 = {0.f, 0.f}; \
        _Pragma("unroll") for (int k_ = 0; k_ < 8; ++k_) { const unsigned w_ = (unsigned)__builtin_amdgcn_readlane((int)upk[k_], (t_)); \
            const float ul_ = __uint_as_float(w_ << 16), uh_ = __uint_as_float(w_ & 0xffff0000u); \
            bu0 = __builtin_elementwise_fma(Bv[2 * k_], (f32x2){ul_, ul_}, bu0); bu1 = __builtin_elementwise_fma(Bv[2 * k_ + 1], (f32x2){uh_, uh_}, bu1); } \
        const f32x2 sw_ = {-st[1], st[0]}; \
        st = __builtin_elementwise_fma(st, lre2, __builtin_elementwise_fma(sw_, lim2, bu0 + bu1)); } while (0)
#pragma unroll 1
    for (int cc = 0; cc < 4; ++cc) {
        const int chunk = wave * 4 + cc, t0 = chunk * 64;
        unsigned upk[8];
        { const bf16_t* up = U + (size_t)(b * 2048 + t0 + lane) * 512 + g * 16; const uint4 q0 = *(const uint4*)up, q1 = *(const uint4*)(up + 8);
            upk[0] = q0.x; upk[1] = q0.y; upk[2] = q0.z; upk[3] = q0.w; upk[4] = q1.x; upk[5] = q1.y; upk[6] = q1.z; upk[7] = q1.w; }
        f32x2 st = {0.f, 0.f};
#pragma unroll 4
        for (int t = 0; t < 64; ++t) S5_STEP(t);
        E[(chunk * 64 + p) * 2] = st[0]; E[(chunk * 64 + p) * 2 + 1] = st[1];
    }
    __syncthreads();
    if (wave == 0) {
        float pr = lre, pi = lim;
#pragma unroll
        for (int q = 0; q < 6; ++q) { const float nr = pr * pr - pi * pi, pp_ = pr * pi, ni = pp_ + pp_; pr = nr; pi = ni; }
        float sr = 0.f, si = 0.f;
        for (int c = 0; c < 32; ++c) { const float er = E[(c * 64 + p) * 2], ei = E[(c * 64 + p) * 2 + 1]; E[(c * 64 + p) * 2] = sr; E[(c * 64 + p) * 2 + 1] = si;
            const float nr = pr * sr - pi * si + er, ni = pr * si + pi * sr + ei; sr = nr; si = ni; }
    }
    __syncthreads();
#pragma unroll 1
    for (int cc = 0; cc < 4; ++cc) {
        const int chunk = wave * 4 + cc, t0 = chunk * 64;
        unsigned upk[8];
        { const bf16_t* up = U + (size_t)(b * 2048 + t0 + lane) * 512 + g * 16; const uint4 q0 = *(const uint4*)up, q1 = *(const uint4*)(up + 8);
            upk[0] = q0.x; upk[1] = q0.y; upk[2] = q0.z; upk[3] = q0.w; upk[4] = q1.x; upk[5] = q1.y; upk[6] = q1.z; upk[7] = q1.w;
            float f[16]; unpack8(q0, f); unpack8(q1, f + 8);
#pragma unroll
            for (int q = 0; q < 4; ++q) *(f32x4*)(ust + lane * 16 + q * 4) = (f32x4){f[q * 4], f[q * 4 + 1], f[q * 4 + 2], f[q * 4 + 3]}; }
        f32x2 st = {E[(chunk * 64 + p) * 2], E[(chunk * 64 + p) * 2 + 1]};
#pragma unroll 1
        for (int sb = 0; sb < 4; ++sb) {
#pragma unroll 4
            for (int tt = 0; tt < 16; ++tt) { S5_STEP(sb * 16 + tt);
                *(unsigned*)(sst + tt * 136 + 2 * p) = pk2(st[0], st[1]);
            }
            LDS_FENCE();
            f32x4 acc = {0.f, 0.f, 0.f, 0.f};
#pragma unroll
            for (int ks = 0; ks < 4; ++ks) { const bf16x8 af = *(const bf16x8*)(sst + (lane & 15) * 136 + ks * 32 + (lane >> 4) * 8);
                acc = __builtin_amdgcn_mfma_f32_16x16x32_bf16(af, Cf[ks], acc, 0, 0, 0); }
#pragma unroll
            for (int r = 0; r < 4; ++r) { const int t = sb * 16 + (lane >> 4) * 4 + r, i = lane & 15;
                const float y = gelu_tanh(acc[r] + dsk * ust[t * 16 + i]);
                Y[(size_t)(b * 2048 + t0 + t) * 512 + g * 16 + i] = (bf16_t)f2bf(y); }
            LDS_FENCE();
        }
    }
    __syncthreads();
#undef S5_STEP
}

__device__ __forceinline__ void pool_unit(const Args& a, int b, int chunk, unsigned char* lds, const int WV) {
    const int TI = fresh_tid(WV);
    bf16_t* T = (bf16_t*)lds;
    const int t0 = chunk * 64;
    const bf16_t* P = (const bf16_t*)(a.ws + WS_P) + (size_t)b * 2048 * 512; bf16_t* O = (bf16_t*)(a.ws + WS_POOLED) + (size_t)b * 2048 * 512;
    __syncthreads();
    for (int i = TI; i < 80 * 64; i += 512) { const int r = i >> 6, c8 = i & 63, t = t0 - 16 + r;
        uint4 v = make_uint4(0u, 0u, 0u, 0u); if (t >= 0) v = *(const uint4*)(P + (size_t)t * 512 + c8 * 8);
        *(uint4*)(T + r * 512 + c8 * 8) = v; }
    __syncthreads();
    const int c = TI, w = 2 << (c >> 7);
    float s = 0.f;
    for (int k = 1; k <= w; ++k) s += bf1(T[(16 - k) * 512 + c]);
#pragma unroll 4
    for (int t = 0; t < 64; ++t) { const float pv = bf1(T[(16 + t) * 512 + c]); s += pv; s -= bf1(T[(16 + t - w) * 512 + c]);
        const int tt = t0 + t + 1; const float mean = s / (float)(tt < w ? tt : w); O[(size_t)(t0 + t) * 512 + c] = (bf16_t)f2bf(mean - pv); }
}

__device__ __forceinline__ unsigned sortkey(float x) { const unsigned u = __float_as_uint(x); return (u & 0x80000000u) ? ~u : (u | 0x80000000u); }
__device__ __forceinline__ void dsa_unit(const Args& a, int b, int tq, unsigned char* lds, const int WV, bf16_t* obase, const int ostride, const int parts) {
    const int TI = fresh_tid(WV);
    int tid = TI;
    int lane = tid & 63; const int wave = WV;
    float* sc = (float*)lds;
    unsigned short* sel = (unsigned short*)(lds + 131072);
    float* wis = (float*)(lds + 131072 + 8192);
    bf16_t* ocat = (bf16_t*)(a.ws + WS_OCAT); const bf16_t* Kn = (const bf16_t*)(a.ws + WS_KN); const bf16_t* V = (const bf16_t*)(a.ws + WS_V);
    const bf16_t* QI = (const bf16_t*)(a.ws + WS_QI); const bf16_t* KI = (const bf16_t*)(a.ws + WS_KI); const float* WI = (const float*)(a.ws + WS_WI);
    const int t0 = tq * 16, row0 = b * 2048 + t0, limit = ((t0 >> 6) + 1) << 6, nkt = limit >> 5, nsel = limit < 256 ? limit : 256;
    __syncthreads();
    if (tid < 128) wis[tid] = WI[(size_t)row0 * 8 + tid];
    __syncthreads();
    if (parts & 1)
    {
        const int g = lane >> 5, c32 = lane & 31;
        bf16x8 Af[4][4];
#pragma unroll
        for (int rb = 0; rb < 4; ++rb) { const int R = rb * 32 + c32; const bf16_t* qp = QI + (size_t)(row0 + (R >> 3)) * 512 + (R & 7) * 64 + g * 8;
#pragma unroll
            for (int s = 0; s < 4; ++s) Af[rb][s] = *(const bf16x8*)(qp + s * 16); }
        bf16x8 Bn[4];
        { const bf16_t* kp0 = KI + (size_t)(b * 2048 + wave * 32 + c32) * 64 + g * 8;
#pragma unroll
            for (int s = 0; s < 4; ++s) Bn[s] = *(const bf16x8*)(kp0 + s * 16); }
#pragma unroll 1
        for (int kt = wave; kt < nkt; kt += 8) {
            bf16x8 Bf[4];
#pragma unroll
            for (int s = 0; s < 4; ++s) Bf[s] = Bn[s];
            if (kt + 8 < nkt) { const bf16_t* kp = KI + (size_t)(b * 2048 + (kt + 8) * 32 + c32) * 64 + g * 8;
#pragma unroll
                for (int s = 0; s < 4; ++s) Bn[s] = *(const bf16x8*)(kp + s * 16); }
#pragma unroll
            for (int rb = 0; rb < 4; ++rb) {
                f32x16 acc;
#pragma unroll
                for (int i = 0; i < 16; ++i) acc[i] = 0.f;
#pragma unroll
                for (int s = 0; s < 4; ++s) acc = __builtin_amdgcn_mfma_f32_32x32x16_bf16(Af[rb][s], Bf[s], acc, 0, 0, 0);
#pragma unroll
                for (int j = 0; j < 4; ++j) { const int q = rb * 4 + j; const f32x4 w4 = *(const f32x4*)(wis + q * 8 + 4 * g);
                    float sp = fmaxf(acc[4 * j], 0.f) * w4[0] + fmaxf(acc[4 * j + 1], 0.f) * w4[1] + fmaxf(acc[4 * j + 2], 0.f) * w4[2] + fmaxf(acc[4 * j + 3], 0.f) * w4[3];
                    sp += __shfl_xor(sp, 32);
                    if (g == 0) sc[q * 2048 + kt * 32 + c32] = sp; }
            }
        }
    }
    __syncthreads();
    lane = fresh_tid(WV) & 63;
    const unsigned long long ltmask = (1ull << lane) - 1ull;
    for (int qq = 0; qq < 2; ++qq) {
        const int q = wave * 2 + qq; unsigned short* sq = sel + q * 256;
        if (limit <= 256 || !(parts & 2)) { for (int j = lane; j < nsel; j += 64) sq[j] = (unsigned short)j; }
        else {
            unsigned key[32];
#pragma unroll
            for (int j = 0; j < 32; ++j) { const int idx = j * 64 + lane; key[j] = (idx < limit) ? sortkey(sc[q * 2048 + idx]) : 0u; }
            unsigned T = 0u;
            for (int bit = 31; bit >= 0; --bit) { const unsigned cand = T | (1u << bit); int cnt = 0;
#pragma unroll
                for (int j = 0; j < 32; ++j) cnt += __popcll(__ballot(key[j] >= cand));
                if (cnt >= 256) { T = cand; if (cnt == 256) break; } }
            int cgt = 0;
#pragma unroll
            for (int j = 0; j < 32; ++j) cgt += __popcll(__ballot(key[j] > T));
            const int need = 256 - cgt; int ob = 0, tb = 0;
#pragma unroll
            for (int j = 0; j < 32; ++j) { const bool gt = key[j] > T, eq = key[j] == T; const unsigned long long me = __ballot(eq);
                const int pe = tb + __popcll(me & ltmask); const bool take = gt || (eq && pe < need); const unsigned long long mt = __ballot(take);
                if (take) sq[ob + __popcll(mt & ltmask)] = (unsigned short)(j * 64 + lane);
                ob += __popcll(mt); tb += __popcll(me); }
        }
    }
    __syncthreads();
    lane = fresh_tid(WV) & 63;
    float* Pw = (float*)lds + wave * 2048;
    const int g4 = lane >> 4, hh = lane & 15;
#pragma unroll 1
    for (int qq = 0; qq < 2; ++qq) {
        const int q = wave * 2 + qq; const size_t row = (size_t)(row0 + q); const unsigned short* sq = sel + q * 256;
        bf16x8 Qf[4];
#pragma unroll
        for (int s = 0; s < 4; ++s) Qf[s] = *(const bf16x8*)(ocat + row * 2048 + (hh & 7) * 128 + g4 * 8 + s * 32);
        float lg[16][4];
#pragma unroll
        for (int kg = 0; kg < 4; ++kg) {
            if (kg * 64 < nsel) {
                bf16x8 kf[4][4];
#pragma unroll
                for (int k4 = 0; k4 < 4; ++k4) { const int idx = sq[(kg * 4 + k4) * 16 + hh]; const bf16_t* kp = Kn + (size_t)(b * 2048 + idx) * 128 + g4 * 8;
#pragma unroll
                    for (int s = 0; s < 4; ++s) kf[k4][s] = *(const bf16x8*)(kp + s * 32); }
#pragma unroll
                for (int k4 = 0; k4 < 4; ++k4) { f32x4 c = {0.f, 0.f, 0.f, 0.f};
#pragma unroll
                    for (int s = 0; s < 4; ++s) c = __builtin_amdgcn_mfma_f32_16x16x32_bf16(kf[k4][s], Qf[s], c, 0, 0, 0);
#pragma unroll
                    for (int r = 0; r < 4; ++r) lg[kg * 4 + k4][r] = c[r] * 0.08838834764831845f; }
            } else {
#pragma unroll
                for (int k4 = 0; k4 < 4; ++k4)
#pragma unroll
                    for (int r = 0; r < 4; ++r) lg[kg * 4 + k4][r] = -1e30f;
            }
        }
        float mx = -1e30f;
#pragma unroll
        for (int kb = 0; kb < 16; ++kb)
#pragma unroll
            for (int r = 0; r < 4; ++r) mx = fmaxf(mx, lg[kb][r]);
        mx = fmaxf(mx, __shfl_xor(mx, 16)); mx = fmaxf(mx, __shfl_xor(mx, 32));
        float sum = 0.f;
#pragma unroll
        for (int kb = 0; kb < 16; ++kb)
#pragma unroll
            for (int r = 0; r < 4; ++r) { const float e = (kb * 16 < nsel) ? __expf(lg[kb][r] - mx) : 0.f; lg[kb][r] = e; sum += e; }
        sum += __shfl_xor(sum, 16); sum += __shfl_xor(sum, 32);
        const float inv = 1.f / sum;
        bf16x8 Pa[8];
#pragma unroll
        for (int ks = 0; ks < 8; ++ks) {
            const unsigned a0 = pk2(lg[2 * ks][0] * inv, lg[2 * ks][1] * inv), a1 = pk2(lg[2 * ks][2] * inv, lg[2 * ks][3] * inv);
            const unsigned a2 = pk2(lg[2 * ks + 1][0] * inv, lg[2 * ks + 1][1] * inv), a3 = pk2(lg[2 * ks + 1][2] * inv, lg[2 * ks + 1][3] * inv);
            const u32x4 t_ = {a0, a1, a2, a3}; Pa[ks] = __builtin_bit_cast(bf16x8, t_); }
        bf16_t* Vs = (bf16_t*)(lds + wave * 10752);
        bf16_t* Os = Vs + 32 * 136;
        f32x4 oacc[8];
#pragma unroll
        for (int nb = 0; nb < 8; ++nb) oacc[nb] = (f32x4){0.f, 0.f, 0.f, 0.f};
        const bf16_t* Vb = V + (size_t)b * 2048 * 128 + hh * 8;
        u32x4 vq[8], vn[8];
#pragma unroll
        for (int jj = 0; jj < 8; ++jj) vn[jj] = (u32x4){0u, 0u, 0u, 0u};
#pragma unroll
        for (int jj = 0; jj < 8; ++jj) { const int idx = sq[jj * 4 + g4]; vq[jj] = *(const u32x4*)(Vb + (size_t)idx * 128); }
#define PV_BATCH(bt) do { if ((bt) * 32 < nsel) { \
            if (((bt) + 1) * 32 < nsel) { _Pragma("unroll") for (int jj = 0; jj < 8; ++jj) { const int idx = sq[((bt) + 1) * 32 + jj * 4 + g4]; vn[jj] = *(const u32x4*)(Vb + (size_t)idx * 128); } } \
            _Pragma("unroll") for (int jj = 0; jj < 8; ++jj) *(u32x4*)(Vs + (jj * 4 + g4) * 136 + hh * 8) = vq[jj]; \
            LDS_FENCE(); \
            _Pragma("unroll") for (int nb = 0; nb < 8; ++nb) { const bf16_t* vp = Vs + (4 * g4) * 136 + nb * 16 + hh; \
                const unsigned w0_ = (unsigned)vp[0 * 136] | ((unsigned)vp[1 * 136] << 16), w1_ = (unsigned)vp[2 * 136] | ((unsigned)vp[3 * 136] << 16); \
                const unsigned w2_ = (unsigned)vp[16 * 136] | ((unsigned)vp[17 * 136] << 16), w3_ = (unsigned)vp[18 * 136] | ((unsigned)vp[19 * 136] << 16); \
                const u32x4 t_ = {w0_, w1_, w2_, w3_}; \
                oacc[nb] = __builtin_amdgcn_mfma_f32_16x16x32_bf16(Pa[(bt)], __builtin_bit_cast(bf16x8, t_), oacc[nb], 0, 0, 0); } \
            LDS_FENCE(); \
            _Pragma("unroll") for (int jj = 0; jj < 8; ++jj) vq[jj] = vn[jj]; } } while (0)
        PV_BATCH(0); PV_BATCH(1); PV_BATCH(2); PV_BATCH(3); PV_BATCH(4); PV_BATCH(5); PV_BATCH(6); PV_BATCH(7);
#undef PV_BATCH
        if (g4 < 2) {
#pragma unroll
            for (int nb = 0; nb < 8; ++nb)
#pragma unroll
                for (int r = 0; r < 4; ++r) Os[(g4 * 4 + r) * 128 + nb * 16 + hh] = (bf16_t)f2bf(oacc[nb][r]);
        }
        LDS_FENCE();
#pragma unroll
        for (int h = 0; h < 2; ++h) { const uint4 ov = *(const uint4*)(Os + h * 512 + lane * 8); *(uint4*)(obase + row * ostride + h * 512 + lane * 8) = ov; }
        LDS_FENCE();
    }
}

__device__ __forceinline__ void phase_fix(const Args& a, int l, const int WV) {
    const int TI = fresh_tid(WV);
    const float* SA = (const float*)(a.ws + WS_SA); const float* SB = (const float*)(a.ws + WS_SB); bf16_t* act = (bf16_t*)(a.ws + WS_R2);
    const float* cw = a.in[I_CONVW] + (size_t)l * 3 * DFF; const float* cb = a.in[I_CONVB] + (size_t)l * DFF;
    const int total = 512 * 2 * DFF;
    for (int i = blockIdx.x * 512 + TI; i < total; i += gridDim.x * 512) {
        const int ch = i % DFF, rb = i / DFF, rr = rb & 1, blk = rb >> 1, r = blk * 64 + rr, t = r & 2047;
        const float a0 = SA[((size_t)blk * 4 + 2 + rr) * DFF + ch];
        float am1, am2;
        if (rr == 0) { am1 = (t >= 1) ? SA[((size_t)(blk - 1) * 4 + 1) * DFF + ch] : 0.f; am2 = (t >= 2) ? SA[((size_t)(blk - 1) * 4 + 0) * DFF + ch] : 0.f; }
        else { am1 = SA[((size_t)blk * 4 + 2) * DFF + ch]; am2 = (t >= 2) ? SA[((size_t)(blk - 1) * 4 + 1) * DFF + ch] : 0.f; }
        const float cv = cb[ch] + cw[ch] * am2 + cw[DFF + ch] * am1 + cw[2 * DFF + ch] * a0;
        act[(size_t)r * DFF + ch] = (bf16_t)f2bf(siluf_(cv) * SB[((size_t)blk * 2 + rr) * DFF + ch]);
    }
}

__device__ __forceinline__ void run_phase(const Args& a, int ph, unsigned char* lds, const int WV, const bool dummy) {
    unsigned char* ws = a.ws;
    LAS unsigned char* ldsl = (LAS unsigned char*)lds;
    const int G = gridDim.x, bx = blockIdx.x;
#ifndef DBG_NOADA
    if (ph == 0) { phase_ada(a, lds, WV); return; }
#else
    if (ph == 0) return;
#endif
    const int l = (ph - 1) / 10, sp = (ph - 1) % 10;
    const float* modl = (const float*)(ws + WS_MOD) + (size_t)l * 16 * 12288;
    const float* xin = (l == 0) ? a.in[I_X] : a.out;
#ifdef DBG_SP
    if (sp != DBG_SP) return;
#endif
    switch (sp) {
    case 0: phase_cvt(a, l, lds, WV); phase_norm(xin, a.in[I_GN1] + l * DM, modl, 0, 2048, (bf16_t*)(ws + WS_R1), WV); break;
    case 1: {
        pg8::Gemm g{(const bf16_t*)(ws + WS_R1), (const bf16_t*)(ws + W_1CAT), MROWS, N1, DM, DM, DM, 1 << 30, 0}; pg8::StaticOrder S; S.init(MROWS, N1, G, bx);
        Epi1 E{(bf16_t*)(ws + WS_OCAT), (bf16_t*)(ws + WS_KN), (bf16_t*)(ws + WS_V), (bf16_t*)(ws + WS_QI), (bf16_t*)(ws + WS_KI), (bf16_t*)(ws + WS_U), (bf16_t*)(ws + WS_P), (bf16_t*)(ws + WS_R2),
               (float*)(ws + WS_WI), a.in[I_BGATE] + (size_t)l * 3 * DM, ldsl + 131072};
        pg8::gemm_phase<Epi1, pg8::StaticOrder>(ldsl, g, S, E, WV); } break;
    case 2:
        if (!dummy) phase_post(a, l, lds, WV);
        __syncthreads();
        for (int u = bx; u < 512; u += G) s5_unit(a, l, u >> 5, u & 31, lds, WV);
        for (int u = bx; u < 512; u += G) pool_unit(a, u >> 5, u & 31, lds, WV);
        break;
    case 3: {
#ifndef DBG_NO_DSA
#ifdef DSA_PROBE
        for (int rep = 0; rep < 2; ++rep) { const bool dm = (rep == 0); const int parts = dm ? (DSA_PROBE) : 15;
#else
        { const bool dm = dummy; const int parts = 15;
#endif
            for (int u = bx; u < 2048; u += G) { const int w = u & 255, i = u >> 8, b = w & 15, s = w >> 4; const int tq = (i & 1) ? (i * 16 + 15 - s) : (i * 16 + s);
                dsa_unit(a, b, tq, lds, WV, dm ? (bf16_t*)(ws + WS_R1 + 64 * MiB) : (bf16_t*)(ws + WS_OCAT), dm ? 1024 : 2048, parts); }
        }
        __syncthreads();
#endif
#ifndef DBG_DSA_ONLY
        { pg8::Gemm g{(const bf16_t*)(ws + WS_Y), (const bf16_t*)(ws + W_GLU), MROWS, 1024, 512, 512, 512, 2, WS_POOLED - WS_Y}; pg8::StaticOrder S; S.init(MROWS, 1024, G, bx);
          EpiGluPool E{(const bf16_t*)(ws + WS_Y), a.in[I_PSCALE] + l * 512, (bf16_t*)(ws + WS_OCAT)}; pg8::gemm_phase<EpiGluPool, pg8::StaticOrder>(ldsl, g, S, E, WV); }
#endif
        } break;
    case 4: {
        pg8::Gemm g{(const bf16_t*)(ws + WS_OCAT), (const bf16_t*)(ws + W_P), MROWS, DM, DM, DM, DM, 1 << 30, 0}; pg8::StaticOrder S; S.init(MROWS, DM, G, bx);
        EpiMerge E{(const bf16_t*)(ws + WS_R2), (bf16_t*)(ws + WS_R1)}; pg8::gemm_phase<EpiMerge, pg8::StaticOrder>(ldsl, g, S, E, WV); } break;
    case 5: {
        pg8::Gemm g{(const bf16_t*)(ws + WS_R1), (const bf16_t*)(ws + W_OUT), MROWS, DM, DM, DM, DM, 1 << 30, 0}; pg8::StaticOrder S; S.init(MROWS, DM, G, bx);
        EpiRes E{xin, dummy ? (float*)(ws + WS_OCAT) : a.out, modl + 4096}; pg8::gemm_phase<EpiRes, pg8::StaticOrder>(ldsl, g, S, E, WV); } break;
    case 6: phase_norm(a.out, a.in[I_GN2] + l * DM, modl, 6144, 8192, (bf16_t*)(ws + WS_R1), WV); break;
    case 7: {
        pg8::Gemm g{(const bf16_t*)(ws + WS_R1), (const bf16_t*)(ws + W_UP), MROWS, 2 * DFF, DM, DM, DM, 1 << 30, 0}; pg8::StaticOrder S; S.init(MROWS, 2 * DFF, G, bx);
        EpiUp E{(bf16_t*)(ws + WS_R2), (float*)(ws + WS_SA), (float*)(ws + WS_SB), a.in[I_CONVW] + (size_t)l * 3 * DFF, a.in[I_CONVB] + (size_t)l * DFF, ldsl + 131072};
        pg8::gemm_phase<EpiUp, pg8::StaticOrder>(ldsl, g, S, E, WV); } break;
    case 8: phase_fix(a, l, WV); break;
    case 9: {
        pg8::Gemm g{(const bf16_t*)(ws + WS_R2), (const bf16_t*)(ws + W_DOWN), MROWS, DM, DFF, DFF, DFF, 1 << 30, 0}; pg8::StaticOrder S; S.init(MROWS, DM, G, bx);
        EpiRes E{a.out, dummy ? (float*)(ws + WS_OCAT) : a.out, modl + 10240}; pg8::gemm_phase<EpiRes, pg8::StaticOrder>(ldsl, g, S, E, WV); } break;
    }
}

#define XB_XCNT(j)  (256  + 64 * (j))
#define XB_XSUB(j)  (1280 + 64 * (j))
#define XB_XGEN(j)  (2304 + 64 * (j))
#define XB_TOP      3328
#define XB_TOPGEN   3392
#define XB_WORDS    3456
__device__ __forceinline__ unsigned xb_ld(unsigned* p)              { return __hip_atomic_load(p, __ATOMIC_RELAXED, __HIP_MEMORY_SCOPE_AGENT); }
__device__ __forceinline__ unsigned xb_add(unsigned* p, unsigned v) { return __hip_atomic_fetch_add(p, v, __ATOMIC_RELAXED, __HIP_MEMORY_SCOPE_AGENT); }
__device__ __forceinline__ unsigned xb_xcc_id() { return (unsigned)__builtin_amdgcn_s_getreg((3 << 11) | 20) & 0xFu; }
#define XB_SPIN(cond) do { unsigned _sp = 0; while (cond) { __builtin_amdgcn_s_sleep(1); if (++_sp > (1u << 22)) break; } } while (0)
__device__ __forceinline__ void grid_bar(unsigned* bar, volatile LAS unsigned* st, int wave_id) {
    asm volatile("s_waitcnt vmcnt(0) lgkmcnt(0)" ::: "memory");
    __syncthreads();
    if (wave_id == 0) {
        const int l = (int)__builtin_amdgcn_mbcnt_hi(~0u, __builtin_amdgcn_mbcnt_lo(~0u, 0u));
        if (l == 0) {
            const unsigned x = xb_xcc_id();
            unsigned nloc = st[0], nx = st[1];
            if (nloc == 0u) {
                const unsigned G = gridDim.x; unsigned sum, cnt, mine, sp = 0u;
                for (;;) { sum = 0u; cnt = 0u; mine = 0u;
#pragma unroll
                    for (unsigned j = 0; j < 16; ++j) { const unsigned c = xb_ld(&bar[XB_XCNT(j)]); sum += c; cnt += (c > 0u) ? 1u : 0u; mine = (j == x) ? c : mine; }
                    if (sum == G) break;
                    __builtin_amdgcn_s_sleep(1); if (++sp > (1u << 22)) break; }
                nloc = mine > 0u ? mine : 1u; nx = cnt > 0u ? cnt : 1u; st[0] = nloc; st[1] = nx;
            }
            const unsigned old = xb_add(&bar[XB_XSUB(x)], 1u);
            const unsigned gen = old / nloc;
            if (old + 1u == (gen + 1u) * nloc) {
                __builtin_amdgcn_fence(__ATOMIC_RELEASE, "agent");
                asm volatile("s_waitcnt vmcnt(0)" ::: "memory");
                const unsigned og = xb_add(&bar[XB_TOP], 1u);
                const unsigned tg = og / nx;
                if (og + 1u == (tg + 1u) * nx) xb_add(&bar[XB_TOPGEN], 1u);
                else XB_SPIN(xb_ld(&bar[XB_TOPGEN]) == tg);
                __builtin_amdgcn_fence(__ATOMIC_ACQUIRE, "agent");
                xb_add(&bar[XB_XGEN(x)], 1u);
                asm volatile("s_waitcnt vmcnt(0)" ::: "memory");
            } else {
                XB_SPIN(xb_ld(&bar[XB_XGEN(x)]) == gen);
                __builtin_amdgcn_fence(__ATOMIC_ACQUIRE, "agent");
                asm volatile("s_waitcnt vmcnt(0)" ::: "memory");
            }
        }
    }
    __syncthreads();
}

__global__ void __launch_bounds__(512, 2) mega_fwd(Args a) {
    extern __shared__ __attribute__((aligned(16))) unsigned char lds[];
    cg::grid_group grid = cg::this_grid();
    const int wave_id = __builtin_amdgcn_readfirstlane((int)(threadIdx.x >> 6));
    const int ph_lo = a.ph_lo, ph_hi = a.ph_hi;
    volatile LAS unsigned* xst = (volatile LAS unsigned*)((LAS unsigned char*)lds + 150016);
    if (threadIdx.x == 0) { xst[0] = 0u; xst[1] = 0u; (void)xb_add((unsigned*)(__attribute__((address_space(1))) unsigned*)a.ws + XB_XCNT(xb_xcc_id()), 1u); }
    __syncthreads();
    for (int ph = ph_lo; ph < ph_hi; ++ph) {
        const __attribute__((address_space(4))) Args* kp = (const __attribute__((address_space(4))) Args*)__builtin_amdgcn_kernarg_segment_ptr();
        asm volatile("" : "+s"(kp));
        Args la;
#pragma unroll
        for (int i = 0; i < 31; ++i) la.in[i] = (const float*)(const __attribute__((address_space(1))) float*)kp->in[i];
        la.ws = (unsigned char*)(__attribute__((address_space(1))) unsigned char*)kp->ws;
        la.out = (float*)(__attribute__((address_space(1))) float*)kp->out;
        la.ph_lo = ph_lo; la.ph_hi = ph_hi;
#ifdef REP_MASK
        if (ph > 0 && ((REP_MASK >> ((ph - 1) % 10)) & 1)) { run_phase(la, ph, lds, wave_id, true); grid.sync(); }
#endif
        run_phase(la, ph, lds, wave_id, false);
        if (ph + 1 < ph_hi) {
            if (ph == ph_lo) grid.sync();
            else grid_bar((unsigned*)la.ws, xst, wave_id);
        }
    }
}

extern "C" void kernel_launch(void* const* d_in, const int* in_sizes, int n_in, void* d_out, int out_size, void* d_ws, size_t ws_size, hipStream_t stream) {
    static int grid = 0;
    if (grid == 0) {
        int dev = 0, cus = 0, per_cu = 0;
        if (n_in != 31 || ws_size < WS_END) { fprintf(stderr, "kernel_launch: unexpected n_in %d / ws %zu\n", n_in, ws_size); grid = -1; return; }
        hipGetDevice(&dev); hipDeviceGetAttribute(&cus, hipDeviceAttributeMultiprocessorCount, dev);
        if (hipFuncSetAttribute((const void*)mega_fwd, hipFuncAttributeMaxDynamicSharedMemorySize, LDS_BYTES) != hipSuccess) { fprintf(stderr, "kernel_launch: hipFuncSetAttribute failed\n"); grid = -1; return; }
        if (hipOccupancyMaxActiveBlocksPerMultiprocessor(&per_cu, (const void*)mega_fwd, 512, LDS_BYTES) != hipSuccess || per_cu < 1) { fprintf(stderr, "kernel_launch: occupancy query says %d blocks/CU\n", per_cu); per_cu = 1; }
        (void)hipGetLastError();
        grid = cus > 0 ? cus : 256;
    }
    if (grid < 0) return;
    if (hipMemsetAsync(d_ws, 0, 16384, stream) != hipSuccess) { fprintf(stderr, "kernel_launch: memset of the barrier word failed\n"); return; }
    Args a{};
    for (int i = 0; i < 31; ++i) a.in[i] = (const float*)d_in[i];
    a.out = (float*)d_out; a.ws = (unsigned char*)d_ws;
#if MK_PER_PHASE
    for (int ph = 0; ph < NPHASE; ++ph) {
        a.ph_lo = ph; a.ph_hi = ph + 1;
        void* args[] = {&a};
        hipError_t e = hipLaunchCooperativeKernel((const void*)mega_fwd, dim3(grid), dim3(512), args, LDS_BYTES, stream);
        if (e != hipSuccess) { fprintf(stderr, "kernel_launch: launch of phase %d failed: %s\n", ph, hipGetErrorString(e)); break; }
    }
#else
    a.ph_lo = 0; a.ph_hi = NPHASE;
    void* args[] = {&a};
    hipError_t e = hipLaunchCooperativeKernel((const void*)mega_fwd, dim3(grid), dim3(512), args, LDS_BYTES, stream);
    if (e != hipSuccess) fprintf(stderr, "kernel_launch: cooperative launch failed: %s (grid %d)\n", hipGetErrorString(e), grid);
#endif
}
```

```cpp
#include <hip/hip_runtime.h>
#include <hip/hip_cooperative_groups.h>
#include <cstdio>
#include <cstdint>
namespace cg = cooperative_groups;

#ifndef MK_PER_PHASE
#define MK_PER_PHASE 0
#endif

typedef unsigned short bf16_t;
typedef short bf16x8 __attribute__((ext_vector_type(8)));
typedef float f32x4 __attribute__((ext_vector_type(4)));
typedef float f32x2 __attribute__((ext_vector_type(2)));
typedef float f32x16 __attribute__((ext_vector_type(16)));
typedef unsigned u32x4 __attribute__((ext_vector_type(4)));
typedef unsigned u32x2 __attribute__((ext_vector_type(2)));
#define LAS __attribute__((address_space(3)))

constexpr int BATCH = 16, SEQ = 2048, DM = 2048, MROWS = BATCH * SEQ, DIN = 2888, DFF = 5504;
constexpr int N1 = 9216;
constexpr float EPS = 1e-6f;
constexpr int NPHASE = 21;

constexpr size_t MiB = 1u << 20;
constexpr size_t WS_MOD = 1 * MiB;
constexpr size_t WS_WI = 3 * MiB;
constexpr size_t WS_W = 4 * MiB;
constexpr size_t W_1CAT = WS_W, W_P = WS_W + 36 * MiB, W_OUT = WS_W + 44 * MiB, W_UP = WS_W + 52 * MiB, W_DOWN = WS_W + 95 * MiB,
                 W_GLU = WS_W + 116 * MiB + MiB / 2, W_POOL = WS_W + 117 * MiB;
constexpr size_t WS_R1 = 122 * MiB;
constexpr size_t WS_Y = WS_R1, WS_POOLED = WS_R1 + 32 * MiB;
constexpr size_t WS_R2 = 250 * MiB;
constexpr size_t WS_OCAT = 634 * MiB;
constexpr size_t WS_SA = WS_OCAT, WS_SB = WS_OCAT + 44 * MiB;
constexpr size_t WS_KN = 762 * MiB, WS_V = 770 * MiB, WS_QI = 778 * MiB, WS_KI = 810 * MiB, WS_U = 814 * MiB, WS_P = 846 * MiB, WS_END = 878 * MiB;
constexpr int LDS_BYTES = 163840;

__device__ __forceinline__ unsigned f2bf(float f) { unsigned u = __float_as_uint(f); return (u + 0x7fffu + ((u >> 16) & 1u)) >> 16; }
__device__ __forceinline__ unsigned pk2(float lo, float hi) { return f2bf(lo) | (f2bf(hi) << 16); }
__device__ __forceinline__ float bflo(unsigned u) { return __uint_as_float(u << 16); }
__device__ __forceinline__ float bfhi(unsigned u) { return __uint_as_float(u & 0xffff0000u); }
__device__ __forceinline__ float bf1(bf16_t b) { return __uint_as_float(((unsigned)b) << 16); }
__device__ __forceinline__ float sigmoidf_(float x) { return 1.f / (1.f + __expf(-x)); }
__device__ __forceinline__ float siluf_(float x) { return x / (1.f + __expf(-x)); }
__device__ __forceinline__ float gelu_tanh(float x) { const float z = 0.7978845608028654f * (x + 0.044715f * x * x * x); const float t = 1.f - 2.f / (1.f + __expf(2.f * z)); return 0.5f * x * (1.f + t); }
__device__ __forceinline__ uint4 pack8(f32x4 a, f32x4 b) { uint4 r; r.x = pk2(a[0], a[1]); r.y = pk2(a[2], a[3]); r.z = pk2(b[0], b[1]); r.w = pk2(b[2], b[3]); return r; }
__device__ __forceinline__ void unpack8(uint4 v, float* f) { f[0] = bflo(v.x); f[1] = bfhi(v.x); f[2] = bflo(v.y); f[3] = bfhi(v.y); f[4] = bflo(v.z); f[5] = bfhi(v.z); f[6] = bflo(v.w); f[7] = bfhi(v.w); }
#define LDS_FENCE() asm volatile("s_waitcnt lgkmcnt(0)" ::: "memory")
__device__ __forceinline__ int fresh_tid(int wv) { int l = (int)__builtin_amdgcn_mbcnt_hi(~0u, __builtin_amdgcn_mbcnt_lo(~0u, 0u)); asm volatile("" : "+v"(l)); return (wv << 6) | l; }

namespace pg8 {
constexpr int BM = 256, BK = 64, HALF = 128, HTB = HALF * BK * 2, STAGE_BYTES = 8 * HTB, NXCD = 8, WGM = 8;
__host__ __device__ __forceinline__ int lds_byte(int r, int c) { const int st = (r >> 4) * 2 + (c >> 5), rr = r & 15, cc = c & 31, ob = rr * 64 + cc * 2; return st * 1024 + (ob ^ (((ob >> 9) & 1) << 5)); }
__host__ __device__ __forceinline__ void stage_rc(int b, int& R, int& C) { const int st = b / 1024, sb = b % 1024, swz = sb ^ (((sb >> 9) & 1) << 5); R = (st >> 1) * 16 + swz / 64; C = (st & 1) * 32 + (swz % 64) / 2; }
__host__ __device__ __forceinline__ int perm32(int rho) { const int n = rho >> 4, i = rho & 15; return 8 * (i >> 2) + 4 * n + (i & 3); }
struct Unit { int pm, pn; };
struct Gemm { const bf16_t* A; const bf16_t* Bt; int M, N, K, lda, ldb; int asplit; size_t aoff; };
struct StaticOrder {
    int nM, nN, nwg, G, c;
    __device__ void init(int M, int N, int G_, int c_) { nM = M / BM; nN = N / BM; nwg = nM * nN; G = G_; c = c_; }
    __device__ bool next(int i, Unit& u) const {
        const long L = (long)i * G + c; if (L >= nwg) return false;
        int wgid = (int)L; { const int q = nwg / NXCD, r = nwg % NXCD, xcd = wgid % NXCD, off = wgid / NXCD; wgid = (xcd < r ? xcd * (q + 1) : r * (q + 1) + (xcd - r) * q) + off; }
        const int nig = WGM * nN, gid = wgid / nig, fm = gid * WGM, gsz = (nM - fm) < WGM ? (nM - fm) : WGM;
        u.pm = fm + ((wgid % nig) % gsz); u.pn = (wgid % nig) / gsz; return true;
    }
};
template <class Epi, class Sched>
__device__ __forceinline__ void gemm_phase(LAS unsigned char* lds, const Gemm g, const Sched& S, const Epi& E, const int WV) {
    const int TI = fresh_tid(WV);
    const int tid = TI, wid = __builtin_amdgcn_readfirstlane(tid >> 6), lane = tid & 63, wr = wid >> 2, wc = wid & 3, fr = lane & 15, fq = lane >> 4;
    const int K = g.K, nt = K / BK;
    unsigned voffA[2], voffB[2];
#pragma unroll
    for (int i = 0; i < 2; ++i) { int R, C; stage_rc(tid * 16 + i * 8192, R, C); const int Rb = Epi::PERM ? ((R & ~31) + perm32(R & 31)) : R;
        voffA[i] = (unsigned)(R * g.lda + C) * 2u; voffB[i] = (unsigned)(Rb * g.ldb + C) * 2u; }
    const size_t kstep = (size_t)(BK * 2);
    const size_t hstepA = (size_t)HALF * g.lda * 2, hstepB = (size_t)HALF * g.ldb * 2;
    const size_t tstepA = 2 * hstepA, tstepB = 2 * hstepB;
    const unsigned ldsw = (unsigned)wid * 1024u;
    const int aoff = lds_byte(wr * 64 + fr, fq * 8), boff = lds_byte(wc * 32 + fr, fq * 8);
#define PG8_SA(b, h) (((b) * 2 + (h)) * HTB)
#define PG8_SB(b, h) ((4 + (b) * 2 + (h)) * HTB)
#define PG8_STAGE(bufoff, gbase, voff) do { _Pragma("unroll") for (int _i = 0; _i < 2; ++_i) \
        __builtin_amdgcn_global_load_lds((const unsigned*)((const char*)(gbase) + (voff)[_i]), (LAS unsigned*)(lds + (bufoff) + ldsw + _i * 8192), 16, 0, 0); } while (0)
#define PG8_LDA(dst, b, h) do { _Pragma("unroll") for (int m = 0; m < 4; ++m) _Pragma("unroll") for (int k = 0; k < 2; ++k) dst[m][k] = *(const LAS bf16x8*)(lds + PG8_SA(b, h) + aoff + m * 2048 + k * 1024); } while (0)
#define PG8_LDB(dst, b, h) do { _Pragma("unroll") for (int n = 0; n < 2; ++n) _Pragma("unroll") for (int k = 0; k < 2; ++k) dst[n][k] = *(const LAS bf16x8*)(lds + PG8_SB(b, h) + boff + n * 2048 + k * 1024); } while (0)
#define PG8_MMA(ai, bj, At, Bt) do { __builtin_amdgcn_s_setprio(1); _Pragma("unroll") for (int m = 0; m < 4; ++m) _Pragma("unroll") for (int n = 0; n < 2; ++n) _Pragma("unroll") for (int k = 0; k < 2; ++k) \
        acc[ai][bj][m][n] = __builtin_amdgcn_mfma_f32_16x16x32_bf16(Bt[n][k], At[m][k], acc[ai][bj][m][n], 0, 0, 0); __builtin_amdgcn_s_setprio(0); } while (0)
#define PG8_WAIT_V(n) asm volatile("s_waitcnt vmcnt(" #n ")" ::: "memory")
#define PG8_WAIT_L(n) asm volatile("s_waitcnt lgkmcnt(" #n ")" ::: "memory")
#define PG8_BAR __builtin_amdgcn_s_barrier()
#define PG8_SCHED __builtin_amdgcn_sched_barrier(0)
#define PG8_ZERO() do { _Pragma("unroll") for (int a_ = 0; a_ < 2; ++a_) _Pragma("unroll") for (int b_ = 0; b_ < 2; ++b_) _Pragma("unroll") for (int m_ = 0; m_ < 4; ++m_) _Pragma("unroll") for (int n_ = 0; n_ < 2; ++n_) acc[a_][b_][m_][n_] = (f32x4){0.f, 0.f, 0.f, 0.f}; } while (0)
    Unit cur, nxt; int ui = 0;
    if (!S.next(0, cur)) return;
    f32x4 acc[2][2][4][2];
    PG8_ZERO();
    bf16x8 At[4][2], B0[2][2], B1[2][2];
    const char* cA = (const char*)g.A + (size_t)cur.pm * tstepA + (cur.pn >= g.asplit ? g.aoff : (size_t)0); const char* cB = (const char*)g.Bt + (size_t)cur.pn * tstepB;
    PG8_STAGE(PG8_SB(0, 0), cB, voffB); PG8_STAGE(PG8_SA(0, 0), cA, voffA); PG8_STAGE(PG8_SB(0, 1), cB + hstepB, voffB); PG8_STAGE(PG8_SA(0, 1), cA + hstepA, voffA);
    if (wr == 1) PG8_BAR;
    PG8_WAIT_V(4); PG8_BAR;
    PG8_STAGE(PG8_SB(1, 0), cB + kstep, voffB); PG8_STAGE(PG8_SA(1, 0), cA + kstep, voffA); PG8_STAGE(PG8_SB(1, 1), cB + hstepB + kstep, voffB);
    PG8_WAIT_V(6); PG8_BAR;
    for (;;) {
        const bool has_next = S.next(ui + 1, nxt);
        const char* nA = has_next ? (const char*)g.A + (size_t)nxt.pm * tstepA + (nxt.pn >= g.asplit ? g.aoff : (size_t)0) : cA; const char* nB = has_next ? (const char*)g.Bt + (size_t)nxt.pn * tstepB : cB;
        for (int t = 0; t < nt; t += 2) {
            const bool last = (t == nt - 2);
            const char* a1 = cA + (size_t)(t + 1) * kstep;
            const char* a2 = last ? nA : cA + (size_t)(t + 2) * kstep; const char* b2 = last ? nB : cB + (size_t)(t + 2) * kstep;
            const char* a3 = a2 + kstep; const char* b3 = b2 + kstep;
            PG8_LDB(B0, 0, 0); PG8_SCHED; PG8_LDA(At, 0, 0); PG8_STAGE(PG8_SA(1, 1), a1 + hstepA, voffA);
            PG8_WAIT_L(8); PG8_BAR; PG8_WAIT_L(0); PG8_MMA(0, 0, At, B0); PG8_BAR; PG8_SCHED;
            PG8_LDB(B1, 0, 1); PG8_STAGE(PG8_SB(0, 0), b2, voffB);
            PG8_BAR; PG8_WAIT_L(0); PG8_MMA(0, 1, At, B1); PG8_BAR;
            PG8_LDA(At, 0, 1); PG8_STAGE(PG8_SA(0, 0), a2, voffA);
            PG8_BAR; PG8_WAIT_L(0); PG8_MMA(1, 0, At, B0); PG8_BAR; PG8_SCHED;
            PG8_STAGE(PG8_SB(0, 1), b2 + hstepB, voffB);
            PG8_WAIT_V(6); PG8_BAR; PG8_MMA(1, 1, At, B1); PG8_BAR;
            PG8_LDB(B0, 1, 0); PG8_SCHED; PG8_LDA(At, 1, 0); PG8_STAGE(PG8_SA(0, 1), a2 + hstepA, voffA);
            PG8_WAIT_L(8); PG8_BAR; PG8_WAIT_L(0); PG8_MMA(0, 0, At, B0); PG8_BAR; PG8_SCHED;
            PG8_LDB(B1, 1, 1); PG8_STAGE(PG8_SB(1, 0), b3, voffB);
            PG8_BAR; PG8_WAIT_L(0); PG8_MMA(0, 1, At, B1); PG8_BAR;
            PG8_LDA(At, 1, 1); PG8_STAGE(PG8_SA(1, 0), a3, voffA);
            PG8_BAR; PG8_WAIT_L(0); PG8_MMA(1, 0, At, B0); PG8_BAR; PG8_SCHED;
            PG8_STAGE(PG8_SB(1, 1), b3 + hstepB, voffB);
            PG8_WAIT_V(6); PG8_BAR; PG8_MMA(1, 1, At, B1); PG8_BAR;
            if constexpr (Epi::SEG) { if (t + 2 == 16 || t + 2 == 24) { E.flush(acc, cur, (t + 2 == 16) ? 0 : 1, wr, wc, fr, fq); PG8_ZERO(); } }
        }
        if constexpr (Epi::SEG) E.flush(acc, cur, 2, wr, wc, fr, fq); else E(acc, cur, wr, wc, fr, fq);
        if (!has_next) break;
        PG8_ZERO();
        cur = nxt; cA = nA; cB = nB; ++ui;
    }
    PG8_WAIT_V(0);
    if (wr == 0) PG8_BAR;
    PG8_BAR;
#undef PG8_SA
#undef PG8_SB
#undef PG8_STAGE
#undef PG8_LDA
#undef PG8_LDB
#undef PG8_MMA
#undef PG8_WAIT_V
#undef PG8_WAIT_L
#undef PG8_BAR
#undef PG8_SCHED
#undef PG8_ZERO
}
}
using pg8::Unit;
typedef const f32x4 (&AccRef)[2][2][4][2];

struct Epi1 {
    static constexpr bool PERM = true, SEG = false;
    bf16_t *ocat, *kn, *vv, *qi, *ki, *u, *p, *gates; float* wi; const float* bgate; LAS unsigned char* stg;
    __device__ __forceinline__ void operator()(AccRef acc, const Unit& un, int wr, int wc, int fr, int fq) const {
        asm volatile("" : "+v"(fr), "+v"(fq));
        const int pn = un.pn, rowb = un.pm * 256 + wr * 64, lane = fq * 16 + fr;
        LAS unsigned char* sb = stg + (wr * 4 + wc) * 2304;
        if (pn == 7 && wc >= 1) {
            if (wc == 1 && fq == 0) {
                const float s = 0.35355339059327373f * 0.125f;
#pragma unroll
                for (int ai = 0; ai < 2; ++ai)
#pragma unroll
                    for (int m = 0; m < 4; ++m) { const size_t row = (size_t)(rowb + ai * 128 + m * 16 + fr);
                        *(f32x4*)(wi + row * 8) = acc[ai][0][m][0] * s; *(f32x4*)(wi + row * 8 + 4) = acc[ai][0][m][1] * s; }
            }
            return;
        }
        if (pn >= 12) {
            const int c0 = (pn - 12) * 256 + 64 * wc;
            f32x4 bz[2][2];
#pragma unroll
            for (int bj = 0; bj < 2; ++bj) { bz[bj][0] = *(const f32x4*)(bgate + c0 + 32 * bj + 8 * fq); bz[bj][1] = *(const f32x4*)(bgate + c0 + 32 * bj + 8 * fq + 4); }
            unsigned char* gb = (unsigned char*)gates + c0;
#pragma unroll
            for (int ai = 0; ai < 2; ++ai)
#pragma unroll
                for (int m = 0; m < 4; ++m) {
#pragma unroll
                    for (int bj = 0; bj < 2; ++bj) { uint2 q; unsigned w[2];
#pragma unroll
                        for (int n = 0; n < 2; ++n) { unsigned t = 0u;
#pragma unroll
                            for (int e = 0; e < 4; ++e) t |= (unsigned)(sigmoidf_(acc[ai][bj][m][n][e] + bz[bj][n][e]) * 255.f + 0.5f) << (8 * e);
                            w[n] = t; }
                        q.x = w[0]; q.y = w[1];
                        *(LAS u32x2*)(sb + fr * 80 + 32 * bj + 8 * fq) = (u32x2){q.x, q.y}; }
                    LDS_FENCE();
                    { const int r = lane >> 2, sg = lane & 3; const u32x4 v = *(const LAS u32x4*)(sb + r * 80 + sg * 16);
                      *(u32x4*)(gb + (size_t)(rowb + ai * 128 + m * 16 + r) * 6144 + sg * 16) = v; }
                    LDS_FENCE();
                }
            return;
        }
        bf16_t* base; int ld;
        if (pn < 4) { base = ocat + pn * 256 + 64 * wc; ld = 2048; }
        else if (pn == 4) { base = (wc < 2 ? kn : vv) + 64 * (wc & 1); ld = 128; }
        else if (pn < 7) { base = qi + (pn - 5) * 256 + 64 * wc; ld = 512; }
        else if (pn == 7) { base = ki; ld = 64; }
        else if (pn < 10) { base = u + (pn - 8) * 256 + 64 * wc; ld = 512; }
        else { base = p + (pn - 10) * 256 + 64 * wc; ld = 512; }
#pragma unroll
        for (int ai = 0; ai < 2; ++ai)
#pragma unroll
            for (int m = 0; m < 4; ++m) {
#pragma unroll
                for (int bj = 0; bj < 2; ++bj) { const uint4 pk_ = pack8(acc[ai][bj][m][0], acc[ai][bj][m][1]); *(LAS u32x4*)(sb + fr * 144 + 64 * bj + 16 * fq) = (u32x4){pk_.x, pk_.y, pk_.z, pk_.w}; }
                LDS_FENCE();
#pragma unroll
                for (int h = 0; h < 2; ++h) { const int r = h * 8 + (lane >> 3), sg = lane & 7; const u32x4 v = *(const LAS u32x4*)(sb + r * 144 + sg * 16);
                    *(u32x4*)(base + (size_t)(rowb + ai * 128 + m * 16 + r) * ld + sg * 8) = v; }
                LDS_FENCE();
            }
    }
};
struct EpiGluPool {
    static constexpr bool PERM = true, SEG = false;
    const bf16_t* y; const float* scale; bf16_t* ocat;
    __device__ __forceinline__ void operator()(AccRef acc, const Unit& un, int wr, int wc, int fr, int fq) const {
        asm volatile("" : "+v"(fr), "+v"(fq));
        const int row0 = un.pm * 256 + wr * 64 + fr; const bool glu = un.pn < 2;
#pragma unroll
        for (int bj = 0; bj < 2; ++bj) { const int col = (un.pn & 1) * 256 + bj * 128 + wc * 32 + 8 * fq;
            f32x4 s0 = {0.f, 0.f, 0.f, 0.f}, s1 = {0.f, 0.f, 0.f, 0.f};
            if (!glu) { s0 = *(const f32x4*)(scale + col); s1 = *(const f32x4*)(scale + col + 4); }
#pragma unroll
            for (int ai = 0; ai < 2; ++ai) {
                uint4 yq[4];
                if (glu) {
#pragma unroll
                    for (int m = 0; m < 4; ++m) yq[m] = *(const uint4*)(y + (size_t)(row0 + ai * 128 + m * 16) * 512 + col); }
#pragma unroll
                for (int m = 0; m < 4; ++m) { const size_t row = (size_t)(row0 + ai * 128 + m * 16);
                    f32x4 v0 = acc[ai][bj][m][0], v1 = acc[ai][bj][m][1];
                    if (glu) { float yv[8]; unpack8(yq[m], yv);
#pragma unroll
                        for (int e = 0; e < 4; ++e) { v0[e] = yv[e] * sigmoidf_(v0[e]); v1[e] = yv[4 + e] * sigmoidf_(v1[e]); }
                        *(uint4*)(ocat + row * 2048 + 1024 + col) = pack8(v0, v1);
                    } else *(uint4*)(ocat + row * 2048 + 1536 + col) = pack8(v0 * s0, v1 * s1); } } }
    }
};
struct EpiMerge {
    static constexpr bool PERM = true, SEG = true;
    const bf16_t* gates; bf16_t* merged;
    __device__ __forceinline__ void flush(AccRef acc, const Unit& un, int seg, int wr, int wc, int fr, int fq) const {
        asm volatile("" : "+v"(fr), "+v"(fq));
        const int row0 = un.pm * 256 + wr * 64 + fr;
#pragma unroll
        for (int bj = 0; bj < 2; ++bj) { const int col = un.pn * 256 + bj * 128 + wc * 32 + 8 * fq;
            uint2 gq[2][4];
#pragma unroll
            for (int ai = 0; ai < 2; ++ai)
#pragma unroll
                for (int m = 0; m < 4; ++m) gq[ai][m] = *(const uint2*)((const unsigned char*)gates + (size_t)(row0 + ai * 128 + m * 16) * 6144 + seg * 2048 + col);
#pragma unroll
            for (int ai = 0; ai < 2; ++ai) {
                uint4 pq[4];
#pragma unroll
                for (int m = 0; m < 4; ++m) { if (seg > 0) pq[m] = *(const uint4*)(merged + (size_t)(row0 + ai * 128 + m * 16) * 2048 + col); else pq[m] = make_uint4(0u, 0u, 0u, 0u); }
#pragma unroll
                for (int m = 0; m < 4; ++m) { const size_t row = (size_t)(row0 + ai * 128 + m * 16);
                    float gv[8], pv[8]; unpack8(pq[m], pv);
#pragma unroll
                    for (int e = 0; e < 4; ++e) { gv[e] = (float)((gq[ai][m].x >> (8 * e)) & 0xffu) * (1.f / 255.f); gv[4 + e] = (float)((gq[ai][m].y >> (8 * e)) & 0xffu) * (1.f / 255.f); }
                    f32x4 v0 = acc[ai][bj][m][0], v1 = acc[ai][bj][m][1];
#pragma unroll
                    for (int e = 0; e < 4; ++e) { v0[e] = pv[e] + gv[e] * v0[e]; v1[e] = pv[4 + e] + gv[4 + e] * v1[e]; }
                    *(uint4*)(merged + row * 2048 + col) = pack8(v0, v1); } } }
    }
};
struct EpiRes {
    static constexpr bool PERM = false, SEG = false;
    const float* xin; float* out; const float* gt;
    __device__ __forceinline__ void operator()(AccRef acc, const Unit& un, int wr, int wc, int fr, int fq) const {
        asm volatile("" : "+v"(fr), "+v"(fq));
        const int row0 = un.pm * 256 + wr * 64 + fr; const float* g = gt + (size_t)(un.pm >> 3) * 12288;
#pragma unroll
        for (int bj = 0; bj < 2; ++bj) { const int col = un.pn * 256 + bj * 128 + wc * 32 + 4 * fq;
            f32x4 gv[2], xv[2][2][4];
#pragma unroll
            for (int n = 0; n < 2; ++n) gv[n] = *(const f32x4*)(g + col + 16 * n);
#pragma unroll
            for (int n = 0; n < 2; ++n)
#pragma unroll
                for (int ai = 0; ai < 2; ++ai)
#pragma unroll
                    for (int m = 0; m < 4; ++m) xv[n][ai][m] = *(const f32x4*)(xin + (size_t)(row0 + ai * 128 + m * 16) * 2048 + col + 16 * n);
#pragma unroll
            for (int n = 0; n < 2; ++n)
#pragma unroll
                for (int ai = 0; ai < 2; ++ai)
#pragma unroll
                    for (int m = 0; m < 4; ++m) *(f32x4*)(out + (size_t)(row0 + ai * 128 + m * 16) * 2048 + col + 16 * n) = xv[n][ai][m] + gv[n] * acc[ai][bj][m][n]; }
    }
};
struct EpiUp {
    static constexpr bool PERM = true, SEG = false;
    bf16_t* act; float* SA; float* SB; const float* cw; const float* cb; LAS unsigned char* stg;
    __device__ __forceinline__ void operator()(AccRef acc, const Unit& un, int wr, int wc, int fr, int fq) const {
        asm volatile("" : "+v"(fr), "+v"(fq));
        const int lg = fq << 4, lane = lg | fr;
        const int src1 = lg | ((fr + 15) & 15), src2 = lg | ((fr + 14) & 15);
        const int ch0 = un.pn * 128 + wc * 32 + 8 * fq;
        LAS unsigned char* sb = stg + (wr * 4 + wc) * 2304;
        f32x4 w0[2], w1[2], w2[2], bb[2];
#pragma unroll
        for (int n = 0; n < 2; ++n) { w0[n] = *(const f32x4*)(cw + ch0 + 4 * n); w1[n] = *(const f32x4*)(cw + DFF + ch0 + 4 * n); w2[n] = *(const f32x4*)(cw + 2 * DFF + ch0 + 4 * n); bb[n] = *(const f32x4*)(cb + ch0 + 4 * n); }
#pragma unroll
        for (int ai = 0; ai < 2; ++ai) {
            const int rowb = un.pm * 256 + ai * 128 + wr * 64; const int blk = rowb >> 6;
#pragma unroll
            for (int m = 0; m < 4; ++m) {
                f32x4 res[2];
#pragma unroll
                for (int n = 0; n < 2; ++n)
#pragma unroll
                    for (int e = 0; e < 4; ++e) {
                        const float cur = acc[ai][0][m][n][e];
                        const float prv = (m > 0) ? acc[ai][0][m > 0 ? m - 1 : 0][n][e] : 0.f;
                        const float p1 = __shfl((fr + 1 >= 16) ? prv : cur, src1);
                        const float p2 = __shfl((fr + 2 >= 16) ? prv : cur, src2);
                        const float cv = bb[n][e] + w0[n][e] * p2 + w1[n][e] * p1 + w2[n][e] * cur;
                        res[n][e] = siluf_(cv) * acc[ai][1][m][n][e];
                    }
                if (m == 0 && fr < 2) {
                    float* sa = SA + ((size_t)(blk * 4 + 2 + fr)) * DFF + ch0; float* sbp = SB + ((size_t)(blk * 2 + fr)) * DFF + ch0;
                    *(f32x4*)sa = acc[ai][0][0][0]; *(f32x4*)(sa + 4) = acc[ai][0][0][1];
                    *(f32x4*)sbp = acc[ai][1][0][0]; *(f32x4*)(sbp + 4) = acc[ai][1][0][1];
                }
                if (m == 3 && fr >= 14) { float* sa = SA + ((size_t)(blk * 4 + (fr - 14))) * DFF + ch0; *(f32x4*)sa = acc[ai][0][3][0]; *(f32x4*)(sa + 4) = acc[ai][0][3][1]; }
                { const uint4 pk_ = pack8(res[0], res[1]); *(LAS u32x4*)(sb + fr * 80 + 16 * fq) = (u32x4){pk_.x, pk_.y, pk_.z, pk_.w}; }
                LDS_FENCE();
                { const int r = lane >> 2, sg = lane & 3; const u32x4 v = *(const LAS u32x4*)(sb + r * 80 + sg * 16);
                  if (!(m == 0 && r < 2)) *(u32x4*)(act + (size_t)(rowb + m * 16 + r) * DFF + un.pn * 128 + wc * 32 + sg * 8) = v; }
                LDS_FENCE();
            }
        }
    }
};

struct Args { const float* in[31]; float* out; unsigned char* ws; int ph_lo, ph_hi; };
enum { I_X = 0, I_C, I_POS, I_WADA, I_BADA, I_GN1, I_GN2, I_WIN, I_GQ, I_GK, I_ARE, I_AIM, I_BRE, I_BIM, I_CRE, I_CIM, I_DSKIP, I_LOGDT, I_WGLU, I_WPOOL, I_PSCALE, I_PA, I_PB, I_PC, I_WGATE, I_BGATE, I_WOUT, I_WUP, I_CONVW, I_CONVB, I_WDOWN };

__device__ __forceinline__ float wave_sum(float v) {
#pragma unroll
    for (int o = 32; o > 0; o >>= 1) v += __shfl_xor(v, o);
    return v;
}

__device__ __forceinline__ void phase_ada(const Args& a, unsigned char* lds, const int WV) {
    const int TI = fresh_tid(WV);
    const int tid = TI;
    float* cact = (float*)lds;
    float* mod = (float*)(a.ws + WS_MOD);
    for (int w = blockIdx.x; w < 256; w += gridDim.x) {
        for (int i = tid; i < 16 * 2048; i += 512) { const int b = i >> 11, k = i & 2047; const float v = a.in[I_C][i]; cact[k * 16 + b] = siluf_(v); }
        __syncthreads();
        const int l = w >> 7, n0 = (w & 127) * 96;
        float acc[16][4];
#pragma unroll
        for (int b = 0; b < 16; ++b)
#pragma unroll
            for (int j = 0; j < 4; ++j) acc[b][j] = 0.f;
        const int cg4 = tid % 24, ks = tid / 24;
        if (tid < 384) {
            const float* wp = a.in[I_WADA] + ((size_t)l * 2048 + ks * 128) * 12288 + n0 + cg4 * 4;
#pragma unroll 4
            for (int k = 0; k < 128; ++k) {
                const f32x4 wv = *(const f32x4*)(wp + (size_t)k * 12288);
                const f32x4* cp = (const f32x4*)(cact + (ks * 128 + k) * 16);
#pragma unroll
                for (int q = 0; q < 4; ++q) { const f32x4 cv = cp[q];
#pragma unroll
                    for (int e = 0; e < 4; ++e)
#pragma unroll
                        for (int j = 0; j < 4; ++j) acc[q * 4 + e][j] += cv[e] * wv[j]; }
            }
        }
        __syncthreads();
        float* part = (float*)lds;
        if (tid < 384) {
#pragma unroll
            for (int b = 0; b < 16; ++b)
#pragma unroll
                for (int j = 0; j < 4; ++j) part[(ks * 16 + b) * 96 + cg4 * 4 + j] = acc[b][j];
        }
        __syncthreads();
        for (int o = tid; o < 1536; o += 512) { const int b = o / 96, cc = o % 96; float s = 0.f;
#pragma unroll
            for (int k2 = 0; k2 < 16; ++k2) s += part[(k2 * 16 + b) * 96 + cc];
            mod[((size_t)l * 16 + b) * 12288 + n0 + cc] = s + a.in[I_BADA][l * 12288 + n0 + cc]; }
        __syncthreads();
    }
}

struct CvtJob { const float* src; bf16_t* dst; int ldS, cbase, cend, kbase, ldD, mode, r0, cs0, kd0; };
__device__ __forceinline__ CvtJob cvt_decode(const Args& a, int l, int t) {
    unsigned char* ws = a.ws; CvtJob J; int ncols, nkt, idx; J.mode = 0; J.r0 = 0; J.kd0 = 0; J.cs0 = 0;
    if (t < 960) { idx = t; J.src = a.in[I_WIN] + (size_t)l * DM * DIN; J.ldS = DIN; ncols = 1864; nkt = 32; J.dst = (bf16_t*)(ws + W_1CAT); J.ldD = 2048; J.mode = 2; }
    else if (t < 1472) { idx = t - 960; J.src = a.in[I_WIN] + (size_t)l * DM * DIN; J.ldS = DIN; J.cs0 = 1864; ncols = 1024; nkt = 32; J.dst = (bf16_t*)(ws + W_1CAT); J.ldD = 2048; J.r0 = 2048; J.mode = 2; }
    else if (t < 4544) { idx = t - 1472; const int gi = idx >> 10; idx &= 1023; J.src = a.in[I_WGATE] + ((size_t)l * 3 + gi) * DM * DM; J.ldS = DM; ncols = 2048; nkt = 32; J.dst = (bf16_t*)(ws + W_1CAT); J.ldD = 2048; J.r0 = 3072 + 2048 * gi; J.mode = 2; }
    else if (t < 5056) { idx = t - 4544; J.src = a.in[I_PA] + (size_t)l * 1024 * DM; J.ldS = DM; ncols = 2048; nkt = 16; J.dst = (bf16_t*)(ws + W_P); J.ldD = 2048; }
    else if (t < 5312) { idx = t - 5056; J.src = a.in[I_PB] + (size_t)l * 512 * DM; J.ldS = DM; ncols = 2048; nkt = 8; J.dst = (bf16_t*)(ws + W_P); J.ldD = 2048; J.kd0 = 1024; }
    else if (t < 5568) { idx = t - 5312; J.src = a.in[I_PC] + (size_t)l * 512 * DM; J.ldS = DM; ncols = 2048; nkt = 8; J.dst = (bf16_t*)(ws + W_P); J.ldD = 2048; J.kd0 = 1536; }
    else if (t < 6592) { idx = t - 5568; J.src = a.in[I_WOUT] + (size_t)l * DM * DM; J.ldS = DM; ncols = 2048; nkt = 32; J.dst = (bf16_t*)(ws + W_OUT); J.ldD = 2048; }
    else if (t < 12096) { idx = t - 6592; J.src = a.in[I_WUP] + (size_t)l * DM * 2 * DFF; J.ldS = 2 * DFF; ncols = 2 * DFF; nkt = 32; J.dst = (bf16_t*)(ws + W_UP); J.ldD = 2048; J.mode = 1; }
    else if (t < 14848) { idx = t - 12096; J.src = a.in[I_WDOWN] + (size_t)l * DFF * DM; J.ldS = DM; ncols = 2048; nkt = 86; J.dst = (bf16_t*)(ws + W_DOWN); J.ldD = DFF; }
    else { idx = t - 14848; J.src = a.in[I_WGLU] + (size_t)l * 512 * 512; J.ldS = 512; ncols = 512; nkt = 8; J.dst = (bf16_t*)(ws + W_GLU); J.ldD = 512; }
    const int tn = idx / nkt, tk = idx - tn * nkt;
    J.cbase = J.cs0 + tn * 64; J.cend = J.cs0 + ncols; J.kbase = tk * 64; return J;
}
__device__ __forceinline__ void phase_cvt(const Args& a, int l, unsigned char* lds, const int WV) {
    const int TI = fresh_tid(WV);
    float* T = (float*)lds;
    const int tid = TI, ty = tid >> 4, tx = tid & 15;
    for (int t4 = blockIdx.x * 8; t4 < 14912; t4 += gridDim.x * 8) {
        f32x4 v[8][2];
#pragma unroll
        for (int q = 0; q < 8; ++q) { const CvtJob J = cvt_decode(a, l, t4 + q);
#pragma unroll
            for (int ps = 0; ps < 2; ++ps) { const int k = ty + ps * 32, c = J.cbase + tx * 4;
                v[q][ps] = (f32x4){0.f, 0.f, 0.f, 0.f};
                if (c < J.cend) v[q][ps] = *(const f32x4*)(J.src + (size_t)(J.kbase + k) * J.ldS + c); } }
#pragma unroll
        for (int q = 0; q < 8; ++q)
#pragma unroll
            for (int ps = 0; ps < 2; ++ps) { float* tp = T + q * (64 * 65) + (ty + ps * 32) * 65 + tx * 4; tp[0] = v[q][ps][0]; tp[1] = v[q][ps][1]; tp[2] = v[q][ps][2]; tp[3] = v[q][ps][3]; }
        __syncthreads();
#pragma unroll
        for (int q = 0; q < 8; ++q) { const CvtJob J = cvt_decode(a, l, t4 + q);
            const int n = tid >> 3, kq = tid & 7, c = J.cbase + n;
            if (c < J.cend) {
                float f[8];
#pragma unroll
                for (int j = 0; j < 8; ++j) f[j] = T[q * (64 * 65) + (kq * 8 + j) * 65 + n];
                int row;
                if (J.mode == 0) row = J.r0 + (c - J.cs0);
                else if (J.mode == 2) { const int r_ = J.r0 + (c - J.cs0), ct = r_ & 255; row = (r_ & ~255) | (((ct >> 5) & 1) << 7) | ((ct >> 6) << 5) | (ct & 31); }
                else { const int bj = c >= DFF ? 1 : 0, ch = c - bj * DFF; row = (ch >> 7) * 256 + bj * 128 + (ch & 127); }
                uint4 o; o.x = pk2(f[0], f[1]); o.y = pk2(f[2], f[3]); o.z = pk2(f[4], f[5]); o.w = pk2(f[6], f[7]);
                *(uint4*)(J.dst + (size_t)row * J.ldD + J.kd0 + J.kbase + kq * 8) = o;
            } }
        __syncthreads();
    }
    bf16_t* wp = (bf16_t*)(a.ws + W_POOL); const float* wsrc = a.in[I_WPOOL] + (size_t)l * 4 * 128 * 128;
    for (int i = blockIdx.x * 512 + TI; i < 512 * 512; i += gridDim.x * 512) { const int n = i >> 9, k = i & 511, g = n >> 7;
        const float v = ((k >> 7) == g) ? wsrc[(g * 128 + (k & 127)) * 128 + (n & 127)] : 0.f; wp[i] = (bf16_t)f2bf(v); }
}

__device__ __forceinline__ void phase_norm(const float* xin, const float* g, const float* modl, int shoff, int scoff, bf16_t* out, const int WV) {
    const int TI = fresh_tid(WV);
    const int lane = TI & 63, wave = TI >> 6;
    for (int r = blockIdx.x * 8 + wave; r < MROWS; r += gridDim.x * 8) {
        const f32x4* xp = (const f32x4*)(xin + (size_t)r * DM); f32x4 v[8]; float ssq = 0.f;
#pragma unroll
        for (int j = 0; j < 8; ++j) { v[j] = xp[j * 64 + lane]; ssq += v[j][0] * v[j][0] + v[j][1] * v[j][1] + v[j][2] * v[j][2] + v[j][3] * v[j][3]; }
        ssq = wave_sum(ssq);
        const float rinv = rsqrtf(ssq * (1.f / DM) + EPS);
        const float* mb = modl + (size_t)(r >> 11) * 12288;
#pragma unroll
        for (int j = 0; j < 8; ++j) { const int col = j * 256 + lane * 4;
            const f32x4 g4 = *(const f32x4*)(g + col), sc = *(const f32x4*)(mb + scoff + col), sh = *(const f32x4*)(mb + shoff + col);
            f32x4 y;
#pragma unroll
            for (int e = 0; e < 4; ++e) y[e] = (v[j][e] * rinv * g4[e]) * (1.f + sc[e]) + sh[e];
            uint2 o; o.x = pk2(y[0], y[1]); o.y = pk2(y[2], y[3]);
            *(uint2*)(out + (size_t)r * DM + col) = o; }
    }
}

__constant__ double kRevPerPos[24] = {0.15915494309189535, 0.0700865215877985, 0.03086376340470123, 0.013591370636193905, 0.005985185712713705, 0.002635675898667414, 0.001160663641240061, 0.0005111175045375439, 0.00022507907903927653, 9.911730936901935e-05, 4.364795279280289e-05, 1.9221100684944863e-05, 8.464330808241401e-06, 3.727408601915352e-06, 1.6414262627950345e-06, 7.228293068832865e-07, 0.15915494309189535, 0.03086376340470123, 0.005985185712713705, 0.001160663641240061, 0.00022507907903927653, 4.364795279280289e-05, 8.464330808241401e-06, 1.6414262627950345e-06};
__device__ __forceinline__ void rmsrope128(bf16_t* p, bool active, const float* g16, int sub, const float* cs) {
    float v[16];
    if (active) { unpack8(*(const uint4*)p, v); unpack8(*(const uint4*)(p + 8), v + 8); }
    else {
#pragma unroll
        for (int i = 0; i < 16; ++i) v[i] = 0.f; }
    float ssq = 0.f;
#pragma unroll
    for (int i = 0; i < 16; ++i) ssq += v[i] * v[i];
    ssq += __shfl_xor(ssq, 1); ssq += __shfl_xor(ssq, 2); ssq += __shfl_xor(ssq, 4);
    const float rinv = rsqrtf(ssq * (1.f / 128.f) + EPS);
#pragma unroll
    for (int i = 0; i < 16; ++i) v[i] = v[i] * rinv * g16[i];
#pragma unroll
    for (int i = 0; i < 16; ++i) { const float o = __shfl_xor(v[i], 1); const float c = cs[2 * i], s = cs[2 * i + 1];
        if (sub == 0) v[i] = v[i] * c - o * s; else if (sub == 1) v[i] = v[i] * c + o * s; }
    if (active) { uint4 o0, o1; o0.x = pk2(v[0], v[1]); o0.y = pk2(v[2], v[3]); o0.z = pk2(v[4], v[5]); o0.w = pk2(v[6], v[7]);
        o1.x = pk2(v[8], v[9]); o1.y = pk2(v[10], v[11]); o1.z = pk2(v[12], v[13]); o1.w = pk2(v[14], v[15]);
        *(uint4*)p = o0; *(uint4*)(p + 8) = o1; }
}
__device__ __forceinline__ void rope64(bf16_t* p, bool active, int sub, const float* cs) {
    float v[8];
    if (active) unpack8(*(const uint4*)p, v);
    else {
#pragma unroll
        for (int i = 0; i < 8; ++i) v[i] = 0.f; }
#pragma unroll
    for (int i = 0; i < 8; ++i) { const float o = __shfl_xor(v[i], 1); const float c = cs[2 * i], s = cs[2 * i + 1];
        if (sub == 0) v[i] = v[i] * c - o * s; else if (sub == 1) v[i] = v[i] * c + o * s; }
    if (active) { uint4 o0; o0.x = pk2(v[0], v[1]); o0.y = pk2(v[2], v[3]); o0.z = pk2(v[4], v[5]); o0.w = pk2(v[6], v[7]); *(uint4*)p = o0; }
}
__device__ __forceinline__ void phase_post(const Args& a, int l, unsigned char* lds, const int WV) {
    const int TI = fresh_tid(WV);
    const int lane = TI & 63, wave = TI >> 6;
    float* cs = (float*)lds + wave * 64;
    bf16_t* ocat = (bf16_t*)(a.ws + WS_OCAT); bf16_t* kn = (bf16_t*)(a.ws + WS_KN); bf16_t* qi = (bf16_t*)(a.ws + WS_QI); bf16_t* ki = (bf16_t*)(a.ws + WS_KI);
    const int* pos = (const int*)a.in[I_POS];
    const int sub = lane & 7, hd = lane >> 3;
    float gq[16], gk[16];
#pragma unroll
    for (int i = 0; i < 16; ++i) { gq[i] = a.in[I_GQ][l * 128 + sub * 16 + i]; gk[i] = a.in[I_GK][l * 128 + sub * 16 + i]; }
    for (int r = blockIdx.x * 8 + wave; r < MROWS; r += gridDim.x * 8) {
        const int ps = pos[r];
        if (lane < 24) {
            double rev = (double)ps * kRevPerPos[lane]; rev -= rint(rev); const float fr = (float)rev;
            cs[lane * 2] = __builtin_amdgcn_cosf(fr); cs[lane * 2 + 1] = __builtin_amdgcn_sinf(fr); }
        LDS_FENCE();
        rmsrope128(ocat + (size_t)r * 2048 + hd * 128 + sub * 16, true, gq, sub, cs);
        rmsrope128(kn + (size_t)r * 128 + sub * 16, lane < 8, gk, sub, cs);
        rope64(qi + (size_t)r * 512 + hd * 64 + sub * 8, true, sub, cs + 32);
        rope64(ki + (size_t)r * 64 + sub * 8, lane < 8, sub, cs + 32);
        LDS_FENCE();
    }
}

__device__ __forceinline__ void s5_unit(const Args& a, int l, int b, int g, unsigned char* lds, const int WV) {
    const int TI = fresh_tid(WV);
    const int lane = TI & 63, wave = __builtin_amdgcn_readfirstlane(TI >> 6), p = lane;
    float* E = (float*)lds;
    float* ust = (float*)(lds + 16384 + wave * 4096);
    bf16_t* sst = (bf16_t*)(lds + 49152 + wave * 4352);
    const bf16_t* U = (const bf16_t*)(a.ws + WS_U); bf16_t* Y = (bf16_t*)(a.ws + WS_Y);
    const int gp = (l * 32 + g) * 64 + p;
    const float are = a.in[I_ARE][gp], aim = a.in[I_AIM][gp], dt = expf(a.in[I_LOGDT][l * 32 + g]);
    const float mag = expf(are * dt);
    float ang = aim * dt; { const float n = rintf(ang * 0.15915494309189535f); ang = fmaf(-n, 6.28318548202514648f, ang); ang = fmaf(n, 1.7484555e-7f, ang); }
    const float lre = mag * cosf(ang), lim = mag * sinf(ang);
    float Bre[16], Bim[16];
    { const float nr = lre - 1.f, ni = lim, den = 1.f / (are * are + aim * aim); const float cr = (nr * are + ni * aim) * den, ci = (ni * are - nr * aim) * den;
#pragma unroll
        for (int j = 0; j < 16; ++j) { const float br = a.in[I_BRE][(size_t)gp * 16 + j], bi = a.in[I_BIM][(size_t)gp * 16 + j]; Bre[j] = cr * br - ci * bi; Bim[j] = cr * bi + ci * br; } }
    bf16x8 Cf[4];
    { const int i = lane & 15;
#pragma unroll
        for (int ks = 0; ks < 4; ++ks)
#pragma unroll
            for (int j = 0; j < 8; ++j) { const int k = ks * 32 + (lane >> 4) * 8 + j, pp = k >> 1; const size_t ci = ((size_t)(l * 32 + g) * 16 + i) * 64 + pp;
                const float v = (k & 1) ? -a.in[I_CIM][ci] : a.in[I_CRE][ci]; Cf[ks][j] = (short)f2bf(v); } }
    const float dsk = a.in[I_DSKIP][l * 512 + g * 16 + (lane & 15)];
    bf16_t* Bl = (bf16_t*)(lds + 83968);
    float* bus = (float*)(lds + 88064 + wave * 8448);
    if (wave == 0) {
#pragma unroll
        for (int q = 0; q < 2; ++q) { uint4 o_; o_.x = pk2(Bre[q * 8], Bre[q * 8 + 1]); o_.y = pk2(Bre[q * 8 + 2], Bre[q * 8 + 3]); o_.z = pk2(Bre[q * 8 + 4], Bre[q * 8 + 5]); o_.w = pk2(Bre[q * 8 + 6], Bre[q * 8 + 7]);
            *(uint4*)(Bl + p * 16 + q * 8) = o_;
            uint4 i_; i_.x = pk2(Bim[q * 8], Bim[q * 8 + 1]); i_.y = pk2(Bim[q * 8 + 2], Bim[q * 8 + 3]); i_.z = pk2(Bim[q * 8 + 4], Bim[q * 8 + 5]); i_.w = pk2(Bim[q * 8 + 6], Bim[q * 8 + 7]);
            *(uint4*)(Bl + (64 + p) * 16 + q * 8) = i_; }
    }
    __syncthreads();
    const int l15 = lane & 15, lg4 = lane >> 4;
    bf16x8 Bf[8];
#pragma unroll
    for (int nb = 0; nb < 8; ++nb) { u32x4 t_ = {0u, 0u, 0u, 0u}; if (lg4 < 2) t_ = *(const u32x4*)(Bl + (nb * 16 + l15) * 16 + lg4 * 8); Bf[nb] = __builtin_bit_cast(bf16x8, t_); }
#define S5_BU(t0_, sb_) do { u32x4 a_ = {0u, 0u, 0u, 0u}; if (lg4 < 2) a_ = *(const u32x4*)(U + (size_t)(b * 2048 + (t0_) + (sb_) * 16 + l15) * 512 + g * 16 + lg4 * 8); \
        const bf16x8 af_ = __builtin_bit_cast(bf16x8, a_); \
        _Pragma("unroll") for (int nb = 0; nb < 8; ++nb) { const f32x4 c_ = __builtin_amdgcn_mfma_f32_16x16x32_bf16(af_, Bf[nb], (f32x4){0.f, 0.f, 0.f, 0.f}, 0, 0, 0); \
            _Pragma("unroll") for (int r = 0; r < 4; ++r) bus[(lg4 * 4 + r) * 132 + nb * 16 + l15] = c_[r]; } \
        LDS_FENCE(); } while (0)
#define S5_STEP(tt_) do { const float br_ = bus[(tt_) * 132 + p], bi_ = bus[(tt_) * 132 + 64 + p]; \
        const float nre_ = lre * sre - lim * sim + br_, nim_ = lre * sim + lim * sre + bi_; sre = nre_; sim = nim_; } while (0)
#pragma unroll 1
    for (int cc = 0; cc < 4; ++cc) {
        const int chunk = wave * 4 + cc, t0 = chunk * 64;
        float sre = 0.f, sim = 0.f;
#pragma unroll 1
        for (int sb = 0; sb < 4; ++sb) {
            S5_BU(t0, sb);
#pragma unroll 4
            for (int tt = 0; tt < 16; ++tt) S5_STEP(tt);
            LDS_FENCE();
        }
        E[(chunk * 64 + p) * 2] = sre; E[(chunk * 64 + p) * 2 + 1] = sim;
    }
    __syncthreads();
    if (wave == 0) {
        float pr = lre, pi = lim;
#pragma unroll
        for (int q = 0; q < 6; ++q) { const float nr = pr * pr - pi * pi, pp_ = pr * pi, ni = pp_ + pp_; pr = nr; pi = ni; }
        float sr = 0.f, si = 0.f;
        for (int c = 0; c < 32; ++c) { const float er = E[(c * 64 + p) * 2], ei = E[(c * 64 + p) * 2 + 1]; E[(c * 64 + p) * 2] = sr; E[(c * 64 + p) * 2 + 1] = si;
            const float nr = pr * sr - pi * si + er, ni = pr * si + pi * sr + ei; sr = nr; si = ni; }
    }
    __syncthreads();
#pragma unroll 1
    for (int cc = 0; cc < 4; ++cc) {
        const int chunk = wave * 4 + cc, t0 = chunk * 64;
        { const bf16_t* up = U + (size_t)(b * 2048 + t0 + lane) * 512 + g * 16; const uint4 q0 = *(const uint4*)up, q1 = *(const uint4*)(up + 8);
            float f[16]; unpack8(q0, f); unpack8(q1, f + 8);
#pragma unroll
            for (int q = 0; q < 4; ++q) *(f32x4*)(ust + lane * 16 + q * 4) = (f32x4){f[q * 4], f[q * 4 + 1], f[q * 4 + 2], f[q * 4 + 3]}; }
        float sre = E[(chunk * 64 + p) * 2], sim = E[(chunk * 64 + p) * 2 + 1];
#pragma unroll 1
        for (int sb = 0; sb < 4; ++sb) {
            S5_BU(t0, sb);
#pragma unroll 4
            for (int tt = 0; tt < 16; ++tt) { S5_STEP(tt);
                *(unsigned*)(sst + tt * 136 + 2 * p) = pk2(sre, sim);
            }
            LDS_FENCE();
            f32x4 acc = {0.f, 0.f, 0.f, 0.f};
#pragma unroll
            for (int ks = 0; ks < 4; ++ks) { const bf16x8 af = *(const bf16x8*)(sst + (lane & 15) * 136 + ks * 32 + (lane >> 4) * 8);
                acc = __builtin_amdgcn_mfma_f32_16x16x32_bf16(af, Cf[ks], acc, 0, 0, 0); }
#pragma unroll
            for (int r = 0; r < 4; ++r) { const int t = sb * 16 + (lane >> 4) * 4 + r, i = lane & 15;
                const float y = gelu_tanh(acc[r] + dsk * ust[t * 16 + i]);
                Y[(size_t)(b * 2048 + t0 + t) * 512 + g * 16 + i] = (bf16_t)f2bf(y); }
            LDS_FENCE();
        }
    }
    __syncthreads();
#undef S5_STEP
#undef S5_BU
}

__device__ __forceinline__ void pool_unit(const Args& a, int b, int chunk, unsigned char* lds, const int WV) {
    const int TI = fresh_tid(WV);
    bf16_t* T = (bf16_t*)lds;
    const int t0 = chunk * 64;
    const bf16_t* P = (const bf16_t*)(a.ws + WS_P) + (size_t)b * 2048 * 512; bf16_t* O = (bf16_t*)(a.ws + WS_POOLED) + (size_t)b * 2048 * 512;
    __syncthreads();
    for (int i = TI; i < 80 * 64; i += 512) { const int r = i >> 6, c8 = i & 63, t = t0 - 16 + r;
        uint4 v = make_uint4(0u, 0u, 0u, 0u); if (t >= 0) v = *(const uint4*)(P + (size_t)t * 512 + c8 * 8);
        *(uint4*)(T + r * 512 + c8 * 8) = v; }
    __syncthreads();
    const int c = TI, w = 2 << (c >> 7);
    float s = 0.f;
    for (int k = 1; k <= w; ++k) s += bf1(T[(16 - k) * 512 + c]);
#pragma unroll 4
    for (int t = 0; t < 64; ++t) { const float pv = bf1(T[(16 + t) * 512 + c]); s += pv; s -= bf1(T[(16 + t - w) * 512 + c]);
        const int tt = t0 + t + 1; const float mean = s / (float)(tt < w ? tt : w); O[(size_t)(t0 + t) * 512 + c] = (bf16_t)f2bf(mean - pv); }
}

__device__ __forceinline__ unsigned sortkey(float x) { const unsigned u = __float_as_uint(x); return (u & 0x80000000u) ? ~u : (u | 0x80000000u); }
template <int NJ>
__device__ __forceinline__ void select256(const float* scq, int limit, unsigned short* sq, int lane) {
    const unsigned long long ltmask = (1ull << lane) - 1ull;
    unsigned key[NJ];
#pragma unroll
    for (int j = 0; j < NJ; ++j) { const int idx = j * 64 + lane; key[j] = (idx < limit) ? sortkey(scq[idx]) : 0u; }
    unsigned T = 0u;
    for (int bit = 31; bit >= 0; --bit) { const unsigned cand = T | (1u << bit); int cnt = 0;
#pragma unroll
        for (int j = 0; j < NJ; ++j) cnt += __popcll(__ballot(key[j] >= cand));
        if (cnt >= 256) { T = cand; if (cnt == 256) break; } }
    int cgt = 0;
#pragma unroll
    for (int j = 0; j < NJ; ++j) cgt += __popcll(__ballot(key[j] > T));
    const int need = 256 - cgt; int ob = 0, tb = 0;
#pragma unroll
    for (int j = 0; j < NJ; ++j) { const bool gt = key[j] > T, eq = key[j] == T; const unsigned long long me = __ballot(eq);
        const int pe = tb + __popcll(me & ltmask); const bool take = gt || (eq && pe < need); const unsigned long long mt = __ballot(take);
        if (take) sq[ob + __popcll(mt & ltmask)] = (unsigned short)(j * 64 + lane);
        ob += __popcll(mt); tb += __popcll(me); }
}
__device__ __forceinline__ void dsa_unit(const Args& a, int b, int tq, unsigned char* lds, const int WV, bf16_t* obase, const int ostride, const int parts) {
    const int TI = fresh_tid(WV);
    int tid = TI;
    int lane = tid & 63; const int wave = WV;
    float* sc = (float*)lds;
    unsigned short* sel = (unsigned short*)(lds + 131072);
    float* wis = (float*)(lds + 131072 + 8192);
    bf16_t* ocat = (bf16_t*)(a.ws + WS_OCAT); const bf16_t* Kn = (const bf16_t*)(a.ws + WS_KN); const bf16_t* V = (const bf16_t*)(a.ws + WS_V);
    const bf16_t* QI = (const bf16_t*)(a.ws + WS_QI); const bf16_t* KI = (const bf16_t*)(a.ws + WS_KI); const float* WI = (const float*)(a.ws + WS_WI);
    const int t0 = tq * 16, row0 = b * 2048 + t0, limit = ((t0 >> 6) + 1) << 6, nkt = limit >> 5, nsel = limit < 256 ? limit : 256;
    __syncthreads();
    if (tid < 128) wis[tid] = WI[(size_t)row0 * 8 + tid];
    __syncthreads();
    if (parts & 1)
    {
        const int g = lane >> 5, c32 = lane & 31;
        bf16x8 Af[4][4];
#pragma unroll
        for (int rb = 0; rb < 4; ++rb) { const int R = rb * 32 + c32; const bf16_t* qp = QI + (size_t)(row0 + (R >> 3)) * 512 + (R & 7) * 64 + g * 8;
#pragma unroll
            for (int s = 0; s < 4; ++s) Af[rb][s] = *(const bf16x8*)(qp + s * 16); }
        bf16x8 Bn[4];
        { const bf16_t* kp0 = KI + (size_t)(b * 2048 + wave * 32 + c32) * 64 + g * 8;
#pragma unroll
            for (int s = 0; s < 4; ++s) Bn[s] = *(const bf16x8*)(kp0 + s * 16); }
#pragma unroll 1
        for (int kt = wave; kt < nkt; kt += 8) {
            bf16x8 Bf[4];
#pragma unroll
            for (int s = 0; s < 4; ++s) Bf[s] = Bn[s];
            if (kt + 8 < nkt) { const bf16_t* kp = KI + (size_t)(b * 2048 + (kt + 8) * 32 + c32) * 64 + g * 8;
#pragma unroll
                for (int s = 0; s < 4; ++s) Bn[s] = *(const bf16x8*)(kp + s * 16); }
#pragma unroll
            for (int rb = 0; rb < 4; ++rb) {
                f32x16 acc;
#pragma unroll
                for (int i = 0; i < 16; ++i) acc[i] = 0.f;
#pragma unroll
                for (int s = 0; s < 4; ++s) acc = __builtin_amdgcn_mfma_f32_32x32x16_bf16(Af[rb][s], Bf[s], acc, 0, 0, 0);
#pragma unroll
                for (int j = 0; j < 4; ++j) { const int q = rb * 4 + j; const f32x4 w4 = *(const f32x4*)(wis + q * 8 + 4 * g);
                    float sp = fmaxf(acc[4 * j], 0.f) * w4[0] + fmaxf(acc[4 * j + 1], 0.f) * w4[1] + fmaxf(acc[4 * j + 2], 0.f) * w4[2] + fmaxf(acc[4 * j + 3], 0.f) * w4[3];
                    sp += __shfl_xor(sp, 32);
                    if (g == 0) sc[q * 2048 + kt * 32 + c32] = sp; }
            }
        }
    }
    __syncthreads();
    lane = fresh_tid(WV) & 63;
    for (int qq = 0; qq < 2; ++qq) {
        const int q = wave * 2 + qq; unsigned short* sq = sel + q * 256;
        if (limit <= 256 || !(parts & 2)) { for (int j = lane; j < nsel; j += 64) sq[j] = (unsigned short)j; }
        else if (limit <= 512) select256<8>(sc + q * 2048, limit, sq, lane);
        else if (limit <= 1024) select256<16>(sc + q * 2048, limit, sq, lane);
        else if (limit <= 1536) select256<24>(sc + q * 2048, limit, sq, lane);
        else select256<32>(sc + q * 2048, limit, sq, lane);
    }
    __syncthreads();
    lane = fresh_tid(WV) & 63;
    float* Pw = (float*)lds + wave * 2048;
    const int g4 = lane >> 4, hh = lane & 15;
#pragma unroll 1
    for (int qq = 0; qq < 2; ++qq) {
        const int q = wave * 2 + qq; const size_t row = (size_t)(row0 + q); const unsigned short* sq = sel + q * 256;
        bf16x8 Qf[4];
#pragma unroll
        for (int s = 0; s < 4; ++s) Qf[s] = *(const bf16x8*)(ocat + row * 2048 + (hh & 7) * 128 + g4 * 8 + s * 32);
        float lg[16][4];
#pragma unroll
        for (int kg = 0; kg < 4; ++kg) {
            if (kg * 64 < nsel) {
                bf16x8 kf[4][4];
#pragma unroll
                for (int k4 = 0; k4 < 4; ++k4) { const int idx = sq[(kg * 4 + k4) * 16 + hh]; const bf16_t* kp = Kn + (size_t)(b * 2048 + idx) * 128 + g4 * 8;
#pragma unroll
                    for (int s = 0; s < 4; ++s) kf[k4][s] = *(const bf16x8*)(kp + s * 32); }
#pragma unroll
                for (int k4 = 0; k4 < 4; ++k4) { f32x4 c = {0.f, 0.f, 0.f, 0.f};
#pragma unroll
                    for (int s = 0; s < 4; ++s) c = __builtin_amdgcn_mfma_f32_16x16x32_bf16(kf[k4][s], Qf[s], c, 0, 0, 0);
#pragma unroll
                    for (int r = 0; r < 4; ++r) lg[kg * 4 + k4][r] = c[r] * 0.08838834764831845f; }
            } else {
#pragma unroll
                for (int k4 = 0; k4 < 4; ++k4)
#pragma unroll
                    for (int r = 0; r < 4; ++r) lg[kg * 4 + k4][r] = -1e30f;
            }
        }
        float mx = -1e30f;
#pragma unroll
        for (int kb = 0; kb < 16; ++kb)
#pragma unroll
            for (int r = 0; r < 4; ++r) mx = fmaxf(mx, lg[kb][r]);
        mx = fmaxf(mx, __shfl_xor(mx, 16)); mx = fmaxf(mx, __shfl_xor(mx, 32));
        float sum = 0.f;
#pragma unroll
        for (int kb = 0; kb < 16; ++kb)
#pragma unroll
            for (int r = 0; r < 4; ++r) { const float e = (kb * 16 < nsel) ? __expf(lg[kb][r] - mx) : 0.f; lg[kb][r] = e; sum += e; }
        sum += __shfl_xor(sum, 16); sum += __shfl_xor(sum, 32);
        const float inv = 1.f / sum;
        bf16x8 Pa[8];
#pragma unroll
        for (int ks = 0; ks < 8; ++ks) {
            const unsigned a0 = pk2(lg[2 * ks][0] * inv, lg[2 * ks][1] * inv), a1 = pk2(lg[2 * ks][2] * inv, lg[2 * ks][3] * inv);
            const unsigned a2 = pk2(lg[2 * ks + 1][0] * inv, lg[2 * ks + 1][1] * inv), a3 = pk2(lg[2 * ks + 1][2] * inv, lg[2 * ks + 1][3] * inv);
            const u32x4 t_ = {a0, a1, a2, a3}; Pa[ks] = __builtin_bit_cast(bf16x8, t_); }
        bf16_t* Vs = (bf16_t*)(lds + wave * 10752);
        bf16_t* Os = Vs + 32 * 136;
        f32x4 oacc[8];
#pragma unroll
        for (int nb = 0; nb < 8; ++nb) oacc[nb] = (f32x4){0.f, 0.f, 0.f, 0.f};
        const bf16_t* Vb = V + (size_t)b * 2048 * 128 + hh * 8;
        u32x4 vq[8], vn[8];
#pragma unroll
        for (int jj = 0; jj < 8; ++jj) vn[jj] = (u32x4){0u, 0u, 0u, 0u};
#pragma unroll
        for (int jj = 0; jj < 8; ++jj) { const int idx = sq[jj * 4 + g4]; vq[jj] = *(const u32x4*)(Vb + (size_t)idx * 128); }
#define PV_BATCH(bt) do { if ((bt) * 32 < nsel) { \
            if (((bt) + 1) * 32 < nsel) { _Pragma("unroll") for (int jj = 0; jj < 8; ++jj) { const int idx = sq[((bt) + 1) * 32 + jj * 4 + g4]; vn[jj] = *(const u32x4*)(Vb + (size_t)idx * 128); } } \
            _Pragma("unroll") for (int jj = 0; jj < 8; ++jj) *(u32x4*)(Vs + (jj * 4 + g4) * 136 + hh * 8) = vq[jj]; \
            LDS_FENCE(); \
            _Pragma("unroll") for (int nb = 0; nb < 8; ++nb) { const bf16_t* vp = Vs + (4 * g4) * 136 + nb * 16 + hh; \
                const unsigned w0_ = (unsigned)vp[0 * 136] | ((unsigned)vp[1 * 136] << 16), w1_ = (unsigned)vp[2 * 136] | ((unsigned)vp[3 * 136] << 16); \
                const unsigned w2_ = (unsigned)vp[16 * 136] | ((unsigned)vp[17 * 136] << 16), w3_ = (unsigned)vp[18 * 136] | ((unsigned)vp[19 * 136] << 16); \
                const u32x4 t_ = {w0_, w1_, w2_, w3_}; \
                oacc[nb] = __builtin_amdgcn_mfma_f32_16x16x32_bf16(Pa[(bt)], __builtin_bit_cast(bf16x8, t_), oacc[nb], 0, 0, 0); } \
            LDS_FENCE(); \
            _Pragma("unroll") for (int jj = 0; jj < 8; ++jj) vq[jj] = vn[jj]; } } while (0)
        PV_BATCH(0); PV_BATCH(1); PV_BATCH(2); PV_BATCH(3); PV_BATCH(4); PV_BATCH(5); PV_BATCH(6); PV_BATCH(7);
#undef PV_BATCH
        if (g4 < 2) {
#pragma unroll
            for (int nb = 0; nb < 8; ++nb)
#pragma unroll
                for (int r = 0; r < 4; ++r) Os[(g4 * 4 + r) * 128 + nb * 16 + hh] = (bf16_t)f2bf(oacc[nb][r]);
        }
        LDS_FENCE();
#pragma unroll
        for (int h = 0; h < 2; ++h) { const uint4 ov = *(const uint4*)(Os + h * 512 + lane * 8); *(uint4*)(obase + row * ostride + h * 512 + lane * 8) = ov; }
        LDS_FENCE();
    }
}

__device__ __forceinline__ void phase_fix(const Args& a, int l, const int WV) {
    const int TI = fresh_tid(WV);
    const float* SA = (const float*)(a.ws + WS_SA); const float* SB = (const float*)(a.ws + WS_SB); bf16_t* act = (bf16_t*)(a.ws + WS_R2);
    const float* cw = a.in[I_CONVW] + (size_t)l * 3 * DFF; const float* cb = a.in[I_CONVB] + (size_t)l * DFF;
    const int total = 512 * 2 * DFF;
    for (int i = blockIdx.x * 512 + TI; i < total; i += gridDim.x * 512) {
        const int ch = i % DFF, rb = i / DFF, rr = rb & 1, blk = rb >> 1, r = blk * 64 + rr, t = r & 2047;
        const float a0 = SA[((size_t)blk * 4 + 2 + rr) * DFF + ch];
        float am1, am2;
        if (rr == 0) { am1 = (t >= 1) ? SA[((size_t)(blk - 1) * 4 + 1) * DFF + ch] : 0.f; am2 = (t >= 2) ? SA[((size_t)(blk - 1) * 4 + 0) * DFF + ch] : 0.f; }
        else { am1 = SA[((size_t)blk * 4 + 2) * DFF + ch]; am2 = (t >= 2) ? SA[((size_t)(blk - 1) * 4 + 1) * DFF + ch] : 0.f; }
        const float cv = cb[ch] + cw[ch] * am2 + cw[DFF + ch] * am1 + cw[2 * DFF + ch] * a0;
        act[(size_t)r * DFF + ch] = (bf16_t)f2bf(siluf_(cv) * SB[((size_t)blk * 2 + rr) * DFF + ch]);
    }
}

__device__ __forceinline__ void run_phase(const Args& a, int ph, unsigned char* lds, const int WV, const bool dummy) {
    unsigned char* ws = a.ws;
    LAS unsigned char* ldsl = (LAS unsigned char*)lds;
    const int G = gridDim.x, bx = blockIdx.x;
#ifndef DBG_NOADA
    if (ph == 0) { phase_ada(a, lds, WV); return; }
#else
    if (ph == 0) return;
#endif
    const int l = (ph - 1) / 10, sp = (ph - 1) % 10;
    const float* modl = (const float*)(ws + WS_MOD) + (size_t)l * 16 * 12288;
    const float* xin = (l == 0) ? a.in[I_X] : a.out;
#ifdef DBG_SP
    if (sp != DBG_SP) return;
#endif
    switch (sp) {
    case 0: phase_cvt(a, l, lds, WV); phase_norm(xin, a.in[I_GN1] + l * DM, modl, 0, 2048, (bf16_t*)(ws + WS_R1), WV); break;
    case 1: {
        pg8::Gemm g{(const bf16_t*)(ws + WS_R1), (const bf16_t*)(ws + W_1CAT), MROWS, N1, DM, DM, DM, 1 << 30, 0}; pg8::StaticOrder S; S.init(MROWS, N1, G, bx);
        Epi1 E{(bf16_t*)(ws + WS_OCAT), (bf16_t*)(ws + WS_KN), (bf16_t*)(ws + WS_V), (bf16_t*)(ws + WS_QI), (bf16_t*)(ws + WS_KI), (bf16_t*)(ws + WS_U), (bf16_t*)(ws + WS_P), (bf16_t*)(ws + WS_R2),
               (float*)(ws + WS_WI), a.in[I_BGATE] + (size_t)l * 3 * DM, ldsl + 131072};
        pg8::gemm_phase<Epi1, pg8::StaticOrder>(ldsl, g, S, E, WV); } break;
    case 2:
        if (!dummy) phase_post(a, l, lds, WV);
        __syncthreads();
        for (int u = bx; u < 512; u += G) s5_unit(a, l, u >> 5, u & 31, lds, WV);
        for (int u = bx; u < 512; u += G) pool_unit(a, u >> 5, u & 31, lds, WV);
        break;
    case 3: {
#ifndef DBG_NO_DSA
#ifdef DSA_PROBE
        for (int rep = 0; rep < 2; ++rep) { const bool dm = (rep == 0); const int parts = dm ? (DSA_PROBE) : 15;
#else
        { const bool dm = dummy; const int parts = 15;
#endif
            for (int u = bx; u < 2048; u += G) { const int w = u & 255, i = u >> 8, b = w & 15, s = w >> 4; const int tq = (i & 1) ? (i * 16 + 15 - s) : (i * 16 + s);
                dsa_unit(a, b, tq, lds, WV, dm ? (bf16_t*)(ws + WS_R1 + 64 * MiB) : (bf16_t*)(ws + WS_OCAT), dm ? 1024 : 2048, parts); }
        }
        __syncthreads();
#endif
#ifndef DBG_DSA_ONLY
        { pg8::Gemm g{(const bf16_t*)(ws + WS_Y), (const bf16_t*)(ws + W_GLU), MROWS, 1024, 512, 512, 512, 2, WS_POOLED - WS_Y}; pg8::StaticOrder S; S.init(MROWS, 1024, G, bx);
          EpiGluPool E{(const bf16_t*)(ws + WS_Y), a.in[I_PSCALE] + l * 512, (bf16_t*)(ws + WS_OCAT)}; pg8::gemm_phase<EpiGluPool, pg8::StaticOrder>(ldsl, g, S, E, WV); }
#endif
        } break;
    case 4: {
        pg8::Gemm g{(const bf16_t*)(ws + WS_OCAT), (const bf16_t*)(ws + W_P), MROWS, DM, DM, DM, DM, 1 << 30, 0}; pg8::StaticOrder S; S.init(MROWS, DM, G, bx);
        EpiMerge E{(const bf16_t*)(ws + WS_R2), (bf16_t*)(ws + WS_R1)}; pg8::gemm_phase<EpiMerge, pg8::StaticOrder>(ldsl, g, S, E, WV); } break;
    case 5: {
        pg8::Gemm g{(const bf16_t*)(ws + WS_R1), (const bf16_t*)(ws + W_OUT), MROWS, DM, DM, DM, DM, 1 << 30, 0}; pg8::StaticOrder S; S.init(MROWS, DM, G, bx);
        EpiRes E{xin, dummy ? (float*)(ws + WS_OCAT) : a.out, modl + 4096}; pg8::gemm_phase<EpiRes, pg8::StaticOrder>(ldsl, g, S, E, WV); } break;
    case 6: phase_norm(a.out, a.in[I_GN2] + l * DM, modl, 6144, 8192, (bf16_t*)(ws + WS_R1), WV); break;
    case 7: {
        pg8::Gemm g{(const bf16_t*)(ws + WS_R1), (const bf16_t*)(ws + W_UP), MROWS, 2 * DFF, DM, DM, DM, 1 << 30, 0}; pg8::StaticOrder S; S.init(MROWS, 2 * DFF, G, bx);
        EpiUp E{(bf16_t*)(ws + WS_R2), (float*)(ws + WS_SA), (float*)(ws + WS_SB), a.in[I_CONVW] + (size_t)l * 3 * DFF, a.in[I_CONVB] + (size_t)l * DFF, ldsl + 131072};
        pg8::gemm_phase<EpiUp, pg8::StaticOrder>(ldsl, g, S, E, WV); } break;
    case 8: phase_fix(a, l, WV); break;
    case 9: {
        pg8::Gemm g{(const bf16_t*)(ws + WS_R2), (const bf16_t*)(ws + W_DOWN), MROWS, DM, DFF, DFF, DFF, 1 << 30, 0}; pg8::StaticOrder S; S.init(MROWS, DM, G, bx);
        EpiRes E{a.out, dummy ? (float*)(ws + WS_OCAT) : a.out, modl + 10240}; pg8::gemm_phase<EpiRes, pg8::StaticOrder>(ldsl, g, S, E, WV); } break;
    }
}

#define XB_XCNT(j)  (256  + 64 * (j))
#define XB_XSUB(j)  (1280 + 64 * (j))
#define XB_XGEN(j)  (2304 + 64 * (j))
#define XB_TOP      3328
#define XB_TOPGEN   3392
#define XB_WORDS    3456
__device__ __forceinline__ unsigned xb_ld(unsigned* p)              { return __hip_atomic_load(p, __ATOMIC_RELAXED, __HIP_MEMORY_SCOPE_AGENT); }
__device__ __forceinline__ unsigned xb_add(unsigned* p, unsigned v) { return __hip_atomic_fetch_add(p, v, __ATOMIC_RELAXED, __HIP_MEMORY_SCOPE_AGENT); }
__device__ __forceinline__ unsigned xb_xcc_id() { return (unsigned)__builtin_amdgcn_s_getreg((3 << 11) | 20) & 0xFu; }
#define XB_SPIN(cond) do { unsigned _sp = 0; while (cond) { __builtin_amdgcn_s_sleep(1); if (++_sp > (1u << 22)) break; } } while (0)
__device__ __forceinline__ void grid_bar(unsigned* bar, volatile LAS unsigned* st, int wave_id) {
    asm volatile("s_waitcnt vmcnt(0) lgkmcnt(0)" ::: "memory");
    __syncthreads();
    if (wave_id == 0) {
        const int l = (int)__builtin_amdgcn_mbcnt_hi(~0u, __builtin_amdgcn_mbcnt_lo(~0u, 0u));
        if (l == 0) {
            const unsigned x = xb_xcc_id();
            unsigned nloc = st[0], nx = st[1];
            if (nloc == 0u) {
                const unsigned G = gridDim.x; unsigned sum, cnt, mine, sp = 0u;
                for (;;) { sum = 0u; cnt = 0u; mine = 0u;
#pragma unroll
                    for (unsigned j = 0; j < 16; ++j) { const unsigned c = xb_ld(&bar[XB_XCNT(j)]); sum += c; cnt += (c > 0u) ? 1u : 0u; mine = (j == x) ? c : mine; }
                    if (sum == G) break;
                    __builtin_amdgcn_s_sleep(1); if (++sp > (1u << 22)) break; }
                nloc = mine > 0u ? mine : 1u; nx = cnt > 0u ? cnt : 1u; st[0] = nloc; st[1] = nx;
            }
            const unsigned old = xb_add(&bar[XB_XSUB(x)], 1u);
            const unsigned gen = old / nloc;
            if (old + 1u == (gen + 1u) * nloc) {
                __builtin_amdgcn_fence(__ATOMIC_RELEASE, "agent");
                asm volatile("s_waitcnt vmcnt(0)" ::: "memory");
                const unsigned og = xb_add(&bar[XB_TOP], 1u);
                const unsigned tg = og / nx;
                if (og + 1u == (tg + 1u) * nx) xb_add(&bar[XB_TOPGEN], 1u);
                else XB_SPIN(xb_ld(&bar[XB_TOPGEN]) == tg);
                __builtin_amdgcn_fence(__ATOMIC_ACQUIRE, "agent");
                xb_add(&bar[XB_XGEN(x)], 1u);
                asm volatile("s_waitcnt vmcnt(0)" ::: "memory");
            } else {
                XB_SPIN(xb_ld(&bar[XB_XGEN(x)]) == gen);
                __builtin_amdgcn_fence(__ATOMIC_ACQUIRE, "agent");
                asm volatile("s_waitcnt vmcnt(0)" ::: "memory");
            }
        }
    }
    __syncthreads();
}

__global__ void __launch_bounds__(512, 2) mega_fwd(Args a) {
    extern __shared__ __attribute__((aligned(16))) unsigned char lds[];
    cg::grid_group grid = cg::this_grid();
    const int wave_id = __builtin_amdgcn_readfirstlane((int)(threadIdx.x >> 6));
    const int ph_lo = a.ph_lo, ph_hi = a.ph_hi;
    volatile LAS unsigned* xst = (volatile LAS unsigned*)((LAS unsigned char*)lds + 163776);
    if (threadIdx.x == 0) { xst[0] = 0u; xst[1] = 0u; (void)xb_add((unsigned*)(__attribute__((address_space(1))) unsigned*)a.ws + XB_XCNT(xb_xcc_id()), 1u); }
    __syncthreads();
    for (int ph = ph_lo; ph < ph_hi; ++ph) {
        const __attribute__((address_space(4))) Args* kp = (const __attribute__((address_space(4))) Args*)__builtin_amdgcn_kernarg_segment_ptr();
        asm volatile("" : "+s"(kp));
        Args la;
#pragma unroll
        for (int i = 0; i < 31; ++i) la.in[i] = (const float*)(const __attribute__((address_space(1))) float*)kp->in[i];
        la.ws = (unsigned char*)(__attribute__((address_space(1))) unsigned char*)kp->ws;
        la.out = (float*)(__attribute__((address_space(1))) float*)kp->out;
        la.ph_lo = ph_lo; la.ph_hi = ph_hi;
#ifdef REP_MASK
        if (ph > 0 && ((REP_MASK >> ((ph - 1) % 10)) & 1)) { run_phase(la, ph, lds, wave_id, true); grid.sync(); }
#endif
        run_phase(la, ph, lds, wave_id, false);
        if (ph + 1 < ph_hi) {
            if (ph == ph_lo) grid.sync();
            else grid_bar((unsigned*)la.ws, xst, wave_id);
        }
    }
}

extern "C" void kernel_launch(void* const* d_in, const int* in_sizes, int n_in, void* d_out, int out_size, void* d_ws, size_t ws_size, hipStream_t stream) {
    static int grid = 0;
    if (grid == 0) {
        int dev = 0, cus = 0, per_cu = 0;
        if (n_in != 31 || ws_size < WS_END) { fprintf(stderr, "kernel_launch: unexpected n_in %d / ws %zu\n", n_in, ws_size); grid = -1; return; }
        hipGetDevice(&dev); hipDeviceGetAttribute(&cus, hipDeviceAttributeMultiprocessorCount, dev);
        if (hipFuncSetAttribute((const void*)mega_fwd, hipFuncAttributeMaxDynamicSharedMemorySize, LDS_BYTES) != hipSuccess) { fprintf(stderr, "kernel_launch: hipFuncSetAttribute failed\n"); grid = -1; return; }
        if (hipOccupancyMaxActiveBlocksPerMultiprocessor(&per_cu, (const void*)mega_fwd, 512, LDS_BYTES) != hipSuccess || per_cu < 1) { fprintf(stderr, "kernel_launch: occupancy query says %d blocks/CU\n", per_cu); per_cu = 1; }
        (void)hipGetLastError();
        grid = cus > 0 ? cus : 256;
    }
    if (grid < 0) return;
    if (hipMemsetAsync(d_ws, 0, 16384, stream) != hipSuccess) { fprintf(stderr, "kernel_launch: memset of the barrier word failed\n"); return; }
    Args a{};
    for (int i = 0; i < 31; ++i) a.in[i] = (const float*)d_in[i];
    a.out = (float*)d_out; a.ws = (unsigned char*)d_ws;
#if MK_PER_PHASE
    for (int ph = 0; ph < NPHASE; ++ph) {
        a.ph_lo = ph; a.ph_hi = ph + 1;
        void* args[] = {&a};
        hipError_t e = hipLaunchCooperativeKernel((const void*)mega_fwd, dim3(grid), dim3(512), args, LDS_BYTES, stream);
        if (e != hipSuccess) { fprintf(stderr, "kernel_launch: launch of phase %d failed: %s\n", ph, hipGetErrorString(e)); break; }
    }
#else
    a.ph_lo = 0; a.ph_hi = NPHASE;
    void* args[] = {&a};
    hipError_t e = hipLaunchCooperativeKernel((const void*)mega_fwd, dim3(grid), dim3(512), args, LDS_BYTES, stream);
    if (e != hipSuccess) fprintf(stderr, "kernel_launch: cooperative launch failed: %s (grid %d)\n", hipGetErrorString(e), grid);
#endif
}
```

```cpp
#include <hip/hip_runtime.h>
#include <hip/hip_cooperative_groups.h>
#include <cstdio>
#include <cstdint>
namespace cg = cooperative_groups;

#ifndef MK_PER_PHASE
#define MK_PER_PHASE 0
#endif

typedef unsigned short bf16_t;
typedef short bf16x8 __attribute__((ext_vector_type(8)));
typedef float f32x4 __attribute__((ext_vector_type(4)));
typedef float f32x2 __attribute__((ext_vector_type(2)));
typedef float f32x16 __attribute__((ext_vector_type(16)));
typedef unsigned u32x4 __attribute__((ext_vector_type(4)));
typedef unsigned u32x2 __attribute__((ext_vector_type(2)));
#define LAS __attribute__((address_space(3)))

constexpr int BATCH = 16, SEQ = 2048, DM = 2048, MROWS = BATCH * SEQ, DIN = 2888, DFF = 5504;
constexpr int N1 = 9216;
constexpr float EPS = 1e-6f;
constexpr int NPHASE = 21;

constexpr size_t MiB = 1u << 20;
constexpr size_t WS_MOD = 1 * MiB;
constexpr size_t WS_WI = 3 * MiB;
constexpr size_t WS_W = 4 * MiB;
constexpr size_t W_1CAT = WS_W, W_P = WS_W + 36 * MiB, W_OUT = WS_W + 44 * MiB, W_UP = WS_W + 52 * MiB, W_DOWN = WS_W + 95 * MiB,
                 W_GLU = WS_W + 116 * MiB + MiB / 2, W_POOL = WS_W + 117 * MiB;
constexpr size_t WS_R1 = 122 * MiB;
constexpr size_t WS_Y = WS_R1, WS_POOLED = WS_R1 + 32 * MiB;
constexpr size_t WS_R2 = 250 * MiB;
constexpr size_t WS_OCAT = 634 * MiB;
constexpr size_t WS_SA = WS_OCAT, WS_SB = WS_OCAT + 44 * MiB;
constexpr size_t WS_KN = 762 * MiB, WS_V = 770 * MiB, WS_QI = 778 * MiB, WS_KI = 810 * MiB, WS_U = 814 * MiB, WS_P = 846 * MiB, WS_END = 878 * MiB;
constexpr int LDS_BYTES = 163840;

__device__ __forceinline__ unsigned f2bf(float f) { unsigned u = __float_as_uint(f); return (u + 0x7fffu + ((u >> 16) & 1u)) >> 16; }
__device__ __forceinline__ unsigned pk2(float lo, float hi) { return f2bf(lo) | (f2bf(hi) << 16); }
__device__ __forceinline__ float bflo(unsigned u) { return __uint_as_float(u << 16); }
__device__ __forceinline__ float bfhi(unsigned u) { return __uint_as_float(u & 0xffff0000u); }
__device__ __forceinline__ float bf1(bf16_t b) { return __uint_as_float(((unsigned)b) << 16); }
__device__ __forceinline__ float sigmoidf_(float x) { return 1.f / (1.f + __expf(-x)); }
__device__ __forceinline__ float siluf_(float x) { return x / (1.f + __expf(-x)); }
__device__ __forceinline__ float gelu_tanh(float x) { const float z = 0.7978845608028654f * (x + 0.044715f * x * x * x); const float t = 1.f - 2.f / (1.f + __expf(2.f * z)); return 0.5f * x * (1.f + t); }
__device__ __forceinline__ uint4 pack8(f32x4 a, f32x4 b) { uint4 r; r.x = pk2(a[0], a[1]); r.y = pk2(a[2], a[3]); r.z = pk2(b[0], b[1]); r.w = pk2(b[2], b[3]); return r; }
__device__ __forceinline__ void unpack8(uint4 v, float* f) { f[0] = bflo(v.x); f[1] = bfhi(v.x); f[2] = bflo(v.y); f[3] = bfhi(v.y); f[4] = bflo(v.z); f[5] = bfhi(v.z); f[6] = bflo(v.w); f[7] = bfhi(v.w); }
#define LDS_FENCE() asm volatile("s_waitcnt lgkmcnt(0)" ::: "memory")
__device__ __forceinline__ int fresh_tid(int wv) { int l = (int)__builtin_amdgcn_mbcnt_hi(~0u, __builtin_amdgcn_mbcnt_lo(~0u, 0u)); asm volatile("" : "+v"(l)); return (wv << 6) | l; }

namespace pg8 {
constexpr int BM = 256, BK = 64, HALF = 128, HTB = HALF * BK * 2, STAGE_BYTES = 8 * HTB, NXCD = 8, WGM = 8;
__host__ __device__ __forceinline__ int lds_byte(int r, int c) { const int st = (r >> 4) * 2 + (c >> 5), rr = r & 15, cc = c & 31, ob = rr * 64 + cc * 2; return st * 1024 + (ob ^ (((ob >> 9) & 1) << 5)); }
__host__ __device__ __forceinline__ void stage_rc(int b, int& R, int& C) { const int st = b / 1024, sb = b % 1024, swz = sb ^ (((sb >> 9) & 1) << 5); R = (st >> 1) * 16 + swz / 64; C = (st & 1) * 32 + (swz % 64) / 2; }
__host__ __device__ __forceinline__ int perm32(int rho) { const int n = rho >> 4, i = rho & 15; return 8 * (i >> 2) + 4 * n + (i & 3); }
struct Unit { int pm, pn; };
struct Gemm { const bf16_t* A; const bf16_t* Bt; int M, N, K, lda, ldb; int asplit; size_t aoff; };
struct StaticOrder {
    int nM, nN, nwg, G, c;
    __device__ void init(int M, int N, int G_, int c_) { nM = M / BM; nN = N / BM; nwg = nM * nN; G = G_; c = c_; }
    __device__ bool next(int i, Unit& u) const {
        const long L = (long)i * G + c; if (L >= nwg) return false;
        int wgid = (int)L; { const int q = nwg / NXCD, r = nwg % NXCD, xcd = wgid % NXCD, off = wgid / NXCD; wgid = (xcd < r ? xcd * (q + 1) : r * (q + 1) + (xcd - r) * q) + off; }
        const int nig = WGM * nN, gid = wgid / nig, fm = gid * WGM, gsz = (nM - fm) < WGM ? (nM - fm) : WGM;
        u.pm = fm + ((wgid % nig) % gsz); u.pn = (wgid % nig) / gsz; return true;
    }
};
template <class Epi, class Sched>
__device__ __forceinline__ void gemm_phase(LAS unsigned char* lds, const Gemm g, const Sched& S, const Epi& E, const int WV) {
    const int TI = fresh_tid(WV);
    const int tid = TI, wid = __builtin_amdgcn_readfirstlane(tid >> 6), lane = tid & 63, wr = wid >> 2, wc = wid & 3, fr = lane & 15, fq = lane >> 4;
    const int K = g.K, nt = K / BK;
    unsigned voffA[2], voffB[2];
#pragma unroll
    for (int i = 0; i < 2; ++i) { int R, C; stage_rc(tid * 16 + i * 8192, R, C); const int Rb = Epi::PERM ? ((R & ~31) + perm32(R & 31)) : R;
        voffA[i] = (unsigned)(R * g.lda + C) * 2u; voffB[i] = (unsigned)(Rb * g.ldb + C) * 2u; }
    const size_t kstep = (size_t)(BK * 2);
    const size_t hstepA = (size_t)HALF * g.lda * 2, hstepB = (size_t)HALF * g.ldb * 2;
    const size_t tstepA = 2 * hstepA, tstepB = 2 * hstepB;
    const unsigned ldsw = (unsigned)wid * 1024u;
    const int aoff = lds_byte(wr * 64 + fr, fq * 8), boff = lds_byte(wc * 32 + fr, fq * 8);
#define PG8_SA(b, h) (((b) * 2 + (h)) * HTB)
#define PG8_SB(b, h) ((4 + (b) * 2 + (h)) * HTB)
#define PG8_STAGE(bufoff, gbase, voff) do { _Pragma("unroll") for (int _i = 0; _i < 2; ++_i) \
        __builtin_amdgcn_global_load_lds((const unsigned*)((const char*)(gbase) + (voff)[_i]), (LAS unsigned*)(lds + (bufoff) + ldsw + _i * 8192), 16, 0, 0); } while (0)
#define PG8_LDA(dst, b, h) do { _Pragma("unroll") for (int m = 0; m < 4; ++m) _Pragma("unroll") for (int k = 0; k < 2; ++k) dst[m][k] = *(const LAS bf16x8*)(lds + PG8_SA(b, h) + aoff + m * 2048 + k * 1024); } while (0)
#define PG8_LDB(dst, b, h) do { _Pragma("unroll") for (int n = 0; n < 2; ++n) _Pragma("unroll") for (int k = 0; k < 2; ++k) dst[n][k] = *(const LAS bf16x8*)(lds + PG8_SB(b, h) + boff + n * 2048 + k * 1024); } while (0)
#define PG8_MMA(ai, bj, At, Bt) do { __builtin_amdgcn_s_setprio(1); _Pragma("unroll") for (int m = 0; m < 4; ++m) _Pragma("unroll") for (int n = 0; n < 2; ++n) _Pragma("unroll") for (int k = 0; k < 2; ++k) \
        acc[ai][bj][m][n] = __builtin_amdgcn_mfma_f32_16x16x32_bf16(Bt[n][k], At[m][k], acc[ai][bj][m][n], 0, 0, 0); __builtin_amdgcn_s_setprio(0); } while (0)
#define PG8_WAIT_V(n) asm volatile("s_waitcnt vmcnt(" #n ")" ::: "memory")
#define PG8_WAIT_L(n) asm volatile("s_waitcnt lgkmcnt(" #n ")" ::: "memory")
#define PG8_BAR __builtin_amdgcn_s_barrier()
#define PG8_SCHED __builtin_amdgcn_sched_barrier(0)
#define PG8_ZERO() do { _Pragma("unroll") for (int a_ = 0; a_ < 2; ++a_) _Pragma("unroll") for (int b_ = 0; b_ < 2; ++b_) _Pragma("unroll") for (int m_ = 0; m_ < 4; ++m_) _Pragma("unroll") for (int n_ = 0; n_ < 2; ++n_) acc[a_][b_][m_][n_] = (f32x4){0.f, 0.f, 0.f, 0.f}; } while (0)
    Unit cur, nxt; int ui = 0;
    if (!S.next(0, cur)) return;
    f32x4 acc[2][2][4][2];
    PG8_ZERO();
    bf16x8 At[4][2], B0[2][2], B1[2][2];
    const char* cA = (const char*)g.A + (size_t)cur.pm * tstepA + (cur.pn >= g.asplit ? g.aoff : (size_t)0); const char* cB = (const char*)g.Bt + (size_t)cur.pn * tstepB;
    PG8_STAGE(PG8_SB(0, 0), cB, voffB); PG8_STAGE(PG8_SA(0, 0), cA, voffA); PG8_STAGE(PG8_SB(0, 1), cB + hstepB, voffB); PG8_STAGE(PG8_SA(0, 1), cA + hstepA, voffA);
    if (wr == 1) PG8_BAR;
    PG8_WAIT_V(4); PG8_BAR;
    PG8_STAGE(PG8_SB(1, 0), cB + kstep, voffB); PG8_STAGE(PG8_SA(1, 0), cA + kstep, voffA); PG8_STAGE(PG8_SB(1, 1), cB + hstepB + kstep, voffB);
    PG8_WAIT_V(6); PG8_BAR;
    for (;;) {
        const bool has_next = S.next(ui + 1, nxt);
        const char* nA = has_next ? (const char*)g.A + (size_t)nxt.pm * tstepA + (nxt.pn >= g.asplit ? g.aoff : (size_t)0) : cA; const char* nB = has_next ? (const char*)g.Bt + (size_t)nxt.pn * tstepB : cB;
        for (int t = 0; t < nt; t += 2) {
            const bool last = (t == nt - 2);
            const char* a1 = cA + (size_t)(t + 1) * kstep;
            const char* a2 = last ? nA : cA + (size_t)(t + 2) * kstep; const char* b2 = last ? nB : cB + (size_t)(t + 2) * kstep;
            const char* a3 = a2 + kstep; const char* b3 = b2 + kstep;
            PG8_LDB(B0, 0, 0); PG8_SCHED; PG8_LDA(At, 0, 0); PG8_STAGE(PG8_SA(1, 1), a1 + hstepA, voffA);
            PG8_WAIT_L(8); PG8_BAR; PG8_WAIT_L(0); PG8_MMA(0, 0, At, B0); PG8_BAR; PG8_SCHED;
            PG8_LDB(B1, 0, 1); PG8_STAGE(PG8_SB(0, 0), b2, voffB);
            PG8_BAR; PG8_WAIT_L(0); PG8_MMA(0, 1, At, B1); PG8_BAR;
            PG8_LDA(At, 0, 1); PG8_STAGE(PG8_SA(0, 0), a2, voffA);
            PG8_BAR; PG8_WAIT_L(0); PG8_MMA(1, 0, At, B0); PG8_BAR; PG8_SCHED;
            PG8_STAGE(PG8_SB(0, 1), b2 + hstepB, voffB);
            PG8_WAIT_V(6); PG8_BAR; PG8_MMA(1, 1, At, B1); PG8_BAR;
            PG8_LDB(B0, 1, 0); PG8_SCHED; PG8_LDA(At, 1, 0); PG8_STAGE(PG8_SA(0, 1), a2 + hstepA, voffA);
            PG8_WAIT_L(8); PG8_BAR; PG8_WAIT_L(0); PG8_MMA(0, 0, At, B0); PG8_BAR; PG8_SCHED;
            PG8_LDB(B1, 1, 1); PG8_STAGE(PG8_SB(1, 0), b3, voffB);
            PG8_BAR; PG8_WAIT_L(0); PG8_MMA(0, 1, At, B1); PG8_BAR;
            PG8_LDA(At, 1, 1); PG8_STAGE(PG8_SA(1, 0), a3, voffA);
            PG8_BAR; PG8_WAIT_L(0); PG8_MMA(1, 0, At, B0); PG8_BAR; PG8_SCHED;
            PG8_STAGE(PG8_SB(1, 1), b3 + hstepB, voffB);
            PG8_WAIT_V(6); PG8_BAR; PG8_MMA(1, 1, At, B1); PG8_BAR;
            if constexpr (Epi::SEG) { if (t + 2 == 16 || t + 2 == 24) { E.flush(acc, cur, (t + 2 == 16) ? 0 : 1, wr, wc, fr, fq); PG8_ZERO(); } }
        }
        if constexpr (Epi::SEG) E.flush(acc, cur, 2, wr, wc, fr, fq); else E(acc, cur, wr, wc, fr, fq);
        if (!has_next) break;
        PG8_ZERO();
        cur = nxt; cA = nA; cB = nB; ++ui;
    }
    PG8_WAIT_V(0);
    if (wr == 0) PG8_BAR;
    PG8_BAR;
#undef PG8_SA
#undef PG8_SB
#undef PG8_STAGE
#undef PG8_LDA
#undef PG8_LDB
#undef PG8_MMA
#undef PG8_WAIT_V
#undef PG8_WAIT_L
#undef PG8_BAR
#undef PG8_SCHED
#undef PG8_ZERO
}
}
using pg8::Unit;
typedef const f32x4 (&AccRef)[2][2][4][2];

struct Epi1 {
    static constexpr bool PERM = true, SEG = false;
    bf16_t *ocat, *kn, *vv, *qi, *ki, *u, *p, *gates; float* wi; const float* bgate; LAS unsigned char* stg;
    __device__ __forceinline__ void operator()(AccRef acc, const Unit& un, int wr, int wc, int fr, int fq) const {
        asm volatile("" : "+v"(fr), "+v"(fq));
        const int pn = un.pn, rowb = un.pm * 256 + wr * 64, lane = fq * 16 + fr;
        LAS unsigned char* sb = stg + (wr * 4 + wc) * 2304;
        if (pn == 7 && wc >= 1) {
            if (wc == 1 && fq == 0) {
                const float s = 0.35355339059327373f * 0.125f;
#pragma unroll
                for (int ai = 0; ai < 2; ++ai)
#pragma unroll
                    for (int m = 0; m < 4; ++m) { const size_t row = (size_t)(rowb + ai * 128 + m * 16 + fr);
                        *(f32x4*)(wi + row * 8) = acc[ai][0][m][0] * s; *(f32x4*)(wi + row * 8 + 4) = acc[ai][0][m][1] * s; }
            }
            return;
        }
        if (pn >= 12) {
            const int c0 = (pn - 12) * 256 + 64 * wc;
            f32x4 bz[2][2];
#pragma unroll
            for (int bj = 0; bj < 2; ++bj) { bz[bj][0] = *(const f32x4*)(bgate + c0 + 32 * bj + 8 * fq); bz[bj][1] = *(const f32x4*)(bgate + c0 + 32 * bj + 8 * fq + 4); }
            unsigned char* gb = (unsigned char*)gates + c0;
#pragma unroll
            for (int ai = 0; ai < 2; ++ai)
#pragma unroll
                for (int m = 0; m < 4; ++m) {
#pragma unroll
                    for (int bj = 0; bj < 2; ++bj) { uint2 q; unsigned w[2];
#pragma unroll
                        for (int n = 0; n < 2; ++n) { unsigned t = 0u;
#pragma unroll
                            for (int e = 0; e < 4; ++e) t |= (unsigned)(sigmoidf_(acc[ai][bj][m][n][e] + bz[bj][n][e]) * 255.f + 0.5f) << (8 * e);
                            w[n] = t; }
                        q.x = w[0]; q.y = w[1];
                        *(LAS u32x2*)(sb + fr * 80 + 32 * bj + 8 * fq) = (u32x2){q.x, q.y}; }
                    LDS_FENCE();
                    { const int r = lane >> 2, sg = lane & 3; const u32x4 v = *(const LAS u32x4*)(sb + r * 80 + sg * 16);
                      *(u32x4*)(gb + (size_t)(rowb + ai * 128 + m * 16 + r) * 6144 + sg * 16) = v; }
                    LDS_FENCE();
                }
            return;
        }
        bf16_t* base; int ld;
        if (pn < 4) { base = ocat + pn * 256 + 64 * wc; ld = 2048; }
        else if (pn == 4) { base = (wc < 2 ? kn : vv) + 64 * (wc & 1); ld = 128; }
        else if (pn < 7) { base = qi + (pn - 5) * 256 + 64 * wc; ld = 512; }
        else if (pn == 7) { base = ki; ld = 64; }
        else if (pn < 10) { base = u + (pn - 8) * 256 + 64 * wc; ld = 512; }
        else { base = p + (pn - 10) * 256 + 64 * wc; ld = 512; }
#pragma unroll
        for (int ai = 0; ai < 2; ++ai)
#pragma unroll
            for (int m = 0; m < 4; ++m) {
#pragma unroll
                for (int bj = 0; bj < 2; ++bj) { const uint4 pk_ = pack8(acc[ai][bj][m][0], acc[ai][bj][m][1]); *(LAS u32x4*)(sb + fr * 144 + 64 * bj + 16 * fq) = (u32x4){pk_.x, pk_.y, pk_.z, pk_.w}; }
                LDS_FENCE();
#pragma unroll
                for (int h = 0; h < 2; ++h) { const int r = h * 8 + (lane >> 3), sg = lane & 7; const u32x4 v = *(const LAS u32x4*)(sb + r * 144 + sg * 16);
                    *(u32x4*)(base + (size_t)(rowb + ai * 128 + m * 16 + r) * ld + sg * 8) = v; }
                LDS_FENCE();
            }
    }
};
struct EpiGluPool {
    static constexpr bool PERM = true, SEG = false;
    const bf16_t* y; const float* scale; bf16_t* ocat;
    __device__ __forceinline__ void operator()(AccRef acc, const Unit& un, int wr, int wc, int fr, int fq) const {
        asm volatile("" : "+v"(fr), "+v"(fq));
        const int row0 = un.pm * 256 + wr * 64 + fr; const bool glu = un.pn < 2;
#pragma unroll
        for (int bj = 0; bj < 2; ++bj) { const int col = (un.pn & 1) * 256 + 64 * wc + 32 * bj + 8 * fq;
            f32x4 s0 = {0.f, 0.f, 0.f, 0.f}, s1 = {0.f, 0.f, 0.f, 0.f};
            if (!glu) { s0 = *(const f32x4*)(scale + col); s1 = *(const f32x4*)(scale + col + 4); }
#pragma unroll
            for (int ai = 0; ai < 2; ++ai) {
                uint4 yq[4];
                if (glu) {
#pragma unroll
                    for (int m = 0; m < 4; ++m) yq[m] = *(const uint4*)(y + (size_t)(row0 + ai * 128 + m * 16) * 512 + col); }
#pragma unroll
                for (int m = 0; m < 4; ++m) { const size_t row = (size_t)(row0 + ai * 128 + m * 16);
                    f32x4 v0 = acc[ai][bj][m][0], v1 = acc[ai][bj][m][1];
                    if (glu) { float yv[8]; unpack8(yq[m], yv);
#pragma unroll
                        for (int e = 0; e < 4; ++e) { v0[e] = yv[e] * sigmoidf_(v0[e]); v1[e] = yv[4 + e] * sigmoidf_(v1[e]); }
                        *(uint4*)(ocat + row * 2048 + 1024 + col) = pack8(v0, v1);
                    } else *(uint4*)(ocat + row * 2048 + 1536 + col) = pack8(v0 * s0, v1 * s1); } } }
    }
};
struct EpiMerge {
    static constexpr bool PERM = true, SEG = true;
    const bf16_t* gates; bf16_t* merged; LAS unsigned char* stg;
    __device__ __forceinline__ void flush(AccRef acc, const Unit& un, int seg, int wr, int wc, int fr, int fq) const {
        asm volatile("" : "+v"(fr), "+v"(fq));
        const int rowb = un.pm * 256 + wr * 64, lane = fq * 16 + fr;
        const int colw = un.pn * 256 + 64 * wc;
        LAS unsigned char* sb = stg + (wr * 4 + wc) * 2304;
#pragma unroll
        for (int ai = 0; ai < 2; ++ai) {
            uint2 gq[2][4]; uint4 pq[2][4];
#pragma unroll
            for (int bj = 0; bj < 2; ++bj)
#pragma unroll
                for (int m = 0; m < 4; ++m) { const size_t row = (size_t)(rowb + ai * 128 + m * 16 + fr); const int col = colw + 32 * bj + 8 * fq;
                    gq[bj][m] = *(const uint2*)((const unsigned char*)gates + row * 6144 + seg * 2048 + col);
                    if (seg > 0) pq[bj][m] = *(const uint4*)(merged + row * 2048 + col); else pq[bj][m] = make_uint4(0u, 0u, 0u, 0u); }
#pragma unroll
            for (int m = 0; m < 4; ++m) {
#pragma unroll
                for (int bj = 0; bj < 2; ++bj) {
                    float gv[8], pv[8]; unpack8(pq[bj][m], pv);
#pragma unroll
                    for (int e = 0; e < 4; ++e) { gv[e] = (float)((gq[bj][m].x >> (8 * e)) & 0xffu) * (1.f / 255.f); gv[4 + e] = (float)((gq[bj][m].y >> (8 * e)) & 0xffu) * (1.f / 255.f); }
                    f32x4 v0 = acc[ai][bj][m][0], v1 = acc[ai][bj][m][1];
#pragma unroll
                    for (int e = 0; e < 4; ++e) { v0[e] = pv[e] + gv[e] * v0[e]; v1[e] = pv[4 + e] + gv[4 + e] * v1[e]; }
                    const uint4 pk_ = pack8(v0, v1); *(LAS u32x4*)(sb + fr * 144 + 64 * bj + 16 * fq) = (u32x4){pk_.x, pk_.y, pk_.z, pk_.w}; }
                LDS_FENCE();
#pragma unroll
                for (int h = 0; h < 2; ++h) { const int r = h * 8 + (lane >> 3), sg = lane & 7; const u32x4 v = *(const LAS u32x4*)(sb + r * 144 + sg * 16);
                    *(u32x4*)(merged + (size_t)(rowb + ai * 128 + m * 16 + r) * 2048 + colw + sg * 8) = v; }
                LDS_FENCE();
            }
        }
    }
};
struct EpiRes {
    static constexpr bool PERM = false, SEG = false;
    const float* xin; float* out; const float* gt;
    __device__ __forceinline__ void operator()(AccRef acc, const Unit& un, int wr, int wc, int fr, int fq) const {
        asm volatile("" : "+v"(fr), "+v"(fq));
        const int row0 = un.pm * 256 + wr * 64 + fr; const float* g = gt + (size_t)(un.pm >> 3) * 12288;
#pragma unroll
        for (int bj = 0; bj < 2; ++bj) { const int col = un.pn * 256 + bj * 128 + wc * 32 + 4 * fq;
            f32x4 gv[2], xv[2][2][4];
#pragma unroll
            for (int n = 0; n < 2; ++n) gv[n] = *(const f32x4*)(g + col + 16 * n);
#pragma unroll
            for (int n = 0; n < 2; ++n)
#pragma unroll
                for (int ai = 0; ai < 2; ++ai)
#pragma unroll
                    for (int m = 0; m < 4; ++m) xv[n][ai][m] = *(const f32x4*)(xin + (size_t)(row0 + ai * 128 + m * 16) * 2048 + col + 16 * n);
#pragma unroll
            for (int n = 0; n < 2; ++n)
#pragma unroll
                for (int ai = 0; ai < 2; ++ai)
#pragma unroll
                    for (int m = 0; m < 4; ++m) *(f32x4*)(out + (size_t)(row0 + ai * 128 + m * 16) * 2048 + col + 16 * n) = xv[n][ai][m] + gv[n] * acc[ai][bj][m][n]; }
    }
};
struct EpiUp {
    static constexpr bool PERM = true, SEG = false;
    bf16_t* act; float* SA; float* SB; const float* cw; const float* cb; LAS unsigned char* stg;
    __device__ __forceinline__ void operator()(AccRef acc, const Unit& un, int wr, int wc, int fr, int fq) const {
        asm volatile("" : "+v"(fr), "+v"(fq));
        const int lg = fq << 4, lane = lg | fr;
        const int src1 = lg | ((fr + 15) & 15), src2 = lg | ((fr + 14) & 15);
        const int ch0 = un.pn * 128 + wc * 32 + 8 * fq;
        LAS unsigned char* sb = stg + (wr * 4 + wc) * 2304;
        f32x4 w0[2], w1[2], w2[2], bb[2];
#pragma unroll
        for (int n = 0; n < 2; ++n) { w0[n] = *(const f32x4*)(cw + ch0 + 4 * n); w1[n] = *(const f32x4*)(cw + DFF + ch0 + 4 * n); w2[n] = *(const f32x4*)(cw + 2 * DFF + ch0 + 4 * n); bb[n] = *(const f32x4*)(cb + ch0 + 4 * n); }
#pragma unroll
        for (int ai = 0; ai < 2; ++ai) {
            const int rowb = un.pm * 256 + ai * 128 + wr * 64; const int blk = rowb >> 6;
#pragma unroll
            for (int m = 0; m < 4; ++m) {
                f32x4 res[2];
#pragma unroll
                for (int n = 0; n < 2; ++n)
#pragma unroll
                    for (int e = 0; e < 4; ++e) {
                        const float cur = acc[ai][0][m][n][e];
                        const float prv = (m > 0) ? acc[ai][0][m > 0 ? m - 1 : 0][n][e] : 0.f;
                        const float p1 = __shfl((fr + 1 >= 16) ? prv : cur, src1);
                        const float p2 = __shfl((fr + 2 >= 16) ? prv : cur, src2);
                        const float cv = bb[n][e] + w0[n][e] * p2 + w1[n][e] * p1 + w2[n][e] * cur;
                        res[n][e] = siluf_(cv) * acc[ai][1][m][n][e];
                    }
                if (m == 0 && fr < 2) {
                    float* sa = SA + ((size_t)(blk * 4 + 2 + fr)) * DFF + ch0; float* sbp = SB + ((size_t)(blk * 2 + fr)) * DFF + ch0;
                    *(f32x4*)sa = acc[ai][0][0][0]; *(f32x4*)(sa + 4) = acc[ai][0][0][1];
                    *(f32x4*)sbp = acc[ai][1][0][0]; *(f32x4*)(sbp + 4) = acc[ai][1][0][1];
                }
                if (m == 3 && fr >= 14) { float* sa = SA + ((size_t)(blk * 4 + (fr - 14))) * DFF + ch0; *(f32x4*)sa = acc[ai][0][3][0]; *(f32x4*)(sa + 4) = acc[ai][0][3][1]; }
                { const uint4 pk_ = pack8(res[0], res[1]); *(LAS u32x4*)(sb + fr * 80 + 16 * fq) = (u32x4){pk_.x, pk_.y, pk_.z, pk_.w}; }
                LDS_FENCE();
                { const int r = lane >> 2, sg = lane & 3; const u32x4 v = *(const LAS u32x4*)(sb + r * 80 + sg * 16);
                  if (!(m == 0 && r < 2)) *(u32x4*)(act + (size_t)(rowb + m * 16 + r) * DFF + un.pn * 128 + wc * 32 + sg * 8) = v; }
                LDS_FENCE();
            }
        }
    }
};

struct Args { const float* in[31]; float* out; unsigned char* ws; int ph_lo, ph_hi; };
enum { I_X = 0, I_C, I_POS, I_WADA, I_BADA, I_GN1, I_GN2, I_WIN, I_GQ, I_GK, I_ARE, I_AIM, I_BRE, I_BIM, I_CRE, I_CIM, I_DSKIP, I_LOGDT, I_WGLU, I_WPOOL, I_PSCALE, I_PA, I_PB, I_PC, I_WGATE, I_BGATE, I_WOUT, I_WUP, I_CONVW, I_CONVB, I_WDOWN };

__device__ __forceinline__ float wave_sum(float v) {
#pragma unroll
    for (int o = 32; o > 0; o >>= 1) v += __shfl_xor(v, o);
    return v;
}

__device__ __forceinline__ void phase_ada(const Args& a, unsigned char* lds, const int WV) {
    const int TI = fresh_tid(WV);
    const int tid = TI;
    float* cact = (float*)lds;
    float* mod = (float*)(a.ws + WS_MOD);
    for (int w = blockIdx.x; w < 256; w += gridDim.x) {
        for (int i = tid; i < 16 * 2048; i += 512) { const int b = i >> 11, k = i & 2047; const float v = a.in[I_C][i]; cact[k * 16 + b] = siluf_(v); }
        __syncthreads();
        const int l = w >> 7, n0 = (w & 127) * 96;
        float acc[16][4];
#pragma unroll
        for (int b = 0; b < 16; ++b)
#pragma unroll
            for (int j = 0; j < 4; ++j) acc[b][j] = 0.f;
        const int cg4 = tid % 24, ks = tid / 24;
        if (tid < 384) {
            const float* wp = a.in[I_WADA] + ((size_t)l * 2048 + ks * 128) * 12288 + n0 + cg4 * 4;
#pragma unroll 4
            for (int k = 0; k < 128; ++k) {
                const f32x4 wv = *(const f32x4*)(wp + (size_t)k * 12288);
                const f32x4* cp = (const f32x4*)(cact + (ks * 128 + k) * 16);
#pragma unroll
                for (int q = 0; q < 4; ++q) { const f32x4 cv = cp[q];
#pragma unroll
                    for (int e = 0; e < 4; ++e)
#pragma unroll
                        for (int j = 0; j < 4; ++j) acc[q * 4 + e][j] += cv[e] * wv[j]; }
            }
        }
        __syncthreads();
        float* part = (float*)lds;
        if (tid < 384) {
#pragma unroll
            for (int b = 0; b < 16; ++b)
#pragma unroll
                for (int j = 0; j < 4; ++j) part[(ks * 16 + b) * 96 + cg4 * 4 + j] = acc[b][j];
        }
        __syncthreads();
        for (int o = tid; o < 1536; o += 512) { const int b = o / 96, cc = o % 96; float s = 0.f;
#pragma unroll
            for (int k2 = 0; k2 < 16; ++k2) s += part[(k2 * 16 + b) * 96 + cc];
            mod[((size_t)l * 16 + b) * 12288 + n0 + cc] = s + a.in[I_BADA][l * 12288 + n0 + cc]; }
        __syncthreads();
    }
}

struct CvtJob { const float* src; bf16_t* dst; int ldS, cbase, cend, kbase, ldD, mode, r0, cs0, kd0; };
__device__ __forceinline__ CvtJob cvt_decode(const Args& a, int l, int t) {
    unsigned char* ws = a.ws; CvtJob J; int ncols, nkt, idx; J.mode = 0; J.r0 = 0; J.kd0 = 0; J.cs0 = 0;
    if (t < 960) { idx = t; J.src = a.in[I_WIN] + (size_t)l * DM * DIN; J.ldS = DIN; ncols = 1864; nkt = 32; J.dst = (bf16_t*)(ws + W_1CAT); J.ldD = 2048; J.mode = 2; }
    else if (t < 1472) { idx = t - 960; J.src = a.in[I_WIN] + (size_t)l * DM * DIN; J.ldS = DIN; J.cs0 = 1864; ncols = 1024; nkt = 32; J.dst = (bf16_t*)(ws + W_1CAT); J.ldD = 2048; J.r0 = 2048; J.mode = 2; }
    else if (t < 4544) { idx = t - 1472; const int gi = idx >> 10; idx &= 1023; J.src = a.in[I_WGATE] + ((size_t)l * 3 + gi) * DM * DM; J.ldS = DM; ncols = 2048; nkt = 32; J.dst = (bf16_t*)(ws + W_1CAT); J.ldD = 2048; J.r0 = 3072 + 2048 * gi; J.mode = 2; }
    else if (t < 5056) { idx = t - 4544; J.src = a.in[I_PA] + (size_t)l * 1024 * DM; J.ldS = DM; ncols = 2048; nkt = 16; J.dst = (bf16_t*)(ws + W_P); J.ldD = 2048; J.mode = 2; }
    else if (t < 5312) { idx = t - 5056; J.src = a.in[I_PB] + (size_t)l * 512 * DM; J.ldS = DM; ncols = 2048; nkt = 8; J.dst = (bf16_t*)(ws + W_P); J.ldD = 2048; J.kd0 = 1024; J.mode = 2; }
    else if (t < 5568) { idx = t - 5312; J.src = a.in[I_PC] + (size_t)l * 512 * DM; J.ldS = DM; ncols = 2048; nkt = 8; J.dst = (bf16_t*)(ws + W_P); J.ldD = 2048; J.kd0 = 1536; J.mode = 2; }
    else if (t < 6592) { idx = t - 5568; J.src = a.in[I_WOUT] + (size_t)l * DM * DM; J.ldS = DM; ncols = 2048; nkt = 32; J.dst = (bf16_t*)(ws + W_OUT); J.ldD = 2048; }
    else if (t < 12096) { idx = t - 6592; J.src = a.in[I_WUP] + (size_t)l * DM * 2 * DFF; J.ldS = 2 * DFF; ncols = 2 * DFF; nkt = 32; J.dst = (bf16_t*)(ws + W_UP); J.ldD = 2048; J.mode = 1; }
    else if (t < 14848) { idx = t - 12096; J.src = a.in[I_WDOWN] + (size_t)l * DFF * DM; J.ldS = DM; ncols = 2048; nkt = 86; J.dst = (bf16_t*)(ws + W_DOWN); J.ldD = DFF; }
    else { idx = t - 14848; J.src = a.in[I_WGLU] + (size_t)l * 512 * 512; J.ldS = 512; ncols = 512; nkt = 8; J.dst = (bf16_t*)(ws + W_GLU); J.ldD = 512; J.mode = 2; }
    const int tn = idx / nkt, tk = idx - tn * nkt;
    J.cbase = J.cs0 + tn * 64; J.cend = J.cs0 + ncols; J.kbase = tk * 64; return J;
}
__device__ __forceinline__ void phase_cvt(const Args& a, int l, unsigned char* lds, const int WV) {
    const int TI = fresh_tid(WV);
    float* T = (float*)lds;
    const int tid = TI, ty = tid >> 4, tx = tid & 15;
    for (int t4 = blockIdx.x * 8; t4 < 14912; t4 += gridDim.x * 8) {
        f32x4 v[8][2];
#pragma unroll
        for (int q = 0; q < 8; ++q) { const CvtJob J = cvt_decode(a, l, t4 + q);
#pragma unroll
            for (int ps = 0; ps < 2; ++ps) { const int k = ty + ps * 32, c = J.cbase + tx * 4;
                v[q][ps] = (f32x4){0.f, 0.f, 0.f, 0.f};
                if (c < J.cend) v[q][ps] = *(const f32x4*)(J.src + (size_t)(J.kbase + k) * J.ldS + c); } }
#pragma unroll
        for (int q = 0; q < 8; ++q)
#pragma unroll
            for (int ps = 0; ps < 2; ++ps) { float* tp = T + q * (64 * 65) + (ty + ps * 32) * 65 + tx * 4; tp[0] = v[q][ps][0]; tp[1] = v[q][ps][1]; tp[2] = v[q][ps][2]; tp[3] = v[q][ps][3]; }
        __syncthreads();
#pragma unroll
        for (int q = 0; q < 8; ++q) { const CvtJob J = cvt_decode(a, l, t4 + q);
            const int n = tid >> 3, kq = tid & 7, c = J.cbase + n;
            if (c < J.cend) {
                float f[8];
#pragma unroll
                for (int j = 0; j < 8; ++j) f[j] = T[q * (64 * 65) + (kq * 8 + j) * 65 + n];
                int row;
                if (J.mode == 0) row = J.r0 + (c - J.cs0);
                else if (J.mode == 2) { const int r_ = J.r0 + (c - J.cs0), ct = r_ & 255; row = (r_ & ~255) | (((ct >> 5) & 1) << 7) | ((ct >> 6) << 5) | (ct & 31); }
                else { const int bj = c >= DFF ? 1 : 0, ch = c - bj * DFF; row = (ch >> 7) * 256 + bj * 128 + (ch & 127); }
                uint4 o; o.x = pk2(f[0], f[1]); o.y = pk2(f[2], f[3]); o.z = pk2(f[4], f[5]); o.w = pk2(f[6], f[7]);
                *(uint4*)(J.dst + (size_t)row * J.ldD + J.kd0 + J.kbase + kq * 8) = o;
            } }
        __syncthreads();
    }
    bf16_t* wp = (bf16_t*)(a.ws + W_POOL); const float* wsrc = a.in[I_WPOOL] + (size_t)l * 4 * 128 * 128;
    for (int i = blockIdx.x * 512 + TI; i < 512 * 512; i += gridDim.x * 512) { const int n = i >> 9, k = i & 511, g = n >> 7;
        const float v = ((k >> 7) == g) ? wsrc[(g * 128 + (k & 127)) * 128 + (n & 127)] : 0.f;
        const int ct = n & 255, nr = (n & ~255) | (((ct >> 5) & 1) << 7) | ((ct >> 6) << 5) | (ct & 31); wp[nr * 512 + k] = (bf16_t)f2bf(v); }
}

__device__ __forceinline__ void phase_norm(const float* xin, const float* g, const float* modl, int shoff, int scoff, bf16_t* out, const int WV) {
    const int TI = fresh_tid(WV);
    const int lane = TI & 63, wave = TI >> 6;
    for (int r = blockIdx.x * 8 + wave; r < MROWS; r += gridDim.x * 8) {
        const f32x4* xp = (const f32x4*)(xin + (size_t)r * DM); f32x4 v[8]; float ssq = 0.f;
#pragma unroll
        for (int j = 0; j < 8; ++j) { v[j] = xp[j * 64 + lane]; ssq += v[j][0] * v[j][0] + v[j][1] * v[j][1] + v[j][2] * v[j][2] + v[j][3] * v[j][3]; }
        ssq = wave_sum(ssq);
        const float rinv = rsqrtf(ssq * (1.f / DM) + EPS);
        const float* mb = modl + (size_t)(r >> 11) * 12288;
#pragma unroll
        for (int j = 0; j < 8; ++j) { const int col = j * 256 + lane * 4;
            const f32x4 g4 = *(const f32x4*)(g + col), sc = *(const f32x4*)(mb + scoff + col), sh = *(const f32x4*)(mb + shoff + col);
            f32x4 y;
#pragma unroll
            for (int e = 0; e < 4; ++e) y[e] = (v[j][e] * rinv * g4[e]) * (1.f + sc[e]) + sh[e];
            uint2 o; o.x = pk2(y[0], y[1]); o.y = pk2(y[2], y[3]);
            *(uint2*)(out + (size_t)r * DM + col) = o; }
    }
}

__constant__ double kRevPerPos[24] = {0.15915494309189535, 0.0700865215877985, 0.03086376340470123, 0.013591370636193905, 0.005985185712713705, 0.002635675898667414, 0.001160663641240061, 0.0005111175045375439, 0.00022507907903927653, 9.911730936901935e-05, 4.364795279280289e-05, 1.9221100684944863e-05, 8.464330808241401e-06, 3.727408601915352e-06, 1.6414262627950345e-06, 7.228293068832865e-07, 0.15915494309189535, 0.03086376340470123, 0.005985185712713705, 0.001160663641240061, 0.00022507907903927653, 4.364795279280289e-05, 8.464330808241401e-06, 1.6414262627950345e-06};
__device__ __forceinline__ void rmsrope128(bf16_t* p, bool active, const float* g16, int sub, const float* cs) {
    float v[16];
    if (active) { unpack8(*(const uint4*)p, v); unpack8(*(const uint4*)(p + 8), v + 8); }
    else {
#pragma unroll
        for (int i = 0; i < 16; ++i) v[i] = 0.f; }
    float ssq = 0.f;
#pragma unroll
    for (int i = 0; i < 16; ++i) ssq += v[i] * v[i];
    ssq += __shfl_xor(ssq, 1); ssq += __shfl_xor(ssq, 2); ssq += __shfl_xor(ssq, 4);
    const float rinv = rsqrtf(ssq * (1.f / 128.f) + EPS);
#pragma unroll
    for (int i = 0; i < 16; ++i) v[i] = v[i] * rinv * g16[i];
#pragma unroll
    for (int i = 0; i < 16; ++i) { const float o = __shfl_xor(v[i], 1); const float c = cs[2 * i], s = cs[2 * i + 1];
        if (sub == 0) v[i] = v[i] * c - o * s; else if (sub == 1) v[i] = v[i] * c + o * s; }
    if (active) { uint4 o0, o1; o0.x = pk2(v[0], v[1]); o0.y = pk2(v[2], v[3]); o0.z = pk2(v[4], v[5]); o0.w = pk2(v[6], v[7]);
        o1.x = pk2(v[8], v[9]); o1.y = pk2(v[10], v[11]); o1.z = pk2(v[12], v[13]); o1.w = pk2(v[14], v[15]);
        *(uint4*)p = o0; *(uint4*)(p + 8) = o1; }
}
__device__ __forceinline__ void rope64(bf16_t* p, bool active, int sub, const float* cs) {
    float v[8];
    if (active) unpack8(*(const uint4*)p, v);
    else {
#pragma unroll
        for (int i = 0; i < 8; ++i) v[i] = 0.f; }
#pragma unroll
    for (int i = 0; i < 8; ++i) { const float o = __shfl_xor(v[i], 1); const float c = cs[2 * i], s = cs[2 * i + 1];
        if (sub == 0) v[i] = v[i] * c - o * s; else if (sub == 1) v[i] = v[i] * c + o * s; }
    if (active) { uint4 o0; o0.x = pk2(v[0], v[1]); o0.y = pk2(v[2], v[3]); o0.z = pk2(v[4], v[5]); o0.w = pk2(v[6], v[7]); *(uint4*)p = o0; }
}
__device__ __forceinline__ void phase_post(const Args& a, int l, unsigned char* lds, const int WV) {
    const int TI = fresh_tid(WV);
    const int lane = TI & 63, wave = TI >> 6;
    float* cs = (float*)lds + wave * 64;
    bf16_t* ocat = (bf16_t*)(a.ws + WS_OCAT); bf16_t* kn = (bf16_t*)(a.ws + WS_KN); bf16_t* qi = (bf16_t*)(a.ws + WS_QI); bf16_t* ki = (bf16_t*)(a.ws + WS_KI);
    const int* pos = (const int*)a.in[I_POS];
    const int sub = lane & 7, hd = lane >> 3;
    float gq[16], gk[16];
#pragma unroll
    for (int i = 0; i < 16; ++i) { gq[i] = a.in[I_GQ][l * 128 + sub * 16 + i]; gk[i] = a.in[I_GK][l * 128 + sub * 16 + i]; }
    for (int r = blockIdx.x * 8 + wave; r < MROWS; r += gridDim.x * 8) {
        const int ps = pos[r];
        if (lane < 24) {
            double rev = (double)ps * kRevPerPos[lane]; rev -= rint(rev); const float fr = (float)rev;
            cs[lane * 2] = __builtin_amdgcn_cosf(fr); cs[lane * 2 + 1] = __builtin_amdgcn_sinf(fr); }
        LDS_FENCE();
        rmsrope128(ocat + (size_t)r * 2048 + hd * 128 + sub * 16, true, gq, sub, cs);
        rmsrope128(kn + (size_t)r * 128 + sub * 16, lane < 8, gk, sub, cs);
        rope64(qi + (size_t)r * 512 + hd * 64 + sub * 8, true, sub, cs + 32);
        rope64(ki + (size_t)r * 64 + sub * 8, lane < 8, sub, cs + 32);
        LDS_FENCE();
    }
}

__device__ __forceinline__ void s5_unit(const Args& a, int l, int b, int g, unsigned char* lds, const int WV) {
    const int TI = fresh_tid(WV);
    const int lane = TI & 63, wave = __builtin_amdgcn_readfirstlane(TI >> 6), p = lane;
    float* E = (float*)lds;
    float* ust = (float*)(lds + 16384 + wave * 4096);
    bf16_t* sst = (bf16_t*)(lds + 49152 + wave * 4352);
    const bf16_t* U = (const bf16_t*)(a.ws + WS_U); bf16_t* Y = (bf16_t*)(a.ws + WS_Y);
    const int gp = (l * 32 + g) * 64 + p;
    const float are = a.in[I_ARE][gp], aim = a.in[I_AIM][gp], dt = expf(a.in[I_LOGDT][l * 32 + g]);
    const float mag = expf(are * dt);
    float ang = aim * dt; { const float n = rintf(ang * 0.15915494309189535f); ang = fmaf(-n, 6.28318548202514648f, ang); ang = fmaf(n, 1.7484555e-7f, ang); }
    const float lre = mag * cosf(ang), lim = mag * sinf(ang);
    float Bre[16], Bim[16];
    { const float nr = lre - 1.f, ni = lim, den = 1.f / (are * are + aim * aim); const float cr = (nr * are + ni * aim) * den, ci = (ni * are - nr * aim) * den;
#pragma unroll
        for (int j = 0; j < 16; ++j) { const float br = a.in[I_BRE][(size_t)gp * 16 + j], bi = a.in[I_BIM][(size_t)gp * 16 + j]; Bre[j] = cr * br - ci * bi; Bim[j] = cr * bi + ci * br; } }
    bf16x8 Cf[4];
    { const int i = lane & 15;
#pragma unroll
        for (int ks = 0; ks < 4; ++ks)
#pragma unroll
            for (int j = 0; j < 8; ++j) { const int k = ks * 32 + (lane >> 4) * 8 + j, pp = k >> 1; const size_t ci = ((size_t)(l * 32 + g) * 16 + i) * 64 + pp;
                const float v = (k & 1) ? -a.in[I_CIM][ci] : a.in[I_CRE][ci]; Cf[ks][j] = (short)f2bf(v); } }
    const float dsk = a.in[I_DSKIP][l * 512 + g * 16 + (lane & 15)];
    bf16_t* Bl = (bf16_t*)(lds + 83968);
    float* bus = (float*)(lds + 88064 + wave * 8448);
    if (wave == 0) {
#pragma unroll
        for (int q = 0; q < 2; ++q) { uint4 o_; o_.x = pk2(Bre[q * 8], Bre[q * 8 + 1]); o_.y = pk2(Bre[q * 8 + 2], Bre[q * 8 + 3]); o_.z = pk2(Bre[q * 8 + 4], Bre[q * 8 + 5]); o_.w = pk2(Bre[q * 8 + 6], Bre[q * 8 + 7]);
            *(uint4*)(Bl + p * 16 + q * 8) = o_;
            uint4 i_; i_.x = pk2(Bim[q * 8], Bim[q * 8 + 1]); i_.y = pk2(Bim[q * 8 + 2], Bim[q * 8 + 3]); i_.z = pk2(Bim[q * 8 + 4], Bim[q * 8 + 5]); i_.w = pk2(Bim[q * 8 + 6], Bim[q * 8 + 7]);
            *(uint4*)(Bl + (64 + p) * 16 + q * 8) = i_; }
    }
    __syncthreads();
    const int l15 = lane & 15, lg4 = lane >> 4;
    bf16x8 Bf[8];
#pragma unroll
    for (int nb = 0; nb < 8; ++nb) { u32x4 t_ = {0u, 0u, 0u, 0u}; if (lg4 < 2) t_ = *(const u32x4*)(Bl + (nb * 16 + l15) * 16 + lg4 * 8); Bf[nb] = __builtin_bit_cast(bf16x8, t_); }
#define S5_BU(t0_, sb_) do { u32x4 a_ = {0u, 0u, 0u, 0u}; if (lg4 < 2) a_ = *(const u32x4*)(U + (size_t)(b * 2048 + (t0_) + (sb_) * 16 + l15) * 512 + g * 16 + lg4 * 8); \
        const bf16x8 af_ = __builtin_bit_cast(bf16x8, a_); \
        _Pragma("unroll") for (int nb = 0; nb < 8; ++nb) { const f32x4 c_ = __builtin_amdgcn_mfma_f32_16x16x32_bf16(af_, Bf[nb], (f32x4){0.f, 0.f, 0.f, 0.f}, 0, 0, 0); \
            _Pragma("unroll") for (int r = 0; r < 4; ++r) bus[(lg4 * 4 + r) * 132 + nb * 16 + l15] = c_[r]; } \
        LDS_FENCE(); } while (0)
#define S5_STEP(tt_) do { const float br_ = bus[(tt_) * 132 + p], bi_ = bus[(tt_) * 132 + 64 + p]; \
        const float nre_ = lre * sre - lim * sim + br_, nim_ = lre * sim + lim * sre + bi_; sre = nre_; sim = nim_; } while (0)
#pragma unroll 1
    for (int cc = 0; cc < 4; ++cc) {
        const int chunk = wave * 4 + cc, t0 = chunk * 64;
        float sre = 0.f, sim = 0.f;
#pragma unroll 1
        for (int sb = 0; sb < 4; ++sb) {
            S5_BU(t0, sb);
#pragma unroll 4
            for (int tt = 0; tt < 16; ++tt) S5_STEP(tt);
            LDS_FENCE();
        }
        E[(chunk * 64 + p) * 2] = sre; E[(chunk * 64 + p) * 2 + 1] = sim;
    }
    __syncthreads();
    if (wave == 0) {
        float pr = lre, pi = lim;
#pragma unroll
        for (int q = 0; q < 6; ++q) { const float nr = pr * pr - pi * pi, pp_ = pr * pi, ni = pp_ + pp_; pr = nr; pi = ni; }
        float sr = 0.f, si = 0.f;
        for (int c = 0; c < 32; ++c) { const float er = E[(c * 64 + p) * 2], ei = E[(c * 64 + p) * 2 + 1]; E[(c * 64 + p) * 2] = sr; E[(c * 64 + p) * 2 + 1] = si;
            const float nr = pr * sr - pi * si + er, ni = pr * si + pi * sr + ei; sr = nr; si = ni; }
    }
    __syncthreads();
#pragma unroll 1
    for (int cc = 0; cc < 4; ++cc) {
        const int chunk = wave * 4 + cc, t0 = chunk * 64;
        { const bf16_t* up = U + (size_t)(b * 2048 + t0 + lane) * 512 + g * 16; const uint4 q0 = *(const uint4*)up, q1 = *(const uint4*)(up + 8);
            float f[16]; unpack8(q0, f); unpack8(q1, f + 8);
#pragma unroll
            for (int q = 0; q < 4; ++q) *(f32x4*)(ust + lane * 16 + q * 4) = (f32x4){f[q * 4], f[q * 4 + 1], f[q * 4 + 2], f[q * 4 + 3]}; }
        float sre = E[(chunk * 64 + p) * 2], sim = E[(chunk * 64 + p) * 2 + 1];
#pragma unroll 1
        for (int sb = 0; sb < 4; ++sb) {
            S5_BU(t0, sb);
#pragma unroll 4
            for (int tt = 0; tt < 16; ++tt) { S5_STEP(tt);
                *(unsigned*)(sst + tt * 136 + 2 * p) = pk2(sre, sim);
            }
            LDS_FENCE();
            f32x4 acc = {0.f, 0.f, 0.f, 0.f};
#pragma unroll
            for (int ks = 0; ks < 4; ++ks) { const bf16x8 af = *(const bf16x8*)(sst + (lane & 15) * 136 + ks * 32 + (lane >> 4) * 8);
                acc = __builtin_amdgcn_mfma_f32_16x16x32_bf16(af, Cf[ks], acc, 0, 0, 0); }
#pragma unroll
            for (int r = 0; r < 4; ++r) { const int t = sb * 16 + (lane >> 4) * 4 + r, i = lane & 15;
                const float y = gelu_tanh(acc[r] + dsk * ust[t * 16 + i]);
                Y[(size_t)(b * 2048 + t0 + t) * 512 + g * 16 + i] = (bf16_t)f2bf(y); }
            LDS_FENCE();
        }
    }
    __syncthreads();
#undef S5_STEP
#undef S5_BU
}

__device__ __forceinline__ void pool_unit(const Args& a, int b, int chunk, unsigned char* lds, const int WV) {
    const int TI = fresh_tid(WV);
    bf16_t* T = (bf16_t*)lds;
    const int t0 = chunk * 64;
    const bf16_t* P = (const bf16_t*)(a.ws + WS_P) + (size_t)b * 2048 * 512; bf16_t* O = (bf16_t*)(a.ws + WS_POOLED) + (size_t)b * 2048 * 512;
    __syncthreads();
    for (int i = TI; i < 80 * 64; i += 512) { const int r = i >> 6, c8 = i & 63, t = t0 - 16 + r;
        uint4 v = make_uint4(0u, 0u, 0u, 0u); if (t >= 0) v = *(const uint4*)(P + (size_t)t * 512 + c8 * 8);
        *(uint4*)(T + r * 512 + c8 * 8) = v; }
    __syncthreads();
    const int c = TI, w = 2 << (c >> 7);
    float s = 0.f;
    for (int k = 1; k <= w; ++k) s += bf1(T[(16 - k) * 512 + c]);
#pragma unroll 4
    for (int t = 0; t < 64; ++t) { const float pv = bf1(T[(16 + t) * 512 + c]); s += pv; s -= bf1(T[(16 + t - w) * 512 + c]);
        const int tt = t0 + t + 1; const float mean = s / (float)(tt < w ? tt : w); O[(size_t)(t0 + t) * 512 + c] = (bf16_t)f2bf(mean - pv); }
}

__device__ __forceinline__ unsigned sortkey(float x) { const unsigned u = __float_as_uint(x); return (u & 0x80000000u) ? ~u : (u | 0x80000000u); }
template <int NJ>
__device__ __forceinline__ void select256(const float* scq, int limit, unsigned short* sq, int lane) {
    const unsigned long long ltmask = (1ull << lane) - 1ull;
    unsigned key[NJ];
#pragma unroll
    for (int j = 0; j < NJ; ++j) { const int idx = j * 64 + lane; key[j] = (idx < limit) ? sortkey(scq[idx]) : 0u; }
    unsigned T = 0u;
    for (int bit = 31; bit >= 0; --bit) { const unsigned cand = T | (1u << bit); int cnt = 0;
#pragma unroll
        for (int j = 0; j < NJ; ++j) cnt += __popcll(__ballot(key[j] >= cand));
        if (cnt >= 256) { T = cand; if (cnt == 256) break; } }
    int cgt = 0;
#pragma unroll
    for (int j = 0; j < NJ; ++j) cgt += __popcll(__ballot(key[j] > T));
    const int need = 256 - cgt; int ob = 0, tb = 0;
#pragma unroll
    for (int j = 0; j < NJ; ++j) { const bool gt = key[j] > T, eq = key[j] == T; const unsigned long long me = __ballot(eq);
        const int pe = tb + __popcll(me & ltmask); const bool take = gt || (eq && pe < need); const unsigned long long mt = __ballot(take);
        if (take) sq[ob + __popcll(mt & ltmask)] = (unsigned short)(j * 64 + lane);
        ob += __popcll(mt); tb += __popcll(me); }
}
__device__ __forceinline__ void dsa_unit(const Args& a, int b, int tq, unsigned char* lds, const int WV, bf16_t* obase, const int ostride, const int parts) {
    const int TI = fresh_tid(WV);
    int tid = TI;
    int lane = tid & 63; const int wave = WV;
    float* sc = (float*)lds;
    unsigned short* sel = (unsigned short*)(lds + 131072);
    float* wis = (float*)(lds + 131072 + 8192);
    bf16_t* ocat = (bf16_t*)(a.ws + WS_OCAT); const bf16_t* Kn = (const bf16_t*)(a.ws + WS_KN); const bf16_t* V = (const bf16_t*)(a.ws + WS_V);
    const bf16_t* QI = (const bf16_t*)(a.ws + WS_QI); const bf16_t* KI = (const bf16_t*)(a.ws + WS_KI); const float* WI = (const float*)(a.ws + WS_WI);
    const int t0 = tq * 16, row0 = b * 2048 + t0, limit = ((t0 >> 6) + 1) << 6, nkt = limit >> 5, nsel = limit < 256 ? limit : 256;
    __syncthreads();
    if (tid < 128) wis[tid] = WI[(size_t)row0 * 8 + tid];
    __syncthreads();
    if (parts & 1)
    {
        const int g = lane >> 5, c32 = lane & 31;
        bf16x8 Af[4][4];
#pragma unroll
        for (int rb = 0; rb < 4; ++rb) { const int R = rb * 32 + c32; const bf16_t* qp = QI + (size_t)(row0 + (R >> 3)) * 512 + (R & 7) * 64 + g * 8;
#pragma unroll
            for (int s = 0; s < 4; ++s) Af[rb][s] = *(const bf16x8*)(qp + s * 16); }
        bf16x8 Bn[4];
        { const bf16_t* kp0 = KI + (size_t)(b * 2048 + wave * 32 + c32) * 64 + g * 8;
#pragma unroll
            for (int s = 0; s < 4; ++s) Bn[s] = *(const bf16x8*)(kp0 + s * 16); }
#pragma unroll 1
        for (int kt = wave; kt < nkt; kt += 8) {
            bf16x8 Bf[4];
#pragma unroll
            for (int s = 0; s < 4; ++s) Bf[s] = Bn[s];
            if (kt + 8 < nkt) { const bf16_t* kp = KI + (size_t)(b * 2048 + (kt + 8) * 32 + c32) * 64 + g * 8;
#pragma unroll
                for (int s = 0; s < 4; ++s) Bn[s] = *(const bf16x8*)(kp + s * 16); }
#pragma unroll
            for (int rb = 0; rb < 4; ++rb) {
                f32x16 acc;
#pragma unroll
                for (int i = 0; i < 16; ++i) acc[i] = 0.f;
#pragma unroll
                for (int s = 0; s < 4; ++s) acc = __builtin_amdgcn_mfma_f32_32x32x16_bf16(Af[rb][s], Bf[s], acc, 0, 0, 0);
#pragma unroll
                for (int j = 0; j < 4; ++j) { const int q = rb * 4 + j; const f32x4 w4 = *(const f32x4*)(wis + q * 8 + 4 * g);
                    float sp = fmaxf(acc[4 * j], 0.f) * w4[0] + fmaxf(acc[4 * j + 1], 0.f) * w4[1] + fmaxf(acc[4 * j + 2], 0.f) * w4[2] + fmaxf(acc[4 * j + 3], 0.f) * w4[3];
                    sp += __shfl_xor(sp, 32);
                    if (g == 0) sc[q * 2048 + kt * 32 + c32] = sp; }
            }
        }
    }
    __syncthreads();
    lane = fresh_tid(WV) & 63;
    for (int qq = 0; qq < 2; ++qq) {
        const int q = wave * 2 + qq; unsigned short* sq = sel + q * 256;
        if (limit <= 256 || !(parts & 2)) { for (int j = lane; j < nsel; j += 64) sq[j] = (unsigned short)j; }
        else if (limit <= 512) select256<8>(sc + q * 2048, limit, sq, lane);
        else if (limit <= 1024) select256<16>(sc + q * 2048, limit, sq, lane);
        else if (limit <= 1536) select256<24>(sc + q * 2048, limit, sq, lane);
        else select256<32>(sc + q * 2048, limit, sq, lane);
    }
    __syncthreads();
    lane = fresh_tid(WV) & 63;
    float* Pw = (float*)lds + wave * 2048;
    const int g4 = lane >> 4, hh = lane & 15;
#pragma unroll 1
    for (int qq = 0; qq < 2; ++qq) {
        const int q = wave * 2 + qq; const size_t row = (size_t)(row0 + q); const unsigned short* sq = sel + q * 256;
        bf16x8 Qf[4];
#pragma unroll
        for (int s = 0; s < 4; ++s) Qf[s] = *(const bf16x8*)(ocat + row * 2048 + (hh & 7) * 128 + g4 * 8 + s * 32);
        float lg[16][4];
#pragma unroll
        for (int kg = 0; kg < 4; ++kg) {
            if (kg * 64 < nsel) {
                bf16x8 kf[4][4];
#pragma unroll
                for (int k4 = 0; k4 < 4; ++k4) { const int idx = sq[(kg * 4 + k4) * 16 + hh]; const bf16_t* kp = Kn + (size_t)(b * 2048 + idx) * 128 + g4 * 8;
#pragma unroll
                    for (int s = 0; s < 4; ++s) kf[k4][s] = *(const bf16x8*)(kp + s * 32); }
#pragma unroll
                for (int k4 = 0; k4 < 4; ++k4) { f32x4 c = {0.f, 0.f, 0.f, 0.f};
#pragma unroll
                    for (int s = 0; s < 4; ++s) c = __builtin_amdgcn_mfma_f32_16x16x32_bf16(kf[k4][s], Qf[s], c, 0, 0, 0);
#pragma unroll
                    for (int r = 0; r < 4; ++r) lg[kg * 4 + k4][r] = c[r] * 0.08838834764831845f; }
            } else {
#pragma unroll
                for (int k4 = 0; k4 < 4; ++k4)
#pragma unroll
                    for (int r = 0; r < 4; ++r) lg[kg * 4 + k4][r] = -1e30f;
            }
        }
        float mx = -1e30f;
#pragma unroll
        for (int kb = 0; kb < 16; ++kb)
#pragma unroll
            for (int r = 0; r < 4; ++r) mx = fmaxf(mx, lg[kb][r]);
        mx = fmaxf(mx, __shfl_xor(mx, 16)); mx = fmaxf(mx, __shfl_xor(mx, 32));
        float sum = 0.f;
#pragma unroll
        for (int kb = 0; kb < 16; ++kb)
#pragma unroll
            for (int r = 0; r < 4; ++r) { const float e = (kb * 16 < nsel) ? __expf(lg[kb][r] - mx) : 0.f; lg[kb][r] = e; sum += e; }
        sum += __shfl_xor(sum, 16); sum += __shfl_xor(sum, 32);
        const float inv = 1.f / sum;
        bf16x8 Pa[8];
#pragma unroll
        for (int ks = 0; ks < 8; ++ks) {
            const unsigned a0 = pk2(lg[2 * ks][0] * inv, lg[2 * ks][1] * inv), a1 = pk2(lg[2 * ks][2] * inv, lg[2 * ks][3] * inv);
            const unsigned a2 = pk2(lg[2 * ks + 1][0] * inv, lg[2 * ks + 1][1] * inv), a3 = pk2(lg[2 * ks + 1][2] * inv, lg[2 * ks + 1][3] * inv);
            const u32x4 t_ = {a0, a1, a2, a3}; Pa[ks] = __builtin_bit_cast(bf16x8, t_); }
        bf16_t* Vs = (bf16_t*)(lds + wave * 10752);
        bf16_t* Os = Vs + 32 * 136;
        f32x4 oacc[8];
#pragma unroll
        for (int nb = 0; nb < 8; ++nb) oacc[nb] = (f32x4){0.f, 0.f, 0.f, 0.f};
        const bf16_t* Vb = V + (size_t)b * 2048 * 128 + hh * 8;
        u32x4 vq[8], vn[8];
#pragma unroll
        for (int jj = 0; jj < 8; ++jj) vn[jj] = (u32x4){0u, 0u, 0u, 0u};
#pragma unroll
        for (int jj = 0; jj < 8; ++jj) { const int idx = sq[jj * 4 + g4]; vq[jj] = *(const u32x4*)(Vb + (size_t)idx * 128); }
#define PV_BATCH(bt) do { if ((bt) * 32 < nsel) { \
            if (((bt) + 1) * 32 < nsel) { _Pragma("unroll") for (int jj = 0; jj < 8; ++jj) { const int idx = sq[((bt) + 1) * 32 + jj * 4 + g4]; vn[jj] = *(const u32x4*)(Vb + (size_t)idx * 128); } } \
            _Pragma("unroll") for (int jj = 0; jj < 8; ++jj) *(u32x4*)(Vs + (jj * 4 + g4) * 136 + hh * 8) = vq[jj]; \
            LDS_FENCE(); \
            _Pragma("unroll") for (int nb = 0; nb < 8; ++nb) { const bf16_t* vp = Vs + (4 * g4) * 136 + nb * 16 + hh; \
                const unsigned w0_ = (unsigned)vp[0 * 136] | ((unsigned)vp[1 * 136] << 16), w1_ = (unsigned)vp[2 * 136] | ((unsigned)vp[3 * 136] << 16); \
                const unsigned w2_ = (unsigned)vp[16 * 136] | ((unsigned)vp[17 * 136] << 16), w3_ = (unsigned)vp[18 * 136] | ((unsigned)vp[19 * 136] << 16); \
                const u32x4 t_ = {w0_, w1_, w2_, w3_}; \
                oacc[nb] = __builtin_amdgcn_mfma_f32_16x16x32_bf16(Pa[(bt)], __builtin_bit_cast(bf16x8, t_), oacc[nb], 0, 0, 0); } \
            LDS_FENCE(); \
            _Pragma("unroll") for (int jj = 0; jj < 8; ++jj) vq[jj] = vn[jj]; } } while (0)
        PV_BATCH(0); PV_BATCH(1); PV_BATCH(2); PV_BATCH(3); PV_BATCH(4); PV_BATCH(5); PV_BATCH(6); PV_BATCH(7);
#undef PV_BATCH
        if (g4 < 2) {
#pragma unroll
            for (int nb = 0; nb < 8; ++nb)
#pragma unroll
                for (int r = 0; r < 4; ++r) Os[(g4 * 4 + r) * 128 + nb * 16 + hh] = (bf16_t)f2bf(oacc[nb][r]);
        }
        LDS_FENCE();
#pragma unroll
        for (int h = 0; h < 2; ++h) { const uint4 ov = *(const uint4*)(Os + h * 512 + lane * 8); *(uint4*)(obase + row * ostride + h * 512 + lane * 8) = ov; }
        LDS_FENCE();
    }
}

__device__ __forceinline__ void phase_fix(const Args& a, int l, const int WV) {
    const int TI = fresh_tid(WV);
    const float* SA = (const float*)(a.ws + WS_SA); const float* SB = (const float*)(a.ws + WS_SB); bf16_t* act = (bf16_t*)(a.ws + WS_R2);
    const float* cw = a.in[I_CONVW] + (size_t)l * 3 * DFF; const float* cb = a.in[I_CONVB] + (size_t)l * DFF;
    const int total = 512 * 2 * DFF;
    for (int i = blockIdx.x * 512 + TI; i < total; i += gridDim.x * 512) {
        const int ch = i % DFF, rb = i / DFF, rr = rb & 1, blk = rb >> 1, r = blk * 64 + rr, t = r & 2047;
        const float a0 = SA[((size_t)blk * 4 + 2 + rr) * DFF + ch];
        float am1, am2;
        if (rr == 0) { am1 = (t >= 1) ? SA[((size_t)(blk - 1) * 4 + 1) * DFF + ch] : 0.f; am2 = (t >= 2) ? SA[((size_t)(blk - 1) * 4 + 0) * DFF + ch] : 0.f; }
        else { am1 = SA[((size_t)blk * 4 + 2) * DFF + ch]; am2 = (t >= 2) ? SA[((size_t)(blk - 1) * 4 + 1) * DFF + ch] : 0.f; }
        const float cv = cb[ch] + cw[ch] * am2 + cw[DFF + ch] * am1 + cw[2 * DFF + ch] * a0;
        act[(size_t)r * DFF + ch] = (bf16_t)f2bf(siluf_(cv) * SB[((size_t)blk * 2 + rr) * DFF + ch]);
    }
}

__device__ __forceinline__ void run_phase(const Args& a, int ph, unsigned char* lds, const int WV, const bool dummy) {
    unsigned char* ws = a.ws;
    LAS unsigned char* ldsl = (LAS unsigned char*)lds;
    const int G = gridDim.x, bx = blockIdx.x;
#ifndef DBG_NOADA
    if (ph == 0) { phase_ada(a, lds, WV); return; }
#else
    if (ph == 0) return;
#endif
    const int l = (ph - 1) / 10, sp = (ph - 1) % 10;
    const float* modl = (const float*)(ws + WS_MOD) + (size_t)l * 16 * 12288;
    const float* xin = (l == 0) ? a.in[I_X] : a.out;
#ifdef DBG_SP
    if (sp != DBG_SP) return;
#endif
    switch (sp) {
    case 0: phase_cvt(a, l, lds, WV); phase_norm(xin, a.in[I_GN1] + l * DM, modl, 0, 2048, (bf16_t*)(ws + WS_R1), WV); break;
    case 1: {
        pg8::Gemm g{(const bf16_t*)(ws + WS_R1), (const bf16_t*)(ws + W_1CAT), MROWS, N1, DM, DM, DM, 1 << 30, 0}; pg8::StaticOrder S; S.init(MROWS, N1, G, bx);
        Epi1 E{(bf16_t*)(ws + WS_OCAT), (bf16_t*)(ws + WS_KN), (bf16_t*)(ws + WS_V), (bf16_t*)(ws + WS_QI), (bf16_t*)(ws + WS_KI), (bf16_t*)(ws + WS_U), (bf16_t*)(ws + WS_P), (bf16_t*)(ws + WS_R2),
               (float*)(ws + WS_WI), a.in[I_BGATE] + (size_t)l * 3 * DM, ldsl + 131072};
        pg8::gemm_phase<Epi1, pg8::StaticOrder>(ldsl, g, S, E, WV); } break;
    case 2:
        if (!dummy) phase_post(a, l, lds, WV);
        __syncthreads();
        for (int u = bx; u < 512; u += G) s5_unit(a, l, u >> 5, u & 31, lds, WV);
        for (int u = bx; u < 512; u += G) pool_unit(a, u >> 5, u & 31, lds, WV);
        break;
    case 3: {
#ifndef DBG_NO_DSA
#ifdef DSA_PROBE
        for (int rep = 0; rep < 2; ++rep) { const bool dm = (rep == 0); const int parts = dm ? (DSA_PROBE) : 15;
#else
        { const bool dm = dummy; const int parts = 15;
#endif
            for (int u = bx; u < 2048; u += G) { const int w = u & 255, i = u >> 8, b = w & 15, s = w >> 4; const int tq = (i & 1) ? (i * 16 + 15 - s) : (i * 16 + s);
                dsa_unit(a, b, tq, lds, WV, dm ? (bf16_t*)(ws + WS_R1 + 64 * MiB) : (bf16_t*)(ws + WS_OCAT), dm ? 1024 : 2048, parts); }
        }
        __syncthreads();
#endif
#ifndef DBG_DSA_ONLY
        { pg8::Gemm g{(const bf16_t*)(ws + WS_Y), (const bf16_t*)(ws + W_GLU), MROWS, 1024, 512, 512, 512, 2, WS_POOLED - WS_Y}; pg8::StaticOrder S; S.init(MROWS, 1024, G, bx);
          EpiGluPool E{(const bf16_t*)(ws + WS_Y), a.in[I_PSCALE] + l * 512, (bf16_t*)(ws + WS_OCAT)}; pg8::gemm_phase<EpiGluPool, pg8::StaticOrder>(ldsl, g, S, E, WV); }
#endif
        } break;
    case 4: {
        pg8::Gemm g{(const bf16_t*)(ws + WS_OCAT), (const bf16_t*)(ws + W_P), MROWS, DM, DM, DM, DM, 1 << 30, 0}; pg8::StaticOrder S; S.init(MROWS, DM, G, bx);
        EpiMerge E{(const bf16_t*)(ws + WS_R2), (bf16_t*)(ws + WS_R1), ldsl + 131072}; pg8::gemm_phase<EpiMerge, pg8::StaticOrder>(ldsl, g, S, E, WV); } break;
    case 5: {
        pg8::Gemm g{(const bf16_t*)(ws + WS_R1), (const bf16_t*)(ws + W_OUT), MROWS, DM, DM, DM, DM, 1 << 30, 0}; pg8::StaticOrder S; S.init(MROWS, DM, G, bx);
        EpiRes E{xin, dummy ? (float*)(ws + WS_OCAT) : a.out, modl + 4096}; pg8::gemm_phase<EpiRes, pg8::StaticOrder>(ldsl, g, S, E, WV); } break;
    case 6: phase_norm(a.out, a.in[I_GN2] + l * DM, modl, 6144, 8192, (bf16_t*)(ws + WS_R1), WV); break;
    case 7: {
        pg8::Gemm g{(const bf16_t*)(ws + WS_R1), (const bf16_t*)(ws + W_UP), MROWS, 2 * DFF, DM, DM, DM, 1 << 30, 0}; pg8::StaticOrder S; S.init(MROWS, 2 * DFF, G, bx);
        EpiUp E{(bf16_t*)(ws + WS_R2), (float*)(ws + WS_SA), (float*)(ws + WS_SB), a.in[I_CONVW] + (size_t)l * 3 * DFF, a.in[I_CONVB] + (size_t)l * DFF, ldsl + 131072};
        pg8::gemm_phase<EpiUp, pg8::StaticOrder>(ldsl, g, S, E, WV); } break;
    case 8: phase_fix(a, l, WV); break;
    case 9: {
        pg8::Gemm g{(const bf16_t*)(ws + WS_R2), (const bf16_t*)(ws + W_DOWN), MROWS, DM, DFF, DFF, DFF, 1 << 30, 0}; pg8::StaticOrder S; S.init(MROWS, DM, G, bx);
        EpiRes E{a.out, dummy ? (float*)(ws + WS_OCAT) : a.out, modl + 10240}; pg8::gemm_phase<EpiRes, pg8::StaticOrder>(ldsl, g, S, E, WV); } break;
    }
}

#define XB_XCNT(j)  (256  + 64 * (j))
#define XB_XSUB(j)  (1280 + 64 * (j))
#define XB_XGEN(j)  (2304 + 64 * (j))
#define XB_TOP      3328
#define XB_TOPGEN   3392
#define XB_WORDS    3456
__device__ __forceinline__ unsigned xb_ld(unsigned* p)              { return __hip_atomic_load(p, __ATOMIC_RELAXED, __HIP_MEMORY_SCOPE_AGENT); }
__device__ __forceinline__ unsigned xb_add(unsigned* p, unsigned v) { return __hip_atomic_fetch_add(p, v, __ATOMIC_RELAXED, __HIP_MEMORY_SCOPE_AGENT); }
__device__ __forceinline__ unsigned xb_xcc_id() { return (unsigned)__builtin_amdgcn_s_getreg((3 << 11) | 20) & 0xFu; }
#define XB_SPIN(cond) do { unsigned _sp = 0; while (cond) { __builtin_amdgcn_s_sleep(1); if (++_sp > (1u << 22)) break; } } while (0)
__device__ __forceinline__ void grid_bar(unsigned* bar, volatile LAS unsigned* st, int wave_id) {
    asm volatile("s_waitcnt vmcnt(0) lgkmcnt(0)" ::: "memory");
    __syncthreads();
    if (wave_id == 0) {
        const int l = (int)__builtin_amdgcn_mbcnt_hi(~0u, __builtin_amdgcn_mbcnt_lo(~0u, 0u));
        if (l == 0) {
            const unsigned x = xb_xcc_id();
            unsigned nloc = st[0], nx = st[1];
            if (nloc == 0u) {
                const unsigned G = gridDim.x; unsigned sum, cnt, mine, sp = 0u;
                for (;;) { sum = 0u; cnt = 0u; mine = 0u;
#pragma unroll
                    for (unsigned j = 0; j < 16; ++j) { const unsigned c = xb_ld(&bar[XB_XCNT(j)]); sum += c; cnt += (c > 0u) ? 1u : 0u; mine = (j == x) ? c : mine; }
                    if (sum == G) break;
                    __builtin_amdgcn_s_sleep(1); if (++sp > (1u << 22)) break; }
                nloc = mine > 0u ? mine : 1u; nx = cnt > 0u ? cnt : 1u; st[0] = nloc; st[1] = nx;
            }
            const unsigned old = xb_add(&bar[XB_XSUB(x)], 1u);
            const unsigned gen = old / nloc;
            if (old + 1u == (gen + 1u) * nloc) {
                __builtin_amdgcn_fence(__ATOMIC_RELEASE, "agent");
                asm volatile("s_waitcnt vmcnt(0)" ::: "memory");
                const unsigned og = xb_add(&bar[XB_TOP], 1u);
                const unsigned tg = og / nx;
                if (og + 1u == (tg + 1u) * nx) xb_add(&bar[XB_TOPGEN], 1u);
                else XB_SPIN(xb_ld(&bar[XB_TOPGEN]) == tg);
                __builtin_amdgcn_fence(__ATOMIC_ACQUIRE, "agent");
                xb_add(&bar[XB_XGEN(x)], 1u);
                asm volatile("s_waitcnt vmcnt(0)" ::: "memory");
            } else {
                XB_SPIN(xb_ld(&bar[XB_XGEN(x)]) == gen);
                __builtin_amdgcn_fence(__ATOMIC_ACQUIRE, "agent");
                asm volatile("s_waitcnt vmcnt(0)" ::: "memory");
            }
        }
    }
    __syncthreads();
}

__global__ void __launch_bounds__(512, 2) mega_fwd(Args a) {
    extern __shared__ __attribute__((aligned(16))) unsigned char lds[];
    cg::grid_group grid = cg::this_grid();
    const int wave_id = __builtin_amdgcn_readfirstlane((int)(threadIdx.x >> 6));
    const int ph_lo = a.ph_lo, ph_hi = a.ph_hi;
    volatile LAS unsigned* xst = (volatile LAS unsigned*)((LAS unsigned char*)lds + 163776);
    if (threadIdx.x == 0) { xst[0] = 0u; xst[1] = 0u; (void)xb_add((unsigned*)(__attribute__((address_space(1))) unsigned*)a.ws + XB_XCNT(xb_xcc_id()), 1u); }
    __syncthreads();
    for (int ph = ph_lo; ph < ph_hi; ++ph) {
        const __attribute__((address_space(4))) Args* kp = (const __attribute__((address_space(4))) Args*)__builtin_amdgcn_kernarg_segment_ptr();
        asm volatile("" : "+s"(kp));
        Args la;
#pragma unroll
        for (int i = 0; i < 31; ++i) la.in[i] = (const float*)(const __attribute__((address_space(1))) float*)kp->in[i];
        la.ws = (unsigned char*)(__attribute__((address_space(1))) unsigned char*)kp->ws;
        la.out = (float*)(__attribute__((address_space(1))) float*)kp->out;
        la.ph_lo = ph_lo; la.ph_hi = ph_hi;
#ifdef REP_MASK
        if (ph > 0 && ((REP_MASK >> ((ph - 1) % 10)) & 1)) { run_phase(la, ph, lds, wave_id, true); grid.sync(); }
#endif
        run_phase(la, ph, lds, wave_id, false);
        if (ph + 1 < ph_hi) {
            if (ph == ph_lo) grid.sync();
            else grid_bar((unsigned*)la.ws, xst, wave_id);
        }
    }
}

extern "C" void kernel_launch(void* const* d_in, const int* in_sizes, int n_in, void* d_out, int out_size, void* d_ws, size_t ws_size, hipStream_t stream) {
    static int grid = 0;
    if (grid == 0) {
        int dev = 0, cus = 0, per_cu = 0;
        if (n_in != 31 || ws_size < WS_END) { fprintf(stderr, "kernel_launch: unexpected n_in %d / ws %zu\n", n_in, ws_size); grid = -1; return; }
        hipGetDevice(&dev); hipDeviceGetAttribute(&cus, hipDeviceAttributeMultiprocessorCount, dev);
        if (hipFuncSetAttribute((const void*)mega_fwd, hipFuncAttributeMaxDynamicSharedMemorySize, LDS_BYTES) != hipSuccess) { fprintf(stderr, "kernel_launch: hipFuncSetAttribute failed\n"); grid = -1; return; }
        if (hipOccupancyMaxActiveBlocksPerMultiprocessor(&per_cu, (const void*)mega_fwd, 512, LDS_BYTES) != hipSuccess || per_cu < 1) { fprintf(stderr, "kernel_launch: occupancy query says %d blocks/CU\n", per_cu); per_cu = 1; }
        (void)hipGetLastError();
        grid = cus > 0 ? cus : 256;
    }
    if (grid < 0) return;
    if (hipMemsetAsync(d_ws, 0, 16384, stream) != hipSuccess) { fprintf(stderr, "kernel_launch: memset of the barrier word failed\n"); return; }
    Args a{};
    for (int i = 0; i < 31; ++i) a.in[i] = (const float*)d_in[i];
    a.out = (float*)d_out; a.ws = (unsigned char*)d_ws;
#if MK_PER_PHASE
    for (int ph = 0; ph < NPHASE; ++ph) {
        a.ph_lo = ph; a.ph_hi = ph + 1;
        void* args[] = {&a};
        hipError_t e = hipLaunchCooperativeKernel((const void*)mega_fwd, dim3(grid), dim3(512), args, LDS_BYTES, stream);
        if (e != hipSuccess) { fprintf(stderr, "kernel_launch: launch of phase %d failed: %s\n", ph, hipGetErrorString(e)); break; }
    }
#else
    a.ph_lo = 0; a.ph_hi = NPHASE;
    void* args[] = {&a};
    hipError_t e = hipLaunchCooperativeKernel((const void*)mega_fwd, dim3(grid), dim3(512), args, LDS_BYTES, stream);
    if (e != hipSuccess) fprintf(stderr, "kernel_launch: cooperative launch failed: %s (grid %d)\n", hipGetErrorString(e), grid);
#endif
}
```

```cpp
#include <hip/hip_runtime.h>
#include <hip/hip_cooperative_groups.h>
#include <cstdio>
#include <cstdint>
namespace cg = cooperative_groups;

#ifndef MK_PER_PHASE
#define MK_PER_PHASE 0
#endif

typedef unsigned short bf16_t;
typedef short bf16x8 __attribute__((ext_vector_type(8)));
typedef float f32x4 __attribute__((ext_vector_type(4)));
typedef float f32x2 __attribute__((ext_vector_type(2)));
typedef float f32x16 __attribute__((ext_vector_type(16)));
typedef unsigned u32x4 __attribute__((ext_vector_type(4)));
typedef unsigned u32x2 __attribute__((ext_vector_type(2)));
#define LAS __attribute__((address_space(3)))

constexpr int BATCH = 16, SEQ = 2048, DM = 2048, MROWS = BATCH * SEQ, DIN = 2888, DFF = 5504;
constexpr int N1 = 9216;
constexpr float EPS = 1e-6f;
constexpr int NPHASE = 21;

constexpr size_t MiB = 1u << 20;
constexpr size_t WS_MOD = 1 * MiB;
constexpr size_t WS_WI = 3 * MiB;
constexpr size_t WS_W = 4 * MiB;
constexpr size_t W_1CAT = WS_W, W_P = WS_W + 36 * MiB, W_OUT = WS_W + 44 * MiB, W_UP = WS_W + 52 * MiB, W_DOWN = WS_W + 95 * MiB,
                 W_GLU = WS_W + 116 * MiB + MiB / 2, W_POOL = WS_W + 117 * MiB;
constexpr size_t WS_R1 = 122 * MiB;
constexpr size_t WS_Y = WS_R1, WS_POOLED = WS_R1 + 32 * MiB;
constexpr size_t WS_R2 = 250 * MiB;
constexpr size_t WS_OCAT = 634 * MiB;
constexpr size_t WS_SA = WS_OCAT, WS_SB = WS_OCAT + 44 * MiB;
constexpr size_t WS_KN = 762 * MiB, WS_V = 770 * MiB, WS_QI = 778 * MiB, WS_KI = 810 * MiB, WS_U = 814 * MiB, WS_P = 846 * MiB, WS_END = 878 * MiB;
constexpr int LDS_BYTES = 163840;

__device__ __forceinline__ unsigned f2bf(float f) { unsigned u = __float_as_uint(f); return (u + 0x7fffu + ((u >> 16) & 1u)) >> 16; }
__device__ __forceinline__ unsigned pk2(float lo, float hi) { return f2bf(lo) | (f2bf(hi) << 16); }
__device__ __forceinline__ float bflo(unsigned u) { return __uint_as_float(u << 16); }
__device__ __forceinline__ float bfhi(unsigned u) { return __uint_as_float(u & 0xffff0000u); }
__device__ __forceinline__ float bf1(bf16_t b) { return __uint_as_float(((unsigned)b) << 16); }
__device__ __forceinline__ float sigmoidf_(float x) { return 1.f / (1.f + __expf(-x)); }
__device__ __forceinline__ float siluf_(float x) { return x / (1.f + __expf(-x)); }
__device__ __forceinline__ float gelu_tanh(float x) { const float z = 0.7978845608028654f * (x + 0.044715f * x * x * x); const float t = 1.f - 2.f / (1.f + __expf(2.f * z)); return 0.5f * x * (1.f + t); }
__device__ __forceinline__ uint4 pack8(f32x4 a, f32x4 b) { uint4 r; r.x = pk2(a[0], a[1]); r.y = pk2(a[2], a[3]); r.z = pk2(b[0], b[1]); r.w = pk2(b[2], b[3]); return r; }
__device__ __forceinline__ void unpack8(uint4 v, float* f) { f[0] = bflo(v.x); f[1] = bfhi(v.x); f[2] = bflo(v.y); f[3] = bfhi(v.y); f[4] = bflo(v.z); f[5] = bfhi(v.z); f[6] = bflo(v.w); f[7] = bfhi(v.w); }
#define LDS_FENCE() asm volatile("s_waitcnt lgkmcnt(0)" ::: "memory")
__device__ __forceinline__ int fresh_tid(int wv) { int l = (int)__builtin_amdgcn_mbcnt_hi(~0u, __builtin_amdgcn_mbcnt_lo(~0u, 0u)); asm volatile("" : "+v"(l)); return (wv << 6) | l; }

namespace pg8 {
constexpr int BM = 256, BK = 64, HALF = 128, HTB = HALF * BK * 2, STAGE_BYTES = 8 * HTB, NXCD = 8, WGM = 8;
__host__ __device__ __forceinline__ int lds_byte(int r, int c) { const int st = (r >> 4) * 2 + (c >> 5), rr = r & 15, cc = c & 31, ob = rr * 64 + cc * 2; return st * 1024 + (ob ^ (((ob >> 9) & 1) << 5)); }
__host__ __device__ __forceinline__ void stage_rc(int b, int& R, int& C) { const int st = b / 1024, sb = b % 1024, swz = sb ^ (((sb >> 9) & 1) << 5); R = (st >> 1) * 16 + swz / 64; C = (st & 1) * 32 + (swz % 64) / 2; }
__host__ __device__ __forceinline__ int perm32(int rho) { const int n = rho >> 4, i = rho & 15; return 8 * (i >> 2) + 4 * n + (i & 3); }
struct Unit { int pm, pn; };
struct Gemm { const bf16_t* A; const bf16_t* Bt; int M, N, K, lda, ldb; int asplit; size_t aoff; };
struct StaticOrder {
    int nM, nN, nwg, G, c;
    __device__ void init(int M, int N, int G_, int c_) { nM = M / BM; nN = N / BM; nwg = nM * nN; G = G_; c = c_; }
    __device__ bool next(int i, Unit& u) const {
        const long L = (long)i * G + c; if (L >= nwg) return false;
        int wgid = (int)L; { const int q = nwg / NXCD, r = nwg % NXCD, xcd = wgid % NXCD, off = wgid / NXCD; wgid = (xcd < r ? xcd * (q + 1) : r * (q + 1) + (xcd - r) * q) + off; }
        const int nig = WGM * nN, gid = wgid / nig, fm = gid * WGM, gsz = (nM - fm) < WGM ? (nM - fm) : WGM;
        u.pm = fm + ((wgid % nig) % gsz); u.pn = (wgid % nig) / gsz; return true;
    }
};
template <class Epi, class Sched>
__device__ __forceinline__ void gemm_phase(LAS unsigned char* lds, const Gemm g, const Sched& S, const Epi& E, const int WV) {
    const int TI = fresh_tid(WV);
    const int tid = TI, wid = __builtin_amdgcn_readfirstlane(tid >> 6), lane = tid & 63, wr = wid >> 2, wc = wid & 3, fr = lane & 15, fq = lane >> 4;
    const int K = g.K, nt = K / BK;
    unsigned voffA[2], voffB[2];
#pragma unroll
    for (int i = 0; i < 2; ++i) { int R, C; stage_rc(tid * 16 + i * 8192, R, C); const int Rb = Epi::PERM ? ((R & ~31) + perm32(R & 31)) : R;
        voffA[i] = (unsigned)(R * g.lda + C) * 2u; voffB[i] = (unsigned)(Rb * g.ldb + C) * 2u; }
    const size_t kstep = (size_t)(BK * 2);
    const size_t hstepA = (size_t)HALF * g.lda * 2, hstepB = (size_t)HALF * g.ldb * 2;
    const size_t tstepA = 2 * hstepA, tstepB = 2 * hstepB;
    const unsigned ldsw = (unsigned)wid * 1024u;
    const int aoff = lds_byte(wr * 64 + fr, fq * 8), boff = lds_byte(wc * 32 + fr, fq * 8);
#define PG8_SA(b, h) (((b) * 2 + (h)) * HTB)
#define PG8_SB(b, h) ((4 + (b) * 2 + (h)) * HTB)
#define PG8_STAGE(bufoff, gbase, voff) do { _Pragma("unroll") for (int _i = 0; _i < 2; ++_i) \
        __builtin_amdgcn_global_load_lds((const unsigned*)((const char*)(gbase) + (voff)[_i]), (LAS unsigned*)(lds + (bufoff) + ldsw + _i * 8192), 16, 0, 0); } while (0)
#define PG8_LDA(dst, b, h) do { _Pragma("unroll") for (int m = 0; m < 4; ++m) _Pragma("unroll") for (int k = 0; k < 2; ++k) dst[m][k] = *(const LAS bf16x8*)(lds + PG8_SA(b, h) + aoff + m * 2048 + k * 1024); } while (0)
#define PG8_LDB(dst, b, h) do { _Pragma("unroll") for (int n = 0; n < 2; ++n) _Pragma("unroll") for (int k = 0; k < 2; ++k) dst[n][k] = *(const LAS bf16x8*)(lds + PG8_SB(b, h) + boff + n * 2048 + k * 1024); } while (0)
#define PG8_MMA(ai, bj, At, Bt) do { __builtin_amdgcn_s_setprio(1); _Pragma("unroll") for (int m = 0; m < 4; ++m) _Pragma("unroll") for (int n = 0; n < 2; ++n) _Pragma("unroll") for (int k = 0; k < 2; ++k) \
        acc[ai][bj][m][n] = __builtin_amdgcn_mfma_f32_16x16x32_bf16(Bt[n][k], At[m][k], acc[ai][bj][m][n], 0, 0, 0); __builtin_amdgcn_s_setprio(0); } while (0)
#define PG8_WAIT_V(n) asm volatile("s_waitcnt vmcnt(" #n ")" ::: "memory")
#define PG8_WAIT_L(n) asm volatile("s_waitcnt lgkmcnt(" #n ")" ::: "memory")
#define PG8_BAR __builtin_amdgcn_s_barrier()
#define PG8_SCHED __builtin_amdgcn_sched_barrier(0)
#define PG8_ZERO() do { _Pragma("unroll") for (int a_ = 0; a_ < 2; ++a_) _Pragma("unroll") for (int b_ = 0; b_ < 2; ++b_) _Pragma("unroll") for (int m_ = 0; m_ < 4; ++m_) _Pragma("unroll") for (int n_ = 0; n_ < 2; ++n_) acc[a_][b_][m_][n_] = (f32x4){0.f, 0.f, 0.f, 0.f}; } while (0)
    Unit cur, nxt; int ui = 0;
    if (!S.next(0, cur)) return;
    f32x4 acc[2][2][4][2];
    PG8_ZERO();
    bf16x8 At[4][2], B0[2][2], B1[2][2];
    const char* cA = (const char*)g.A + (size_t)cur.pm * tstepA + (cur.pn >= g.asplit ? g.aoff : (size_t)0); const char* cB = (const char*)g.Bt + (size_t)cur.pn * tstepB;
    PG8_STAGE(PG8_SB(0, 0), cB, voffB); PG8_STAGE(PG8_SB(0, 1), cB + hstepB, voffB); PG8_STAGE(PG8_SA(0, 0), cA, voffA); PG8_STAGE(PG8_SA(0, 1), cA + hstepA, voffA);
    if (wr == 1) PG8_BAR;
    PG8_WAIT_V(2); PG8_BAR;
    PG8_STAGE(PG8_SB(1, 0), cB + kstep, voffB); PG8_STAGE(PG8_SA(1, 0), cA + kstep, voffA); PG8_STAGE(PG8_SB(1, 1), cB + hstepB + kstep, voffB);
    PG8_WAIT_V(6); PG8_BAR;
    for (;;) {
        const bool has_next = S.next(ui + 1, nxt);
        const char* nA = has_next ? (const char*)g.A + (size_t)nxt.pm * tstepA + (nxt.pn >= g.asplit ? g.aoff : (size_t)0) : cA; const char* nB = has_next ? (const char*)g.Bt + (size_t)nxt.pn * tstepB : cB;
        for (int t = 0; t < nt; t += 2) {
            const bool last = (t == nt - 2);
            const char* a1 = cA + (size_t)(t + 1) * kstep;
            const char* a2 = last ? nA : cA + (size_t)(t + 2) * kstep; const char* b2 = last ? nB : cB + (size_t)(t + 2) * kstep;
            const char* a3 = a2 + kstep; const char* b3 = b2 + kstep;
            PG8_LDB(B0, 0, 0); PG8_LDB(B1, 0, 1); PG8_SCHED; PG8_LDA(At, 0, 0); PG8_STAGE(PG8_SA(1, 1), a1 + hstepA, voffA);
            PG8_WAIT_V(8); PG8_WAIT_L(0); PG8_BAR; PG8_MMA(0, 0, At, B0); PG8_MMA(0, 1, At, B1); PG8_BAR; PG8_SCHED;
            PG8_LDA(At, 0, 1); PG8_STAGE(PG8_SB(0, 0), b2, voffB); PG8_STAGE(PG8_SB(0, 1), b2 + hstepB, voffB); PG8_STAGE(PG8_SA(0, 0), a2, voffA);
            PG8_WAIT_V(8); PG8_WAIT_L(0); PG8_BAR; PG8_MMA(1, 0, At, B0); PG8_MMA(1, 1, At, B1); PG8_BAR; PG8_SCHED;
            PG8_LDB(B0, 1, 0); PG8_LDB(B1, 1, 1); PG8_SCHED; PG8_LDA(At, 1, 0); PG8_STAGE(PG8_SA(0, 1), a2 + hstepA, voffA);
            PG8_WAIT_V(8); PG8_WAIT_L(0); PG8_BAR; PG8_MMA(0, 0, At, B0); PG8_MMA(0, 1, At, B1); PG8_BAR; PG8_SCHED;
            PG8_LDA(At, 1, 1); PG8_STAGE(PG8_SB(1, 0), b3, voffB); PG8_STAGE(PG8_SB(1, 1), b3 + hstepB, voffB); PG8_STAGE(PG8_SA(1, 0), a3, voffA);
            PG8_WAIT_V(8); PG8_WAIT_L(0); PG8_BAR; PG8_MMA(1, 0, At, B0); PG8_MMA(1, 1, At, B1); PG8_BAR; PG8_SCHED;
            if constexpr (Epi::SEG) { if (t + 2 == 16 || t + 2 == 24) { E.flush(acc, cur, (t + 2 == 16) ? 0 : 1, wr, wc, fr, fq); PG8_ZERO(); } }
        }
        if (wr == 0) PG8_BAR;
        if constexpr (Epi::SEG) E.flush(acc, cur, 2, wr, wc, fr, fq); else E(acc, cur, wr, wc, fr, fq);
        if (!has_next) break;
        PG8_ZERO();
        cur = nxt; cA = nA; cB = nB; ++ui;
        if (wr == 1) PG8_BAR;
    }
    PG8_WAIT_V(0);
    PG8_BAR;
#undef PG8_SA
#undef PG8_SB
#undef PG8_STAGE
#undef PG8_LDA
#undef PG8_LDB
#undef PG8_MMA
#undef PG8_WAIT_V
#undef PG8_WAIT_L
#undef PG8_BAR
#undef PG8_SCHED
#undef PG8_ZERO
}
}
using pg8::Unit;
typedef const f32x4 (&AccRef)[2][2][4][2];

struct Epi1 {
    static constexpr bool PERM = true, SEG = false;
    bf16_t *ocat, *kn, *vv, *qi, *ki, *u, *p, *gates; float* wi; const float* bgate; LAS unsigned char* stg;
    __device__ __forceinline__ void operator()(AccRef acc, const Unit& un, int wr, int wc, int fr, int fq) const {
        asm volatile("" : "+v"(fr), "+v"(fq));
        const int pn = un.pn, rowb = un.pm * 256 + wr * 64, lane = fq * 16 + fr;
        LAS unsigned char* sb = stg + (wr * 4 + wc) * 2304;
        if (pn == 7 && wc >= 1) {
            if (wc == 1 && fq == 0) {
                const float s = 0.35355339059327373f * 0.125f;
#pragma unroll
                for (int ai = 0; ai < 2; ++ai)
#pragma unroll
                    for (int m = 0; m < 4; ++m) { const size_t row = (size_t)(rowb + ai * 128 + m * 16 + fr);
                        *(f32x4*)(wi + row * 8) = acc[ai][0][m][0] * s; *(f32x4*)(wi + row * 8 + 4) = acc[ai][0][m][1] * s; }
            }
            return;
        }
        if (pn >= 12) {
            const int c0 = (pn - 12) * 256 + 64 * wc;
            f32x4 bz[2][2];
#pragma unroll
            for (int bj = 0; bj < 2; ++bj) { bz[bj][0] = *(const f32x4*)(bgate + c0 + 32 * bj + 8 * fq); bz[bj][1] = *(const f32x4*)(bgate + c0 + 32 * bj + 8 * fq + 4); }
            unsigned char* gb = (unsigned char*)gates + c0;
#pragma unroll
            for (int ai = 0; ai < 2; ++ai)
#pragma unroll
                for (int m = 0; m < 4; ++m) {
#pragma unroll
                    for (int bj = 0; bj < 2; ++bj) { uint2 q; unsigned w[2];
#pragma unroll
                        for (int n = 0; n < 2; ++n) { unsigned t = 0u;
#pragma unroll
                            for (int e = 0; e < 4; ++e) t |= (unsigned)(sigmoidf_(acc[ai][bj][m][n][e] + bz[bj][n][e]) * 255.f + 0.5f) << (8 * e);
                            w[n] = t; }
                        q.x = w[0]; q.y = w[1];
                        *(LAS u32x2*)(sb + fr * 80 + 32 * bj + 8 * fq) = (u32x2){q.x, q.y}; }
                    LDS_FENCE();
                    { const int r = lane >> 2, sg = lane & 3; const u32x4 v = *(const LAS u32x4*)(sb + r * 80 + sg * 16);
                      *(u32x4*)(gb + (size_t)(rowb + ai * 128 + m * 16 + r) * 6144 + sg * 16) = v; }
                    LDS_FENCE();
                }
            return;
        }
        bf16_t* base; int ld;
        if (pn < 4) { base = ocat + pn * 256 + 64 * wc; ld = 2048; }
        else if (pn == 4) { base = (wc < 2 ? kn : vv) + 64 * (wc & 1); ld = 128; }
        else if (pn < 7) { base = qi + (pn - 5) * 256 + 64 * wc; ld = 512; }
        else if (pn == 7) { base = ki; ld = 64; }
        else if (pn < 10) { base = u + (pn - 8) * 256 + 64 * wc; ld = 512; }
        else { base = p + (pn - 10) * 256 + 64 * wc; ld = 512; }
#pragma unroll
        for (int ai = 0; ai < 2; ++ai)
#pragma unroll
            for (int m = 0; m < 4; ++m) {
#pragma unroll
                for (int bj = 0; bj < 2; ++bj) { const uint4 pk_ = pack8(acc[ai][bj][m][0], acc[ai][bj][m][1]); *(LAS u32x4*)(sb + fr * 144 + 64 * bj + 16 * fq) = (u32x4){pk_.x, pk_.y, pk_.z, pk_.w}; }
                LDS_FENCE();
#pragma unroll
                for (int h = 0; h < 2; ++h) { const int r = h * 8 + (lane >> 3), sg = lane & 7; const u32x4 v = *(const LAS u32x4*)(sb + r * 144 + sg * 16);
                    *(u32x4*)(base + (size_t)(rowb + ai * 128 + m * 16 + r) * ld + sg * 8) = v; }
                LDS_FENCE();
            }
    }
};
struct EpiGluPool {
    static constexpr bool PERM = true, SEG = false;
    const bf16_t* y; const float* scale; bf16_t* ocat;
    __device__ __forceinline__ void operator()(AccRef acc, const Unit& un, int wr, int wc, int fr, int fq) const {
        asm volatile("" : "+v"(fr), "+v"(fq));
        const int row0 = un.pm * 256 + wr * 64 + fr; const bool glu = un.pn < 2;
#pragma unroll
        for (int bj = 0; bj < 2; ++bj) { const int col = (un.pn & 1) * 256 + 64 * wc + 32 * bj + 8 * fq;
            f32x4 s0 = {0.f, 0.f, 0.f, 0.f}, s1 = {0.f, 0.f, 0.f, 0.f};
            if (!glu) { s0 = *(const f32x4*)(scale + col); s1 = *(const f32x4*)(scale + col + 4); }
#pragma unroll
            for (int ai = 0; ai < 2; ++ai) {
                uint4 yq[4];
                if (glu) {
#pragma unroll
                    for (int m = 0; m < 4; ++m) yq[m] = *(const uint4*)(y + (size_t)(row0 + ai * 128 + m * 16) * 512 + col); }
#pragma unroll
                for (int m = 0; m < 4; ++m) { const size_t row = (size_t)(row0 + ai * 128 + m * 16);
                    f32x4 v0 = acc[ai][bj][m][0], v1 = acc[ai][bj][m][1];
                    if (glu) { float yv[8]; unpack8(yq[m], yv);
#pragma unroll
                        for (int e = 0; e < 4; ++e) { v0[e] = yv[e] * sigmoidf_(v0[e]); v1[e] = yv[4 + e] * sigmoidf_(v1[e]); }
                        *(uint4*)(ocat + row * 2048 + 1024 + col) = pack8(v0, v1);
                    } else *(uint4*)(ocat + row * 2048 + 1536 + col) = pack8(v0 * s0, v1 * s1); } } }
    }
};
struct EpiMerge {
    static constexpr bool PERM = true, SEG = true;
    const bf16_t* gates; bf16_t* merged; LAS unsigned char* stg;
    __device__ __forceinline__ void flush(AccRef acc, const Unit& un, int seg, int wr, int wc, int fr, int fq) const {
        asm volatile("" : "+v"(fr), "+v"(fq));
        const int rowb = un.pm * 256 + wr * 64, lane = fq * 16 + fr;
        const int colw = un.pn * 256 + 64 * wc;
        LAS unsigned char* sb = stg + (wr * 4 + wc) * 2304;
#pragma unroll
        for (int ai = 0; ai < 2; ++ai) {
            uint2 gq[2][4]; uint4 pq[2][4];
#pragma unroll
            for (int bj = 0; bj < 2; ++bj)
#pragma unroll
                for (int m = 0; m < 4; ++m) { const size_t row = (size_t)(rowb + ai * 128 + m * 16 + fr); const int col = colw + 32 * bj + 8 * fq;
                    gq[bj][m] = *(const uint2*)((const unsigned char*)gates + row * 6144 + seg * 2048 + col);
                    if (seg > 0) pq[bj][m] = *(const uint4*)(merged + row * 2048 + col); else pq[bj][m] = make_uint4(0u, 0u, 0u, 0u); }
#pragma unroll
            for (int m = 0; m < 4; ++m) {
#pragma unroll
                for (int bj = 0; bj < 2; ++bj) {
                    float gv[8], pv[8]; unpack8(pq[bj][m], pv);
#pragma unroll
                    for (int e = 0; e < 4; ++e) { gv[e] = (float)((gq[bj][m].x >> (8 * e)) & 0xffu) * (1.f / 255.f); gv[4 + e] = (float)((gq[bj][m].y >> (8 * e)) & 0xffu) * (1.f / 255.f); }
                    f32x4 v0 = acc[ai][bj][m][0], v1 = acc[ai][bj][m][1];
#pragma unroll
                    for (int e = 0; e < 4; ++e) { v0[e] = pv[e] + gv[e] * v0[e]; v1[e] = pv[4 + e] + gv[4 + e] * v1[e]; }
                    const uint4 pk_ = pack8(v0, v1); *(LAS u32x4*)(sb + fr * 144 + 64 * bj + 16 * fq) = (u32x4){pk_.x, pk_.y, pk_.z, pk_.w}; }
                LDS_FENCE();
#pragma unroll
                for (int h = 0; h < 2; ++h) { const int r = h * 8 + (lane >> 3), sg = lane & 7; const u32x4 v = *(const LAS u32x4*)(sb + r * 144 + sg * 16);
                    *(u32x4*)(merged + (size_t)(rowb + ai * 128 + m * 16 + r) * 2048 + colw + sg * 8) = v; }
                LDS_FENCE();
            }
        }
    }
};
struct EpiRes {
    static constexpr bool PERM = false, SEG = false;
    const float* xin; float* out; const float* gt;
    __device__ __forceinline__ void operator()(AccRef acc, const Unit& un, int wr, int wc, int fr, int fq) const {
        asm volatile("" : "+v"(fr), "+v"(fq));
        const int row0 = un.pm * 256 + wr * 64 + fr; const float* g = gt + (size_t)(un.pm >> 3) * 12288;
#pragma unroll
        for (int bj = 0; bj < 2; ++bj) { const int col = un.pn * 256 + bj * 128 + wc * 32 + 4 * fq;
            f32x4 gv[2], xv[2][2][4];
#pragma unroll
            for (int n = 0; n < 2; ++n) gv[n] = *(const f32x4*)(g + col + 16 * n);
#pragma unroll
            for (int n = 0; n < 2; ++n)
#pragma unroll
                for (int ai = 0; ai < 2; ++ai)
#pragma unroll
                    for (int m = 0; m < 4; ++m) xv[n][ai][m] = *(const f32x4*)(xin + (size_t)(row0 + ai * 128 + m * 16) * 2048 + col + 16 * n);
#pragma unroll
            for (int n = 0; n < 2; ++n)
#pragma unroll
                for (int ai = 0; ai < 2; ++ai)
#pragma unroll
                    for (int m = 0; m < 4; ++m) *(f32x4*)(out + (size_t)(row0 + ai * 128 + m * 16) * 2048 + col + 16 * n) = xv[n][ai][m] + gv[n] * acc[ai][bj][m][n]; }
    }
};
struct EpiUp {
    static constexpr bool PERM = true, SEG = false;
    bf16_t* act; float* SA; float* SB; const float* cw; const float* cb; LAS unsigned char* stg;
    __device__ __forceinline__ void operator()(AccRef acc, const Unit& un, int wr, int wc, int fr, int fq) const {
        asm volatile("" : "+v"(fr), "+v"(fq));
        const int lg = fq << 4, lane = lg | fr;
        const int src1 = lg | ((fr + 15) & 15), src2 = lg | ((fr + 14) & 15);
        const int ch0 = un.pn * 128 + wc * 32 + 8 * fq;
        LAS unsigned char* sb = stg + (wr * 4 + wc) * 2304;
        f32x4 w0[2], w1[2], w2[2], bb[2];
#pragma unroll
        for (int n = 0; n < 2; ++n) { w0[n] = *(const f32x4*)(cw + ch0 + 4 * n); w1[n] = *(const f32x4*)(cw + DFF + ch0 + 4 * n); w2[n] = *(const f32x4*)(cw + 2 * DFF + ch0 + 4 * n); bb[n] = *(const f32x4*)(cb + ch0 + 4 * n); }
#pragma unroll
        for (int ai = 0; ai < 2; ++ai) {
            const int rowb = un.pm * 256 + ai * 128 + wr * 64; const int blk = rowb >> 6;
#pragma unroll
            for (int m = 0; m < 4; ++m) {
                f32x4 res[2];
#pragma unroll
                for (int n = 0; n < 2; ++n)
#pragma unroll
                    for (int e = 0; e < 4; ++e) {
                        const float cur = acc[ai][0][m][n][e];
                        const float prv = (m > 0) ? acc[ai][0][m > 0 ? m - 1 : 0][n][e] : 0.f;
                        const float p1 = __shfl((fr + 1 >= 16) ? prv : cur, src1);
                        const float p2 = __shfl((fr + 2 >= 16) ? prv : cur, src2);
                        const float cv = bb[n][e] + w0[n][e] * p2 + w1[n][e] * p1 + w2[n][e] * cur;
                        res[n][e] = siluf_(cv) * acc[ai][1][m][n][e];
                    }
                if (m == 0 && fr < 2) {
                    float* sa = SA + ((size_t)(blk * 4 + 2 + fr)) * DFF + ch0; float* sbp = SB + ((size_t)(blk * 2 + fr)) * DFF + ch0;
                    *(f32x4*)sa = acc[ai][0][0][0]; *(f32x4*)(sa + 4) = acc[ai][0][0][1];
                    *(f32x4*)sbp = acc[ai][1][0][0]; *(f32x4*)(sbp + 4) = acc[ai][1][0][1];
                }
                if (m == 3 && fr >= 14) { float* sa = SA + ((size_t)(blk * 4 + (fr - 14))) * DFF + ch0; *(f32x4*)sa = acc[ai][0][3][0]; *(f32x4*)(sa + 4) = acc[ai][0][3][1]; }
                { const uint4 pk_ = pack8(res[0], res[1]); *(LAS u32x4*)(sb + fr * 80 + 16 * fq) = (u32x4){pk_.x, pk_.y, pk_.z, pk_.w}; }
                LDS_FENCE();
                { const int r = lane >> 2, sg = lane & 3; const u32x4 v = *(const LAS u32x4*)(sb + r * 80 + sg * 16);
                  if (!(m == 0 && r < 2)) *(u32x4*)(act + (size_t)(rowb + m * 16 + r) * DFF + un.pn * 128 + wc * 32 + sg * 8) = v; }
                LDS_FENCE();
            }
        }
    }
};

struct Args { const float* in[31]; float* out; unsigned char* ws; int ph_lo, ph_hi; };
enum { I_X = 0, I_C, I_POS, I_WADA, I_BADA, I_GN1, I_GN2, I_WIN, I_GQ, I_GK, I_ARE, I_AIM, I_BRE, I_BIM, I_CRE, I_CIM, I_DSKIP, I_LOGDT, I_WGLU, I_WPOOL, I_PSCALE, I_PA, I_PB, I_PC, I_WGATE, I_BGATE, I_WOUT, I_WUP, I_CONVW, I_CONVB, I_WDOWN };

__device__ __forceinline__ float wave_sum(float v) {
#pragma unroll
    for (int o = 32; o > 0; o >>= 1) v += __shfl_xor(v, o);
    return v;
}

__device__ __forceinline__ void phase_ada(const Args& a, unsigned char* lds, const int WV) {
    const int TI = fresh_tid(WV);
    const int tid = TI;
    float* cact = (float*)lds;
    float* mod = (float*)(a.ws + WS_MOD);
    for (int w = blockIdx.x; w < 256; w += gridDim.x) {
        for (int i = tid; i < 16 * 2048; i += 512) { const int b = i >> 11, k = i & 2047; const float v = a.in[I_C][i]; cact[k * 16 + b] = siluf_(v); }
        __syncthreads();
        const int l = w >> 7, n0 = (w & 127) * 96;
        float acc[16][4];
#pragma unroll
        for (int b = 0; b < 16; ++b)
#pragma unroll
            for (int j = 0; j < 4; ++j) acc[b][j] = 0.f;
        const int cg4 = tid % 24, ks = tid / 24;
        if (tid < 384) {
            const float* wp = a.in[I_WADA] + ((size_t)l * 2048 + ks * 128) * 12288 + n0 + cg4 * 4;
#pragma unroll 4
            for (int k = 0; k < 128; ++k) {
                const f32x4 wv = *(const f32x4*)(wp + (size_t)k * 12288);
                const f32x4* cp = (const f32x4*)(cact + (ks * 128 + k) * 16);
#pragma unroll
                for (int q = 0; q < 4; ++q) { const f32x4 cv = cp[q];
#pragma unroll
                    for (int e = 0; e < 4; ++e)
#pragma unroll
                        for (int j = 0; j < 4; ++j) acc[q * 4 + e][j] += cv[e] * wv[j]; }
            }
        }
        __syncthreads();
        float* part = (float*)lds;
        if (tid < 384) {
#pragma unroll
            for (int b = 0; b < 16; ++b)
#pragma unroll
                for (int j = 0; j < 4; ++j) part[(ks * 16 + b) * 96 + cg4 * 4 + j] = acc[b][j];
        }
        __syncthreads();
        for (int o = tid; o < 1536; o += 512) { const int b = o / 96, cc = o % 96; float s = 0.f;
#pragma unroll
            for (int k2 = 0; k2 < 16; ++k2) s += part[(k2 * 16 + b) * 96 + cc];
            mod[((size_t)l * 16 + b) * 12288 + n0 + cc] = s + a.in[I_BADA][l * 12288 + n0 + cc]; }
        __syncthreads();
    }
}

struct CvtJob { const float* src; bf16_t* dst; int ldS, cbase, cend, kbase, ldD, mode, r0, cs0, kd0; };
__device__ __forceinline__ CvtJob cvt_decode(const Args& a, int l, int t) {
    unsigned char* ws = a.ws; CvtJob J; int ncols, nkt, idx; J.mode = 0; J.r0 = 0; J.kd0 = 0; J.cs0 = 0;
    if (t < 960) { idx = t; J.src = a.in[I_WIN] + (size_t)l * DM * DIN; J.ldS = DIN; ncols = 1864; nkt = 32; J.dst = (bf16_t*)(ws + W_1CAT); J.ldD = 2048; J.mode = 2; }
    else if (t < 1472) { idx = t - 960; J.src = a.in[I_WIN] + (size_t)l * DM * DIN; J.ldS = DIN; J.cs0 = 1864; ncols = 1024; nkt = 32; J.dst = (bf16_t*)(ws + W_1CAT); J.ldD = 2048; J.r0 = 2048; J.mode = 2; }
    else if (t < 4544) { idx = t - 1472; const int gi = idx >> 10; idx &= 1023; J.src = a.in[I_WGATE] + ((size_t)l * 3 + gi) * DM * DM; J.ldS = DM; ncols = 2048; nkt = 32; J.dst = (bf16_t*)(ws + W_1CAT); J.ldD = 2048; J.r0 = 3072 + 2048 * gi; J.mode = 2; }
    else if (t < 5056) { idx = t - 4544; J.src = a.in[I_PA] + (size_t)l * 1024 * DM; J.ldS = DM; ncols = 2048; nkt = 16; J.dst = (bf16_t*)(ws + W_P); J.ldD = 2048; J.mode = 2; }
    else if (t < 5312) { idx = t - 5056; J.src = a.in[I_PB] + (size_t)l * 512 * DM; J.ldS = DM; ncols = 2048; nkt = 8; J.dst = (bf16_t*)(ws + W_P); J.ldD = 2048; J.kd0 = 1024; J.mode = 2; }
    else if (t < 5568) { idx = t - 5312; J.src = a.in[I_PC] + (size_t)l * 512 * DM; J.ldS = DM; ncols = 2048; nkt = 8; J.dst = (bf16_t*)(ws + W_P); J.ldD = 2048; J.kd0 = 1536; J.mode = 2; }
    else if (t < 6592) { idx = t - 5568; J.src = a.in[I_WOUT] + (size_t)l * DM * DM; J.ldS = DM; ncols = 2048; nkt = 32; J.dst = (bf16_t*)(ws + W_OUT); J.ldD = 2048; }
    else if (t < 12096) { idx = t - 6592; J.src = a.in[I_WUP] + (size_t)l * DM * 2 * DFF; J.ldS = 2 * DFF; ncols = 2 * DFF; nkt = 32; J.dst = (bf16_t*)(ws + W_UP); J.ldD = 2048; J.mode = 1; }
    else if (t < 14848) { idx = t - 12096; J.src = a.in[I_WDOWN] + (size_t)l * DFF * DM; J.ldS = DM; ncols = 2048; nkt = 86; J.dst = (bf16_t*)(ws + W_DOWN); J.ldD = DFF; }
    else { idx = t - 14848; J.src = a.in[I_WGLU] + (size_t)l * 512 * 512; J.ldS = 512; ncols = 512; nkt = 8; J.dst = (bf16_t*)(ws + W_GLU); J.ldD = 512; J.mode = 2; }
    const int tn = idx / nkt, tk = idx - tn * nkt;
    J.cbase = J.cs0 + tn * 64; J.cend = J.cs0 + ncols; J.kbase = tk * 64; return J;
}
__device__ __forceinline__ void phase_cvt(const Args& a, int l, unsigned char* lds, const int WV) {
    const int TI = fresh_tid(WV);
    float* T = (float*)lds;
    const int tid = TI, ty = tid >> 4, tx = tid & 15;
    for (int t4 = blockIdx.x * 8; t4 < 14912; t4 += gridDim.x * 8) {
        f32x4 v[8][2];
#pragma unroll
        for (int q = 0; q < 8; ++q) { const CvtJob J = cvt_decode(a, l, t4 + q);
#pragma unroll
            for (int ps = 0; ps < 2; ++ps) { const int k = ty + ps * 32, c = J.cbase + tx * 4;
                v[q][ps] = (f32x4){0.f, 0.f, 0.f, 0.f};
                if (c < J.cend) v[q][ps] = *(const f32x4*)(J.src + (size_t)(J.kbase + k) * J.ldS + c); } }
#pragma unroll
        for (int q = 0; q < 8; ++q)
#pragma unroll
            for (int ps = 0; ps < 2; ++ps) { float* tp = T + q * (64 * 65) + (ty + ps * 32) * 65 + tx * 4; tp[0] = v[q][ps][0]; tp[1] = v[q][ps][1]; tp[2] = v[q][ps][2]; tp[3] = v[q][ps][3]; }
        __syncthreads();
#pragma unroll
        for (int q = 0; q < 8; ++q) { const CvtJob J = cvt_decode(a, l, t4 + q);
            const int n = tid >> 3, kq = tid & 7, c = J.cbase + n;
            if (c < J.cend) {
                float f[8];
#pragma unroll
                for (int j = 0; j < 8; ++j) f[j] = T[q * (64 * 65) + (kq * 8 + j) * 65 + n];
                int row;
                if (J.mode == 0) row = J.r0 + (c - J.cs0);
                else if (J.mode == 2) { const int r_ = J.r0 + (c - J.cs0), ct = r_ & 255; row = (r_ & ~255) | (((ct >> 5) & 1) << 7) | ((ct >> 6) << 5) | (ct & 31); }
                else { const int bj = c >= DFF ? 1 : 0, ch = c - bj * DFF; row = (ch >> 7) * 256 + bj * 128 + (ch & 127); }
                uint4 o; o.x = pk2(f[0], f[1]); o.y = pk2(f[2], f[3]); o.z = pk2(f[4], f[5]); o.w = pk2(f[6], f[7]);
                *(uint4*)(J.dst + (size_t)row * J.ldD + J.kd0 + J.kbase + kq * 8) = o;
            } }
        __syncthreads();
    }
    bf16_t* wp = (bf16_t*)(a.ws + W_POOL); const float* wsrc = a.in[I_WPOOL] + (size_t)l * 4 * 128 * 128;
    for (int i = blockIdx.x * 512 + TI; i < 512 * 512; i += gridDim.x * 512) { const int n = i >> 9, k = i & 511, g = n >> 7;
        const float v = ((k >> 7) == g) ? wsrc[(g * 128 + (k & 127)) * 128 + (n & 127)] : 0.f;
        const int ct = n & 255, nr = (n & ~255) | (((ct >> 5) & 1) << 7) | ((ct >> 6) << 5) | (ct & 31); wp[nr * 512 + k] = (bf16_t)f2bf(v); }
}

__device__ __forceinline__ void phase_norm(const float* xin, const float* g, const float* modl, int shoff, int scoff, bf16_t* out, const int WV) {
    const int TI = fresh_tid(WV);
    const int lane = TI & 63, wave = TI >> 6;
    for (int r = blockIdx.x * 8 + wave; r < MROWS; r += gridDim.x * 8) {
        const f32x4* xp = (const f32x4*)(xin + (size_t)r * DM); f32x4 v[8]; float ssq = 0.f;
#pragma unroll
        for (int j = 0; j < 8; ++j) { v[j] = xp[j * 64 + lane]; ssq += v[j][0] * v[j][0] + v[j][1] * v[j][1] + v[j][2] * v[j][2] + v[j][3] * v[j][3]; }
        ssq = wave_sum(ssq);
        const float rinv = rsqrtf(ssq * (1.f / DM) + EPS);
        const float* mb = modl + (size_t)(r >> 11) * 12288;
#pragma unroll
        for (int j = 0; j < 8; ++j) { const int col = j * 256 + lane * 4;
            const f32x4 g4 = *(const f32x4*)(g + col), sc = *(const f32x4*)(mb + scoff + col), sh = *(const f32x4*)(mb + shoff + col);
            f32x4 y;
#pragma unroll
            for (int e = 0; e < 4; ++e) y[e] = (v[j][e] * rinv * g4[e]) * (1.f + sc[e]) + sh[e];
            uint2 o; o.x = pk2(y[0], y[1]); o.y = pk2(y[2], y[3]);
            *(uint2*)(out + (size_t)r * DM + col) = o; }
    }
}

__constant__ double kRevPerPos[24] = {0.15915494309189535, 0.0700865215877985, 0.03086376340470123, 0.013591370636193905, 0.005985185712713705, 0.002635675898667414, 0.001160663641240061, 0.0005111175045375439, 0.00022507907903927653, 9.911730936901935e-05, 4.364795279280289e-05, 1.9221100684944863e-05, 8.464330808241401e-06, 3.727408601915352e-06, 1.6414262627950345e-06, 7.228293068832865e-07, 0.15915494309189535, 0.03086376340470123, 0.005985185712713705, 0.001160663641240061, 0.00022507907903927653, 4.364795279280289e-05, 8.464330808241401e-06, 1.6414262627950345e-06};
__device__ __forceinline__ void rmsrope128(bf16_t* p, bool active, const float* g16, int sub, const float* cs) {
    float v[16];
    if (active) { unpack8(*(const uint4*)p, v); unpack8(*(const uint4*)(p + 8), v + 8); }
    else {
#pragma unroll
        for (int i = 0; i < 16; ++i) v[i] = 0.f; }
    float ssq = 0.f;
#pragma unroll
    for (int i = 0; i < 16; ++i) ssq += v[i] * v[i];
    ssq += __shfl_xor(ssq, 1); ssq += __shfl_xor(ssq, 2); ssq += __shfl_xor(ssq, 4);
    const float rinv = rsqrtf(ssq * (1.f / 128.f) + EPS);
#pragma unroll
    for (int i = 0; i < 16; ++i) v[i] = v[i] * rinv * g16[i];
#pragma unroll
    for (int i = 0; i < 16; ++i) { const float o = __shfl_xor(v[i], 1); const float c = cs[2 * i], s = cs[2 * i + 1];
        if (sub == 0) v[i] = v[i] * c - o * s; else if (sub == 1) v[i] = v[i] * c + o * s; }
    if (active) { uint4 o0, o1; o0.x = pk2(v[0], v[1]); o0.y = pk2(v[2], v[3]); o0.z = pk2(v[4], v[5]); o0.w = pk2(v[6], v[7]);
        o1.x = pk2(v[8], v[9]); o1.y = pk2(v[10], v[11]); o1.z = pk2(v[12], v[13]); o1.w = pk2(v[14], v[15]);
        *(uint4*)p = o0; *(uint4*)(p + 8) = o1; }
}
__device__ __forceinline__ void rope64(bf16_t* p, bool active, int sub, const float* cs) {
    float v[8];
    if (active) unpack8(*(const uint4*)p, v);
    else {
#pragma unroll
        for (int i = 0; i < 8; ++i) v[i] = 0.f; }
#pragma unroll
    for (int i = 0; i < 8; ++i) { const float o = __shfl_xor(v[i], 1); const float c = cs[2 * i], s = cs[2 * i + 1];
        if (sub == 0) v[i] = v[i] * c - o * s; else if (sub == 1) v[i] = v[i] * c + o * s; }
    if (active) { uint4 o0; o0.x = pk2(v[0], v[1]); o0.y = pk2(v[2], v[3]); o0.z = pk2(v[4], v[5]); o0.w = pk2(v[6], v[7]); *(uint4*)p = o0; }
}
__device__ __forceinline__ void phase_post(const Args& a, int l, unsigned char* lds, const int WV) {
    const int TI = fresh_tid(WV);
    const int lane = TI & 63, wave = TI >> 6;
    float* cs = (float*)lds + wave * 64;
    bf16_t* ocat = (bf16_t*)(a.ws + WS_OCAT); bf16_t* kn = (bf16_t*)(a.ws + WS_KN); bf16_t* qi = (bf16_t*)(a.ws + WS_QI); bf16_t* ki = (bf16_t*)(a.ws + WS_KI);
    const int* pos = (const int*)a.in[I_POS];
    const int sub = lane & 7, hd = lane >> 3;
    float gq[16], gk[16];
#pragma unroll
    for (int i = 0; i < 16; ++i) { gq[i] = a.in[I_GQ][l * 128 + sub * 16 + i]; gk[i] = a.in[I_GK][l * 128 + sub * 16 + i]; }
    for (int r = blockIdx.x * 8 + wave; r < MROWS; r += gridDim.x * 8) {
        const int ps = pos[r];
        if (lane < 24) {
            double rev = (double)ps * kRevPerPos[lane]; rev -= rint(rev); const float fr = (float)rev;
            cs[lane * 2] = __builtin_amdgcn_cosf(fr); cs[lane * 2 + 1] = __builtin_amdgcn_sinf(fr); }
        LDS_FENCE();
        rmsrope128(ocat + (size_t)r * 2048 + hd * 128 + sub * 16, true, gq, sub, cs);
        rmsrope128(kn + (size_t)r * 128 + sub * 16, lane < 8, gk, sub, cs);
        rope64(qi + (size_t)r * 512 + hd * 64 + sub * 8, true, sub, cs + 32);
        rope64(ki + (size_t)r * 64 + sub * 8, lane < 8, sub, cs + 32);
        LDS_FENCE();
    }
}

__device__ __forceinline__ void s5_unit(const Args& a, int l, int b, int g, unsigned char* lds, const int WV) {
    const int TI = fresh_tid(WV);
    const int lane = TI & 63, wave = __builtin_amdgcn_readfirstlane(TI >> 6), p = lane;
    float* E = (float*)lds;
    float* ust = (float*)(lds + 16384 + wave * 4096);
    bf16_t* sst = (bf16_t*)(lds + 49152 + wave * 4352);
    const bf16_t* U = (const bf16_t*)(a.ws + WS_U); bf16_t* Y = (bf16_t*)(a.ws + WS_Y);
    const int gp = (l * 32 + g) * 64 + p;
    const float are = a.in[I_ARE][gp], aim = a.in[I_AIM][gp], dt = expf(a.in[I_LOGDT][l * 32 + g]);
    const float mag = expf(are * dt);
    float ang = aim * dt; { const float n = rintf(ang * 0.15915494309189535f); ang = fmaf(-n, 6.28318548202514648f, ang); ang = fmaf(n, 1.7484555e-7f, ang); }
    const float lre = mag * cosf(ang), lim = mag * sinf(ang);
    float Bre[16], Bim[16];
    { const float nr = lre - 1.f, ni = lim, den = 1.f / (are * are + aim * aim); const float cr = (nr * are + ni * aim) * den, ci = (ni * are - nr * aim) * den;
#pragma unroll
        for (int j = 0; j < 16; ++j) { const float br = a.in[I_BRE][(size_t)gp * 16 + j], bi = a.in[I_BIM][(size_t)gp * 16 + j]; Bre[j] = cr * br - ci * bi; Bim[j] = cr * bi + ci * br; } }
    bf16x8 Cf[4];
    { const int i = lane & 15;
#pragma unroll
        for (int ks = 0; ks < 4; ++ks)
#pragma unroll
            for (int j = 0; j < 8; ++j) { const int k = ks * 32 + (lane >> 4) * 8 + j, pp = k >> 1; const size_t ci = ((size_t)(l * 32 + g) * 16 + i) * 64 + pp;
                const float v = (k & 1) ? -a.in[I_CIM][ci] : a.in[I_CRE][ci]; Cf[ks][j] = (short)f2bf(v); } }
    const float dsk = a.in[I_DSKIP][l * 512 + g * 16 + (lane & 15)];
    bf16_t* Bl = (bf16_t*)(lds + 83968);
    float* bus = (float*)(lds + 88064 + wave * 8448);
    if (wave == 0) {
#pragma unroll
        for (int q = 0; q < 2; ++q) { uint4 o_; o_.x = pk2(Bre[q * 8], Bre[q * 8 + 1]); o_.y = pk2(Bre[q * 8 + 2], Bre[q * 8 + 3]); o_.z = pk2(Bre[q * 8 + 4], Bre[q * 8 + 5]); o_.w = pk2(Bre[q * 8 + 6], Bre[q * 8 + 7]);
            *(uint4*)(Bl + p * 16 + q * 8) = o_;
            uint4 i_; i_.x = pk2(Bim[q * 8], Bim[q * 8 + 1]); i_.y = pk2(Bim[q * 8 + 2], Bim[q * 8 + 3]); i_.z = pk2(Bim[q * 8 + 4], Bim[q * 8 + 5]); i_.w = pk2(Bim[q * 8 + 6], Bim[q * 8 + 7]);
            *(uint4*)(Bl + (64 + p) * 16 + q * 8) = i_; }
    }
    __syncthreads();
    const int l15 = lane & 15, lg4 = lane >> 4;
    bf16x8 Bf[8];
#pragma unroll
    for (int nb = 0; nb < 8; ++nb) { u32x4 t_ = {0u, 0u, 0u, 0u}; if (lg4 < 2) t_ = *(const u32x4*)(Bl + (nb * 16 + l15) * 16 + lg4 * 8); Bf[nb] = __builtin_bit_cast(bf16x8, t_); }
#define S5_BU(t0_, sb_) do { u32x4 a_ = {0u, 0u, 0u, 0u}; if (lg4 < 2) a_ = *(const u32x4*)(U + (size_t)(b * 2048 + (t0_) + (sb_) * 16 + l15) * 512 + g * 16 + lg4 * 8); \
        const bf16x8 af_ = __builtin_bit_cast(bf16x8, a_); \
        _Pragma("unroll") for (int nb = 0; nb < 8; ++nb) { const f32x4 c_ = __builtin_amdgcn_mfma_f32_16x16x32_bf16(af_, Bf[nb], (f32x4){0.f, 0.f, 0.f, 0.f}, 0, 0, 0); \
            _Pragma("unroll") for (int r = 0; r < 4; ++r) bus[(lg4 * 4 + r) * 132 + nb * 16 + l15] = c_[r]; } \
        LDS_FENCE(); } while (0)
#define S5_STEP(tt_) do { const float br_ = bus[(tt_) * 132 + p], bi_ = bus[(tt_) * 132 + 64 + p]; \
        const float nre_ = lre * sre - lim * sim + br_, nim_ = lre * sim + lim * sre + bi_; sre = nre_; sim = nim_; } while (0)
#pragma unroll 1
    for (int cc = 0; cc < 4; ++cc) {
        const int chunk = wave * 4 + cc, t0 = chunk * 64;
        float sre = 0.f, sim = 0.f;
#pragma unroll 1
        for (int sb = 0; sb < 4; ++sb) {
            S5_BU(t0, sb);
#pragma unroll 4
            for (int tt = 0; tt < 16; ++tt) S5_STEP(tt);
            LDS_FENCE();
        }
        E[(chunk * 64 + p) * 2] = sre; E[(chunk * 64 + p) * 2 + 1] = sim;
    }
    __syncthreads();
    if (wave == 0) {
        float pr = lre, pi = lim;
#pragma unroll
        for (int q = 0; q < 6; ++q) { const float nr = pr * pr - pi * pi, pp_ = pr * pi, ni = pp_ + pp_; pr = nr; pi = ni; }
        float sr = 0.f, si = 0.f;
        for (int c = 0; c < 32; ++c) { const float er = E[(c * 64 + p) * 2], ei = E[(c * 64 + p) * 2 + 1]; E[(c * 64 + p) * 2] = sr; E[(c * 64 + p) * 2 + 1] = si;
            const float nr = pr * sr - pi * si + er, ni = pr * si + pi * sr + ei; sr = nr; si = ni; }
    }
    __syncthreads();
#pragma unroll 1
    for (int cc = 0; cc < 4; ++cc) {
        const int chunk = wave * 4 + cc, t0 = chunk * 64;
        { const bf16_t* up = U + (size_t)(b * 2048 + t0 + lane) * 512 + g * 16; const uint4 q0 = *(const uint4*)up, q1 = *(const uint4*)(up + 8);
            float f[16]; unpack8(q0, f); unpack8(q1, f + 8);
#pragma unroll
            for (int q = 0; q < 4; ++q) *(f32x4*)(ust + lane * 16 + q * 4) = (f32x4){f[q * 4], f[q * 4 + 1], f[q * 4 + 2], f[q * 4 + 3]}; }
        float sre = E[(chunk * 64 + p) * 2], sim = E[(chunk * 64 + p) * 2 + 1];
#pragma unroll 1
        for (int sb = 0; sb < 4; ++sb) {
            S5_BU(t0, sb);
#pragma unroll 4
            for (int tt = 0; tt < 16; ++tt) { S5_STEP(tt);
                *(unsigned*)(sst + tt * 136 + 2 * p) = pk2(sre, sim);
            }
            LDS_FENCE();
            f32x4 acc = {0.f, 0.f, 0.f, 0.f};
#pragma unroll
            for (int ks = 0; ks < 4; ++ks) { const bf16x8 af = *(const bf16x8*)(sst + (lane & 15) * 136 + ks * 32 + (lane >> 4) * 8);
                acc = __builtin_amdgcn_mfma_f32_16x16x32_bf16(af, Cf[ks], acc, 0, 0, 0); }
#pragma unroll
            for (int r = 0; r < 4; ++r) { const int t = sb * 16 + (lane >> 4) * 4 + r, i = lane & 15;
                const float y = gelu_tanh(acc[r] + dsk * ust[t * 16 + i]);
                Y[(size_t)(b * 2048 + t0 + t) * 512 + g * 16 + i] = (bf16_t)f2bf(y); }
            LDS_FENCE();
        }
    }
    __syncthreads();
#undef S5_STEP
#undef S5_BU
}

__device__ __forceinline__ void pool_unit(const Args& a, int b, int chunk, unsigned char* lds, const int WV) {
    const int TI = fresh_tid(WV);
    bf16_t* T = (bf16_t*)lds;
    const int t0 = chunk * 64;
    const bf16_t* P = (const bf16_t*)(a.ws + WS_P) + (size_t)b * 2048 * 512; bf16_t* O = (bf16_t*)(a.ws + WS_POOLED) + (size_t)b * 2048 * 512;
    __syncthreads();
    for (int i = TI; i < 80 * 64; i += 512) { const int r = i >> 6, c8 = i & 63, t = t0 - 16 + r;
        uint4 v = make_uint4(0u, 0u, 0u, 0u); if (t >= 0) v = *(const uint4*)(P + (size_t)t * 512 + c8 * 8);
        *(uint4*)(T + r * 512 + c8 * 8) = v; }
    __syncthreads();
    const int c = TI, w = 2 << (c >> 7);
    float s = 0.f;
    for (int k = 1; k <= w; ++k) s += bf1(T[(16 - k) * 512 + c]);
#pragma unroll 4
    for (int t = 0; t < 64; ++t) { const float pv = bf1(T[(16 + t) * 512 + c]); s += pv; s -= bf1(T[(16 + t - w) * 512 + c]);
        const int tt = t0 + t + 1; const float mean = s / (float)(tt < w ? tt : w); O[(size_t)(t0 + t) * 512 + c] = (bf16_t)f2bf(mean - pv); }
}

__device__ __forceinline__ unsigned sortkey(float x) { const unsigned u = __float_as_uint(x); return (u & 0x80000000u) ? ~u : (u | 0x80000000u); }
template <int NJ>
__device__ __forceinline__ void select256(const float* scq, int limit, unsigned short* sq, int lane) {
    const unsigned long long ltmask = (1ull << lane) - 1ull;
    unsigned key[NJ];
#pragma unroll
    for (int j = 0; j < NJ; ++j) { const int idx = j * 64 + lane; key[j] = (idx < limit) ? sortkey(scq[idx]) : 0u; }
    unsigned T = 0u;
    for (int bit = 31; bit >= 0; --bit) { const unsigned cand = T | (1u << bit); int cnt = 0;
#pragma unroll
        for (int j = 0; j < NJ; ++j) cnt += __popcll(__ballot(key[j] >= cand));
        if (cnt >= 256) { T = cand; if (cnt == 256) break; } }
    int cgt = 0;
#pragma unroll
    for (int j = 0; j < NJ; ++j) cgt += __popcll(__ballot(key[j] > T));
    const int need = 256 - cgt; int ob = 0, tb = 0;
#pragma unroll
    for (int j = 0; j < NJ; ++j) { const bool gt = key[j] > T, eq = key[j] == T; const unsigned long long me = __ballot(eq);
        const int pe = tb + __popcll(me & ltmask); const bool take = gt || (eq && pe < need); const unsigned long long mt = __ballot(take);
        if (take) sq[ob + __popcll(mt & ltmask)] = (unsigned short)(j * 64 + lane);
        ob += __popcll(mt); tb += __popcll(me); }
}
__device__ __forceinline__ void dsa_unit(const Args& a, int b, int tq, unsigned char* lds, const int WV, bf16_t* obase, const int ostride, const int parts) {
    const int TI = fresh_tid(WV);
    int tid = TI;
    int lane = tid & 63; const int wave = WV;
    float* sc = (float*)lds;
    unsigned short* sel = (unsigned short*)(lds + 131072);
    float* wis = (float*)(lds + 131072 + 8192);
    bf16_t* ocat = (bf16_t*)(a.ws + WS_OCAT); const bf16_t* Kn = (const bf16_t*)(a.ws + WS_KN); const bf16_t* V = (const bf16_t*)(a.ws + WS_V);
    const bf16_t* QI = (const bf16_t*)(a.ws + WS_QI); const bf16_t* KI = (const bf16_t*)(a.ws + WS_KI); const float* WI = (const float*)(a.ws + WS_WI);
    const int t0 = tq * 16, row0 = b * 2048 + t0, limit = ((t0 >> 6) + 1) << 6, nkt = limit >> 5, nsel = limit < 256 ? limit : 256;
    __syncthreads();
    if (tid < 128) wis[tid] = WI[(size_t)row0 * 8 + tid];
    __syncthreads();
    if (parts & 1)
    {
        const int g = lane >> 5, c32 = lane & 31;
        bf16x8 Af[4][4];
#pragma unroll
        for (int rb = 0; rb < 4; ++rb) { const int R = rb * 32 + c32; const bf16_t* qp = QI + (size_t)(row0 + (R >> 3)) * 512 + (R & 7) * 64 + g * 8;
#pragma unroll
            for (int s = 0; s < 4; ++s) Af[rb][s] = *(const bf16x8*)(qp + s * 16); }
        bf16x8 Bn[4];
        { const bf16_t* kp0 = KI + (size_t)(b * 2048 + wave * 32 + c32) * 64 + g * 8;
#pragma unroll
            for (int s = 0; s < 4; ++s) Bn[s] = *(const bf16x8*)(kp0 + s * 16); }
#pragma unroll 1
        for (int kt = wave; kt < nkt; kt += 8) {
            bf16x8 Bf[4];
#pragma unroll
            for (int s = 0; s < 4; ++s) Bf[s] = Bn[s];
            if (kt + 8 < nkt) { const bf16_t* kp = KI + (size_t)(b * 2048 + (kt + 8) * 32 + c32) * 64 + g * 8;
#pragma unroll
                for (int s = 0; s < 4; ++s) Bn[s] = *(const bf16x8*)(kp + s * 16); }
#pragma unroll
            for (int rb = 0; rb < 4; ++rb) {
                f32x16 acc;
#pragma unroll
                for (int i = 0; i < 16; ++i) acc[i] = 0.f;
#pragma unroll
                for (int s = 0; s < 4; ++s) acc = __builtin_amdgcn_mfma_f32_32x32x16_bf16(Af[rb][s], Bf[s], acc, 0, 0, 0);
#pragma unroll
                for (int j = 0; j < 4; ++j) { const int q = rb * 4 + j; const f32x4 w4 = *(const f32x4*)(wis + q * 8 + 4 * g);
                    float sp = fmaxf(acc[4 * j], 0.f) * w4[0] + fmaxf(acc[4 * j + 1], 0.f) * w4[1] + fmaxf(acc[4 * j + 2], 0.f) * w4[2] + fmaxf(acc[4 * j + 3], 0.f) * w4[3];
                    sp += __shfl_xor(sp, 32);
                    if (g == 0) sc[q * 2048 + kt * 32 + c32] = sp; }
            }
        }
    }
    __syncthreads();
    lane = fresh_tid(WV) & 63;
    for (int qq = 0; qq < 2; ++qq) {
        const int q = wave * 2 + qq; unsigned short* sq = sel + q * 256;
        if (limit <= 256 || !(parts & 2)) { for (int j = lane; j < nsel; j += 64) sq[j] = (unsigned short)j; }
        else if (limit <= 512) select256<8>(sc + q * 2048, limit, sq, lane);
        else if (limit <= 1024) select256<16>(sc + q * 2048, limit, sq, lane);
        else if (limit <= 1536) select256<24>(sc + q * 2048, limit, sq, lane);
        else select256<32>(sc + q * 2048, limit, sq, lane);
    }
    __syncthreads();
    lane = fresh_tid(WV) & 63;
    float* Pw = (float*)lds + wave * 2048;
    const int g4 = lane >> 4, hh = lane & 15;
#pragma unroll 1
    for (int qq = 0; qq < 2; ++qq) {
        const int q = wave * 2 + qq; const size_t row = (size_t)(row0 + q); const unsigned short* sq = sel + q * 256;
        bf16x8 Qf[4];
#pragma unroll
        for (int s = 0; s < 4; ++s) Qf[s] = *(const bf16x8*)(ocat + row * 2048 + (hh & 7) * 128 + g4 * 8 + s * 32);
        float lg[16][4];
#pragma unroll
        for (int kg = 0; kg < 4; ++kg) {
            if (kg * 64 < nsel) {
                bf16x8 kf[4][4];
#pragma unroll
                for (int k4 = 0; k4 < 4; ++k4) { const int idx = sq[(kg * 4 + k4) * 16 + hh]; const bf16_t* kp = Kn + (size_t)(b * 2048 + idx) * 128 + g4 * 8;
#pragma unroll
                    for (int s = 0; s < 4; ++s) kf[k4][s] = *(const bf16x8*)(kp + s * 32); }
#pragma unroll
                for (int k4 = 0; k4 < 4; ++k4) { f32x4 c = {0.f, 0.f, 0.f, 0.f};
#pragma unroll
                    for (int s = 0; s < 4; ++s) c = __builtin_amdgcn_mfma_f32_16x16x32_bf16(kf[k4][s], Qf[s], c, 0, 0, 0);
#pragma unroll
                    for (int r = 0; r < 4; ++r) lg[kg * 4 + k4][r] = c[r] * 0.08838834764831845f; }
            } else {
#pragma unroll
                for (int k4 = 0; k4 < 4; ++k4)
#pragma unroll
                    for (int r = 0; r < 4; ++r) lg[kg * 4 + k4][r] = -1e30f;
            }
        }
        float mx = -1e30f;
#pragma unroll
        for (int kb = 0; kb < 16; ++kb)
#pragma unroll
            for (int r = 0; r < 4; ++r) mx = fmaxf(mx, lg[kb][r]);
        mx = fmaxf(mx, __shfl_xor(mx, 16)); mx = fmaxf(mx, __shfl_xor(mx, 32));
        float sum = 0.f;
#pragma unroll
        for (int kb = 0; kb < 16; ++kb)
#pragma unroll
            for (int r = 0; r < 4; ++r) { const float e = (kb * 16 < nsel) ? __expf(lg[kb][r] - mx) : 0.f; lg[kb][r] = e; sum += e; }
        sum += __shfl_xor(sum, 16); sum += __shfl_xor(sum, 32);
        const float inv = 1.f / sum;
        bf16x8 Pa[8];
#pragma unroll
        for (int ks = 0; ks < 8; ++ks) {
            const unsigned a0 = pk2(lg[2 * ks][0] * inv, lg[2 * ks][1] * inv), a1 = pk2(lg[2 * ks][2] * inv, lg[2 * ks][3] * inv);
            const unsigned a2 = pk2(lg[2 * ks + 1][0] * inv, lg[2 * ks + 1][1] * inv), a3 = pk2(lg[2 * ks + 1][2] * inv, lg[2 * ks + 1][3] * inv);
            const u32x4 t_ = {a0, a1, a2, a3}; Pa[ks] = __builtin_bit_cast(bf16x8, t_); }
        bf16_t* Vs = (bf16_t*)(lds + wave * 10752);
        bf16_t* Os = Vs + 32 * 136;
        f32x4 oacc[8];
#pragma unroll
        for (int nb = 0; nb < 8; ++nb) oacc[nb] = (f32x4){0.f, 0.f, 0.f, 0.f};
        const bf16_t* Vb = V + (size_t)b * 2048 * 128 + hh * 8;
        u32x4 vq[8], vn[8];
#pragma unroll
        for (int jj = 0; jj < 8; ++jj) vn[jj] = (u32x4){0u, 0u, 0u, 0u};
#pragma unroll
        for (int jj = 0; jj < 8; ++jj) { const int idx = sq[jj * 4 + g4]; vq[jj] = *(const u32x4*)(Vb + (size_t)idx * 128); }
#define PV_BATCH(bt) do { if ((bt) * 32 < nsel) { \
            if (((bt) + 1) * 32 < nsel) { _Pragma("unroll") for (int jj = 0; jj < 8; ++jj) { const int idx = sq[((bt) + 1) * 32 + jj * 4 + g4]; vn[jj] = *(const u32x4*)(Vb + (size_t)idx * 128); } } \
            _Pragma("unroll") for (int jj = 0; jj < 8; ++jj) *(u32x4*)(Vs + (jj * 4 + g4) * 136 + hh * 8) = vq[jj]; \
            LDS_FENCE(); \
            _Pragma("unroll") for (int nb = 0; nb < 8; ++nb) { const bf16_t* vp = Vs + (4 * g4) * 136 + nb * 16 + hh; \
                const unsigned w0_ = (unsigned)vp[0 * 136] | ((unsigned)vp[1 * 136] << 16), w1_ = (unsigned)vp[2 * 136] | ((unsigned)vp[3 * 136] << 16); \
                const unsigned w2_ = (unsigned)vp[16 * 136] | ((unsigned)vp[17 * 136] << 16), w3_ = (unsigned)vp[18 * 136] | ((unsigned)vp[19 * 136] << 16); \
                const u32x4 t_ = {w0_, w1_, w2_, w3_}; \
                oacc[nb] = __builtin_amdgcn_mfma_f32_16x16x32_bf16(Pa[(bt)], __builtin_bit_cast(bf16x8, t_), oacc[nb], 0, 0, 0); } \
            LDS_FENCE(); \
            _Pragma("unroll") for (int jj = 0; jj < 8; ++jj) vq[jj] = vn[jj]; } } while (0)
        PV_BATCH(0); PV_BATCH(1); PV_BATCH(2); PV_BATCH(3); PV_BATCH(4); PV_BATCH(5); PV_BATCH(6); PV_BATCH(7);
#undef PV_BATCH
        if (g4 < 2) {
#pragma unroll
            for (int nb = 0; nb < 8; ++nb)
#pragma unroll
                for (int r = 0; r < 4; ++r) Os[(g4 * 4 + r) * 128 + nb * 16 + hh] = (bf16_t)f2bf(oacc[nb][r]);
        }
        LDS_FENCE();
#pragma unroll
        for (int h = 0; h < 2; ++h) { const uint4 ov = *(const uint4*)(Os + h * 512 + lane * 8); *(uint4*)(obase + row * ostride + h * 512 + lane * 8) = ov; }
        LDS_FENCE();
    }
}

__device__ __forceinline__ void phase_fix(const Args& a, int l, const int WV) {
    const int TI = fresh_tid(WV);
    const float* SA = (const float*)(a.ws + WS_SA); const float* SB = (const float*)(a.ws + WS_SB); bf16_t* act = (bf16_t*)(a.ws + WS_R2);
    const float* cw = a.in[I_CONVW] + (size_t)l * 3 * DFF; const float* cb = a.in[I_CONVB] + (size_t)l * DFF;
    const int total = 512 * 2 * DFF;
    for (int i = blockIdx.x * 512 + TI; i < total; i += gridDim.x * 512) {
        const int ch = i % DFF, rb = i / DFF, rr = rb & 1, blk = rb >> 1, r = blk * 64 + rr, t = r & 2047;
        const float a0 = SA[((size_t)blk * 4 + 2 + rr) * DFF + ch];
        float am1, am2;
        if (rr == 0) { am1 = (t >= 1) ? SA[((size_t)(blk - 1) * 4 + 1) * DFF + ch] : 0.f; am2 = (t >= 2) ? SA[((size_t)(blk - 1) * 4 + 0) * DFF + ch] : 0.f; }
        else { am1 = SA[((size_t)blk * 4 + 2) * DFF + ch]; am2 = (t >= 2) ? SA[((size_t)(blk - 1) * 4 + 1) * DFF + ch] : 0.f; }
        const float cv = cb[ch] + cw[ch] * am2 + cw[DFF + ch] * am1 + cw[2 * DFF + ch] * a0;
        act[(size_t)r * DFF + ch] = (bf16_t)f2bf(siluf_(cv) * SB[((size_t)blk * 2 + rr) * DFF + ch]);
    }
}

__device__ __forceinline__ void run_phase(const Args& a, int ph, unsigned char* lds, const int WV, const bool dummy) {
    unsigned char* ws = a.ws;
    LAS unsigned char* ldsl = (LAS unsigned char*)lds;
    const int G = gridDim.x, bx = blockIdx.x;
#ifndef DBG_NOADA
    if (ph == 0) { phase_ada(a, lds, WV); return; }
#else
    if (ph == 0) return;
#endif
    const int l = (ph - 1) / 10, sp = (ph - 1) % 10;
    const float* modl = (const float*)(ws + WS_MOD) + (size_t)l * 16 * 12288;
    const float* xin = (l == 0) ? a.in[I_X] : a.out;
#ifdef DBG_SP
    if (sp != DBG_SP) return;
#endif
    switch (sp) {
    case 0: phase_cvt(a, l, lds, WV); phase_norm(xin, a.in[I_GN1] + l * DM, modl, 0, 2048, (bf16_t*)(ws + WS_R1), WV); break;
    case 1: {
        pg8::Gemm g{(const bf16_t*)(ws + WS_R1), (const bf16_t*)(ws + W_1CAT), MROWS, N1, DM, DM, DM, 1 << 30, 0}; pg8::StaticOrder S; S.init(MROWS, N1, G, bx);
        Epi1 E{(bf16_t*)(ws + WS_OCAT), (bf16_t*)(ws + WS_KN), (bf16_t*)(ws + WS_V), (bf16_t*)(ws + WS_QI), (bf16_t*)(ws + WS_KI), (bf16_t*)(ws + WS_U), (bf16_t*)(ws + WS_P), (bf16_t*)(ws + WS_R2),
               (float*)(ws + WS_WI), a.in[I_BGATE] + (size_t)l * 3 * DM, ldsl + 131072};
        pg8::gemm_phase<Epi1, pg8::StaticOrder>(ldsl, g, S, E, WV); } break;
    case 2:
        if (!dummy) phase_post(a, l, lds, WV);
        __syncthreads();
        for (int u = bx; u < 512; u += G) s5_unit(a, l, u >> 5, u & 31, lds, WV);
        for (int u = bx; u < 512; u += G) pool_unit(a, u >> 5, u & 31, lds, WV);
        break;
    case 3: {
#ifndef DBG_NO_DSA
#ifdef DSA_PROBE
        for (int rep = 0; rep < 2; ++rep) { const bool dm = (rep == 0); const int parts = dm ? (DSA_PROBE) : 15;
#else
        { const bool dm = dummy; const int parts = 15;
#endif
            for (int u = bx; u < 2048; u += G) { const int w = u & 255, i = u >> 8, b = w & 15, s = w >> 4; const int tq = (i & 1) ? (i * 16 + 15 - s) : (i * 16 + s);
                dsa_unit(a, b, tq, lds, WV, dm ? (bf16_t*)(ws + WS_R1 + 64 * MiB) : (bf16_t*)(ws + WS_OCAT), dm ? 1024 : 2048, parts); }
        }
        __syncthreads();
#endif
#ifndef DBG_DSA_ONLY
        { pg8::Gemm g{(const bf16_t*)(ws + WS_Y), (const bf16_t*)(ws + W_GLU), MROWS, 1024, 512, 512, 512, 2, WS_POOLED - WS_Y}; pg8::StaticOrder S; S.init(MROWS, 1024, G, bx);
          EpiGluPool E{(const bf16_t*)(ws + WS_Y), a.in[I_PSCALE] + l * 512, (bf16_t*)(ws + WS_OCAT)}; pg8::gemm_phase<EpiGluPool, pg8::StaticOrder>(ldsl, g, S, E, WV); }
#endif
        } break;
    case 4: {
        pg8::Gemm g{(const bf16_t*)(ws + WS_OCAT), (const bf16_t*)(ws + W_P), MROWS, DM, DM, DM, DM, 1 << 30, 0}; pg8::StaticOrder S; S.init(MROWS, DM, G, bx);
        EpiMerge E{(const bf16_t*)(ws + WS_R2), (bf16_t*)(ws + WS_R1), ldsl + 131072}; pg8::gemm_phase<EpiMerge, pg8::StaticOrder>(ldsl, g, S, E, WV); } break;
    case 5: {
        pg8::Gemm g{(const bf16_t*)(ws + WS_R1), (const bf16_t*)(ws + W_OUT), MROWS, DM, DM, DM, DM, 1 << 30, 0}; pg8::StaticOrder S; S.init(MROWS, DM, G, bx);
        EpiRes E{xin, dummy ? (float*)(ws + WS_OCAT) : a.out, modl + 4096}; pg8::gemm_phase<EpiRes, pg8::StaticOrder>(ldsl, g, S, E, WV); } break;
    case 6: phase_norm(a.out, a.in[I_GN2] + l * DM, modl, 6144, 8192, (bf16_t*)(ws + WS_R1), WV); break;
    case 7: {
        pg8::Gemm g{(const bf16_t*)(ws + WS_R1), (const bf16_t*)(ws + W_UP), MROWS, 2 * DFF, DM, DM, DM, 1 << 30, 0}; pg8::StaticOrder S; S.init(MROWS, 2 * DFF, G, bx);
        EpiUp E{(bf16_t*)(ws + WS_R2), (float*)(ws + WS_SA), (float*)(ws + WS_SB), a.in[I_CONVW] + (size_t)l * 3 * DFF, a.in[I_CONVB] + (size_t)l * DFF, ldsl + 131072};
        pg8::gemm_phase<EpiUp, pg8::StaticOrder>(ldsl, g, S, E, WV); } break;
    case 8: phase_fix(a, l, WV); break;
    case 9: {
        pg8::Gemm g{(const bf16_t*)(ws + WS_R2), (const bf16_t*)(ws + W_DOWN), MROWS, DM, DFF, DFF, DFF, 1 << 30, 0}; pg8::StaticOrder S; S.init(MROWS, DM, G, bx);
        EpiRes E{a.out, dummy ? (float*)(ws + WS_OCAT) : a.out, modl + 10240}; pg8::gemm_phase<EpiRes, pg8::StaticOrder>(ldsl, g, S, E, WV); } break;
    }
}

#define XB_XCNT(j)  (256  + 64 * (j))
#define XB_XSUB(j)  (1280 + 64 * (j))
#define XB_XGEN(j)  (2304 + 64 * (j))
#define XB_TOP      3328
#define XB_TOPGEN   3392
#define XB_WORDS    3456
__device__ __forceinline__ unsigned xb_ld(unsigned* p)              { return __hip_atomic_load(p, __ATOMIC_RELAXED, __HIP_MEMORY_SCOPE_AGENT); }
__device__ __forceinline__ unsigned xb_add(unsigned* p, unsigned v) { return __hip_atomic_fetch_add(p, v, __ATOMIC_RELAXED, __HIP_MEMORY_SCOPE_AGENT); }
__device__ __forceinline__ unsigned xb_xcc_id() { return (unsigned)__builtin_amdgcn_s_getreg((3 << 11) | 20) & 0xFu; }
#define XB_SPIN(cond) do { unsigned _sp = 0; while (cond) { __builtin_amdgcn_s_sleep(1); if (++_sp > (1u << 22)) break; } } while (0)
__device__ __forceinline__ void grid_bar(unsigned* bar, volatile LAS unsigned* st, int wave_id) {
    asm volatile("s_waitcnt vmcnt(0) lgkmcnt(0)" ::: "memory");
    __syncthreads();
    if (wave_id == 0) {
        const int l = (int)__builtin_amdgcn_mbcnt_hi(~0u, __builtin_amdgcn_mbcnt_lo(~0u, 0u));
        if (l == 0) {
            const unsigned x = xb_xcc_id();
            unsigned nloc = st[0], nx = st[1];
            if (nloc == 0u) {
                const unsigned G = gridDim.x; unsigned sum, cnt, mine, sp = 0u;
                for (;;) { sum = 0u; cnt = 0u; mine = 0u;
#pragma unroll
                    for (unsigned j = 0; j < 16; ++j) { const unsigned c = xb_ld(&bar[XB_XCNT(j)]); sum += c; cnt += (c > 0u) ? 1u : 0u; mine = (j == x) ? c : mine; }
                    if (sum == G) break;
                    __builtin_amdgcn_s_sleep(1); if (++sp > (1u << 22)) break; }
                nloc = mine > 0u ? mine : 1u; nx = cnt > 0u ? cnt : 1u; st[0] = nloc; st[1] = nx;
            }
            const unsigned old = xb_add(&bar[XB_XSUB(x)], 1u);
            const unsigned gen = old / nloc;
            if (old + 1u == (gen + 1u) * nloc) {
                __builtin_amdgcn_fence(__ATOMIC_RELEASE, "agent");
                asm volatile("s_waitcnt vmcnt(0)" ::: "memory");
                const unsigned og = xb_add(&bar[XB_TOP], 1u);
                const unsigned tg = og / nx;
                if (og + 1u == (tg + 1u) * nx) xb_add(&bar[XB_TOPGEN], 1u);
                else XB_SPIN(xb_ld(&bar[XB_TOPGEN]) == tg);
                __builtin_amdgcn_fence(__ATOMIC_ACQUIRE, "agent");
                xb_add(&bar[XB_XGEN(x)], 1u);
                asm volatile("s_waitcnt vmcnt(0)" ::: "memory");
            } else {
                XB_SPIN(xb_ld(&bar[XB_XGEN(x)]) == gen);
                __builtin_amdgcn_fence(__ATOMIC_ACQUIRE, "agent");
                asm volatile("s_waitcnt vmcnt(0)" ::: "memory");
            }
        }
    }
    __syncthreads();
}

__global__ void __launch_bounds__(512, 2) mega_fwd(Args a) {
    extern __shared__ __attribute__((aligned(16))) unsigned char lds[];
    cg::grid_group grid = cg::this_grid();
    const int wave_id = __builtin_amdgcn_readfirstlane((int)(threadIdx.x >> 6));
    const int ph_lo = a.ph_lo, ph_hi = a.ph_hi;
    volatile LAS unsigned* xst = (volatile LAS unsigned*)((LAS unsigned char*)lds + 163776);
    if (threadIdx.x == 0) { xst[0] = 0u; xst[1] = 0u; (void)xb_add((unsigned*)(__attribute__((address_space(1))) unsigned*)a.ws + XB_XCNT(xb_xcc_id()), 1u); }
    __syncthreads();
    for (int ph = ph_lo; ph < ph_hi; ++ph) {
        const __attribute__((address_space(4))) Args* kp = (const __attribute__((address_space(4))) Args*)__builtin_amdgcn_kernarg_segment_ptr();
        asm volatile("" : "+s"(kp));
        Args la;
#pragma unroll
        for (int i = 0; i < 31; ++i) la.in[i] = (const float*)(const __attribute__((address_space(1))) float*)kp->in[i];
        la.ws = (unsigned char*)(__attribute__((address_space(1))) unsigned char*)kp->ws;
        la.out = (float*)(__attribute__((address_space(1))) float*)kp->out;
        la.ph_lo = ph_lo; la.ph_hi = ph_hi;
#ifdef REP_MASK
        if (ph > 0 && ((REP_MASK >> ((ph - 1) % 10)) & 1)) { run_phase(la, ph, lds, wave_id, true); grid.sync(); }
#endif
        run_phase(la, ph, lds, wave_id, false);
        if (ph + 1 < ph_hi) {
            if (ph == ph_lo) grid.sync();
            else grid_bar((unsigned*)la.ws, xst, wave_id);
        }
    }
}

extern "C" void kernel_launch(void* const* d_in, const int* in_sizes, int n_in, void* d_out, int out_size, void* d_ws, size_t ws_size, hipStream_t stream) {
    static int grid = 0;
    if (grid == 0) {
        int dev = 0, cus = 0, per_cu = 0;
        if (n_in != 31 || ws_size < WS_END) { fprintf(stderr, "kernel_launch: unexpected n_in %d / ws %zu\n", n_in, ws_size); grid = -1; return; }
        hipGetDevice(&dev); hipDeviceGetAttribute(&cus, hipDeviceAttributeMultiprocessorCount, dev);
        if (hipFuncSetAttribute((const void*)mega_fwd, hipFuncAttributeMaxDynamicSharedMemorySize, LDS_BYTES) != hipSuccess) { fprintf(stderr, "kernel_launch: hipFuncSetAttribute failed\n"); grid = -1; return; }
        if (hipOccupancyMaxActiveBlocksPerMultiprocessor(&per_cu, (const void*)mega_fwd, 512, LDS_BYTES) != hipSuccess || per_cu < 1) { fprintf(stderr, "kernel_launch: occupancy query says %d blocks/CU\n", per_cu); per_cu = 1; }
        (void)hipGetLastError();
        grid = cus > 0 ? cus : 256;
    }
    if (grid < 0) return;
    if (hipMemsetAsync(d_ws, 0, 16384, stream) != hipSuccess) { fprintf(stderr, "kernel_launch: memset of the barrier word failed\n"); return; }
    Args a{};
    for (int i = 0; i < 31; ++i) a.in[i] = (const float*)d_in[i];
    a.out = (float*)d_out; a.ws = (unsigned char*)d_ws;
#if MK_PER_PHASE
    for (int ph = 0; ph < NPHASE; ++ph) {
        a.ph_lo = ph; a.ph_hi = ph + 1;
        void* args[] = {&a};
        hipError_t e = hipLaunchCooperativeKernel((const void*)mega_fwd, dim3(grid), dim3(512), args, LDS_BYTES, stream);
        if (e != hipSuccess) { fprintf(stderr, "kernel_launch: launch of phase %d failed: %s\n", ph, hipGetErrorString(e)); break; }
    }
#else
    a.ph_lo = 0; a.ph_hi = NPHASE;
    void* args[] = {&a};
    hipError_t e = hipLaunchCooperativeKernel((const void*)mega_fwd, dim3(grid), dim3(512), args, LDS_BYTES, stream);
    if (e != hipSuccess) fprintf(stderr, "kernel_launch: cooperative launch failed: %s (grid %d)\n", hipGetErrorString(e), grid);
#endif
}
```

```cpp
#include <hip/hip_runtime.h>
#include <hip/hip_cooperative_groups.h>
#include <cstdio>
#include <cstdint>
namespace cg = cooperative_groups;

#ifndef MK_PER_PHASE
#define MK_PER_PHASE 0
#endif

typedef unsigned short bf16_t;
typedef short bf16x8 __attribute__((ext_vector_type(8)));
typedef float f32x4 __attribute__((ext_vector_type(4)));
typedef float f32x2 __attribute__((ext_vector_type(2)));
typedef float f32x16 __attribute__((ext_vector_type(16)));
typedef unsigned u32x4 __attribute__((ext_vector_type(4)));
typedef unsigned u32x2 __attribute__((ext_vector_type(2)));
#define LAS __attribute__((address_space(3)))

constexpr int BATCH = 16, SEQ = 2048, DM = 2048, MROWS = BATCH * SEQ, DIN = 2888, DFF = 5504;
constexpr int N1 = 9216;
constexpr float EPS = 1e-6f;
constexpr int NPHASE = 21;

constexpr size_t MiB = 1u << 20;
constexpr size_t WS_MOD = 1 * MiB;
constexpr size_t WS_WI = 3 * MiB;
constexpr size_t WS_W = 4 * MiB;
constexpr size_t W_1CAT = WS_W, W_P = WS_W + 36 * MiB, W_OUT = WS_W + 44 * MiB, W_UP = WS_W + 52 * MiB, W_DOWN = WS_W + 95 * MiB,
                 W_GLU = WS_W + 116 * MiB + MiB / 2, W_POOL = WS_W + 117 * MiB;
constexpr size_t WS_R1 = 122 * MiB;
constexpr size_t WS_Y = WS_R1, WS_POOLED = WS_R1 + 32 * MiB;
constexpr size_t WS_R2 = 250 * MiB;
constexpr size_t WS_OCAT = 634 * MiB;
constexpr size_t WS_SA = WS_OCAT, WS_SB = WS_OCAT + 44 * MiB;
constexpr size_t WS_KN = 762 * MiB, WS_V = 770 * MiB, WS_QI = 778 * MiB, WS_KI = 810 * MiB, WS_U = 814 * MiB, WS_P = 846 * MiB, WS_END = 878 * MiB;
constexpr int LDS_BYTES = 163840;

__device__ __forceinline__ unsigned f2bf(float f) { unsigned u = __float_as_uint(f); return (u + 0x7fffu + ((u >> 16) & 1u)) >> 16; }
__device__ __forceinline__ unsigned pk2(float lo, float hi) { return f2bf(lo) | (f2bf(hi) << 16); }
__device__ __forceinline__ float bflo(unsigned u) { return __uint_as_float(u << 16); }
__device__ __forceinline__ float bfhi(unsigned u) { return __uint_as_float(u & 0xffff0000u); }
__device__ __forceinline__ float bf1(bf16_t b) { return __uint_as_float(((unsigned)b) << 16); }
__device__ __forceinline__ float sigmoidf_(float x) { return 1.f / (1.f + __expf(-x)); }
__device__ __forceinline__ float siluf_(float x) { return x / (1.f + __expf(-x)); }
__device__ __forceinline__ float gelu_tanh(float x) { const float z = 0.7978845608028654f * (x + 0.044715f * x * x * x); const float t = 1.f - 2.f / (1.f + __expf(2.f * z)); return 0.5f * x * (1.f + t); }
__device__ __forceinline__ uint4 pack8(f32x4 a, f32x4 b) { uint4 r; r.x = pk2(a[0], a[1]); r.y = pk2(a[2], a[3]); r.z = pk2(b[0], b[1]); r.w = pk2(b[2], b[3]); return r; }
__device__ __forceinline__ void unpack8(uint4 v, float* f) { f[0] = bflo(v.x); f[1] = bfhi(v.x); f[2] = bflo(v.y); f[3] = bfhi(v.y); f[4] = bflo(v.z); f[5] = bfhi(v.z); f[6] = bflo(v.w); f[7] = bfhi(v.w); }
#define LDS_FENCE() asm volatile("s_waitcnt lgkmcnt(0)" ::: "memory")
__device__ __forceinline__ int fresh_tid(int wv) { int l = (int)__builtin_amdgcn_mbcnt_hi(~0u, __builtin_amdgcn_mbcnt_lo(~0u, 0u)); asm volatile("" : "+v"(l)); return (wv << 6) | l; }

namespace pg8 {
constexpr int BM = 256, BK = 64, HALF = 128, HTB = HALF * BK * 2, STAGE_BYTES = 8 * HTB, NXCD = 8, WGM = 4;
__host__ __device__ __forceinline__ int lds_byte(int r, int c) { const int st = (r >> 4) * 2 + (c >> 5), rr = r & 15, cc = c & 31, ob = rr * 64 + cc * 2; return st * 1024 + (ob ^ (((ob >> 9) & 1) << 5)); }
__host__ __device__ __forceinline__ void stage_rc(int b, int& R, int& C) { const int st = b / 1024, sb = b % 1024, swz = sb ^ (((sb >> 9) & 1) << 5); R = (st >> 1) * 16 + swz / 64; C = (st & 1) * 32 + (swz % 64) / 2; }
__host__ __device__ __forceinline__ int perm32(int rho) { const int n = rho >> 4, i = rho & 15; return 8 * (i >> 2) + 4 * n + (i & 3); }
struct Unit { int pm, pn; };
struct Gemm { const bf16_t* A; const bf16_t* Bt; int M, N, K, lda, ldb; int asplit; size_t aoff; };
struct StaticOrder {
    int nM, nN, nwg, G, c;
    __device__ void init(int M, int N, int G_, int c_) { nM = M / BM; nN = N / BM; nwg = nM * nN; G = G_; c = c_; }
    __device__ bool next(int i, Unit& u) const {
        const long L = (long)i * G + c; if (L >= nwg) return false;
        int wgid = (int)L; { const int q = nwg / NXCD, r = nwg % NXCD, xcd = wgid % NXCD, off = wgid / NXCD; wgid = (xcd < r ? xcd * (q + 1) : r * (q + 1) + (xcd - r) * q) + off; }
        const int nig = WGM * nN, gid = wgid / nig, fm = gid * WGM, gsz = (nM - fm) < WGM ? (nM - fm) : WGM;
        u.pm = fm + ((wgid % nig) % gsz); u.pn = (wgid % nig) / gsz; return true;
    }
};
template <class Epi, class Sched>
__device__ __forceinline__ void gemm_phase(LAS unsigned char* lds, const Gemm g, const Sched& S, const Epi& E, const int WV) {
    const int TI = fresh_tid(WV);
    const int tid = TI, wid = __builtin_amdgcn_readfirstlane(tid >> 6), lane = tid & 63, wr = wid >> 2, wc = wid & 3, fr = lane & 15, fq = lane >> 4;
    const int K = g.K, nt = K / BK;
    unsigned voffA[2], voffB[2];
#pragma unroll
    for (int i = 0; i < 2; ++i) { int R, C; stage_rc(tid * 16 + i * 8192, R, C); const int Rb = Epi::PERM ? ((R & ~31) + perm32(R & 31)) : R;
        voffA[i] = (unsigned)(R * g.lda + C) * 2u; voffB[i] = (unsigned)(Rb * g.ldb + C) * 2u; }
    const size_t kstep = (size_t)(BK * 2);
    const size_t hstepA = (size_t)HALF * g.lda * 2, hstepB = (size_t)HALF * g.ldb * 2;
    const size_t tstepA = 2 * hstepA, tstepB = 2 * hstepB;
    const unsigned ldsw = (unsigned)wid * 1024u;
    const int aoff = lds_byte(wr * 64 + fr, fq * 8), boff = lds_byte(wc * 32 + fr, fq * 8);
#define PG8_SA(b, h) (((b) * 2 + (h)) * HTB)
#define PG8_SB(b, h) ((4 + (b) * 2 + (h)) * HTB)
#define PG8_STAGE(bufoff, gbase, voff) do { _Pragma("unroll") for (int _i = 0; _i < 2; ++_i) \
        __builtin_amdgcn_global_load_lds((const unsigned*)((const char*)(gbase) + (voff)[_i]), (LAS unsigned*)(lds + (bufoff) + ldsw + _i * 8192), 16, 0, 0); } while (0)
#define PG8_LDA(dst, b, h) do { _Pragma("unroll") for (int m = 0; m < 4; ++m) _Pragma("unroll") for (int k = 0; k < 2; ++k) dst[m][k] = *(const LAS bf16x8*)(lds + PG8_SA(b, h) + aoff + m * 2048 + k * 1024); } while (0)
#define PG8_LDB(dst, b, h) do { _Pragma("unroll") for (int n = 0; n < 2; ++n) _Pragma("unroll") for (int k = 0; k < 2; ++k) dst[n][k] = *(const LAS bf16x8*)(lds + PG8_SB(b, h) + boff + n * 2048 + k * 1024); } while (0)
#define PG8_MMA(ai, bj, At, Bt) do { __builtin_amdgcn_s_setprio(1); _Pragma("unroll") for (int m = 0; m < 4; ++m) _Pragma("unroll") for (int n = 0; n < 2; ++n) _Pragma("unroll") for (int k = 0; k < 2; ++k) \
        acc[ai][bj][m][n] = __builtin_amdgcn_mfma_f32_16x16x32_bf16(Bt[n][k], At[m][k], acc[ai][bj][m][n], 0, 0, 0); __builtin_amdgcn_s_setprio(0); } while (0)
#define PG8_WAIT_V(n) asm volatile("s_waitcnt vmcnt(" #n ")" ::: "memory")
#define PG8_WAIT_L(n) asm volatile("s_waitcnt lgkmcnt(" #n ")" ::: "memory")
#define PG8_BAR __builtin_amdgcn_s_barrier()
#define PG8_SCHED __builtin_amdgcn_sched_barrier(0)
#define PG8_ZERO() do { _Pragma("unroll") for (int a_ = 0; a_ < 2; ++a_) _Pragma("unroll") for (int b_ = 0; b_ < 2; ++b_) _Pragma("unroll") for (int m_ = 0; m_ < 4; ++m_) _Pragma("unroll") for (int n_ = 0; n_ < 2; ++n_) acc[a_][b_][m_][n_] = (f32x4){0.f, 0.f, 0.f, 0.f}; } while (0)
    Unit cur, nxt; int ui = 0;
    if (!S.next(0, cur)) return;
    f32x4 acc[2][2][4][2];
    PG8_ZERO();
    bf16x8 At[4][2], B0[2][2], B1[2][2];
    const char* cA = (const char*)g.A + (size_t)cur.pm * tstepA + (cur.pn >= g.asplit ? g.aoff : (size_t)0); const char* cB = (const char*)g.Bt + (size_t)cur.pn * tstepB;
    PG8_STAGE(PG8_SB(0, 0), cB, voffB); PG8_STAGE(PG8_SB(0, 1), cB + hstepB, voffB); PG8_STAGE(PG8_SA(0, 0), cA, voffA); PG8_STAGE(PG8_SA(0, 1), cA + hstepA, voffA);
    if (wr == 1) PG8_BAR;
    PG8_WAIT_V(2); PG8_BAR;
    PG8_STAGE(PG8_SB(1, 0), cB + kstep, voffB); PG8_STAGE(PG8_SA(1, 0), cA + kstep, voffA); PG8_STAGE(PG8_SB(1, 1), cB + hstepB + kstep, voffB);
    PG8_WAIT_V(6); PG8_BAR;
    for (;;) {
        const bool has_next = S.next(ui + 1, nxt);
        const char* nA = has_next ? (const char*)g.A + (size_t)nxt.pm * tstepA + (nxt.pn >= g.asplit ? g.aoff : (size_t)0) : cA; const char* nB = has_next ? (const char*)g.Bt + (size_t)nxt.pn * tstepB : cB;
        for (int t = 0; t < nt; t += 2) {
            const bool last = (t == nt - 2);
            const char* a1 = cA + (size_t)(t + 1) * kstep;
            const char* a2 = last ? nA : cA + (size_t)(t + 2) * kstep; const char* b2 = last ? nB : cB + (size_t)(t + 2) * kstep;
            const char* a3 = a2 + kstep; const char* b3 = b2 + kstep;
            PG8_LDB(B0, 0, 0); PG8_LDB(B1, 0, 1); PG8_SCHED; PG8_LDA(At, 0, 0); PG8_STAGE(PG8_SA(1, 1), a1 + hstepA, voffA);
            PG8_WAIT_V(8); PG8_WAIT_L(0); PG8_BAR; PG8_MMA(0, 0, At, B0); PG8_MMA(0, 1, At, B1); PG8_BAR; PG8_SCHED;
            PG8_LDA(At, 0, 1); PG8_STAGE(PG8_SB(0, 0), b2, voffB); PG8_STAGE(PG8_SB(0, 1), b2 + hstepB, voffB); PG8_STAGE(PG8_SA(0, 0), a2, voffA);
            PG8_WAIT_V(8); PG8_WAIT_L(0); PG8_BAR; PG8_MMA(1, 0, At, B0); PG8_MMA(1, 1, At, B1); PG8_BAR; PG8_SCHED;
            PG8_LDB(B0, 1, 0); PG8_LDB(B1, 1, 1); PG8_SCHED; PG8_LDA(At, 1, 0); PG8_STAGE(PG8_SA(0, 1), a2 + hstepA, voffA);
            PG8_WAIT_V(8); PG8_WAIT_L(0); PG8_BAR; PG8_MMA(0, 0, At, B0); PG8_MMA(0, 1, At, B1); PG8_BAR; PG8_SCHED;
            PG8_LDA(At, 1, 1); PG8_STAGE(PG8_SB(1, 0), b3, voffB); PG8_STAGE(PG8_SB(1, 1), b3 + hstepB, voffB); PG8_STAGE(PG8_SA(1, 0), a3, voffA);
            PG8_WAIT_V(8); PG8_WAIT_L(0); PG8_BAR; PG8_MMA(1, 0, At, B0); PG8_MMA(1, 1, At, B1); PG8_BAR; PG8_SCHED;
            if constexpr (Epi::SEG) { if (t + 2 == 16 || t + 2 == 24) { E.flush(acc, cur, (t + 2 == 16) ? 0 : 1, wr, wc, fr, fq); PG8_ZERO(); } }
        }
        if (wr == 0) PG8_BAR;
        if constexpr (Epi::SEG) E.flush(acc, cur, 2, wr, wc, fr, fq); else E(acc, cur, wr, wc, fr, fq);
        if (!has_next) break;
        PG8_ZERO();
        cur = nxt; cA = nA; cB = nB; ++ui;
        if (wr == 1) PG8_BAR;
    }
    PG8_WAIT_V(0);
    PG8_BAR;
#undef PG8_SA
#undef PG8_SB
#undef PG8_STAGE
#undef PG8_LDA
#undef PG8_LDB
#undef PG8_MMA
#undef PG8_WAIT_V
#undef PG8_WAIT_L
#undef PG8_BAR
#undef PG8_SCHED
#undef PG8_ZERO
}
}
using pg8::Unit;
typedef const f32x4 (&AccRef)[2][2][4][2];

struct Epi1 {
    static constexpr bool PERM = true, SEG = false;
    bf16_t *ocat, *kn, *vv, *qi, *ki, *u, *p, *gates; float* wi; const float* bgate; LAS unsigned char* stg;
    __device__ __forceinline__ void operator()(AccRef acc, const Unit& un, int wr, int wc, int fr, int fq) const {
        asm volatile("" : "+v"(fr), "+v"(fq));
        const int pn = un.pn, rowb = un.pm * 256 + wr * 64, lane = fq * 16 + fr;
        LAS unsigned char* sb = stg + (wr * 4 + wc) * 2304;
        if (pn == 7 && wc >= 1) {
            if (wc == 1 && fq == 0) {
                const float s = 0.35355339059327373f * 0.125f;
#pragma unroll
                for (int ai = 0; ai < 2; ++ai)
#pragma unroll
                    for (int m = 0; m < 4; ++m) { const size_t row = (size_t)(rowb + ai * 128 + m * 16 + fr);
                        *(f32x4*)(wi + row * 8) = acc[ai][0][m][0] * s; *(f32x4*)(wi + row * 8 + 4) = acc[ai][0][m][1] * s; }
            }
            return;
        }
        if (pn >= 12) {
            const int c0 = (pn - 12) * 256 + 64 * wc;
            f32x4 bz[2][2];
#pragma unroll
            for (int bj = 0; bj < 2; ++bj) { bz[bj][0] = *(const f32x4*)(bgate + c0 + 32 * bj + 8 * fq); bz[bj][1] = *(const f32x4*)(bgate + c0 + 32 * bj + 8 * fq + 4); }
            unsigned char* gb = (unsigned char*)gates + c0;
#pragma unroll
            for (int ai = 0; ai < 2; ++ai)
#pragma unroll
                for (int m = 0; m < 4; ++m) {
#pragma unroll
                    for (int bj = 0; bj < 2; ++bj) { uint2 q; unsigned w[2];
#pragma unroll
                        for (int n = 0; n < 2; ++n) { unsigned t = 0u;
#pragma unroll
                            for (int e = 0; e < 4; ++e) t |= (unsigned)(sigmoidf_(acc[ai][bj][m][n][e] + bz[bj][n][e]) * 255.f + 0.5f) << (8 * e);
                            w[n] = t; }
                        q.x = w[0]; q.y = w[1];
                        *(LAS u32x2*)(sb + fr * 80 + 32 * bj + 8 * fq) = (u32x2){q.x, q.y}; }
                    LDS_FENCE();
                    { const int r = lane >> 2, sg = lane & 3; const u32x4 v = *(const LAS u32x4*)(sb + r * 80 + sg * 16);
                      *(u32x4*)(gb + (size_t)(rowb + ai * 128 + m * 16 + r) * 6144 + sg * 16) = v; }
                    LDS_FENCE();
                }
            return;
        }
        bf16_t* base; int ld;
        if (pn < 4) { base = ocat + pn * 256 + 64 * wc; ld = 2048; }
        else if (pn == 4) { base = (wc < 2 ? kn : vv) + 64 * (wc & 1); ld = 128; }
        else if (pn < 7) { base = qi + (pn - 5) * 256 + 64 * wc; ld = 512; }
        else if (pn == 7) { base = ki; ld = 64; }
        else if (pn < 10) { base = u + (pn - 8) * 256 + 64 * wc; ld = 512; }
        else { base = p + (pn - 10) * 256 + 64 * wc; ld = 512; }
#pragma unroll
        for (int ai = 0; ai < 2; ++ai)
#pragma unroll
            for (int m = 0; m < 4; ++m) {
#pragma unroll
                for (int bj = 0; bj < 2; ++bj) { const uint4 pk_ = pack8(acc[ai][bj][m][0], acc[ai][bj][m][1]); *(LAS u32x4*)(sb + fr * 144 + 64 * bj + 16 * fq) = (u32x4){pk_.x, pk_.y, pk_.z, pk_.w}; }
                LDS_FENCE();
#pragma unroll
                for (int h = 0; h < 2; ++h) { const int r = h * 8 + (lane >> 3), sg = lane & 7; const u32x4 v = *(const LAS u32x4*)(sb + r * 144 + sg * 16);
                    *(u32x4*)(base + (size_t)(rowb + ai * 128 + m * 16 + r) * ld + sg * 8) = v; }
                LDS_FENCE();
            }
    }
};
struct EpiGluPool {
    static constexpr bool PERM = true, SEG = false;
    const bf16_t* y; const float* scale; bf16_t* ocat;
    __device__ __forceinline__ void operator()(AccRef acc, const Unit& un, int wr, int wc, int fr, int fq) const {
        asm volatile("" : "+v"(fr), "+v"(fq));
        const int row0 = un.pm * 256 + wr * 64 + fr; const bool glu = un.pn < 2;
#pragma unroll
        for (int bj = 0; bj < 2; ++bj) { const int col = (un.pn & 1) * 256 + 64 * wc + 32 * bj + 8 * fq;
            f32x4 s0 = {0.f, 0.f, 0.f, 0.f}, s1 = {0.f, 0.f, 0.f, 0.f};
            if (!glu) { s0 = *(const f32x4*)(scale + col); s1 = *(const f32x4*)(scale + col + 4); }
#pragma unroll
            for (int ai = 0; ai < 2; ++ai) {
                uint4 yq[4];
                if (glu) {
#pragma unroll
                    for (int m = 0; m < 4; ++m) yq[m] = *(const uint4*)(y + (size_t)(row0 + ai * 128 + m * 16) * 512 + col); }
#pragma unroll
                for (int m = 0; m < 4; ++m) { const size_t row = (size_t)(row0 + ai * 128 + m * 16);
                    f32x4 v0 = acc[ai][bj][m][0], v1 = acc[ai][bj][m][1];
                    if (glu) { float yv[8]; unpack8(yq[m], yv);
#pragma unroll
                        for (int e = 0; e < 4; ++e) { v0[e] = yv[e] * sigmoidf_(v0[e]); v1[e] = yv[4 + e] * sigmoidf_(v1[e]); }
                        *(uint4*)(ocat + row * 2048 + 1024 + col) = pack8(v0, v1);
                    } else *(uint4*)(ocat + row * 2048 + 1536 + col) = pack8(v0 * s0, v1 * s1); } } }
    }
};
struct EpiMerge {
    static constexpr bool PERM = true, SEG = true;
    const bf16_t* gates; bf16_t* merged; LAS unsigned char* stg;
    __device__ __forceinline__ void flush(AccRef acc, const Unit& un, int seg, int wr, int wc, int fr, int fq) const {
        asm volatile("" : "+v"(fr), "+v"(fq));
        const int rowb = un.pm * 256 + wr * 64, lane = fq * 16 + fr;
        const int colw = un.pn * 256 + 64 * wc;
        LAS unsigned char* sb = stg + (wr * 4 + wc) * 2304;
#pragma unroll
        for (int ai = 0; ai < 2; ++ai) {
            uint2 gq[2][4]; uint4 pq[2][4];
#pragma unroll
            for (int bj = 0; bj < 2; ++bj)
#pragma unroll
                for (int m = 0; m < 4; ++m) { const size_t row = (size_t)(rowb + ai * 128 + m * 16 + fr); const int col = colw + 32 * bj + 8 * fq;
                    gq[bj][m] = *(const uint2*)((const unsigned char*)gates + row * 6144 + seg * 2048 + col);
                    if (seg > 0) pq[bj][m] = *(const uint4*)(merged + row * 2048 + col); else pq[bj][m] = make_uint4(0u, 0u, 0u, 0u); }
#pragma unroll
            for (int m = 0; m < 4; ++m) {
#pragma unroll
                for (int bj = 0; bj < 2; ++bj) {
                    float gv[8], pv[8]; unpack8(pq[bj][m], pv);
#pragma unroll
                    for (int e = 0; e < 4; ++e) { gv[e] = (float)((gq[bj][m].x >> (8 * e)) & 0xffu) * (1.f / 255.f); gv[4 + e] = (float)((gq[bj][m].y >> (8 * e)) & 0xffu) * (1.f / 255.f); }
                    f32x4 v0 = acc[ai][bj][m][0], v1 = acc[ai][bj][m][1];
#pragma unroll
                    for (int e = 0; e < 4; ++e) { v0[e] = pv[e] + gv[e] * v0[e]; v1[e] = pv[4 + e] + gv[4 + e] * v1[e]; }
                    const uint4 pk_ = pack8(v0, v1); *(LAS u32x4*)(sb + fr * 144 + 64 * bj + 16 * fq) = (u32x4){pk_.x, pk_.y, pk_.z, pk_.w}; }
                LDS_FENCE();
#pragma unroll
                for (int h = 0; h < 2; ++h) { const int r = h * 8 + (lane >> 3), sg = lane & 7; const u32x4 v = *(const LAS u32x4*)(sb + r * 144 + sg * 16);
                    *(u32x4*)(merged + (size_t)(rowb + ai * 128 + m * 16 + r) * 2048 + colw + sg * 8) = v; }
                LDS_FENCE();
            }
        }
    }
};
struct EpiRes {
    static constexpr bool PERM = false, SEG = false;
    const float* xin; float* out; const float* gt;
    __device__ __forceinline__ void operator()(AccRef acc, const Unit& un, int wr, int wc, int fr, int fq) const {
        asm volatile("" : "+v"(fr), "+v"(fq));
        const int row0 = un.pm * 256 + wr * 64 + fr; const float* g = gt + (size_t)(un.pm >> 3) * 12288;
#pragma unroll
        for (int bj = 0; bj < 2; ++bj) { const int col = un.pn * 256 + bj * 128 + wc * 32 + 4 * fq;
            f32x4 gv[2], xv[2][2][4];
#pragma unroll
            for (int n = 0; n < 2; ++n) gv[n] = *(const f32x4*)(g + col + 16 * n);
#pragma unroll
            for (int n = 0; n < 2; ++n)
#pragma unroll
                for (int ai = 0; ai < 2; ++ai)
#pragma unroll
                    for (int m = 0; m < 4; ++m) xv[n][ai][m] = *(const f32x4*)(xin + (size_t)(row0 + ai * 128 + m * 16) * 2048 + col + 16 * n);
#pragma unroll
            for (int n = 0; n < 2; ++n)
#pragma unroll
                for (int ai = 0; ai < 2; ++ai)
#pragma unroll
                    for (int m = 0; m < 4; ++m) *(f32x4*)(out + (size_t)(row0 + ai * 128 + m * 16) * 2048 + col + 16 * n) = xv[n][ai][m] + gv[n] * acc[ai][bj][m][n]; }
    }
};
struct EpiUp {
    static constexpr bool PERM = true, SEG = false;
    bf16_t* act; float* SA; float* SB; const float* cw; const float* cb; LAS unsigned char* stg;
    __device__ __forceinline__ void operator()(AccRef acc, const Unit& un, int wr, int wc, int fr, int fq) const {
        asm volatile("" : "+v"(fr), "+v"(fq));
        const int lg = fq << 4, lane = lg | fr;
        const int src1 = lg | ((fr + 15) & 15), src2 = lg | ((fr + 14) & 15);
        const int ch0 = un.pn * 128 + wc * 32 + 8 * fq;
        LAS unsigned char* sb = stg + (wr * 4 + wc) * 2304;
        f32x4 w0[2], w1[2], w2[2], bb[2];
#pragma unroll
        for (int n = 0; n < 2; ++n) { w0[n] = *(const f32x4*)(cw + ch0 + 4 * n); w1[n] = *(const f32x4*)(cw + DFF + ch0 + 4 * n); w2[n] = *(const f32x4*)(cw + 2 * DFF + ch0 + 4 * n); bb[n] = *(const f32x4*)(cb + ch0 + 4 * n); }
#pragma unroll
        for (int ai = 0; ai < 2; ++ai) {
            const int rowb = un.pm * 256 + ai * 128 + wr * 64; const int blk = rowb >> 6;
#pragma unroll
            for (int m = 0; m < 4; ++m) {
                f32x4 res[2];
#pragma unroll
                for (int n = 0; n < 2; ++n)
#pragma unroll
                    for (int e = 0; e < 4; ++e) {
                        const float cur = acc[ai][0][m][n][e];
                        const float prv = (m > 0) ? acc[ai][0][m > 0 ? m - 1 : 0][n][e] : 0.f;
                        const float p1 = __shfl((fr + 1 >= 16) ? prv : cur, src1);
                        const float p2 = __shfl((fr + 2 >= 16) ? prv : cur, src2);
                        const float cv = bb[n][e] + w0[n][e] * p2 + w1[n][e] * p1 + w2[n][e] * cur;
                        res[n][e] = siluf_(cv) * acc[ai][1][m][n][e];
                    }
                if (m == 0 && fr < 2) {
                    float* sa = SA + ((size_t)(blk * 4 + 2 + fr)) * DFF + ch0; float* sbp = SB + ((size_t)(blk * 2 + fr)) * DFF + ch0;
                    *(f32x4*)sa = acc[ai][0][0][0]; *(f32x4*)(sa + 4) = acc[ai][0][0][1];
                    *(f32x4*)sbp = acc[ai][1][0][0]; *(f32x4*)(sbp + 4) = acc[ai][1][0][1];
                }
                if (m == 3 && fr >= 14) { float* sa = SA + ((size_t)(blk * 4 + (fr - 14))) * DFF + ch0; *(f32x4*)sa = acc[ai][0][3][0]; *(f32x4*)(sa + 4) = acc[ai][0][3][1]; }
                { const uint4 pk_ = pack8(res[0], res[1]); *(LAS u32x4*)(sb + fr * 80 + 16 * fq) = (u32x4){pk_.x, pk_.y, pk_.z, pk_.w}; }
                LDS_FENCE();
                { const int r = lane >> 2, sg = lane & 3; const u32x4 v = *(const LAS u32x4*)(sb + r * 80 + sg * 16);
                  if (!(m == 0 && r < 2)) *(u32x4*)(act + (size_t)(rowb + m * 16 + r) * DFF + un.pn * 128 + wc * 32 + sg * 8) = v; }
                LDS_FENCE();
            }
        }
    }
};

struct Args { const float* in[31]; float* out; unsigned char* ws; int ph_lo, ph_hi; };
enum { I_X = 0, I_C, I_POS, I_WADA, I_BADA, I_GN1, I_GN2, I_WIN, I_GQ, I_GK, I_ARE, I_AIM, I_BRE, I_BIM, I_CRE, I_CIM, I_DSKIP, I_LOGDT, I_WGLU, I_WPOOL, I_PSCALE, I_PA, I_PB, I_PC, I_WGATE, I_BGATE, I_WOUT, I_WUP, I_CONVW, I_CONVB, I_WDOWN };

__device__ __forceinline__ float wave_sum(float v) {
#pragma unroll
    for (int o = 32; o > 0; o >>= 1) v += __shfl_xor(v, o);
    return v;
}

__device__ __forceinline__ void phase_ada(const Args& a, unsigned char* lds, const int WV) {
    const int TI = fresh_tid(WV);
    const int tid = TI;
    float* cact = (float*)lds;
    float* mod = (float*)(a.ws + WS_MOD);
    for (int w = blockIdx.x; w < 256; w += gridDim.x) {
        for (int i = tid; i < 16 * 2048; i += 512) { const int b = i >> 11, k = i & 2047; const float v = a.in[I_C][i]; cact[k * 16 + b] = siluf_(v); }
        __syncthreads();
        const int l = w >> 7, n0 = (w & 127) * 96;
        float acc[16][4];
#pragma unroll
        for (int b = 0; b < 16; ++b)
#pragma unroll
            for (int j = 0; j < 4; ++j) acc[b][j] = 0.f;
        const int cg4 = tid % 24, ks = tid / 24;
        if (tid < 384) {
            const float* wp = a.in[I_WADA] + ((size_t)l * 2048 + ks * 128) * 12288 + n0 + cg4 * 4;
#pragma unroll 4
            for (int k = 0; k < 128; ++k) {
                const f32x4 wv = *(const f32x4*)(wp + (size_t)k * 12288);
                const f32x4* cp = (const f32x4*)(cact + (ks * 128 + k) * 16);
#pragma unroll
                for (int q = 0; q < 4; ++q) { const f32x4 cv = cp[q];
#pragma unroll
                    for (int e = 0; e < 4; ++e)
#pragma unroll
                        for (int j = 0; j < 4; ++j) acc[q * 4 + e][j] += cv[e] * wv[j]; }
            }
        }
        __syncthreads();
        float* part = (float*)lds;
        if (tid < 384) {
#pragma unroll
            for (int b = 0; b < 16; ++b)
#pragma unroll
                for (int j = 0; j < 4; ++j) part[(ks * 16 + b) * 96 + cg4 * 4 + j] = acc[b][j];
        }
        __syncthreads();
        for (int o = tid; o < 1536; o += 512) { const int b = o / 96, cc = o % 96; float s = 0.f;
#pragma unroll
            for (int k2 = 0; k2 < 16; ++k2) s += part[(k2 * 16 + b) * 96 + cc];
            mod[((size_t)l * 16 + b) * 12288 + n0 + cc] = s + a.in[I_BADA][l * 12288 + n0 + cc]; }
        __syncthreads();
    }
}

struct CvtJob { const float* src; bf16_t* dst; int ldS, cbase, cend, kbase, ldD, mode, r0, cs0, kd0; };
__device__ __forceinline__ CvtJob cvt_decode(const Args& a, int l, int t) {
    unsigned char* ws = a.ws; CvtJob J; int ncols, nkt, idx; J.mode = 0; J.r0 = 0; J.kd0 = 0; J.cs0 = 0;
    if (t < 960) { idx = t; J.src = a.in[I_WIN] + (size_t)l * DM * DIN; J.ldS = DIN; ncols = 1864; nkt = 32; J.dst = (bf16_t*)(ws + W_1CAT); J.ldD = 2048; J.mode = 2; }
    else if (t < 1472) { idx = t - 960; J.src = a.in[I_WIN] + (size_t)l * DM * DIN; J.ldS = DIN; J.cs0 = 1864; ncols = 1024; nkt = 32; J.dst = (bf16_t*)(ws + W_1CAT); J.ldD = 2048; J.r0 = 2048; J.mode = 2; }
    else if (t < 4544) { idx = t - 1472; const int gi = idx >> 10; idx &= 1023; J.src = a.in[I_WGATE] + ((size_t)l * 3 + gi) * DM * DM; J.ldS = DM; ncols = 2048; nkt = 32; J.dst = (bf16_t*)(ws + W_1CAT); J.ldD = 2048; J.r0 = 3072 + 2048 * gi; J.mode = 2; }
    else if (t < 5056) { idx = t - 4544; J.src = a.in[I_PA] + (size_t)l * 1024 * DM; J.ldS = DM; ncols = 2048; nkt = 16; J.dst = (bf16_t*)(ws + W_P); J.ldD = 2048; J.mode = 2; }
    else if (t < 5312) { idx = t - 5056; J.src = a.in[I_PB] + (size_t)l * 512 * DM; J.ldS = DM; ncols = 2048; nkt = 8; J.dst = (bf16_t*)(ws + W_P); J.ldD = 2048; J.kd0 = 1024; J.mode = 2; }
    else if (t < 5568) { idx = t - 5312; J.src = a.in[I_PC] + (size_t)l * 512 * DM; J.ldS = DM; ncols = 2048; nkt = 8; J.dst = (bf16_t*)(ws + W_P); J.ldD = 2048; J.kd0 = 1536; J.mode = 2; }
    else if (t < 6592) { idx = t - 5568; J.src = a.in[I_WOUT] + (size_t)l * DM * DM; J.ldS = DM; ncols = 2048; nkt = 32; J.dst = (bf16_t*)(ws + W_OUT); J.ldD = 2048; }
    else if (t < 12096) { idx = t - 6592; J.src = a.in[I_WUP] + (size_t)l * DM * 2 * DFF; J.ldS = 2 * DFF; ncols = 2 * DFF; nkt = 32; J.dst = (bf16_t*)(ws + W_UP); J.ldD = 2048; J.mode = 1; }
    else if (t < 14848) { idx = t - 12096; J.src = a.in[I_WDOWN] + (size_t)l * DFF * DM; J.ldS = DM; ncols = 2048; nkt = 86; J.dst = (bf16_t*)(ws + W_DOWN); J.ldD = DFF; }
    else { idx = t - 14848; J.src = a.in[I_WGLU] + (size_t)l * 512 * 512; J.ldS = 512; ncols = 512; nkt = 8; J.dst = (bf16_t*)(ws + W_GLU); J.ldD = 512; J.mode = 2; }
    const int tn = idx / nkt, tk = idx - tn * nkt;
    J.cbase = J.cs0 + tn * 64; J.cend = J.cs0 + ncols; J.kbase = tk * 64; return J;
}
__device__ __forceinline__ void phase_cvt(const Args& a, int l, unsigned char* lds, const int WV) {
    const int TI = fresh_tid(WV);
    float* T = (float*)lds;
    const int tid = TI, ty = tid >> 4, tx = tid & 15;
    for (int t4 = blockIdx.x * 8; t4 < 14912; t4 += gridDim.x * 8) {
        f32x4 v[8][2];
#pragma unroll
        for (int q = 0; q < 8; ++q) { const CvtJob J = cvt_decode(a, l, t4 + q);
#pragma unroll
            for (int ps = 0; ps < 2; ++ps) { const int k = ty + ps * 32, c = J.cbase + tx * 4;
                v[q][ps] = (f32x4){0.f, 0.f, 0.f, 0.f};
                if (c < J.cend) v[q][ps] = *(const f32x4*)(J.src + (size_t)(J.kbase + k) * J.ldS + c); } }
#pragma unroll
        for (int q = 0; q < 8; ++q)
#pragma unroll
            for (int ps = 0; ps < 2; ++ps) { float* tp = T + q * (64 * 65) + (ty + ps * 32) * 65 + tx * 4; tp[0] = v[q][ps][0]; tp[1] = v[q][ps][1]; tp[2] = v[q][ps][2]; tp[3] = v[q][ps][3]; }
        __syncthreads();
#pragma unroll
        for (int q = 0; q < 8; ++q) { const CvtJob J = cvt_decode(a, l, t4 + q);
            const int n = tid >> 3, kq = tid & 7, c = J.cbase + n;
            if (c < J.cend) {
                float f[8];
#pragma unroll
                for (int j = 0; j < 8; ++j) f[j] = T[q * (64 * 65) + (kq * 8 + j) * 65 + n];
                int row;
                if (J.mode == 0) row = J.r0 + (c - J.cs0);
                else if (J.mode == 2) { const int r_ = J.r0 + (c - J.cs0), ct = r_ & 255; row = (r_ & ~255) | (((ct >> 5) & 1) << 7) | ((ct >> 6) << 5) | (ct & 31); }
                else { const int bj = c >= DFF ? 1 : 0, ch = c - bj * DFF; row = (ch >> 7) * 256 + bj * 128 + (ch & 127); }
                uint4 o; o.x = pk2(f[0], f[1]); o.y = pk2(f[2], f[3]); o.z = pk2(f[4], f[5]); o.w = pk2(f[6], f[7]);
                *(uint4*)(J.dst + (size_t)row * J.ldD + J.kd0 + J.kbase + kq * 8) = o;
            } }
        __syncthreads();
    }
    bf16_t* wp = (bf16_t*)(a.ws + W_POOL); const float* wsrc = a.in[I_WPOOL] + (size_t)l * 4 * 128 * 128;
    for (int i = blockIdx.x * 512 + TI; i < 512 * 512; i += gridDim.x * 512) { const int n = i >> 9, k = i & 511, g = n >> 7;
        const float v = ((k >> 7) == g) ? wsrc[(g * 128 + (k & 127)) * 128 + (n & 127)] : 0.f;
        const int ct = n & 255, nr = (n & ~255) | (((ct >> 5) & 1) << 7) | ((ct >> 6) << 5) | (ct & 31); wp[nr * 512 + k] = (bf16_t)f2bf(v); }
}

__device__ __forceinline__ void phase_norm(const float* xin, const float* g, const float* modl, int shoff, int scoff, bf16_t* out, const int WV) {
    const int TI = fresh_tid(WV);
    const int lane = TI & 63, wave = TI >> 6;
    for (int r = blockIdx.x * 8 + wave; r < MROWS; r += gridDim.x * 8) {
        const f32x4* xp = (const f32x4*)(xin + (size_t)r * DM); f32x4 v[8]; float ssq = 0.f;
#pragma unroll
        for (int j = 0; j < 8; ++j) { v[j] = xp[j * 64 + lane]; ssq += v[j][0] * v[j][0] + v[j][1] * v[j][1] + v[j][2] * v[j][2] + v[j][3] * v[j][3]; }
        ssq = wave_sum(ssq);
        const float rinv = rsqrtf(ssq * (1.f / DM) + EPS);
        const float* mb = modl + (size_t)(r >> 11) * 12288;
#pragma unroll
        for (int j = 0; j < 8; ++j) { const int col = j * 256 + lane * 4;
            const f32x4 g4 = *(const f32x4*)(g + col), sc = *(const f32x4*)(mb + scoff + col), sh = *(const f32x4*)(mb + shoff + col);
            f32x4 y;
#pragma unroll
            for (int e = 0; e < 4; ++e) y[e] = (v[j][e] * rinv * g4[e]) * (1.f + sc[e]) + sh[e];
            uint2 o; o.x = pk2(y[0], y[1]); o.y = pk2(y[2], y[3]);
            *(uint2*)(out + (size_t)r * DM + col) = o; }
    }
}

__constant__ double kRevPerPos[24] = {0.15915494309189535, 0.0700865215877985, 0.03086376340470123, 0.013591370636193905, 0.005985185712713705, 0.002635675898667414, 0.001160663641240061, 0.0005111175045375439, 0.00022507907903927653, 9.911730936901935e-05, 4.364795279280289e-05, 1.9221100684944863e-05, 8.464330808241401e-06, 3.727408601915352e-06, 1.6414262627950345e-06, 7.228293068832865e-07, 0.15915494309189535, 0.03086376340470123, 0.005985185712713705, 0.001160663641240061, 0.00022507907903927653, 4.364795279280289e-05, 8.464330808241401e-06, 1.6414262627950345e-06};
__device__ __forceinline__ void rmsrope128(bf16_t* p, bool active, const float* g16, int sub, const float* cs) {
    float v[16];
    if (active) { unpack8(*(const uint4*)p, v); unpack8(*(const uint4*)(p + 8), v + 8); }
    else {
#pragma unroll
        for (int i = 0; i < 16; ++i) v[i] = 0.f; }
    float ssq = 0.f;
#pragma unroll
    for (int i = 0; i < 16; ++i) ssq += v[i] * v[i];
    ssq += __shfl_xor(ssq, 1); ssq += __shfl_xor(ssq, 2); ssq += __shfl_xor(ssq, 4);
    const float rinv = rsqrtf(ssq * (1.f / 128.f) + EPS);
#pragma unroll
    for (int i = 0; i < 16; ++i) v[i] = v[i] * rinv * g16[i];
#pragma unroll
    for (int i = 0; i < 16; ++i) { const float o = __shfl_xor(v[i], 1); const float c = cs[2 * i], s = cs[2 * i + 1];
        if (sub == 0) v[i] = v[i] * c - o * s; else if (sub == 1) v[i] = v[i] * c + o * s; }
    if (active) { uint4 o0, o1; o0.x = pk2(v[0], v[1]); o0.y = pk2(v[2], v[3]); o0.z = pk2(v[4], v[5]); o0.w = pk2(v[6], v[7]);
        o1.x = pk2(v[8], v[9]); o1.y = pk2(v[10], v[11]); o1.z = pk2(v[12], v[13]); o1.w = pk2(v[14], v[15]);
        *(uint4*)p = o0; *(uint4*)(p + 8) = o1; }
}
__device__ __forceinline__ void rope64(bf16_t* p, bool active, int sub, const float* cs) {
    float v[8];
    if (active) unpack8(*(const uint4*)p, v);
    else {
#pragma unroll
        for (int i = 0; i < 8; ++i) v[i] = 0.f; }
#pragma unroll
    for (int i = 0; i < 8; ++i) { const float o = __shfl_xor(v[i], 1); const float c = cs[2 * i], s = cs[2 * i + 1];
        if (sub == 0) v[i] = v[i] * c - o * s; else if (sub == 1) v[i] = v[i] * c + o * s; }
    if (active) { uint4 o0; o0.x = pk2(v[0], v[1]); o0.y = pk2(v[2], v[3]); o0.z = pk2(v[4], v[5]); o0.w = pk2(v[6], v[7]); *(uint4*)p = o0; }
}
__device__ __forceinline__ void phase_post(const Args& a, int l, unsigned char* lds, const int WV) {
    const int TI = fresh_tid(WV);
    const int lane = TI & 63, wave = TI >> 6;
    float* cs = (float*)lds + wave * 64;
    bf16_t* ocat = (bf16_t*)(a.ws + WS_OCAT); bf16_t* kn = (bf16_t*)(a.ws + WS_KN); bf16_t* qi = (bf16_t*)(a.ws + WS_QI); bf16_t* ki = (bf16_t*)(a.ws + WS_KI);
    const int* pos = (const int*)a.in[I_POS];
    const int sub = lane & 7, hd = lane >> 3;
    float gq[16], gk[16];
#pragma unroll
    for (int i = 0; i < 16; ++i) { gq[i] = a.in[I_GQ][l * 128 + sub * 16 + i]; gk[i] = a.in[I_GK][l * 128 + sub * 16 + i]; }
    for (int r = blockIdx.x * 8 + wave; r < MROWS; r += gridDim.x * 8) {
        const int ps = pos[r];
        if (lane < 24) {
            double rev = (double)ps * kRevPerPos[lane]; rev -= rint(rev); const float fr = (float)rev;
            cs[lane * 2] = __builtin_amdgcn_cosf(fr); cs[lane * 2 + 1] = __builtin_amdgcn_sinf(fr); }
        LDS_FENCE();
        rmsrope128(ocat + (size_t)r * 2048 + hd * 128 + sub * 16, true, gq, sub, cs);
        rmsrope128(kn + (size_t)r * 128 + sub * 16, lane < 8, gk, sub, cs);
        rope64(qi + (size_t)r * 512 + hd * 64 + sub * 8, true, sub, cs + 32);
        rope64(ki + (size_t)r * 64 + sub * 8, lane < 8, sub, cs + 32);
        LDS_FENCE();
    }
}

__device__ __forceinline__ void s5_unit(const Args& a, int l, int b, int g, unsigned char* lds, const int WV) {
    const int TI = fresh_tid(WV);
    const int lane = TI & 63, wave = __builtin_amdgcn_readfirstlane(TI >> 6), p = lane;
    float* E = (float*)lds;
    float* ust = (float*)(lds + 16384 + wave * 4096);
    bf16_t* sst = (bf16_t*)(lds + 49152 + wave * 4352);
    const bf16_t* U = (const bf16_t*)(a.ws + WS_U); bf16_t* Y = (bf16_t*)(a.ws + WS_Y);
    const int gp = (l * 32 + g) * 64 + p;
    const float are = a.in[I_ARE][gp], aim = a.in[I_AIM][gp], dt = expf(a.in[I_LOGDT][l * 32 + g]);
    const float mag = expf(are * dt);
    float ang = aim * dt; { const float n = rintf(ang * 0.15915494309189535f); ang = fmaf(-n, 6.28318548202514648f, ang); ang = fmaf(n, 1.7484555e-7f, ang); }
    const float lre = mag * cosf(ang), lim = mag * sinf(ang);
    float Bre[16], Bim[16];
    { const float nr = lre - 1.f, ni = lim, den = 1.f / (are * are + aim * aim); const float cr = (nr * are + ni * aim) * den, ci = (ni * are - nr * aim) * den;
#pragma unroll
        for (int j = 0; j < 16; ++j) { const float br = a.in[I_BRE][(size_t)gp * 16 + j], bi = a.in[I_BIM][(size_t)gp * 16 + j]; Bre[j] = cr * br - ci * bi; Bim[j] = cr * bi + ci * br; } }
    bf16x8 Cf[4];
    { const int i = lane & 15;
#pragma unroll
        for (int ks = 0; ks < 4; ++ks)
#pragma unroll
            for (int j = 0; j < 8; ++j) { const int k = ks * 32 + (lane >> 4) * 8 + j, pp = k >> 1; const size_t ci = ((size_t)(l * 32 + g) * 16 + i) * 64 + pp;
                const float v = (k & 1) ? -a.in[I_CIM][ci] : a.in[I_CRE][ci]; Cf[ks][j] = (short)f2bf(v); } }
    const float dsk = a.in[I_DSKIP][l * 512 + g * 16 + (lane & 15)];
    bf16_t* Bl = (bf16_t*)(lds + 83968);
    float* bus = (float*)(lds + 88064 + wave * 8448);
    if (wave == 0) {
#pragma unroll
        for (int q = 0; q < 2; ++q) { uint4 o_; o_.x = pk2(Bre[q * 8], Bre[q * 8 + 1]); o_.y = pk2(Bre[q * 8 + 2], Bre[q * 8 + 3]); o_.z = pk2(Bre[q * 8 + 4], Bre[q * 8 + 5]); o_.w = pk2(Bre[q * 8 + 6], Bre[q * 8 + 7]);
            *(uint4*)(Bl + p * 16 + q * 8) = o_;
            uint4 i_; i_.x = pk2(Bim[q * 8], Bim[q * 8 + 1]); i_.y = pk2(Bim[q * 8 + 2], Bim[q * 8 + 3]); i_.z = pk2(Bim[q * 8 + 4], Bim[q * 8 + 5]); i_.w = pk2(Bim[q * 8 + 6], Bim[q * 8 + 7]);
            *(uint4*)(Bl + (64 + p) * 16 + q * 8) = i_; }
    }
    __syncthreads();
    const int l15 = lane & 15, lg4 = lane >> 4;
    bf16x8 Bf[8];
#pragma unroll
    for (int nb = 0; nb < 8; ++nb) { u32x4 t_ = {0u, 0u, 0u, 0u}; if (lg4 < 2) t_ = *(const u32x4*)(Bl + (nb * 16 + l15) * 16 + lg4 * 8); Bf[nb] = __builtin_bit_cast(bf16x8, t_); }
#define S5_BU(t0_, sb_) do { u32x4 a_ = {0u, 0u, 0u, 0u}; if (lg4 < 2) a_ = *(const u32x4*)(U + (size_t)(b * 2048 + (t0_) + (sb_) * 16 + l15) * 512 + g * 16 + lg4 * 8); \
        const bf16x8 af_ = __builtin_bit_cast(bf16x8, a_); \
        _Pragma("unroll") for (int nb = 0; nb < 8; ++nb) { const f32x4 c_ = __builtin_amdgcn_mfma_f32_16x16x32_bf16(af_, Bf[nb], (f32x4){0.f, 0.f, 0.f, 0.f}, 0, 0, 0); \
            _Pragma("unroll") for (int r = 0; r < 4; ++r) bus[(lg4 * 4 + r) * 132 + nb * 16 + l15] = c_[r]; } \
        LDS_FENCE(); } while (0)
#define S5_STEP(tt_) do { const float br_ = bus[(tt_) * 132 + p], bi_ = bus[(tt_) * 132 + 64 + p]; \
        const float nre_ = lre * sre - lim * sim + br_, nim_ = lre * sim + lim * sre + bi_; sre = nre_; sim = nim_; } while (0)
#pragma unroll 1
    for (int cc = 0; cc < 4; ++cc) {
        const int chunk = wave * 4 + cc, t0 = chunk * 64;
        float sre = 0.f, sim = 0.f;
#pragma unroll 1
        for (int sb = 0; sb < 4; ++sb) {
            S5_BU(t0, sb);
#pragma unroll 4
            for (int tt = 0; tt < 16; ++tt) S5_STEP(tt);
            LDS_FENCE();
        }
        E[(chunk * 64 + p) * 2] = sre; E[(chunk * 64 + p) * 2 + 1] = sim;
    }
    __syncthreads();
    if (wave == 0) {
        float pr = lre, pi = lim;
#pragma unroll
        for (int q = 0; q < 6; ++q) { const float nr = pr * pr - pi * pi, pp_ = pr * pi, ni = pp_ + pp_; pr = nr; pi = ni; }
        float sr = 0.f, si = 0.f;
        for (int c = 0; c < 32; ++c) { const float er = E[(c * 64 + p) * 2], ei = E[(c * 64 + p) * 2 + 1]; E[(c * 64 + p) * 2] = sr; E[(c * 64 + p) * 2 + 1] = si;
            const float nr = pr * sr - pi * si + er, ni = pr * si + pi * sr + ei; sr = nr; si = ni; }
    }
    __syncthreads();
#pragma unroll 1
    for (int cc = 0; cc < 4; ++cc) {
        const int chunk = wave * 4 + cc, t0 = chunk * 64;
        { const bf16_t* up = U + (size_t)(b * 2048 + t0 + lane) * 512 + g * 16; const uint4 q0 = *(const uint4*)up, q1 = *(const uint4*)(up + 8);
            float f[16]; unpack8(q0, f); unpack8(q1, f + 8);
#pragma unroll
            for (int q = 0; q < 4; ++q) *(f32x4*)(ust + lane * 16 + q * 4) = (f32x4){f[q * 4], f[q * 4 + 1], f[q * 4 + 2], f[q * 4 + 3]}; }
        float sre = E[(chunk * 64 + p) * 2], sim = E[(chunk * 64 + p) * 2 + 1];
#pragma unroll 1
        for (int sb = 0; sb < 4; ++sb) {
            S5_BU(t0, sb);
#pragma unroll 4
            for (int tt = 0; tt < 16; ++tt) { S5_STEP(tt);
                *(unsigned*)(sst + tt * 136 + 2 * p) = pk2(sre, sim);
            }
            LDS_FENCE();
            f32x4 acc = {0.f, 0.f, 0.f, 0.f};
#pragma unroll
            for (int ks = 0; ks < 4; ++ks) { const bf16x8 af = *(const bf16x8*)(sst + (lane & 15) * 136 + ks * 32 + (lane >> 4) * 8);
                acc = __builtin_amdgcn_mfma_f32_16x16x32_bf16(af, Cf[ks], acc, 0, 0, 0); }
#pragma unroll
            for (int r = 0; r < 4; ++r) { const int t = sb * 16 + (lane >> 4) * 4 + r, i = lane & 15;
                const float y = gelu_tanh(acc[r] + dsk * ust[t * 16 + i]);
                Y[(size_t)(b * 2048 + t0 + t) * 512 + g * 16 + i] = (bf16_t)f2bf(y); }
            LDS_FENCE();
        }
    }
    __syncthreads();
#undef S5_STEP
#undef S5_BU
}

__device__ __forceinline__ void pool_unit(const Args& a, int b, int chunk, unsigned char* lds, const int WV) {
    const int TI = fresh_tid(WV);
    bf16_t* T = (bf16_t*)lds;
    const int t0 = chunk * 64;
    const bf16_t* P = (const bf16_t*)(a.ws + WS_P) + (size_t)b * 2048 * 512; bf16_t* O = (bf16_t*)(a.ws + WS_POOLED) + (size_t)b * 2048 * 512;
    __syncthreads();
    for (int i = TI; i < 80 * 64; i += 512) { const int r = i >> 6, c8 = i & 63, t = t0 - 16 + r;
        uint4 v = make_uint4(0u, 0u, 0u, 0u); if (t >= 0) v = *(const uint4*)(P + (size_t)t * 512 + c8 * 8);
        *(uint4*)(T + r * 512 + c8 * 8) = v; }
    __syncthreads();
    const int c = TI, w = 2 << (c >> 7);
    float s = 0.f;
    for (int k = 1; k <= w; ++k) s += bf1(T[(16 - k) * 512 + c]);
#pragma unroll 4
    for (int t = 0; t < 64; ++t) { const float pv = bf1(T[(16 + t) * 512 + c]); s += pv; s -= bf1(T[(16 + t - w) * 512 + c]);
        const int tt = t0 + t + 1; const float mean = s / (float)(tt < w ? tt : w); O[(size_t)(t0 + t) * 512 + c] = (bf16_t)f2bf(mean - pv); }
}

__device__ __forceinline__ unsigned sortkey(float x) { const unsigned u = __float_as_uint(x); return (u & 0x80000000u) ? ~u : (u | 0x80000000u); }
template <int NJ>
__device__ __forceinline__ void select256(const float* scq, int limit, unsigned short* sq, int lane) {
    const unsigned long long ltmask = (1ull << lane) - 1ull;
    unsigned key[NJ];
#pragma unroll
    for (int j = 0; j < NJ; ++j) { const int idx = j * 64 + lane; key[j] = (idx < limit) ? sortkey(scq[idx]) : 0u; }
    unsigned T = 0u;
    for (int bit = 31; bit >= 0; --bit) { const unsigned cand = T | (1u << bit); int cnt = 0;
#pragma unroll
        for (int j = 0; j < NJ; ++j) cnt += __popcll(__ballot(key[j] >= cand));
        if (cnt >= 256) { T = cand; if (cnt == 256) break; } }
    int cgt = 0;
#pragma unroll
    for (int j = 0; j < NJ; ++j) cgt += __popcll(__ballot(key[j] > T));
    const int need = 256 - cgt; int ob = 0, tb = 0;
#pragma unroll
    for (int j = 0; j < NJ; ++j) { const bool gt = key[j] > T, eq = key[j] == T; const unsigned long long me = __ballot(eq);
        const int pe = tb + __popcll(me & ltmask); const bool take = gt || (eq && pe < need); const unsigned long long mt = __ballot(take);
        if (take) sq[ob + __popcll(mt & ltmask)] = (unsigned short)(j * 64 + lane);
        ob += __popcll(mt); tb += __popcll(me); }
}
__device__ __forceinline__ void dsa_unit(const Args& a, int b, int tq, unsigned char* lds, const int WV, bf16_t* obase, const int ostride, const int parts) {
    const int TI = fresh_tid(WV);
    int tid = TI;
    int lane = tid & 63; const int wave = WV;
    float* sc = (float*)lds;
    unsigned short* sel = (unsigned short*)(lds + 131072);
    float* wis = (float*)(lds + 131072 + 8192);
    bf16_t* ocat = (bf16_t*)(a.ws + WS_OCAT); const bf16_t* Kn = (const bf16_t*)(a.ws + WS_KN); const bf16_t* V = (const bf16_t*)(a.ws + WS_V);
    const bf16_t* QI = (const bf16_t*)(a.ws + WS_QI); const bf16_t* KI = (const bf16_t*)(a.ws + WS_KI); const float* WI = (const float*)(a.ws + WS_WI);
    const int t0 = tq * 16, row0 = b * 2048 + t0, limit = ((t0 >> 6) + 1) << 6, nkt = limit >> 5, nsel = limit < 256 ? limit : 256;
    __syncthreads();
    if (tid < 128) wis[tid] = WI[(size_t)row0 * 8 + tid];
    __syncthreads();
    if (parts & 1)
    {
        const int g = lane >> 5, c32 = lane & 31;
        bf16x8 Af[4][4];
#pragma unroll
        for (int rb = 0; rb < 4; ++rb) { const int R = rb * 32 + c32; const bf16_t* qp = QI + (size_t)(row0 + (R >> 3)) * 512 + (R & 7) * 64 + g * 8;
#pragma unroll
            for (int s = 0; s < 4; ++s) Af[rb][s] = *(const bf16x8*)(qp + s * 16); }
        bf16x8 Bn[4];
        { const bf16_t* kp0 = KI + (size_t)(b * 2048 + wave * 32 + c32) * 64 + g * 8;
#pragma unroll
            for (int s = 0; s < 4; ++s) Bn[s] = *(const bf16x8*)(kp0 + s * 16); }
#pragma unroll 1
        for (int kt = wave; kt < nkt; kt += 8) {
            bf16x8 Bf[4];
#pragma unroll
            for (int s = 0; s < 4; ++s) Bf[s] = Bn[s];
            if (kt + 8 < nkt) { const bf16_t* kp = KI + (size_t)(b * 2048 + (kt + 8) * 32 + c32) * 64 + g * 8;
#pragma unroll
                for (int s = 0; s < 4; ++s) Bn[s] = *(const bf16x8*)(kp + s * 16); }
#pragma unroll
            for (int rb = 0; rb < 4; ++rb) {
                f32x16 acc;
#pragma unroll
                for (int i = 0; i < 16; ++i) acc[i] = 0.f;
#pragma unroll
                for (int s = 0; s < 4; ++s) acc = __builtin_amdgcn_mfma_f32_32x32x16_bf16(Af[rb][s], Bf[s], acc, 0, 0, 0);
#pragma unroll
                for (int j = 0; j < 4; ++j) { const int q = rb * 4 + j; const f32x4 w4 = *(const f32x4*)(wis + q * 8 + 4 * g);
                    float sp = fmaxf(acc[4 * j], 0.f) * w4[0] + fmaxf(acc[4 * j + 1], 0.f) * w4[1] + fmaxf(acc[4 * j + 2], 0.f) * w4[2] + fmaxf(acc[4 * j + 3], 0.f) * w4[3];
                    sp += __shfl_xor(sp, 32);
                    if (g == 0) sc[q * 2048 + kt * 32 + c32] = sp; }
            }
        }
    }
    __syncthreads();
    lane = fresh_tid(WV) & 63;
    for (int qq = 0; qq < 2; ++qq) {
        const int q = wave * 2 + qq; unsigned short* sq = sel + q * 256;
        if (limit <= 256 || !(parts & 2)) { for (int j = lane; j < nsel; j += 64) sq[j] = (unsigned short)j; }
        else if (limit <= 512) select256<8>(sc + q * 2048, limit, sq, lane);
        else if (limit <= 1024) select256<16>(sc + q * 2048, limit, sq, lane);
        else if (limit <= 1536) select256<24>(sc + q * 2048, limit, sq, lane);
        else select256<32>(sc + q * 2048, limit, sq, lane);
    }
    __syncthreads();
    lane = fresh_tid(WV) & 63;
    float* Pw = (float*)lds + wave * 2048;
    const int g4 = lane >> 4, hh = lane & 15;
#pragma unroll 1
    for (int qq = 0; qq < 2; ++qq) {
        const int q = wave * 2 + qq; const size_t row = (size_t)(row0 + q); const unsigned short* sq = sel + q * 256;
        bf16x8 Qf[4];
#pragma unroll
        for (int s = 0; s < 4; ++s) Qf[s] = *(const bf16x8*)(ocat + row * 2048 + (hh & 7) * 128 + g4 * 8 + s * 32);
        float lg[16][4];
#pragma unroll
        for (int kg = 0; kg < 4; ++kg) {
            if (kg * 64 < nsel) {
                bf16x8 kf[4][4];
#pragma unroll
                for (int k4 = 0; k4 < 4; ++k4) { const int idx = sq[(kg * 4 + k4) * 16 + hh]; const bf16_t* kp = Kn + (size_t)(b * 2048 + idx) * 128 + g4 * 8;
#pragma unroll
                    for (int s = 0; s < 4; ++s) kf[k4][s] = *(const bf16x8*)(kp + s * 32); }
#pragma unroll
                for (int k4 = 0; k4 < 4; ++k4) { f32x4 c = {0.f, 0.f, 0.f, 0.f};
#pragma unroll
                    for (int s = 0; s < 4; ++s) c = __builtin_amdgcn_mfma_f32_16x16x32_bf16(kf[k4][s], Qf[s], c, 0, 0, 0);
#pragma unroll
                    for (int r = 0; r < 4; ++r) lg[kg * 4 + k4][r] = c[r] * 0.08838834764831845f; }
            } else {
#pragma unroll
                for (int k4 = 0; k4 < 4; ++k4)
#pragma unroll
                    for (int r = 0; r < 4; ++r) lg[kg * 4 + k4][r] = -1e30f;
            }
        }
        float mx = -1e30f;
#pragma unroll
        for (int kb = 0; kb < 16; ++kb)
#pragma unroll
            for (int r = 0; r < 4; ++r) mx = fmaxf(mx, lg[kb][r]);
        mx = fmaxf(mx, __shfl_xor(mx, 16)); mx = fmaxf(mx, __shfl_xor(mx, 32));
        float sum = 0.f;
#pragma unroll
        for (int kb = 0; kb < 16; ++kb)
#pragma unroll
            for (int r = 0; r < 4; ++r) { const float e = (kb * 16 < nsel) ? __expf(lg[kb][r] - mx) : 0.f; lg[kb][r] = e; sum += e; }
        sum += __shfl_xor(sum, 16); sum += __shfl_xor(sum, 32);
        const float inv = 1.f / sum;
        bf16x8 Pa[8];
#pragma unroll
        for (int ks = 0; ks < 8; ++ks) {
            const unsigned a0 = pk2(lg[2 * ks][0] * inv, lg[2 * ks][1] * inv), a1 = pk2(lg[2 * ks][2] * inv, lg[2 * ks][3] * inv);
            const unsigned a2 = pk2(lg[2 * ks + 1][0] * inv, lg[2 * ks + 1][1] * inv), a3 = pk2(lg[2 * ks + 1][2] * inv, lg[2 * ks + 1][3] * inv);
            const u32x4 t_ = {a0, a1, a2, a3}; Pa[ks] = __builtin_bit_cast(bf16x8, t_); }
        bf16_t* Vs = (bf16_t*)(lds + wave * 10752);
        bf16_t* Os = Vs + 32 * 136;
        f32x4 oacc[8];
#pragma unroll
        for (int nb = 0; nb < 8; ++nb) oacc[nb] = (f32x4){0.f, 0.f, 0.f, 0.f};
        const bf16_t* Vb = V + (size_t)b * 2048 * 128 + hh * 8;
        u32x4 vq[8], vn[8];
#pragma unroll
        for (int jj = 0; jj < 8; ++jj) vn[jj] = (u32x4){0u, 0u, 0u, 0u};
#pragma unroll
        for (int jj = 0; jj < 8; ++jj) { const int idx = sq[jj * 4 + g4]; vq[jj] = *(const u32x4*)(Vb + (size_t)idx * 128); }
#define PV_BATCH(bt) do { if ((bt) * 32 < nsel) { \
            if (((bt) + 1) * 32 < nsel) { _Pragma("unroll") for (int jj = 0; jj < 8; ++jj) { const int idx = sq[((bt) + 1) * 32 + jj * 4 + g4]; vn[jj] = *(const u32x4*)(Vb + (size_t)idx * 128); } } \
            _Pragma("unroll") for (int jj = 0; jj < 8; ++jj) *(u32x4*)(Vs + (jj * 4 + g4) * 136 + hh * 8) = vq[jj]; \
            LDS_FENCE(); \
            _Pragma("unroll") for (int nb = 0; nb < 8; ++nb) { const bf16_t* vp = Vs + (4 * g4) * 136 + nb * 16 + hh; \
                const unsigned w0_ = (unsigned)vp[0 * 136] | ((unsigned)vp[1 * 136] << 16), w1_ = (unsigned)vp[2 * 136] | ((unsigned)vp[3 * 136] << 16); \
                const unsigned w2_ = (unsigned)vp[16 * 136] | ((unsigned)vp[17 * 136] << 16), w3_ = (unsigned)vp[18 * 136] | ((unsigned)vp[19 * 136] << 16); \
                const u32x4 t_ = {w0_, w1_, w2_, w3_}; \
                oacc[nb] = __builtin_amdgcn_mfma_f32_16x16x32_bf16(Pa[(bt)], __builtin_bit_cast(bf16x8, t_), oacc[nb], 0, 0, 0); } \
            LDS_FENCE(); \
            _Pragma("unroll") for (int jj = 0; jj < 8; ++jj) vq[jj] = vn[jj]; } } while (0)
        PV_BATCH(0); PV_BATCH(1); PV_BATCH(2); PV_BATCH(3); PV_BATCH(4); PV_BATCH(5); PV_BATCH(6); PV_BATCH(7);
#undef PV_BATCH
        if (g4 < 2) {
#pragma unroll
            for (int nb = 0; nb < 8; ++nb)
#pragma unroll
                for (int r = 0; r < 4; ++r) Os[(g4 * 4 + r) * 128 + nb * 16 + hh] = (bf16_t)f2bf(oacc[nb][r]);
        }
        LDS_FENCE();
#pragma unroll
        for (int h = 0; h < 2; ++h) { const uint4 ov = *(const uint4*)(Os + h * 512 + lane * 8); *(uint4*)(obase + row * ostride + h * 512 + lane * 8) = ov; }
        LDS_FENCE();
    }
}

__device__ __forceinline__ void phase_fix(const Args& a, int l, const int WV) {
    const int TI = fresh_tid(WV);
    const float* SA = (const float*)(a.ws + WS_SA); const float* SB = (const float*)(a.ws + WS_SB); bf16_t* act = (bf16_t*)(a.ws + WS_R2);
    const float* cw = a.in[I_CONVW] + (size_t)l * 3 * DFF; const float* cb = a.in[I_CONVB] + (size_t)l * DFF;
    const int total = 512 * 2 * DFF;
    for (int i = blockIdx.x * 512 + TI; i < total; i += gridDim.x * 512) {
        const int ch = i % DFF, rb = i / DFF, rr = rb & 1, blk = rb >> 1, r = blk * 64 + rr, t = r & 2047;
        const float a0 = SA[((size_t)blk * 4 + 2 + rr) * DFF + ch];
        float am1, am2;
        if (rr == 0) { am1 = (t >= 1) ? SA[((size_t)(blk - 1) * 4 + 1) * DFF + ch] : 0.f; am2 = (t >= 2) ? SA[((size_t)(blk - 1) * 4 + 0) * DFF + ch] : 0.f; }
        else { am1 = SA[((size_t)blk * 4 + 2) * DFF + ch]; am2 = (t >= 2) ? SA[((size_t)(blk - 1) * 4 + 1) * DFF + ch] : 0.f; }
        const float cv = cb[ch] + cw[ch] * am2 + cw[DFF + ch] * am1 + cw[2 * DFF + ch] * a0;
        act[(size_t)r * DFF + ch] = (bf16_t)f2bf(siluf_(cv) * SB[((size_t)blk * 2 + rr) * DFF + ch]);
    }
}

__device__ __forceinline__ void run_phase(const Args& a, int ph, unsigned char* lds, const int WV, const bool dummy) {
    unsigned char* ws = a.ws;
    LAS unsigned char* ldsl = (LAS unsigned char*)lds;
    const int G = gridDim.x, bx = blockIdx.x;
#ifndef DBG_NOADA
    if (ph == 0) { phase_ada(a, lds, WV); return; }
#else
    if (ph == 0) return;
#endif
    const int l = (ph - 1) / 10, sp = (ph - 1) % 10;
    const float* modl = (const float*)(ws + WS_MOD) + (size_t)l * 16 * 12288;
    const float* xin = (l == 0) ? a.in[I_X] : a.out;
#ifdef DBG_SP
    if (sp != DBG_SP) return;
#endif
    switch (sp) {
    case 0: phase_cvt(a, l, lds, WV); phase_norm(xin, a.in[I_GN1] + l * DM, modl, 0, 2048, (bf16_t*)(ws + WS_R1), WV); break;
    case 1: {
        pg8::Gemm g{(const bf16_t*)(ws + WS_R1), (const bf16_t*)(ws + W_1CAT), MROWS, N1, DM, DM, DM, 1 << 30, 0}; pg8::StaticOrder S; S.init(MROWS, N1, G, bx);
        Epi1 E{(bf16_t*)(ws + WS_OCAT), (bf16_t*)(ws + WS_KN), (bf16_t*)(ws + WS_V), (bf16_t*)(ws + WS_QI), (bf16_t*)(ws + WS_KI), (bf16_t*)(ws + WS_U), (bf16_t*)(ws + WS_P), (bf16_t*)(ws + WS_R2),
               (float*)(ws + WS_WI), a.in[I_BGATE] + (size_t)l * 3 * DM, ldsl + 131072};
        pg8::gemm_phase<Epi1, pg8::StaticOrder>(ldsl, g, S, E, WV); } break;
    case 2:
        if (!dummy) phase_post(a, l, lds, WV);
        __syncthreads();
        for (int u = bx; u < 512; u += G) s5_unit(a, l, u >> 5, u & 31, lds, WV);
        for (int u = bx; u < 512; u += G) pool_unit(a, u >> 5, u & 31, lds, WV);
        break;
    case 3: {
#ifndef DBG_NO_DSA
#ifdef DSA_PROBE
        for (int rep = 0; rep < 2; ++rep) { const bool dm = (rep == 0); const int parts = dm ? (DSA_PROBE) : 15;
#else
        { const bool dm = dummy; const int parts = 15;
#endif
            for (int u = bx; u < 2048; u += G) { const int w = u & 255, i = u >> 8, b = w & 15, s = w >> 4; const int tq = (i & 1) ? (i * 16 + 15 - s) : (i * 16 + s);
                dsa_unit(a, b, tq, lds, WV, dm ? (bf16_t*)(ws + WS_R1 + 64 * MiB) : (bf16_t*)(ws + WS_OCAT), dm ? 1024 : 2048, parts); }
        }
        __syncthreads();
#endif
#ifndef DBG_DSA_ONLY
        { pg8::Gemm g{(const bf16_t*)(ws + WS_Y), (const bf16_t*)(ws + W_GLU), MROWS, 1024, 512, 512, 512, 2, WS_POOLED - WS_Y}; pg8::StaticOrder S; S.init(MROWS, 1024, G, bx);
          EpiGluPool E{(const bf16_t*)(ws + WS_Y), a.in[I_PSCALE] + l * 512, (bf16_t*)(ws + WS_OCAT)}; pg8::gemm_phase<EpiGluPool, pg8::StaticOrder>(ldsl, g, S, E, WV); }
#endif
        } break;
    case 4: {
        pg8::Gemm g{(const bf16_t*)(ws + WS_OCAT), (const bf16_t*)(ws + W_P), MROWS, DM, DM, DM, DM, 1 << 30, 0}; pg8::StaticOrder S; S.init(MROWS, DM, G, bx);
        EpiMerge E{(const bf16_t*)(ws + WS_R2), (bf16_t*)(ws + WS_R1), ldsl + 131072}; pg8::gemm_phase<EpiMerge, pg8::StaticOrder>(ldsl, g, S, E, WV); } break;
    case 5: {
        pg8::Gemm g{(const bf16_t*)(ws + WS_R1), (const bf16_t*)(ws + W_OUT), MROWS, DM, DM, DM, DM, 1 << 30, 0}; pg8::StaticOrder S; S.init(MROWS, DM, G, bx);
        EpiRes E{xin, dummy ? (float*)(ws + WS_OCAT) : a.out, modl + 4096}; pg8::gemm_phase<EpiRes, pg8::StaticOrder>(ldsl, g, S, E, WV); } break;
    case 6: phase_norm(a.out, a.in[I_GN2] + l * DM, modl, 6144, 8192, (bf16_t*)(ws + WS_R1), WV); break;
    case 7: {
        pg8::Gemm g{(const bf16_t*)(ws + WS_R1), (const bf16_t*)(ws + W_UP), MROWS, 2 * DFF, DM, DM, DM, 1 << 30, 0}; pg8::StaticOrder S; S.init(MROWS, 2 * DFF, G, bx);
        EpiUp E{(bf16_t*)(ws + WS_R2), (float*)(ws + WS_SA), (float*)(ws + WS_SB), a.in[I_CONVW] + (size_t)l * 3 * DFF, a.in[I_CONVB] + (size_t)l * DFF, ldsl + 131072};
        pg8::gemm_phase<EpiUp, pg8::StaticOrder>(ldsl, g, S, E, WV); } break;
    case 8: phase_fix(a, l, WV); break;
    case 9: {
        pg8::Gemm g{(const bf16_t*)(ws + WS_R2), (const bf16_t*)(ws + W_DOWN), MROWS, DM, DFF, DFF, DFF, 1 << 30, 0}; pg8::StaticOrder S; S.init(MROWS, DM, G, bx);
        EpiRes E{a.out, dummy ? (float*)(ws + WS_OCAT) : a.out, modl + 10240}; pg8::gemm_phase<EpiRes, pg8::StaticOrder>(ldsl, g, S, E, WV); } break;
    }
}

#define XB_XCNT(j)  (256  + 64 * (j))
#define XB_XSUB(j)  (1280 + 64 * (j))
#define XB_XGEN(j)  (2304 + 64 * (j))
#define XB_TOP      3328
#define XB_TOPGEN   3392
#define XB_WORDS    3456
__device__ __forceinline__ unsigned xb_ld(unsigned* p)              { return __hip_atomic_load(p, __ATOMIC_RELAXED, __HIP_MEMORY_SCOPE_AGENT); }
__device__ __forceinline__ unsigned xb_add(unsigned* p, unsigned v) { return __hip_atomic_fetch_add(p, v, __ATOMIC_RELAXED, __HIP_MEMORY_SCOPE_AGENT); }
__device__ __forceinline__ unsigned xb_xcc_id() { return (unsigned)__builtin_amdgcn_s_getreg((3 << 11) | 20) & 0xFu; }
#define XB_SPIN(cond) do { unsigned _sp = 0; while (cond) { __builtin_amdgcn_s_sleep(1); if (++_sp > (1u << 22)) break; } } while (0)
__device__ __forceinline__ void grid_bar(unsigned* bar, volatile LAS unsigned* st, int wave_id) {
    asm volatile("s_waitcnt vmcnt(0) lgkmcnt(0)" ::: "memory");
    __syncthreads();
    if (wave_id == 0) {
        const int l = (int)__builtin_amdgcn_mbcnt_hi(~0u, __builtin_amdgcn_mbcnt_lo(~0u, 0u));
        if (l == 0) {
            const unsigned x = xb_xcc_id();
            unsigned nloc = st[0], nx = st[1];
            if (nloc == 0u) {
                const unsigned G = gridDim.x; unsigned sum, cnt, mine, sp = 0u;
                for (;;) { sum = 0u; cnt = 0u; mine = 0u;
#pragma unroll
                    for (unsigned j = 0; j < 16; ++j) { const unsigned c = xb_ld(&bar[XB_XCNT(j)]); sum += c; cnt += (c > 0u) ? 1u : 0u; mine = (j == x) ? c : mine; }
                    if (sum == G) break;
                    __builtin_amdgcn_s_sleep(1); if (++sp > (1u << 22)) break; }
                nloc = mine > 0u ? mine : 1u; nx = cnt > 0u ? cnt : 1u; st[0] = nloc; st[1] = nx;
            }
            const unsigned old = xb_add(&bar[XB_XSUB(x)], 1u);
            const unsigned gen = old / nloc;
            if (old + 1u == (gen + 1u) * nloc) {
                __builtin_amdgcn_fence(__ATOMIC_RELEASE, "agent");
                asm volatile("s_waitcnt vmcnt(0)" ::: "memory");
                const unsigned og = xb_add(&bar[XB_TOP], 1u);
                const unsigned tg = og / nx;
                if (og + 1u == (tg + 1u) * nx) xb_add(&bar[XB_TOPGEN], 1u);
                else XB_SPIN(xb_ld(&bar[XB_TOPGEN]) == tg);
                __builtin_amdgcn_fence(__ATOMIC_ACQUIRE, "agent");
                xb_add(&bar[XB_XGEN(x)], 1u);
                asm volatile("s_waitcnt vmcnt(0)" ::: "memory");
            } else {
                XB_SPIN(xb_ld(&bar[XB_XGEN(x)]) == gen);
                __builtin_amdgcn_fence(__ATOMIC_ACQUIRE, "agent");
                asm volatile("s_waitcnt vmcnt(0)" ::: "memory");
            }
        }
    }
    __syncthreads();
}

__global__ void __launch_bounds__(512, 2) mega_fwd(Args a) {
    extern __shared__ __attribute__((aligned(16))) unsigned char lds[];
    cg::grid_group grid = cg::this_grid();
    const int wave_id = __builtin_amdgcn_readfirstlane((int)(threadIdx.x >> 6));
    const int ph_lo = a.ph_lo, ph_hi = a.ph_hi;
    volatile LAS unsigned* xst = (volatile LAS unsigned*)((LAS unsigned char*)lds + 163776);
    if (threadIdx.x == 0) { xst[0] = 0u; xst[1] = 0u; (void)xb_add((unsigned*)(__attribute__((address_space(1))) unsigned*)a.ws + XB_XCNT(xb_xcc_id()), 1u); }
    __syncthreads();
    for (int ph = ph_lo; ph < ph_hi; ++ph) {
        const __attribute__((address_space(4))) Args* kp = (const __attribute__((address_space(4))) Args*)__builtin_amdgcn_kernarg_segment_ptr();
        asm volatile("" : "+s"(kp));
        Args la;
#pragma unroll
        for (int i = 0; i < 31; ++i) la.in[i] = (const float*)(const __attribute__((address_space(1))) float*)kp->in[i];
        la.ws = (unsigned char*)(__attribute__((address_space(1))) unsigned char*)kp->ws;
        la.out = (float*)(__attribute__((address_space(1))) float*)kp->out;
        la.ph_lo = ph_lo; la.ph_hi = ph_hi;
#ifdef REP_MASK
        if (ph > 0 && ((REP_MASK >> ((ph - 1) % 10)) & 1)) { run_phase(la, ph, lds, wave_id, true); grid.sync(); }
#endif
        run_phase(la, ph, lds, wave_id, false);
        if (ph + 1 < ph_hi) {
            if (ph == ph_lo) grid.sync();
            else grid_bar((unsigned*)la.ws, xst, wave_id);
        }
    }
}

extern "C" void kernel_launch(void* const* d_in, const int* in_sizes, int n_in, void* d_out, int out_size, void* d_ws, size_t ws_size, hipStream_t stream) {
    static int grid = 0;
    if (grid == 0) {
        int dev = 0, cus = 0, per_cu = 0;
        if (n_in != 31 || ws_size < WS_END) { fprintf(stderr, "kernel_launch: unexpected n_in %d / ws %zu\n", n_in, ws_size); grid = -1; return; }
        hipGetDevice(&dev); hipDeviceGetAttribute(&cus, hipDeviceAttributeMultiprocessorCount, dev);
        if (hipFuncSetAttribute((const void*)mega_fwd, hipFuncAttributeMaxDynamicSharedMemorySize, LDS_BYTES) != hipSuccess) { fprintf(stderr, "kernel_launch: hipFuncSetAttribute failed\n"); grid = -1; return; }
        if (hipOccupancyMaxActiveBlocksPerMultiprocessor(&per_cu, (const void*)mega_fwd, 512, LDS_BYTES) != hipSuccess || per_cu < 1) { fprintf(stderr, "kernel_launch: occupancy query says %d blocks/CU\n", per_cu); per_cu = 1; }
        (void)hipGetLastError();
        grid = cus > 0 ? cus : 256;
    }
    if (grid < 0) return;
    if (hipMemsetAsync(d_ws, 0, 16384, stream) != hipSuccess) { fprintf(stderr, "kernel_launch: memset of the barrier word failed\n"); return; }
    Args a{};
    for (int i = 0; i < 31; ++i) a.in[i] = (const float*)d_in[i];
    a.out = (float*)d_out; a.ws = (unsigned char*)d_ws;
#if MK_PER_PHASE
    for (int ph = 0; ph < NPHASE; ++ph) {
        a.ph_lo = ph; a.ph_hi = ph + 1;
        void* args[] = {&a};
        hipError_t e = hipLaunchCooperativeKernel((const void*)mega_fwd, dim3(grid), dim3(512), args, LDS_BYTES, stream);
        if (e != hipSuccess) { fprintf(stderr, "kernel_launch: launch of phase %d failed: %s\n", ph, hipGetErrorString(e)); break; }
    }
#else
    a.ph_lo = 0; a.ph_hi = NPHASE;
    void* args[] = {&a};
    hipError_t e = hipLaunchCooperativeKernel((const void*)mega_fwd, dim3(grid), dim3(512), args, LDS_BYTES, stream);
    if (e != hipSuccess) fprintf(stderr, "kernel_launch: cooperative launch failed: %s (grid %d)\n", hipGetErrorString(e), grid);
#endif
}
```

```cpp
#include <hip/hip_runtime.h>
#include <hip/hip_cooperative_groups.h>
#include <cstdio>
#include <cstdint>
namespace cg = cooperative_groups;

#ifndef MK_PER_PHASE
#define MK_PER_PHASE 0
#endif

typedef unsigned short bf16_t;
typedef short bf16x8 __attribute__((ext_vector_type(8)));
typedef float f32x4 __attribute__((ext_vector_type(4)));
typedef float f32x2 __attribute__((ext_vector_type(2)));
typedef float f32x16 __attribute__((ext_vector_type(16)));
typedef unsigned u32x4 __attribute__((ext_vector_type(4)));
typedef unsigned u32x2 __attribute__((ext_vector_type(2)));
#define LAS __attribute__((address_space(3)))

constexpr int BATCH = 16, SEQ = 2048, DM = 2048, MROWS = BATCH * SEQ, DIN = 2888, DFF = 5504;
constexpr int N1 = 9216;
constexpr float EPS = 1e-6f;
constexpr int NPHASE = 21;

constexpr size_t MiB = 1u << 20;
constexpr size_t WS_MOD = 1 * MiB;
constexpr size_t WS_WI = 3 * MiB;
constexpr size_t WS_W = 4 * MiB;
constexpr size_t W_1CAT = WS_W, W_P = WS_W + 36 * MiB, W_OUT = WS_W + 44 * MiB, W_UP = WS_W + 52 * MiB, W_DOWN = WS_W + 95 * MiB,
                 W_GLU = WS_W + 116 * MiB + MiB / 2, W_POOL = WS_W + 117 * MiB;
constexpr size_t WS_R1 = 122 * MiB;
constexpr size_t WS_Y = WS_R1, WS_POOLED = WS_R1 + 32 * MiB;
constexpr size_t WS_R2 = 250 * MiB;
constexpr size_t WS_OCAT = 634 * MiB;
constexpr size_t WS_SA = WS_OCAT, WS_SB = WS_OCAT + 44 * MiB;
constexpr size_t WS_KN = 762 * MiB, WS_V = 770 * MiB, WS_QI = 778 * MiB, WS_KI = 810 * MiB, WS_U = 814 * MiB, WS_P = 846 * MiB, WS_END = 878 * MiB;
constexpr int LDS_BYTES = 163840;

__device__ __forceinline__ unsigned f2bf(float f) { unsigned u = __float_as_uint(f); return (u + 0x7fffu + ((u >> 16) & 1u)) >> 16; }
__device__ __forceinline__ unsigned pk2(float lo, float hi) { return f2bf(lo) | (f2bf(hi) << 16); }
__device__ __forceinline__ float bflo(unsigned u) { return __uint_as_float(u << 16); }
__device__ __forceinline__ float bfhi(unsigned u) { return __uint_as_float(u & 0xffff0000u); }
__device__ __forceinline__ float bf1(bf16_t b) { return __uint_as_float(((unsigned)b) << 16); }
__device__ __forceinline__ float sigmoidf_(float x) { return __builtin_amdgcn_rcpf(1.f + __expf(-x)); }
__device__ __forceinline__ float siluf_(float x) { return x * __builtin_amdgcn_rcpf(1.f + __expf(-x)); }
__device__ __forceinline__ float dpp_ror1(float v) { return __builtin_bit_cast(float, __builtin_amdgcn_update_dpp(0, __builtin_bit_cast(int, v), 0x121, 0xf, 0xf, false)); }
__device__ __forceinline__ float dpp_ror2(float v) { return __builtin_bit_cast(float, __builtin_amdgcn_update_dpp(0, __builtin_bit_cast(int, v), 0x122, 0xf, 0xf, false)); }
__device__ __forceinline__ float gelu_tanh(float x) { const float z = 0.7978845608028654f * (x + 0.044715f * x * x * x); const float t = 1.f - 2.f * __builtin_amdgcn_rcpf(1.f + __expf(2.f * z)); return 0.5f * x * (1.f + t); }
__device__ __forceinline__ uint4 pack8(f32x4 a, f32x4 b) { uint4 r; r.x = pk2(a[0], a[1]); r.y = pk2(a[2], a[3]); r.z = pk2(b[0], b[1]); r.w = pk2(b[2], b[3]); return r; }
__device__ __forceinline__ void unpack8(uint4 v, float* f) { f[0] = bflo(v.x); f[1] = bfhi(v.x); f[2] = bflo(v.y); f[3] = bfhi(v.y); f[4] = bflo(v.z); f[5] = bfhi(v.z); f[6] = bflo(v.w); f[7] = bfhi(v.w); }
#define LDS_FENCE() asm volatile("s_waitcnt lgkmcnt(0)" ::: "memory")
__device__ __forceinline__ int fresh_tid(int wv) { int l = (int)__builtin_amdgcn_mbcnt_hi(~0u, __builtin_amdgcn_mbcnt_lo(~0u, 0u)); asm volatile("" : "+v"(l)); return (wv << 6) | l; }

namespace pg8 {
constexpr int BM = 256, BK = 64, HALF = 128, HTB = HALF * BK * 2, STAGE_BYTES = 8 * HTB, NXCD = 8, WGM = 4;
__host__ __device__ __forceinline__ int lds_byte(int r, int c) { const int st = (r >> 4) * 2 + (c >> 5), rr = r & 15, cc = c & 31, ob = rr * 64 + cc * 2; return st * 1024 + (ob ^ (((ob >> 9) & 1) << 5)); }
__host__ __device__ __forceinline__ void stage_rc(int b, int& R, int& C) { const int st = b / 1024, sb = b % 1024, swz = sb ^ (((sb >> 9) & 1) << 5); R = (st >> 1) * 16 + swz / 64; C = (st & 1) * 32 + (swz % 64) / 2; }
__host__ __device__ __forceinline__ int perm32(int rho) { const int n = rho >> 4, i = rho & 15; return 8 * (i >> 2) + 4 * n + (i & 3); }
struct Unit { int pm, pn; };
struct Gemm { const bf16_t* A; const bf16_t* Bt; int M, N, K, lda, ldb; int asplit; size_t aoff; };
struct StaticOrder {
    int nM, nN, nwg, G, c;
    __device__ void init(int M, int N, int G_, int c_) { nM = M / BM; nN = N / BM; nwg = nM * nN; G = G_; c = c_; }
    __device__ bool next(int i, Unit& u) const {
        const long L = (long)i * G + c; if (L >= nwg) return false;
        int wgid = (int)L; { const int q = nwg / NXCD, r = nwg % NXCD, xcd = wgid % NXCD, off = wgid / NXCD; wgid = (xcd < r ? xcd * (q + 1) : r * (q + 1) + (xcd - r) * q) + off; }
        const int nig = WGM * nN, gid = wgid / nig, fm = gid * WGM, gsz = (nM - fm) < WGM ? (nM - fm) : WGM;
        u.pm = fm + ((wgid % nig) % gsz); u.pn = (wgid % nig) / gsz; return true;
    }
};
template <class Epi, class Sched>
__device__ __forceinline__ void gemm_phase(LAS unsigned char* lds, const Gemm g, const Sched& S, const Epi& E, const int WV) {
    const int TI = fresh_tid(WV);
    const int tid = TI, wid = __builtin_amdgcn_readfirstlane(tid >> 6), lane = tid & 63, wr = wid >> 2, wc = wid & 3, fr = lane & 15, fq = lane >> 4;
    const int K = g.K, nt = K / BK;
    unsigned voffA[2], voffB[2];
#pragma unroll
    for (int i = 0; i < 2; ++i) { int R, C; stage_rc(tid * 16 + i * 8192, R, C); const int Rb = Epi::PERM ? ((R & ~31) + perm32(R & 31)) : R;
        voffA[i] = (unsigned)(R * g.lda + C) * 2u; voffB[i] = (unsigned)(Rb * g.ldb + C) * 2u; }
    const size_t kstep = (size_t)(BK * 2);
    const size_t hstepA = (size_t)HALF * g.lda * 2, hstepB = (size_t)HALF * g.ldb * 2;
    const size_t tstepA = 2 * hstepA, tstepB = 2 * hstepB;
    const unsigned ldsw = (unsigned)wid * 1024u;
    const int aoff = lds_byte(wr * 64 + fr, fq * 8), boff = lds_byte(wc * 32 + fr, fq * 8);
#define PG8_SA(b, h) (((b) * 2 + (h)) * HTB)
#define PG8_SB(b, h) ((4 + (b) * 2 + (h)) * HTB)
#define PG8_STAGE(bufoff, gbase, voff) do { _Pragma("unroll") for (int _i = 0; _i < 2; ++_i) \
        __builtin_amdgcn_global_load_lds((const unsigned*)((const char*)(gbase) + (voff)[_i]), (LAS unsigned*)(lds + (bufoff) + ldsw + _i * 8192), 16, 0, 0); } while (0)
#define PG8_LDA(dst, b, h) do { _Pragma("unroll") for (int m = 0; m < 4; ++m) _Pragma("unroll") for (int k = 0; k < 2; ++k) dst[m][k] = *(const LAS bf16x8*)(lds + PG8_SA(b, h) + aoff + m * 2048 + k * 1024); } while (0)
#define PG8_LDB(dst, b, h) do { _Pragma("unroll") for (int n = 0; n < 2; ++n) _Pragma("unroll") for (int k = 0; k < 2; ++k) dst[n][k] = *(const LAS bf16x8*)(lds + PG8_SB(b, h) + boff + n * 2048 + k * 1024); } while (0)
#define PG8_MMA(ai, bj, At, Bt) do { __builtin_amdgcn_s_setprio(1); _Pragma("unroll") for (int m = 0; m < 4; ++m) _Pragma("unroll") for (int n = 0; n < 2; ++n) _Pragma("unroll") for (int k = 0; k < 2; ++k) \
        acc[ai][bj][m][n] = __builtin_amdgcn_mfma_f32_16x16x32_bf16(Bt[n][k], At[m][k], acc[ai][bj][m][n], 0, 0, 0); __builtin_amdgcn_s_setprio(0); } while (0)
#define PG8_WAIT_V(n) asm volatile("s_waitcnt vmcnt(" #n ")" ::: "memory")
#define PG8_WAIT_L(n) asm volatile("s_waitcnt lgkmcnt(" #n ")" ::: "memory")
#define PG8_BAR __builtin_amdgcn_s_barrier()
#define PG8_SCHED __builtin_amdgcn_sched_barrier(0)
#define PG8_ZERO() do { _Pragma("unroll") for (int a_ = 0; a_ < 2; ++a_) _Pragma("unroll") for (int b_ = 0; b_ < 2; ++b_) _Pragma("unroll") for (int m_ = 0; m_ < 4; ++m_) _Pragma("unroll") for (int n_ = 0; n_ < 2; ++n_) acc[a_][b_][m_][n_] = (f32x4){0.f, 0.f, 0.f, 0.f}; } while (0)
    Unit cur, nxt; int ui = 0;
    if (!S.next(0, cur)) return;
    f32x4 acc[2][2][4][2];
    PG8_ZERO();
    bf16x8 At[4][2], B0[2][2], B1[2][2];
    const char* cA = (const char*)g.A + (size_t)cur.pm * tstepA + (cur.pn >= g.asplit ? g.aoff : (size_t)0); const char* cB = (const char*)g.Bt + (size_t)cur.pn * tstepB;
    PG8_STAGE(PG8_SB(0, 0), cB, voffB); PG8_STAGE(PG8_SB(0, 1), cB + hstepB, voffB); PG8_STAGE(PG8_SA(0, 0), cA, voffA); PG8_STAGE(PG8_SA(0, 1), cA + hstepA, voffA);
    if (wr == 1) PG8_BAR;
    PG8_WAIT_V(2); PG8_BAR;
    PG8_STAGE(PG8_SB(1, 0), cB + kstep, voffB); PG8_STAGE(PG8_SA(1, 0), cA + kstep, voffA); PG8_STAGE(PG8_SB(1, 1), cB + hstepB + kstep, voffB);
    PG8_WAIT_V(6); PG8_BAR;
    for (;;) {
        const bool has_next = S.next(ui + 1, nxt);
        const char* nA = has_next ? (const char*)g.A + (size_t)nxt.pm * tstepA + (nxt.pn >= g.asplit ? g.aoff : (size_t)0) : cA; const char* nB = has_next ? (const char*)g.Bt + (size_t)nxt.pn * tstepB : cB;
        for (int t = 0; t < nt; t += 2) {
            const bool last = (t == nt - 2);
            const char* a1 = cA + (size_t)(t + 1) * kstep;
            const char* a2 = last ? nA : cA + (size_t)(t + 2) * kstep; const char* b2 = last ? nB : cB + (size_t)(t + 2) * kstep;
            const char* a3 = a2 + kstep; const char* b3 = b2 + kstep;
            PG8_LDB(B0, 0, 0); PG8_LDB(B1, 0, 1); PG8_SCHED; PG8_LDA(At, 0, 0); PG8_STAGE(PG8_SA(1, 1), a1 + hstepA, voffA);
            PG8_WAIT_V(8); PG8_WAIT_L(0); PG8_BAR; PG8_MMA(0, 0, At, B0); PG8_MMA(0, 1, At, B1); PG8_BAR; PG8_SCHED;
            PG8_LDA(At, 0, 1); PG8_STAGE(PG8_SB(0, 0), b2, voffB); PG8_STAGE(PG8_SB(0, 1), b2 + hstepB, voffB); PG8_STAGE(PG8_SA(0, 0), a2, voffA);
            PG8_WAIT_V(8); PG8_WAIT_L(0); PG8_BAR; PG8_MMA(1, 0, At, B0); PG8_MMA(1, 1, At, B1); PG8_BAR; PG8_SCHED;
            PG8_LDB(B0, 1, 0); PG8_LDB(B1, 1, 1); PG8_SCHED; PG8_LDA(At, 1, 0); PG8_STAGE(PG8_SA(0, 1), a2 + hstepA, voffA);
            PG8_WAIT_V(8); PG8_WAIT_L(0); PG8_BAR; PG8_MMA(0, 0, At, B0); PG8_MMA(0, 1, At, B1); PG8_BAR; PG8_SCHED;
            PG8_LDA(At, 1, 1); PG8_STAGE(PG8_SB(1, 0), b3, voffB); PG8_STAGE(PG8_SB(1, 1), b3 + hstepB, voffB); PG8_STAGE(PG8_SA(1, 0), a3, voffA);
            PG8_WAIT_V(8); PG8_WAIT_L(0); PG8_BAR; PG8_MMA(1, 0, At, B0); PG8_MMA(1, 1, At, B1); PG8_BAR; PG8_SCHED;
            if constexpr (Epi::SEG) { if (t + 2 == 16 || t + 2 == 24) { E.flush(acc, cur, (t + 2 == 16) ? 0 : 1, wr, wc, fr, fq); PG8_ZERO(); } }
        }
        if (wr == 0) PG8_BAR;
        if constexpr (Epi::SEG) E.flush(acc, cur, 2, wr, wc, fr, fq); else E(acc, cur, wr, wc, fr, fq);
        if (!has_next) break;
        PG8_ZERO();
        cur = nxt; cA = nA; cB = nB; ++ui;
        if (wr == 1) PG8_BAR;
    }
    PG8_WAIT_V(0);
    PG8_BAR;
#undef PG8_SA
#undef PG8_SB
#undef PG8_STAGE
#undef PG8_LDA
#undef PG8_LDB
#undef PG8_MMA
#undef PG8_WAIT_V
#undef PG8_WAIT_L
#undef PG8_BAR
#undef PG8_SCHED
#undef PG8_ZERO
}
}
using pg8::Unit;
typedef const f32x4 (&AccRef)[2][2][4][2];

struct Epi1 {
    static constexpr bool PERM = true, SEG = false;
    bf16_t *ocat, *kn, *vv, *qi, *ki, *u, *p, *gates; float* wi; const float* bgate; LAS unsigned char* stg;
    __device__ __forceinline__ void operator()(AccRef acc, const Unit& un, int wr, int wc, int fr, int fq) const {
        asm volatile("" : "+v"(fr), "+v"(fq));
        const int pn = un.pn, rowb = un.pm * 256 + wr * 64, lane = fq * 16 + fr;
        LAS unsigned char* sb = stg + (wr * 4 + wc) * 2304;
        if (pn == 7 && wc >= 1) {
            if (wc == 1 && fq == 0) {
                const float s = 0.35355339059327373f * 0.125f;
#pragma unroll
                for (int ai = 0; ai < 2; ++ai)
#pragma unroll
                    for (int m = 0; m < 4; ++m) { const size_t row = (size_t)(rowb + ai * 128 + m * 16 + fr);
                        *(f32x4*)(wi + row * 8) = acc[ai][0][m][0] * s; *(f32x4*)(wi + row * 8 + 4) = acc[ai][0][m][1] * s; }
            }
            return;
        }
        if (pn >= 12) {
            const int c0 = (pn - 12) * 256 + 64 * wc;
            f32x4 bz[2][2];
#pragma unroll
            for (int bj = 0; bj < 2; ++bj) { bz[bj][0] = *(const f32x4*)(bgate + c0 + 32 * bj + 8 * fq); bz[bj][1] = *(const f32x4*)(bgate + c0 + 32 * bj + 8 * fq + 4); }
            unsigned char* gb = (unsigned char*)gates + c0;
#pragma unroll
            for (int ai = 0; ai < 2; ++ai)
#pragma unroll
                for (int m = 0; m < 4; ++m) {
#pragma unroll
                    for (int bj = 0; bj < 2; ++bj) { uint2 q; unsigned w[2];
#pragma unroll
                        for (int n = 0; n < 2; ++n) { unsigned t = 0u;
#pragma unroll
                            for (int e = 0; e < 4; ++e) t |= (unsigned)(sigmoidf_(acc[ai][bj][m][n][e] + bz[bj][n][e]) * 255.f + 0.5f) << (8 * e);
                            w[n] = t; }
                        q.x = w[0]; q.y = w[1];
                        *(LAS u32x2*)(sb + fr * 80 + 32 * bj + 8 * fq) = (u32x2){q.x, q.y}; }
                    LDS_FENCE();
                    { const int r = lane >> 2, sg = lane & 3; const u32x4 v = *(const LAS u32x4*)(sb + r * 80 + sg * 16);
                      *(u32x4*)(gb + (size_t)(rowb + ai * 128 + m * 16 + r) * 6144 + sg * 16) = v; }
                    LDS_FENCE();
                }
            return;
        }
        bf16_t* base; int ld;
        if (pn < 4) { base = ocat + pn * 256 + 64 * wc; ld = 2048; }
        else if (pn == 4) { base = (wc < 2 ? kn : vv) + 64 * (wc & 1); ld = 128; }
        else if (pn < 7) { base = qi + (pn - 5) * 256 + 64 * wc; ld = 512; }
        else if (pn == 7) { base = ki; ld = 64; }
        else if (pn < 10) { base = u + (pn - 8) * 256 + 64 * wc; ld = 512; }
        else { base = p + (pn - 10) * 256 + 64 * wc; ld = 512; }
#pragma unroll
        for (int ai = 0; ai < 2; ++ai)
#pragma unroll
            for (int m = 0; m < 4; ++m) {
#pragma unroll
                for (int bj = 0; bj < 2; ++bj) { const uint4 pk_ = pack8(acc[ai][bj][m][0], acc[ai][bj][m][1]); *(LAS u32x4*)(sb + fr * 144 + 64 * bj + 16 * fq) = (u32x4){pk_.x, pk_.y, pk_.z, pk_.w}; }
                LDS_FENCE();
#pragma unroll
                for (int h = 0; h < 2; ++h) { const int r = h * 8 + (lane >> 3), sg = lane & 7; const u32x4 v = *(const LAS u32x4*)(sb + r * 144 + sg * 16);
                    *(u32x4*)(base + (size_t)(rowb + ai * 128 + m * 16 + r) * ld + sg * 8) = v; }
                LDS_FENCE();
            }
    }
};
struct EpiGluPool {
    static constexpr bool PERM = true, SEG = false;
    const bf16_t* y; const float* scale; bf16_t* ocat;
    __device__ __forceinline__ void operator()(AccRef acc, const Unit& un, int wr, int wc, int fr, int fq) const {
        asm volatile("" : "+v"(fr), "+v"(fq));
        const int row0 = un.pm * 256 + wr * 64 + fr; const bool glu = un.pn < 2;
#pragma unroll
        for (int bj = 0; bj < 2; ++bj) { const int col = (un.pn & 1) * 256 + 64 * wc + 32 * bj + 8 * fq;
            f32x4 s0 = {0.f, 0.f, 0.f, 0.f}, s1 = {0.f, 0.f, 0.f, 0.f};
            if (!glu) { s0 = *(const f32x4*)(scale + col); s1 = *(const f32x4*)(scale + col + 4); }
#pragma unroll
            for (int ai = 0; ai < 2; ++ai) {
                uint4 yq[4];
                if (glu) {
#pragma unroll
                    for (int m = 0; m < 4; ++m) yq[m] = *(const uint4*)(y + (size_t)(row0 + ai * 128 + m * 16) * 512 + col); }
#pragma unroll
                for (int m = 0; m < 4; ++m) { const size_t row = (size_t)(row0 + ai * 128 + m * 16);
                    f32x4 v0 = acc[ai][bj][m][0], v1 = acc[ai][bj][m][1];
                    if (glu) { float yv[8]; unpack8(yq[m], yv);
#pragma unroll
                        for (int e = 0; e < 4; ++e) { v0[e] = yv[e] * sigmoidf_(v0[e]); v1[e] = yv[4 + e] * sigmoidf_(v1[e]); }
                        *(uint4*)(ocat + row * 2048 + 1024 + col) = pack8(v0, v1);
                    } else *(uint4*)(ocat + row * 2048 + 1536 + col) = pack8(v0 * s0, v1 * s1); } } }
    }
};
struct EpiMerge {
    static constexpr bool PERM = true, SEG = true;
    const bf16_t* gates; bf16_t* merged; LAS unsigned char* stg;
    __device__ __forceinline__ void flush(AccRef acc, const Unit& un, int seg, int wr, int wc, int fr, int fq) const {
        asm volatile("" : "+v"(fr), "+v"(fq));
        const int rowb = un.pm * 256 + wr * 64, lane = fq * 16 + fr;
        const int colw = un.pn * 256 + 64 * wc;
        LAS unsigned char* sb = stg + (wr * 4 + wc) * 2304;
#pragma unroll
        for (int ai = 0; ai < 2; ++ai) {
            uint2 gq[2][4]; uint4 pq[2][4];
#pragma unroll
            for (int bj = 0; bj < 2; ++bj)
#pragma unroll
                for (int m = 0; m < 4; ++m) { const size_t row = (size_t)(rowb + ai * 128 + m * 16 + fr); const int col = colw + 32 * bj + 8 * fq;
                    gq[bj][m] = *(const uint2*)((const unsigned char*)gates + row * 6144 + seg * 2048 + col);
                    if (seg > 0) pq[bj][m] = *(const uint4*)(merged + row * 2048 + col); else pq[bj][m] = make_uint4(0u, 0u, 0u, 0u); }
#pragma unroll
            for (int m = 0; m < 4; ++m) {
#pragma unroll
                for (int bj = 0; bj < 2; ++bj) {
                    float gv[8], pv[8]; unpack8(pq[bj][m], pv);
#pragma unroll
                    for (int e = 0; e < 4; ++e) { gv[e] = (float)((gq[bj][m].x >> (8 * e)) & 0xffu) * (1.f / 255.f); gv[4 + e] = (float)((gq[bj][m].y >> (8 * e)) & 0xffu) * (1.f / 255.f); }
                    f32x4 v0 = acc[ai][bj][m][0], v1 = acc[ai][bj][m][1];
#pragma unroll
                    for (int e = 0; e < 4; ++e) { v0[e] = pv[e] + gv[e] * v0[e]; v1[e] = pv[4 + e] + gv[4 + e] * v1[e]; }
                    const uint4 pk_ = pack8(v0, v1); *(LAS u32x4*)(sb + fr * 144 + 64 * bj + 16 * fq) = (u32x4){pk_.x, pk_.y, pk_.z, pk_.w}; }
                LDS_FENCE();
#pragma unroll
                for (int h = 0; h < 2; ++h) { const int r = h * 8 + (lane >> 3), sg = lane & 7; const u32x4 v = *(const LAS u32x4*)(sb + r * 144 + sg * 16);
                    *(u32x4*)(merged + (size_t)(rowb + ai * 128 + m * 16 + r) * 2048 + colw + sg * 8) = v; }
                LDS_FENCE();
            }
        }
    }
};
struct EpiRes {
    static constexpr bool PERM = false, SEG = false;
    const float* xin; float* out; const float* gt;
    __device__ __forceinline__ void operator()(AccRef acc, const Unit& un, int wr, int wc, int fr, int fq) const {
        asm volatile("" : "+v"(fr), "+v"(fq));
        const int row0 = un.pm * 256 + wr * 64 + fr; const float* g = gt + (size_t)(un.pm >> 3) * 12288;
#pragma unroll
        for (int bj = 0; bj < 2; ++bj) { const int col = un.pn * 256 + bj * 128 + wc * 32 + 4 * fq;
            f32x4 gv[2], xv[2][2][4];
#pragma unroll
            for (int n = 0; n < 2; ++n) gv[n] = *(const f32x4*)(g + col + 16 * n);
#pragma unroll
            for (int n = 0; n < 2; ++n)
#pragma unroll
                for (int ai = 0; ai < 2; ++ai)
#pragma unroll
                    for (int m = 0; m < 4; ++m) xv[n][ai][m] = *(const f32x4*)(xin + (size_t)(row0 + ai * 128 + m * 16) * 2048 + col + 16 * n);
#pragma unroll
            for (int n = 0; n < 2; ++n)
#pragma unroll
                for (int ai = 0; ai < 2; ++ai)
#pragma unroll
                    for (int m = 0; m < 4; ++m) *(f32x4*)(out + (size_t)(row0 + ai * 128 + m * 16) * 2048 + col + 16 * n) = xv[n][ai][m] + gv[n] * acc[ai][bj][m][n]; }
    }
};
struct EpiUp {
    static constexpr bool PERM = true, SEG = false;
    bf16_t* act; float* SA; float* SB; const float* cw; const float* cb; LAS unsigned char* stg;
    __device__ __forceinline__ void operator()(AccRef acc, const Unit& un, int wr, int wc, int fr, int fq) const {
        asm volatile("" : "+v"(fr), "+v"(fq));
        const int lg = fq << 4, lane = lg | fr;
        const int src1 = lg | ((fr + 15) & 15), src2 = lg | ((fr + 14) & 15);
        const int ch0 = un.pn * 128 + wc * 32 + 8 * fq;
        LAS unsigned char* sb = stg + (wr * 4 + wc) * 2304;
        f32x4 w0[2], w1[2], w2[2], bb[2];
#pragma unroll
        for (int n = 0; n < 2; ++n) { w0[n] = *(const f32x4*)(cw + ch0 + 4 * n); w1[n] = *(const f32x4*)(cw + DFF + ch0 + 4 * n); w2[n] = *(const f32x4*)(cw + 2 * DFF + ch0 + 4 * n); bb[n] = *(const f32x4*)(cb + ch0 + 4 * n); }
#pragma unroll
        for (int ai = 0; ai < 2; ++ai) {
            const int rowb = un.pm * 256 + ai * 128 + wr * 64; const int blk = rowb >> 6;
#pragma unroll
            for (int m = 0; m < 4; ++m) {
                f32x4 res[2];
#pragma unroll
                for (int n = 0; n < 2; ++n)
#pragma unroll
                    for (int e = 0; e < 4; ++e) {
                        const float cur = acc[ai][0][m][n][e];
                        const float prv = (m > 0) ? acc[ai][0][m > 0 ? m - 1 : 0][n][e] : 0.f;
                        const float p1 = dpp_ror1((fr + 1 >= 16) ? prv : cur);
                        const float p2 = dpp_ror2((fr + 2 >= 16) ? prv : cur);
                        const float cv = bb[n][e] + w0[n][e] * p2 + w1[n][e] * p1 + w2[n][e] * cur;
                        res[n][e] = siluf_(cv) * acc[ai][1][m][n][e];
                    }
                if (m == 0 && fr < 2) {
                    float* sa = SA + ((size_t)(blk * 4 + 2 + fr)) * DFF + ch0; float* sbp = SB + ((size_t)(blk * 2 + fr)) * DFF + ch0;
                    *(f32x4*)sa = acc[ai][0][0][0]; *(f32x4*)(sa + 4) = acc[ai][0][0][1];
                    *(f32x4*)sbp = acc[ai][1][0][0]; *(f32x4*)(sbp + 4) = acc[ai][1][0][1];
                }
                if (m == 3 && fr >= 14) { float* sa = SA + ((size_t)(blk * 4 + (fr - 14))) * DFF + ch0; *(f32x4*)sa = acc[ai][0][3][0]; *(f32x4*)(sa + 4) = acc[ai][0][3][1]; }
                { const uint4 pk_ = pack8(res[0], res[1]); *(LAS u32x4*)(sb + fr * 80 + 16 * fq) = (u32x4){pk_.x, pk_.y, pk_.z, pk_.w}; }
                LDS_FENCE();
                { const int r = lane >> 2, sg = lane & 3; const u32x4 v = *(const LAS u32x4*)(sb + r * 80 + sg * 16);
                  if (!(m == 0 && r < 2)) *(u32x4*)(act + (size_t)(rowb + m * 16 + r) * DFF + un.pn * 128 + wc * 32 + sg * 8) = v; }
                LDS_FENCE();
            }
        }
    }
};

struct Args { const float* in[31]; float* out; unsigned char* ws; int ph_lo, ph_hi; };
enum { I_X = 0, I_C, I_POS, I_WADA, I_BADA, I_GN1, I_GN2, I_WIN, I_GQ, I_GK, I_ARE, I_AIM, I_BRE, I_BIM, I_CRE, I_CIM, I_DSKIP, I_LOGDT, I_WGLU, I_WPOOL, I_PSCALE, I_PA, I_PB, I_PC, I_WGATE, I_BGATE, I_WOUT, I_WUP, I_CONVW, I_CONVB, I_WDOWN };

__device__ __forceinline__ float wave_sum(float v) {
#pragma unroll
    for (int o = 32; o > 0; o >>= 1) v += __shfl_xor(v, o);
    return v;
}

__device__ __forceinline__ void phase_ada(const Args& a, unsigned char* lds, const int WV) {
    const int TI = fresh_tid(WV);
    const int tid = TI;
    float* cact = (float*)lds;
    float* mod = (float*)(a.ws + WS_MOD);
    for (int w = blockIdx.x; w < 256; w += gridDim.x) {
        for (int i = tid; i < 16 * 2048; i += 512) { const int b = i >> 11, k = i & 2047; const float v = a.in[I_C][i]; cact[k * 16 + b] = siluf_(v); }
        __syncthreads();
        const int l = w >> 7, n0 = (w & 127) * 96;
        float acc[16][4];
#pragma unroll
        for (int b = 0; b < 16; ++b)
#pragma unroll
            for (int j = 0; j < 4; ++j) acc[b][j] = 0.f;
        const int cg4 = tid % 24, ks = tid / 24;
        if (tid < 384) {
            const float* wp = a.in[I_WADA] + ((size_t)l * 2048 + ks * 128) * 12288 + n0 + cg4 * 4;
#pragma unroll 4
            for (int k = 0; k < 128; ++k) {
                const f32x4 wv = *(const f32x4*)(wp + (size_t)k * 12288);
                const f32x4* cp = (const f32x4*)(cact + (ks * 128 + k) * 16);
#pragma unroll
                for (int q = 0; q < 4; ++q) { const f32x4 cv = cp[q];
#pragma unroll
                    for (int e = 0; e < 4; ++e)
#pragma unroll
                        for (int j = 0; j < 4; ++j) acc[q * 4 + e][j] += cv[e] * wv[j]; }
            }
        }
        __syncthreads();
        float* part = (float*)lds;
        if (tid < 384) {
#pragma unroll
            for (int b = 0; b < 16; ++b)
#pragma unroll
                for (int j = 0; j < 4; ++j) part[(ks * 16 + b) * 96 + cg4 * 4 + j] = acc[b][j];
        }
        __syncthreads();
        for (int o = tid; o < 1536; o += 512) { const int b = o / 96, cc = o % 96; float s = 0.f;
#pragma unroll
            for (int k2 = 0; k2 < 16; ++k2) s += part[(k2 * 16 + b) * 96 + cc];
            mod[((size_t)l * 16 + b) * 12288 + n0 + cc] = s + a.in[I_BADA][l * 12288 + n0 + cc]; }
        __syncthreads();
    }
}

struct CvtJob { const float* src; bf16_t* dst; int ldS, cbase, cend, kbase, ldD, mode, r0, cs0, kd0; };
__device__ __forceinline__ CvtJob cvt_decode(const Args& a, int l, int t) {
    unsigned char* ws = a.ws; CvtJob J; int ncols, nkt, idx; J.mode = 0; J.r0 = 0; J.kd0 = 0; J.cs0 = 0;
    if (t < 960) { idx = t; J.src = a.in[I_WIN] + (size_t)l * DM * DIN; J.ldS = DIN; ncols = 1864; nkt = 32; J.dst = (bf16_t*)(ws + W_1CAT); J.ldD = 2048; J.mode = 2; }
    else if (t < 1472) { idx = t - 960; J.src = a.in[I_WIN] + (size_t)l * DM * DIN; J.ldS = DIN; J.cs0 = 1864; ncols = 1024; nkt = 32; J.dst = (bf16_t*)(ws + W_1CAT); J.ldD = 2048; J.r0 = 2048; J.mode = 2; }
    else if (t < 4544) { idx = t - 1472; const int gi = idx >> 10; idx &= 1023; J.src = a.in[I_WGATE] + ((size_t)l * 3 + gi) * DM * DM; J.ldS = DM; ncols = 2048; nkt = 32; J.dst = (bf16_t*)(ws + W_1CAT); J.ldD = 2048; J.r0 = 3072 + 2048 * gi; J.mode = 2; }
    else if (t < 5056) { idx = t - 4544; J.src = a.in[I_PA] + (size_t)l * 1024 * DM; J.ldS = DM; ncols = 2048; nkt = 16; J.dst = (bf16_t*)(ws + W_P); J.ldD = 2048; J.mode = 2; }
    else if (t < 5312) { idx = t - 5056; J.src = a.in[I_PB] + (size_t)l * 512 * DM; J.ldS = DM; ncols = 2048; nkt = 8; J.dst = (bf16_t*)(ws + W_P); J.ldD = 2048; J.kd0 = 1024; J.mode = 2; }
    else if (t < 5568) { idx = t - 5312; J.src = a.in[I_PC] + (size_t)l * 512 * DM; J.ldS = DM; ncols = 2048; nkt = 8; J.dst = (bf16_t*)(ws + W_P); J.ldD = 2048; J.kd0 = 1536; J.mode = 2; }
    else if (t < 6592) { idx = t - 5568; J.src = a.in[I_WOUT] + (size_t)l * DM * DM; J.ldS = DM; ncols = 2048; nkt = 32; J.dst = (bf16_t*)(ws + W_OUT); J.ldD = 2048; }
    else if (t < 12096) { idx = t - 6592; J.src = a.in[I_WUP] + (size_t)l * DM * 2 * DFF; J.ldS = 2 * DFF; ncols = 2 * DFF; nkt = 32; J.dst = (bf16_t*)(ws + W_UP); J.ldD = 2048; J.mode = 1; }
    else if (t < 14848) { idx = t - 12096; J.src = a.in[I_WDOWN] + (size_t)l * DFF * DM; J.ldS = DM; ncols = 2048; nkt = 86; J.dst = (bf16_t*)(ws + W_DOWN); J.ldD = DFF; }
    else { idx = t - 14848; J.src = a.in[I_WGLU] + (size_t)l * 512 * 512; J.ldS = 512; ncols = 512; nkt = 8; J.dst = (bf16_t*)(ws + W_GLU); J.ldD = 512; J.mode = 2; }
    const int tn = idx / nkt, tk = idx - tn * nkt;
    J.cbase = J.cs0 + tn * 64; J.cend = J.cs0 + ncols; J.kbase = tk * 64; return J;
}
__device__ __forceinline__ void phase_cvt(const Args& a, int l, unsigned char* lds, const int WV) {
    const int TI = fresh_tid(WV);
    float* T = (float*)lds;
    const int tid = TI, ty = tid >> 4, tx = tid & 15;
    for (int t4 = blockIdx.x * 8; t4 < 14912; t4 += gridDim.x * 8) {
        f32x4 v[8][2];
#pragma unroll
        for (int q = 0; q < 8; ++q) { const CvtJob J = cvt_decode(a, l, t4 + q);
#pragma unroll
            for (int ps = 0; ps < 2; ++ps) { const int k = ty + ps * 32, c = J.cbase + tx * 4;
                v[q][ps] = (f32x4){0.f, 0.f, 0.f, 0.f};
                if (c < J.cend) v[q][ps] = *(const f32x4*)(J.src + (size_t)(J.kbase + k) * J.ldS + c); } }
#pragma unroll
        for (int q = 0; q < 8; ++q)
#pragma unroll
            for (int ps = 0; ps < 2; ++ps) { float* tp = T + q * (64 * 65) + (ty + ps * 32) * 65 + tx * 4; tp[0] = v[q][ps][0]; tp[1] = v[q][ps][1]; tp[2] = v[q][ps][2]; tp[3] = v[q][ps][3]; }
        __syncthreads();
#pragma unroll
        for (int q = 0; q < 8; ++q) { const CvtJob J = cvt_decode(a, l, t4 + q);
            const int n = tid >> 3, kq = tid & 7, c = J.cbase + n;
            if (c < J.cend) {
                float f[8];
#pragma unroll
                for (int j = 0; j < 8; ++j) f[j] = T[q * (64 * 65) + (kq * 8 + j) * 65 + n];
                int row;
                if (J.mode == 0) row = J.r0 + (c - J.cs0);
                else if (J.mode == 2) { const int r_ = J.r0 + (c - J.cs0), ct = r_ & 255; row = (r_ & ~255) | (((ct >> 5) & 1) << 7) | ((ct >> 6) << 5) | (ct & 31); }
                else { const int bj = c >= DFF ? 1 : 0, ch = c - bj * DFF; row = (ch >> 7) * 256 + bj * 128 + (ch & 127); }
                uint4 o; o.x = pk2(f[0], f[1]); o.y = pk2(f[2], f[3]); o.z = pk2(f[4], f[5]); o.w = pk2(f[6], f[7]);
                *(uint4*)(J.dst + (size_t)row * J.ldD + J.kd0 + J.kbase + kq * 8) = o;
            } }
        __syncthreads();
    }
    bf16_t* wp = (bf16_t*)(a.ws + W_POOL); const float* wsrc = a.in[I_WPOOL] + (size_t)l * 4 * 128 * 128;
    for (int i = blockIdx.x * 512 + TI; i < 512 * 512; i += gridDim.x * 512) { const int n = i >> 9, k = i & 511, g = n >> 7;
        const float v = ((k >> 7) == g) ? wsrc[(g * 128 + (k & 127)) * 128 + (n & 127)] : 0.f;
        const int ct = n & 255, nr = (n & ~255) | (((ct >> 5) & 1) << 7) | ((ct >> 6) << 5) | (ct & 31); wp[nr * 512 + k] = (bf16_t)f2bf(v); }
}

__device__ __forceinline__ void phase_norm(const float* xin, const float* g, const float* modl, int shoff, int scoff, bf16_t* out, const int WV) {
    const int TI = fresh_tid(WV);
    const int lane = TI & 63, wave = TI >> 6;
    for (int r = blockIdx.x * 8 + wave; r < MROWS; r += gridDim.x * 8) {
        const f32x4* xp = (const f32x4*)(xin + (size_t)r * DM); f32x4 v[8]; float ssq = 0.f;
#pragma unroll
        for (int j = 0; j < 8; ++j) { v[j] = xp[j * 64 + lane]; ssq += v[j][0] * v[j][0] + v[j][1] * v[j][1] + v[j][2] * v[j][2] + v[j][3] * v[j][3]; }
        ssq = wave_sum(ssq);
        const float rinv = rsqrtf(ssq * (1.f / DM) + EPS);
        const float* mb = modl + (size_t)(r >> 11) * 12288;
#pragma unroll
        for (int j = 0; j < 8; ++j) { const int col = j * 256 + lane * 4;
            const f32x4 g4 = *(const f32x4*)(g + col), sc = *(const f32x4*)(mb + scoff + col), sh = *(const f32x4*)(mb + shoff + col);
            f32x4 y;
#pragma unroll
            for (int e = 0; e < 4; ++e) y[e] = (v[j][e] * rinv * g4[e]) * (1.f + sc[e]) + sh[e];
            uint2 o; o.x = pk2(y[0], y[1]); o.y = pk2(y[2], y[3]);
            *(uint2*)(out + (size_t)r * DM + col) = o; }
    }
}

__constant__ double kRevPerPos[24] = {0.15915494309189535, 0.0700865215877985, 0.03086376340470123, 0.013591370636193905, 0.005985185712713705, 0.002635675898667414, 0.001160663641240061, 0.0005111175045375439, 0.00022507907903927653, 9.911730936901935e-05, 4.364795279280289e-05, 1.9221100684944863e-05, 8.464330808241401e-06, 3.727408601915352e-06, 1.6414262627950345e-06, 7.228293068832865e-07, 0.15915494309189535, 0.03086376340470123, 0.005985185712713705, 0.001160663641240061, 0.00022507907903927653, 4.364795279280289e-05, 8.464330808241401e-06, 1.6414262627950345e-06};
__device__ __forceinline__ void rmsrope128(bf16_t* p, bool active, const float* g16, int sub, const float* cs) {
    float v[16];
    if (active) { unpack8(*(const uint4*)p, v); unpack8(*(const uint4*)(p + 8), v + 8); }
    else {
#pragma unroll
        for (int i = 0; i < 16; ++i) v[i] = 0.f; }
    float ssq = 0.f;
#pragma unroll
    for (int i = 0; i < 16; ++i) ssq += v[i] * v[i];
    ssq += __shfl_xor(ssq, 1); ssq += __shfl_xor(ssq, 2); ssq += __shfl_xor(ssq, 4);
    const float rinv = rsqrtf(ssq * (1.f / 128.f) + EPS);
#pragma unroll
    for (int i = 0; i < 16; ++i) v[i] = v[i] * rinv * g16[i];
#pragma unroll
    for (int i = 0; i < 16; ++i) { const float o = __shfl_xor(v[i], 1); const float c = cs[2 * i], s = cs[2 * i + 1];
        if (sub == 0) v[i] = v[i] * c - o * s; else if (sub == 1) v[i] = v[i] * c + o * s; }
    if (active) { uint4 o0, o1; o0.x = pk2(v[0], v[1]); o0.y = pk2(v[2], v[3]); o0.z = pk2(v[4], v[5]); o0.w = pk2(v[6], v[7]);
        o1.x = pk2(v[8], v[9]); o1.y = pk2(v[10], v[11]); o1.z = pk2(v[12], v[13]); o1.w = pk2(v[14], v[15]);
        *(uint4*)p = o0; *(uint4*)(p + 8) = o1; }
}
__device__ __forceinline__ void rope64(bf16_t* p, bool active, int sub, const float* cs) {
    float v[8];
    if (active) unpack8(*(const uint4*)p, v);
    else {
#pragma unroll
        for (int i = 0; i < 8; ++i) v[i] = 0.f; }
#pragma unroll
    for (int i = 0; i < 8; ++i) { const float o = __shfl_xor(v[i], 1); const float c = cs[2 * i], s = cs[2 * i + 1];
        if (sub == 0) v[i] = v[i] * c - o * s; else if (sub == 1) v[i] = v[i] * c + o * s; }
    if (active) { uint4 o0; o0.x = pk2(v[0], v[1]); o0.y = pk2(v[2], v[3]); o0.z = pk2(v[4], v[5]); o0.w = pk2(v[6], v[7]); *(uint4*)p = o0; }
}
__device__ __forceinline__ void phase_post(const Args& a, int l, unsigned char* lds, const int WV) {
    const int TI = fresh_tid(WV);
    const int lane = TI & 63, wave = TI >> 6;
    float* cs = (float*)lds + wave * 64;
    bf16_t* ocat = (bf16_t*)(a.ws + WS_OCAT); bf16_t* kn = (bf16_t*)(a.ws + WS_KN); bf16_t* qi = (bf16_t*)(a.ws + WS_QI); bf16_t* ki = (bf16_t*)(a.ws + WS_KI);
    const int* pos = (const int*)a.in[I_POS];
    const int sub = lane & 7, hd = lane >> 3;
    float gq[16], gk[16];
#pragma unroll
    for (int i = 0; i < 16; ++i) { gq[i] = a.in[I_GQ][l * 128 + sub * 16 + i]; gk[i] = a.in[I_GK][l * 128 + sub * 16 + i]; }
    for (int r = blockIdx.x * 8 + wave; r < MROWS; r += gridDim.x * 8) {
        const int ps = pos[r];
        if (lane < 24) {
            double rev = (double)ps * kRevPerPos[lane]; rev -= rint(rev); const float fr = (float)rev;
            cs[lane * 2] = __builtin_amdgcn_cosf(fr); cs[lane * 2 + 1] = __builtin_amdgcn_sinf(fr); }
        LDS_FENCE();
        rmsrope128(ocat + (size_t)r * 2048 + hd * 128 + sub * 16, true, gq, sub, cs);
        rmsrope128(kn + (size_t)r * 128 + sub * 16, lane < 8, gk, sub, cs);
        rope64(qi + (size_t)r * 512 + hd * 64 + sub * 8, true, sub, cs + 32);
        rope64(ki + (size_t)r * 64 + sub * 8, lane < 8, sub, cs + 32);
        LDS_FENCE();
    }
}

__device__ __forceinline__ void s5_unit(const Args& a, int l, int b, int g, unsigned char* lds, const int WV) {
    const int TI = fresh_tid(WV);
    const int lane = TI & 63, wave = __builtin_amdgcn_readfirstlane(TI >> 6), p = lane;
    float* E = (float*)lds;
    float* ust = (float*)(lds + 16384 + wave * 4096);
    bf16_t* sst = (bf16_t*)(lds + 49152 + wave * 4352);
    const bf16_t* U = (const bf16_t*)(a.ws + WS_U); bf16_t* Y = (bf16_t*)(a.ws + WS_Y);
    const int gp = (l * 32 + g) * 64 + p;
    const float are = a.in[I_ARE][gp], aim = a.in[I_AIM][gp], dt = expf(a.in[I_LOGDT][l * 32 + g]);
    const float mag = expf(are * dt);
    float ang = aim * dt; { const float n = rintf(ang * 0.15915494309189535f); ang = fmaf(-n, 6.28318548202514648f, ang); ang = fmaf(n, 1.7484555e-7f, ang); }
    const float lre = mag * cosf(ang), lim = mag * sinf(ang);
    float Bre[16], Bim[16];
    { const float nr = lre - 1.f, ni = lim, den = 1.f / (are * are + aim * aim); const float cr = (nr * are + ni * aim) * den, ci = (ni * are - nr * aim) * den;
#pragma unroll
        for (int j = 0; j < 16; ++j) { const float br = a.in[I_BRE][(size_t)gp * 16 + j], bi = a.in[I_BIM][(size_t)gp * 16 + j]; Bre[j] = cr * br - ci * bi; Bim[j] = cr * bi + ci * br; } }
    bf16x8 Cf[4];
    { const int i = lane & 15;
#pragma unroll
        for (int ks = 0; ks < 4; ++ks)
#pragma unroll
            for (int j = 0; j < 8; ++j) { const int k = ks * 32 + (lane >> 4) * 8 + j, pp = k >> 1; const size_t ci = ((size_t)(l * 32 + g) * 16 + i) * 64 + pp;
                const float v = (k & 1) ? -a.in[I_CIM][ci] : a.in[I_CRE][ci]; Cf[ks][j] = (short)f2bf(v); } }
    const float dsk = a.in[I_DSKIP][l * 512 + g * 16 + (lane & 15)];
    bf16_t* Bl = (bf16_t*)(lds + 83968);
    float* bus = (float*)(lds + 88064 + wave * 8448);
    if (wave == 0) {
#pragma unroll
        for (int q = 0; q < 2; ++q) { uint4 o_; o_.x = pk2(Bre[q * 8], Bre[q * 8 + 1]); o_.y = pk2(Bre[q * 8 + 2], Bre[q * 8 + 3]); o_.z = pk2(Bre[q * 8 + 4], Bre[q * 8 + 5]); o_.w = pk2(Bre[q * 8 + 6], Bre[q * 8 + 7]);
            *(uint4*)(Bl + p * 16 + q * 8) = o_;
            uint4 i_; i_.x = pk2(Bim[q * 8], Bim[q * 8 + 1]); i_.y = pk2(Bim[q * 8 + 2], Bim[q * 8 + 3]); i_.z = pk2(Bim[q * 8 + 4], Bim[q * 8 + 5]); i_.w = pk2(Bim[q * 8 + 6], Bim[q * 8 + 7]);
            *(uint4*)(Bl + (64 + p) * 16 + q * 8) = i_; }
    }
    __syncthreads();
    const int l15 = lane & 15, lg4 = lane >> 4;
    bf16x8 Bf[8];
#pragma unroll
    for (int nb = 0; nb < 8; ++nb) { u32x4 t_ = {0u, 0u, 0u, 0u}; if (lg4 < 2) t_ = *(const u32x4*)(Bl + (nb * 16 + l15) * 16 + lg4 * 8); Bf[nb] = __builtin_bit_cast(bf16x8, t_); }
#define S5_BU(t0_, sb_) do { u32x4 a_ = {0u, 0u, 0u, 0u}; if (lg4 < 2) a_ = *(const u32x4*)(U + (size_t)(b * 2048 + (t0_) + (sb_) * 16 + l15) * 512 + g * 16 + lg4 * 8); \
        const bf16x8 af_ = __builtin_bit_cast(bf16x8, a_); \
        _Pragma("unroll") for (int nb = 0; nb < 8; ++nb) { const f32x4 c_ = __builtin_amdgcn_mfma_f32_16x16x32_bf16(af_, Bf[nb], (f32x4){0.f, 0.f, 0.f, 0.f}, 0, 0, 0); \
            _Pragma("unroll") for (int r = 0; r < 4; ++r) bus[(lg4 * 4 + r) * 132 + nb * 16 + l15] = c_[r]; } \
        LDS_FENCE(); } while (0)
#define S5_STEP(tt_) do { const float br_ = bus[(tt_) * 132 + p], bi_ = bus[(tt_) * 132 + 64 + p]; \
        const float nre_ = lre * sre - lim * sim + br_, nim_ = lre * sim + lim * sre + bi_; sre = nre_; sim = nim_; } while (0)
#pragma unroll 1
    for (int cc = 0; cc < 4; ++cc) {
        const int chunk = wave * 4 + cc, t0 = chunk * 64;
        float sre = 0.f, sim = 0.f;
#pragma unroll 1
        for (int sb = 0; sb < 4; ++sb) {
            S5_BU(t0, sb);
#pragma unroll 4
            for (int tt = 0; tt < 16; ++tt) S5_STEP(tt);
            LDS_FENCE();
        }
        E[(chunk * 64 + p) * 2] = sre; E[(chunk * 64 + p) * 2 + 1] = sim;
    }
    __syncthreads();
    if (wave == 0) {
        float pr = lre, pi = lim;
#pragma unroll
        for (int q = 0; q < 6; ++q) { const float nr = pr * pr - pi * pi, pp_ = pr * pi, ni = pp_ + pp_; pr = nr; pi = ni; }
        float sr = 0.f, si = 0.f;
        for (int c = 0; c < 32; ++c) { const float er = E[(c * 64 + p) * 2], ei = E[(c * 64 + p) * 2 + 1]; E[(c * 64 + p) * 2] = sr; E[(c * 64 + p) * 2 + 1] = si;
            const float nr = pr * sr - pi * si + er, ni = pr * si + pi * sr + ei; sr = nr; si = ni; }
    }
    __syncthreads();
#pragma unroll 1
    for (int cc = 0; cc < 4; ++cc) {
        const int chunk = wave * 4 + cc, t0 = chunk * 64;
        { const bf16_t* up = U + (size_t)(b * 2048 + t0 + lane) * 512 + g * 16; const uint4 q0 = *(const uint4*)up, q1 = *(const uint4*)(up + 8);
            float f[16]; unpack8(q0, f); unpack8(q1, f + 8);
#pragma unroll
            for (int q = 0; q < 4; ++q) *(f32x4*)(ust + lane * 16 + q * 4) = (f32x4){f[q * 4], f[q * 4 + 1], f[q * 4 + 2], f[q * 4 + 3]}; }
        float sre = E[(chunk * 64 + p) * 2], sim = E[(chunk * 64 + p) * 2 + 1];
#pragma unroll 1
        for (int sb = 0; sb < 4; ++sb) {
            S5_BU(t0, sb);
#pragma unroll 4
            for (int tt = 0; tt < 16; ++tt) { S5_STEP(tt);
                *(unsigned*)(sst + tt * 136 + 2 * p) = pk2(sre, sim);
            }
            LDS_FENCE();
            f32x4 acc = {0.f, 0.f, 0.f, 0.f};
#pragma unroll
            for (int ks = 0; ks < 4; ++ks) { const bf16x8 af = *(const bf16x8*)(sst + (lane & 15) * 136 + ks * 32 + (lane >> 4) * 8);
                acc = __builtin_amdgcn_mfma_f32_16x16x32_bf16(af, Cf[ks], acc, 0, 0, 0); }
#pragma unroll
            for (int r = 0; r < 4; ++r) { const int t = sb * 16 + (lane >> 4) * 4 + r, i = lane & 15;
                const float y = gelu_tanh(acc[r] + dsk * ust[t * 16 + i]);
                Y[(size_t)(b * 2048 + t0 + t) * 512 + g * 16 + i] = (bf16_t)f2bf(y); }
            LDS_FENCE();
        }
    }
    __syncthreads();
#undef S5_STEP
#undef S5_BU
}

__device__ __forceinline__ void pool_unit(const Args& a, int b, int chunk, unsigned char* lds, const int WV) {
    const int TI = fresh_tid(WV);
    bf16_t* T = (bf16_t*)lds;
    const int t0 = chunk * 64;
    const bf16_t* P = (const bf16_t*)(a.ws + WS_P) + (size_t)b * 2048 * 512; bf16_t* O = (bf16_t*)(a.ws + WS_POOLED) + (size_t)b * 2048 * 512;
    __syncthreads();
    for (int i = TI; i < 80 * 64; i += 512) { const int r = i >> 6, c8 = i & 63, t = t0 - 16 + r;
        uint4 v = make_uint4(0u, 0u, 0u, 0u); if (t >= 0) v = *(const uint4*)(P + (size_t)t * 512 + c8 * 8);
        *(uint4*)(T + r * 512 + c8 * 8) = v; }
    __syncthreads();
    const int c = TI, w = 2 << (c >> 7);
    float s = 0.f;
    for (int k = 1; k <= w; ++k) s += bf1(T[(16 - k) * 512 + c]);
#pragma unroll 4
    for (int t = 0; t < 64; ++t) { const float pv = bf1(T[(16 + t) * 512 + c]); s += pv; s -= bf1(T[(16 + t - w) * 512 + c]);
        const int tt = t0 + t + 1; const float mean = s / (float)(tt < w ? tt : w); O[(size_t)(t0 + t) * 512 + c] = (bf16_t)f2bf(mean - pv); }
}

__device__ __forceinline__ unsigned sortkey(float x) { const unsigned u = __float_as_uint(x); return (u & 0x80000000u) ? ~u : (u | 0x80000000u); }
template <int NJ>
__device__ __forceinline__ void select256(const float* scq, int limit, unsigned short* sq, int lane) {
    const unsigned long long ltmask = (1ull << lane) - 1ull;
    unsigned key[NJ];
#pragma unroll
    for (int j = 0; j < NJ; ++j) { const int idx = j * 64 + lane; key[j] = (idx < limit) ? sortkey(scq[idx]) : 0u; }
    unsigned T = 0u;
    for (int bit = 31; bit >= 0; --bit) { const unsigned cand = T | (1u << bit); int cnt = 0;
#pragma unroll
        for (int j = 0; j < NJ; ++j) cnt += __popcll(__ballot(key[j] >= cand));
        if (cnt >= 256) { T = cand; if (cnt == 256) break; } }
    int cgt = 0;
#pragma unroll
    for (int j = 0; j < NJ; ++j) cgt += __popcll(__ballot(key[j] > T));
    const int need = 256 - cgt; int ob = 0, tb = 0;
#pragma unroll
    for (int j = 0; j < NJ; ++j) { const bool gt = key[j] > T, eq = key[j] == T; const unsigned long long me = __ballot(eq);
        const int pe = tb + __popcll(me & ltmask); const bool take = gt || (eq && pe < need); const unsigned long long mt = __ballot(take);
        if (take) sq[ob + __popcll(mt & ltmask)] = (unsigned short)(j * 64 + lane);
        ob += __popcll(mt); tb += __popcll(me); }
}
__device__ __forceinline__ void dsa_unit(const Args& a, int b, int tq, unsigned char* lds, const int WV, bf16_t* obase, const int ostride, const int parts) {
    const int TI = fresh_tid(WV);
    int tid = TI;
    int lane = tid & 63; const int wave = WV;
    float* sc = (float*)lds;
    unsigned short* sel = (unsigned short*)(lds + 131072);
    float* wis = (float*)(lds + 131072 + 8192);
    bf16_t* ocat = (bf16_t*)(a.ws + WS_OCAT); const bf16_t* Kn = (const bf16_t*)(a.ws + WS_KN); const bf16_t* V = (const bf16_t*)(a.ws + WS_V);
    const bf16_t* QI = (const bf16_t*)(a.ws + WS_QI); const bf16_t* KI = (const bf16_t*)(a.ws + WS_KI); const float* WI = (const float*)(a.ws + WS_WI);
    const int t0 = tq * 16, row0 = b * 2048 + t0, limit = ((t0 >> 6) + 1) << 6, nkt = limit >> 5, nsel = limit < 256 ? limit : 256;
    __syncthreads();
    if (tid < 128) wis[tid] = WI[(size_t)row0 * 8 + tid];
    __syncthreads();
    if (parts & 1)
    {
        const int g = lane >> 5, c32 = lane & 31;
        bf16x8 Af[4][4];
#pragma unroll
        for (int rb = 0; rb < 4; ++rb) { const int R = rb * 32 + c32; const bf16_t* qp = QI + (size_t)(row0 + (R >> 3)) * 512 + (R & 7) * 64 + g * 8;
#pragma unroll
            for (int s = 0; s < 4; ++s) Af[rb][s] = *(const bf16x8*)(qp + s * 16); }
        bf16x8 Bn[4];
        { const bf16_t* kp0 = KI + (size_t)(b * 2048 + wave * 32 + c32) * 64 + g * 8;
#pragma unroll
            for (int s = 0; s < 4; ++s) Bn[s] = *(const bf16x8*)(kp0 + s * 16); }
#pragma unroll 1
        for (int kt = wave; kt < nkt; kt += 8) {
            bf16x8 Bf[4];
#pragma unroll
            for (int s = 0; s < 4; ++s) Bf[s] = Bn[s];
            if (kt + 8 < nkt) { const bf16_t* kp = KI + (size_t)(b * 2048 + (kt + 8) * 32 + c32) * 64 + g * 8;
#pragma unroll
                for (int s = 0; s < 4; ++s) Bn[s] = *(const bf16x8*)(kp + s * 16); }
#pragma unroll
            for (int rb = 0; rb < 4; ++rb) {
                f32x16 acc;
#pragma unroll
                for (int i = 0; i < 16; ++i) acc[i] = 0.f;
#pragma unroll
                for (int s = 0; s < 4; ++s) acc = __builtin_amdgcn_mfma_f32_32x32x16_bf16(Af[rb][s], Bf[s], acc, 0, 0, 0);
#pragma unroll
                for (int j = 0; j < 4; ++j) { const int q = rb * 4 + j; const f32x4 w4 = *(const f32x4*)(wis + q * 8 + 4 * g);
                    float sp = fmaxf(acc[4 * j], 0.f) * w4[0] + fmaxf(acc[4 * j + 1], 0.f) * w4[1] + fmaxf(acc[4 * j + 2], 0.f) * w4[2] + fmaxf(acc[4 * j + 3], 0.f) * w4[3];
                    sp += __shfl_xor(sp, 32);
                    if (g == 0) sc[q * 2048 + kt * 32 + c32] = sp; }
            }
        }
    }
    __syncthreads();
    lane = fresh_tid(WV) & 63;
    for (int qq = 0; qq < 2; ++qq) {
        const int q = wave * 2 + qq; unsigned short* sq = sel + q * 256;
        if (limit <= 256 || !(parts & 2)) { for (int j = lane; j < nsel; j += 64) sq[j] = (unsigned short)j; }
        else if (limit <= 512) select256<8>(sc + q * 2048, limit, sq, lane);
        else if (limit <= 1024) select256<16>(sc + q * 2048, limit, sq, lane);
        else if (limit <= 1536) select256<24>(sc + q * 2048, limit, sq, lane);
        else select256<32>(sc + q * 2048, limit, sq, lane);
    }
    __syncthreads();
    lane = fresh_tid(WV) & 63;
    float* Pw = (float*)lds + wave * 2048;
    const int g4 = lane >> 4, hh = lane & 15;
#pragma unroll 1
    for (int qq = 0; qq < 2; ++qq) {
        const int q = wave * 2 + qq; const size_t row = (size_t)(row0 + q); const unsigned short* sq = sel + q * 256;
        bf16x8 Qf[4];
#pragma unroll
        for (int s = 0; s < 4; ++s) Qf[s] = *(const bf16x8*)(ocat + row * 2048 + (hh & 7) * 128 + g4 * 8 + s * 32);
        float lg[16][4];
#pragma unroll
        for (int kg = 0; kg < 4; ++kg) {
            if (kg * 64 < nsel) {
                bf16x8 kf[4][4];
#pragma unroll
                for (int k4 = 0; k4 < 4; ++k4) { const int idx = sq[(kg * 4 + k4) * 16 + hh]; const bf16_t* kp = Kn + (size_t)(b * 2048 + idx) * 128 + g4 * 8;
#pragma unroll
                    for (int s = 0; s < 4; ++s) kf[k4][s] = *(const bf16x8*)(kp + s * 32); }
#pragma unroll
                for (int k4 = 0; k4 < 4; ++k4) { f32x4 c = {0.f, 0.f, 0.f, 0.f};
#pragma unroll
                    for (int s = 0; s < 4; ++s) c = __builtin_amdgcn_mfma_f32_16x16x32_bf16(kf[k4][s], Qf[s], c, 0, 0, 0);
#pragma unroll
                    for (int r = 0; r < 4; ++r) lg[kg * 4 + k4][r] = c[r] * 0.08838834764831845f; }
            } else {
#pragma unroll
                for (int k4 = 0; k4 < 4; ++k4)
#pragma unroll
                    for (int r = 0; r < 4; ++r) lg[kg * 4 + k4][r] = -1e30f;
            }
        }
        float mx = -1e30f;
#pragma unroll
        for (int kb = 0; kb < 16; ++kb)
#pragma unroll
            for (int r = 0; r < 4; ++r) mx = fmaxf(mx, lg[kb][r]);
        mx = fmaxf(mx, __shfl_xor(mx, 16)); mx = fmaxf(mx, __shfl_xor(mx, 32));
        float sum = 0.f;
#pragma unroll
        for (int kb = 0; kb < 16; ++kb)
#pragma unroll
            for (int r = 0; r < 4; ++r) { const float e = (kb * 16 < nsel) ? __expf(lg[kb][r] - mx) : 0.f; lg[kb][r] = e; sum += e; }
        sum += __shfl_xor(sum, 16); sum += __shfl_xor(sum, 32);
        const float inv = 1.f / sum;
        bf16x8 Pa[8];
#pragma unroll
        for (int ks = 0; ks < 8; ++ks) {
            const unsigned a0 = pk2(lg[2 * ks][0] * inv, lg[2 * ks][1] * inv), a1 = pk2(lg[2 * ks][2] * inv, lg[2 * ks][3] * inv);
            const unsigned a2 = pk2(lg[2 * ks + 1][0] * inv, lg[2 * ks + 1][1] * inv), a3 = pk2(lg[2 * ks + 1][2] * inv, lg[2 * ks + 1][3] * inv);
            const u32x4 t_ = {a0, a1, a2, a3}; Pa[ks] = __builtin_bit_cast(bf16x8, t_); }
        bf16_t* Vs = (bf16_t*)(lds + wave * 10752);
        bf16_t* Os = Vs + 32 * 136;
        f32x4 oacc[8];
#pragma unroll
        for (int nb = 0; nb < 8; ++nb) oacc[nb] = (f32x4){0.f, 0.f, 0.f, 0.f};
        const bf16_t* Vb = V + (size_t)b * 2048 * 128 + hh * 8;
        u32x4 vq[8], vn[8];
#pragma unroll
        for (int jj = 0; jj < 8; ++jj) vn[jj] = (u32x4){0u, 0u, 0u, 0u};
#pragma unroll
        for (int jj = 0; jj < 8; ++jj) { const int idx = sq[jj * 4 + g4]; vq[jj] = *(const u32x4*)(Vb + (size_t)idx * 128); }
#define PV_BATCH(bt) do { if ((bt) * 32 < nsel) { \
            if (((bt) + 1) * 32 < nsel) { _Pragma("unroll") for (int jj = 0; jj < 8; ++jj) { const int idx = sq[((bt) + 1) * 32 + jj * 4 + g4]; vn[jj] = *(const u32x4*)(Vb + (size_t)idx * 128); } } \
            _Pragma("unroll") for (int jj = 0; jj < 8; ++jj) *(u32x4*)(Vs + (jj * 4 + g4) * 136 + hh * 8) = vq[jj]; \
            LDS_FENCE(); \
            _Pragma("unroll") for (int nb = 0; nb < 8; ++nb) { const bf16_t* vp = Vs + (4 * g4) * 136 + nb * 16 + hh; \
                const unsigned w0_ = (unsigned)vp[0 * 136] | ((unsigned)vp[1 * 136] << 16), w1_ = (unsigned)vp[2 * 136] | ((unsigned)vp[3 * 136] << 16); \
                const unsigned w2_ = (unsigned)vp[16 * 136] | ((unsigned)vp[17 * 136] << 16), w3_ = (unsigned)vp[18 * 136] | ((unsigned)vp[19 * 136] << 16); \
                const u32x4 t_ = {w0_, w1_, w2_, w3_}; \
                oacc[nb] = __builtin_amdgcn_mfma_f32_16x16x32_bf16(Pa[(bt)], __builtin_bit_cast(bf16x8, t_), oacc[nb], 0, 0, 0); } \
            LDS_FENCE(); \
            _Pragma("unroll") for (int jj = 0; jj < 8; ++jj) vq[jj] = vn[jj]; } } while (0)
        PV_BATCH(0); PV_BATCH(1); PV_BATCH(2); PV_BATCH(3); PV_BATCH(4); PV_BATCH(5); PV_BATCH(6); PV_BATCH(7);
#undef PV_BATCH
        if (g4 < 2) {
#pragma unroll
            for (int nb = 0; nb < 8; ++nb)
#pragma unroll
                for (int r = 0; r < 4; ++r) Os[(g4 * 4 + r) * 128 + nb * 16 + hh] = (bf16_t)f2bf(oacc[nb][r]);
        }
        LDS_FENCE();
#pragma unroll
        for (int h = 0; h < 2; ++h) { const uint4 ov = *(const uint4*)(Os + h * 512 + lane * 8); *(uint4*)(obase + row * ostride + h * 512 + lane * 8) = ov; }
        LDS_FENCE();
    }
}

__device__ __forceinline__ void phase_fix(const Args& a, int l, const int WV) {
    const int TI = fresh_tid(WV);
    const float* SA = (const float*)(a.ws + WS_SA); const float* SB = (const float*)(a.ws + WS_SB); bf16_t* act = (bf16_t*)(a.ws + WS_R2);
    const float* cw = a.in[I_CONVW] + (size_t)l * 3 * DFF; const float* cb = a.in[I_CONVB] + (size_t)l * DFF;
    const int total = 512 * 2 * DFF;
    for (int i = blockIdx.x * 512 + TI; i < total; i += gridDim.x * 512) {
        const int ch = i % DFF, rb = i / DFF, rr = rb & 1, blk = rb >> 1, r = blk * 64 + rr, t = r & 2047;
        const float a0 = SA[((size_t)blk * 4 + 2 + rr) * DFF + ch];
        float am1, am2;
        if (rr == 0) { am1 = (t >= 1) ? SA[((size_t)(blk - 1) * 4 + 1) * DFF + ch] : 0.f; am2 = (t >= 2) ? SA[((size_t)(blk - 1) * 4 + 0) * DFF + ch] : 0.f; }
        else { am1 = SA[((size_t)blk * 4 + 2) * DFF + ch]; am2 = (t >= 2) ? SA[((size_t)(blk - 1) * 4 + 1) * DFF + ch] : 0.f; }
        const float cv = cb[ch] + cw[ch] * am2 + cw[DFF + ch] * am1 + cw[2 * DFF + ch] * a0;
        act[(size_t)r * DFF + ch] = (bf16_t)f2bf(siluf_(cv) * SB[((size_t)blk * 2 + rr) * DFF + ch]);
    }
}

__device__ __forceinline__ void run_phase(const Args& a, int ph, unsigned char* lds, const int WV, const bool dummy) {
    unsigned char* ws = a.ws;
    LAS unsigned char* ldsl = (LAS unsigned char*)lds;
    const int G = gridDim.x, bx = blockIdx.x;
#ifndef DBG_NOADA
    if (ph == 0) { phase_ada(a, lds, WV); return; }
#else
    if (ph == 0) return;
#endif
    const int l = (ph - 1) / 10, sp = (ph - 1) % 10;
    const float* modl = (const float*)(ws + WS_MOD) + (size_t)l * 16 * 12288;
    const float* xin = (l == 0) ? a.in[I_X] : a.out;
#ifdef DBG_SP
    if (sp != DBG_SP) return;
#endif
    switch (sp) {
    case 0: phase_cvt(a, l, lds, WV); phase_norm(xin, a.in[I_GN1] + l * DM, modl, 0, 2048, (bf16_t*)(ws + WS_R1), WV); break;
    case 1: {
        pg8::Gemm g{(const bf16_t*)(ws + WS_R1), (const bf16_t*)(ws + W_1CAT), MROWS, N1, DM, DM, DM, 1 << 30, 0}; pg8::StaticOrder S; S.init(MROWS, N1, G, bx);
        Epi1 E{(bf16_t*)(ws + WS_OCAT), (bf16_t*)(ws + WS_KN), (bf16_t*)(ws + WS_V), (bf16_t*)(ws + WS_QI), (bf16_t*)(ws + WS_KI), (bf16_t*)(ws + WS_U), (bf16_t*)(ws + WS_P), (bf16_t*)(ws + WS_R2),
               (float*)(ws + WS_WI), a.in[I_BGATE] + (size_t)l * 3 * DM, ldsl + 131072};
        pg8::gemm_phase<Epi1, pg8::StaticOrder>(ldsl, g, S, E, WV); } break;
    case 2:
        if (!dummy) phase_post(a, l, lds, WV);
        __syncthreads();
        for (int u = bx; u < 512; u += G) s5_unit(a, l, u >> 5, u & 31, lds, WV);
        for (int u = bx; u < 512; u += G) pool_unit(a, u >> 5, u & 31, lds, WV);
        break;
    case 3: {
#ifndef DBG_NO_DSA
#ifdef DSA_PROBE
        for (int rep = 0; rep < 2; ++rep) { const bool dm = (rep == 0); const int parts = dm ? (DSA_PROBE) : 15;
#else
        { const bool dm = dummy; const int parts = 15;
#endif
            for (int u = bx; u < 2048; u += G) { const int w = u & 255, i = u >> 8, b = w & 15, s = w >> 4; const int tq = (i & 1) ? (i * 16 + 15 - s) : (i * 16 + s);
                dsa_unit(a, b, tq, lds, WV, dm ? (bf16_t*)(ws + WS_R1 + 64 * MiB) : (bf16_t*)(ws + WS_OCAT), dm ? 1024 : 2048, parts); }
        }
        __syncthreads();
#endif
#ifndef DBG_DSA_ONLY
        { pg8::Gemm g{(const bf16_t*)(ws + WS_Y), (const bf16_t*)(ws + W_GLU), MROWS, 1024, 512, 512, 512, 2, WS_POOLED - WS_Y}; pg8::StaticOrder S; S.init(MROWS, 1024, G, bx);
          EpiGluPool E{(const bf16_t*)(ws + WS_Y), a.in[I_PSCALE] + l * 512, (bf16_t*)(ws + WS_OCAT)}; pg8::gemm_phase<EpiGluPool, pg8::StaticOrder>(ldsl, g, S, E, WV); }
#endif
        } break;
    case 4: {
        pg8::Gemm g{(const bf16_t*)(ws + WS_OCAT), (const bf16_t*)(ws + W_P), MROWS, DM, DM, DM, DM, 1 << 30, 0}; pg8::StaticOrder S; S.init(MROWS, DM, G, bx);
        EpiMerge E{(const bf16_t*)(ws + WS_R2), (bf16_t*)(ws + WS_R1), ldsl + 131072}; pg8::gemm_phase<EpiMerge, pg8::StaticOrder>(ldsl, g, S, E, WV); } break;
    case 5: {
        pg8::Gemm g{(const bf16_t*)(ws + WS_R1), (const bf16_t*)(ws + W_OUT), MROWS, DM, DM, DM, DM, 1 << 30, 0}; pg8::StaticOrder S; S.init(MROWS, DM, G, bx);
        EpiRes E{xin, dummy ? (float*)(ws + WS_OCAT) : a.out, modl + 4096}; pg8::gemm_phase<EpiRes, pg8::StaticOrder>(ldsl, g, S, E, WV); } break;
    case 6: phase_norm(a.out, a.in[I_GN2] + l * DM, modl, 6144, 8192, (bf16_t*)(ws + WS_R1), WV); break;
    case 7: {
        pg8::Gemm g{(const bf16_t*)(ws + WS_R1), (const bf16_t*)(ws + W_UP), MROWS, 2 * DFF, DM, DM, DM, 1 << 30, 0}; pg8::StaticOrder S; S.init(MROWS, 2 * DFF, G, bx);
        EpiUp E{(bf16_t*)(ws + WS_R2), (float*)(ws + WS_SA), (float*)(ws + WS_SB), a.in[I_CONVW] + (size_t)l * 3 * DFF, a.in[I_CONVB] + (size_t)l * DFF, ldsl + 131072};
        pg8::gemm_phase<EpiUp, pg8::StaticOrder>(ldsl, g, S, E, WV); } break;
    case 8: phase_fix(a, l, WV); break;
    case 9: {
        pg8::Gemm g{(const bf16_t*)(ws + WS_R2), (const bf16_t*)(ws + W_DOWN), MROWS, DM, DFF, DFF, DFF, 1 << 30, 0}; pg8::StaticOrder S; S.init(MROWS, DM, G, bx);
        EpiRes E{a.out, dummy ? (float*)(ws + WS_OCAT) : a.out, modl + 10240}; pg8::gemm_phase<EpiRes, pg8::StaticOrder>(ldsl, g, S, E, WV); } break;
    }
}

#define XB_XCNT(j)  (256  + 64 * (j))
#define XB_XSUB(j)  (1280 + 64 * (j))
#define XB_XGEN(j)  (2304 + 64 * (j))
#define XB_TOP      3328
#define XB_TOPGEN   3392
#define XB_WORDS    3456
__device__ __forceinline__ unsigned xb_ld(unsigned* p)              { return __hip_atomic_load(p, __ATOMIC_RELAXED, __HIP_MEMORY_SCOPE_AGENT); }
__device__ __forceinline__ unsigned xb_add(unsigned* p, unsigned v) { return __hip_atomic_fetch_add(p, v, __ATOMIC_RELAXED, __HIP_MEMORY_SCOPE_AGENT); }
__device__ __forceinline__ unsigned xb_xcc_id() { return (unsigned)__builtin_amdgcn_s_getreg((3 << 11) | 20) & 0xFu; }
#define XB_SPIN(cond) do { unsigned _sp = 0; while (cond) { __builtin_amdgcn_s_sleep(1); if (++_sp > (1u << 22)) break; } } while (0)
__device__ __forceinline__ void grid_bar(unsigned* bar, volatile LAS unsigned* st, int wave_id) {
    asm volatile("s_waitcnt vmcnt(0) lgkmcnt(0)" ::: "memory");
    __syncthreads();
    if (wave_id == 0) {
        const int l = (int)__builtin_amdgcn_mbcnt_hi(~0u, __builtin_amdgcn_mbcnt_lo(~0u, 0u));
        if (l == 0) {
            const unsigned x = xb_xcc_id();
            unsigned nloc = st[0], nx = st[1];
            if (nloc == 0u) {
                const unsigned G = gridDim.x; unsigned sum, cnt, mine, sp = 0u;
                for (;;) { sum = 0u; cnt = 0u; mine = 0u;
#pragma unroll
                    for (unsigned j = 0; j < 16; ++j) { const unsigned c = xb_ld(&bar[XB_XCNT(j)]); sum += c; cnt += (c > 0u) ? 1u : 0u; mine = (j == x) ? c : mine; }
                    if (sum == G) break;
                    __builtin_amdgcn_s_sleep(1); if (++sp > (1u << 22)) break; }
                nloc = mine > 0u ? mine : 1u; nx = cnt > 0u ? cnt : 1u; st[0] = nloc; st[1] = nx;
            }
            const unsigned old = xb_add(&bar[XB_XSUB(x)], 1u);
            const unsigned gen = old / nloc;
            if (old + 1u == (gen + 1u) * nloc) {
                __builtin_amdgcn_fence(__ATOMIC_RELEASE, "agent");
                asm volatile("s_waitcnt vmcnt(0)" ::: "memory");
                const unsigned og = xb_add(&bar[XB_TOP], 1u);
                const unsigned tg = og / nx;
                if (og + 1u == (tg + 1u) * nx) xb_add(&bar[XB_TOPGEN], 1u);
                else XB_SPIN(xb_ld(&bar[XB_TOPGEN]) == tg);
                __builtin_amdgcn_fence(__ATOMIC_ACQUIRE, "agent");
                xb_add(&bar[XB_XGEN(x)], 1u);
                asm volatile("s_waitcnt vmcnt(0)" ::: "memory");
            } else {
                XB_SPIN(xb_ld(&bar[XB_XGEN(x)]) == gen);
                __builtin_amdgcn_fence(__ATOMIC_ACQUIRE, "agent");
                asm volatile("s_waitcnt vmcnt(0)" ::: "memory");
            }
        }
    }
    __syncthreads();
}

__global__ void __launch_bounds__(512, 2) mega_fwd(Args a) {
    extern __shared__ __attribute__((aligned(16))) unsigned char lds[];
    cg::grid_group grid = cg::this_grid();
    const int wave_id = __builtin_amdgcn_readfirstlane((int)(threadIdx.x >> 6));
    const int ph_lo = a.ph_lo, ph_hi = a.ph_hi;
    volatile LAS unsigned* xst = (volatile LAS unsigned*)((LAS unsigned char*)lds + 163776);
    if (threadIdx.x == 0) { xst[0] = 0u; xst[1] = 0u; (void)xb_add((unsigned*)(__attribute__((address_space(1))) unsigned*)a.ws + XB_XCNT(xb_xcc_id()), 1u); }
    __syncthreads();
    for (int ph = ph_lo; ph < ph_hi; ++ph) {
        const __attribute__((address_space(4))) Args* kp = (const __attribute__((address_space(4))) Args*)__builtin_amdgcn_kernarg_segment_ptr();
        asm volatile("" : "+s"(kp));
        Args la;
#pragma unroll
        for (int i = 0; i < 31; ++i) la.in[i] = (const float*)(const __attribute__((address_space(1))) float*)kp->in[i];
        la.ws = (unsigned char*)(__attribute__((address_space(1))) unsigned char*)kp->ws;
        la.out = (float*)(__attribute__((address_space(1))) float*)kp->out;
        la.ph_lo = ph_lo; la.ph_hi = ph_hi;
#ifdef REP_MASK
        if (ph > 0 && ((REP_MASK >> ((ph - 1) % 10)) & 1)) { run_phase(la, ph, lds, wave_id, true); grid.sync(); }
#endif
        run_phase(la, ph, lds, wave_id, false);
        if (ph + 1 < ph_hi) {
            if (ph == ph_lo) grid.sync();
            else grid_bar((unsigned*)la.ws, xst, wave_id);
        }
    }
}

extern "C" void kernel_launch(void* const* d_in, const int* in_sizes, int n_in, void* d_out, int out_size, void* d_ws, size_t ws_size, hipStream_t stream) {
    static int grid = 0;
    if (grid == 0) {
        int dev = 0, cus = 0, per_cu = 0;
        if (n_in != 31 || ws_size < WS_END) { fprintf(stderr, "kernel_launch: unexpected n_in %d / ws %zu\n", n_in, ws_size); grid = -1; return; }
        hipGetDevice(&dev); hipDeviceGetAttribute(&cus, hipDeviceAttributeMultiprocessorCount, dev);
        if (hipFuncSetAttribute((const void*)mega_fwd, hipFuncAttributeMaxDynamicSharedMemorySize, LDS_BYTES) != hipSuccess) { fprintf(stderr, "kernel_launch: hipFuncSetAttribute failed\n"); grid = -1; return; }
        if (hipOccupancyMaxActiveBlocksPerMultiprocessor(&per_cu, (const void*)mega_fwd, 512, LDS_BYTES) != hipSuccess || per_cu < 1) { fprintf(stderr, "kernel_launch: occupancy query says %d blocks/CU\n", per_cu); per_cu = 1; }
        (void)hipGetLastError();
        grid = cus > 0 ? cus : 256;
    }
    if (grid < 0) return;
    if (hipMemsetAsync(d_ws, 0, 16384, stream) != hipSuccess) { fprintf(stderr, "kernel_launch: memset of the barrier word failed\n"); return; }
    Args a{};
    for (int i = 0; i < 31; ++i) a.in[i] = (const float*)d_in[i];
    a.out = (float*)d_out; a.ws = (unsigned char*)d_ws;
#if MK_PER_PHASE
    for (int ph = 0; ph < NPHASE; ++ph) {
        a.ph_lo = ph; a.ph_hi = ph + 1;
        void* args[] = {&a};
        hipError_t e = hipLaunchCooperativeKernel((const void*)mega_fwd, dim3(grid), dim3(512), args, LDS_BYTES, stream);
        if (e != hipSuccess) { fprintf(stderr, "kernel_launch: launch of phase %d failed: %s\n", ph, hipGetErrorString(e)); break; }
    }
#else
    a.ph_lo = 0; a.ph_hi = NPHASE;
    void* args[] = {&a};
    hipError_t e = hipLaunchCooperativeKernel((const void*)mega_fwd, dim3(grid), dim3(512), args, LDS_BYTES, stream);
    if (e != hipSuccess) fprintf(stderr, "kernel_launch: cooperative launch failed: %s (grid %d)\n", hipGetErrorString(e), grid);
#endif
}
```

```cpp
#include <hip/hip_runtime.h>
#include <hip/hip_cooperative_groups.h>
#include <cstdio>
#include <cstdint>
namespace cg = cooperative_groups;

#ifndef MK_PER_PHASE
#define MK_PER_PHASE 0
#endif

typedef unsigned short bf16_t;
typedef short bf16x8 __attribute__((ext_vector_type(8)));
typedef float f32x4 __attribute__((ext_vector_type(4)));
typedef float f32x2 __attribute__((ext_vector_type(2)));
typedef float f32x16 __attribute__((ext_vector_type(16)));
typedef unsigned u32x4 __attribute__((ext_vector_type(4)));
typedef unsigned u32x2 __attribute__((ext_vector_type(2)));
#define LAS __attribute__((address_space(3)))

constexpr int BATCH = 16, SEQ = 2048, DM = 2048, MROWS = BATCH * SEQ, DIN = 2888, DFF = 5504;
constexpr int N1 = 9216;
constexpr float EPS = 1e-6f;
constexpr int NPHASE = 21;

constexpr size_t MiB = 1u << 20;
constexpr size_t WS_MOD = 1 * MiB;
constexpr size_t WS_WI = 3 * MiB;
constexpr size_t WS_W = 4 * MiB;
constexpr size_t W_1CAT = WS_W, W_P = WS_W + 36 * MiB, W_OUT = WS_W + 44 * MiB, W_UP = WS_W + 52 * MiB, W_DOWN = WS_W + 95 * MiB,
                 W_GLU = WS_W + 116 * MiB + MiB / 2, W_POOL = WS_W + 117 * MiB;
constexpr size_t WS_R1 = 122 * MiB;
constexpr size_t WS_Y = WS_R1, WS_POOLED = WS_R1 + 32 * MiB;
constexpr size_t WS_R2 = 250 * MiB;
constexpr size_t WS_OCAT = 634 * MiB;
constexpr size_t WS_SA = WS_OCAT, WS_SB = WS_OCAT + 44 * MiB;
constexpr size_t WS_KN = 762 * MiB, WS_V = 770 * MiB, WS_QI = 778 * MiB, WS_KI = 810 * MiB, WS_U = 814 * MiB, WS_P = 846 * MiB, WS_END = 878 * MiB;
constexpr int LDS_BYTES = 163840;

__device__ __forceinline__ unsigned f2bf(float f) { unsigned u = __float_as_uint(f); return (u + 0x7fffu + ((u >> 16) & 1u)) >> 16; }
__device__ __forceinline__ unsigned pk2(float lo, float hi) { unsigned r; asm("v_cvt_pk_bf16_f32 %0, %1, %2" : "=v"(r) : "v"(lo), "v"(hi)); return r; }
__device__ __forceinline__ float bflo(unsigned u) { return __uint_as_float(u << 16); }
__device__ __forceinline__ float bfhi(unsigned u) { return __uint_as_float(u & 0xffff0000u); }
__device__ __forceinline__ float bf1(bf16_t b) { return __uint_as_float(((unsigned)b) << 16); }
__device__ __forceinline__ float sigmoidf_(float x) { return __builtin_amdgcn_rcpf(1.f + __expf(-x)); }
__device__ __forceinline__ float siluf_(float x) { return x * __builtin_amdgcn_rcpf(1.f + __expf(-x)); }
__device__ __forceinline__ float dpp_ror1(float v) { return __builtin_bit_cast(float, __builtin_amdgcn_update_dpp(0, __builtin_bit_cast(int, v), 0x121, 0xf, 0xf, false)); }
__device__ __forceinline__ float dpp_ror2(float v) { return __builtin_bit_cast(float, __builtin_amdgcn_update_dpp(0, __builtin_bit_cast(int, v), 0x122, 0xf, 0xf, false)); }
__device__ __forceinline__ float gelu_tanh(float x) { const float z = 0.7978845608028654f * (x + 0.044715f * x * x * x); const float t = 1.f - 2.f * __builtin_amdgcn_rcpf(1.f + __expf(2.f * z)); return 0.5f * x * (1.f + t); }
__device__ __forceinline__ uint4 pack8(f32x4 a, f32x4 b) { uint4 r; r.x = pk2(a[0], a[1]); r.y = pk2(a[2], a[3]); r.z = pk2(b[0], b[1]); r.w = pk2(b[2], b[3]); return r; }
__device__ __forceinline__ void unpack8(uint4 v, float* f) { f[0] = bflo(v.x); f[1] = bfhi(v.x); f[2] = bflo(v.y); f[3] = bfhi(v.y); f[4] = bflo(v.z); f[5] = bfhi(v.z); f[6] = bflo(v.w); f[7] = bfhi(v.w); }
#define LDS_FENCE() asm volatile("s_waitcnt lgkmcnt(0)" ::: "memory")
__device__ __forceinline__ int fresh_tid(int wv) { int l = (int)__builtin_amdgcn_mbcnt_hi(~0u, __builtin_amdgcn_mbcnt_lo(~0u, 0u)); asm volatile("" : "+v"(l)); return (wv << 6) | l; }

namespace pg8 {
constexpr int BM = 256, BK = 64, HALF = 128, HTB = HALF * BK * 2, STAGE_BYTES = 8 * HTB, NXCD = 8, WGM = 4;
__host__ __device__ __forceinline__ int lds_byte(int r, int c) { const int st = (r >> 4) * 2 + (c >> 5), rr = r & 15, cc = c & 31, ob = rr * 64 + cc * 2; return st * 1024 + (ob ^ (((ob >> 9) & 1) << 5)); }
__host__ __device__ __forceinline__ void stage_rc(int b, int& R, int& C) { const int st = b / 1024, sb = b % 1024, swz = sb ^ (((sb >> 9) & 1) << 5); R = (st >> 1) * 16 + swz / 64; C = (st & 1) * 32 + (swz % 64) / 2; }
__host__ __device__ __forceinline__ int perm32(int rho) { const int n = rho >> 4, i = rho & 15; return 8 * (i >> 2) + 4 * n + (i & 3); }
struct Unit { int pm, pn; };
struct Gemm { const bf16_t* A; const bf16_t* Bt; int M, N, K, lda, ldb; int asplit; size_t aoff; };
struct StaticOrder {
    int nM, nN, nwg, G, c;
    __device__ void init(int M, int N, int G_, int c_) { nM = M / BM; nN = N / BM; nwg = nM * nN; G = G_; c = c_; }
    __device__ bool next(int i, Unit& u) const {
        const long L = (long)i * G + c; if (L >= nwg) return false;
        int wgid = (int)L; { const int q = nwg / NXCD, r = nwg % NXCD, xcd = wgid % NXCD, off = wgid / NXCD; wgid = (xcd < r ? xcd * (q + 1) : r * (q + 1) + (xcd - r) * q) + off; }
        const int nig = WGM * nN, gid = wgid / nig, fm = gid * WGM, gsz = (nM - fm) < WGM ? (nM - fm) : WGM;
        u.pm = fm + ((wgid % nig) % gsz); u.pn = (wgid % nig) / gsz; return true;
    }
};
template <class Epi, class Sched>
__device__ __forceinline__ void gemm_phase(LAS unsigned char* lds, const Gemm g, const Sched& S, const Epi& E, const int WV) {
    const int TI = fresh_tid(WV);
    const int tid = TI, wid = __builtin_amdgcn_readfirstlane(tid >> 6), lane = tid & 63, wr = wid >> 2, wc = wid & 3, fr = lane & 15, fq = lane >> 4;
    const int K = g.K, nt = K / BK;
    unsigned voffA[2], voffB[2];
#pragma unroll
    for (int i = 0; i < 2; ++i) { int R, C; stage_rc(tid * 16 + i * 8192, R, C); const int Rb = Epi::PERM ? ((R & ~31) + perm32(R & 31)) : R;
        voffA[i] = (unsigned)(R * g.lda + C) * 2u; voffB[i] = (unsigned)(Rb * g.ldb + C) * 2u; }
    const size_t kstep = (size_t)(BK * 2);
    const size_t hstepA = (size_t)HALF * g.lda * 2, hstepB = (size_t)HALF * g.ldb * 2;
    const size_t tstepA = 2 * hstepA, tstepB = 2 * hstepB;
    const unsigned ldsw = (unsigned)wid * 1024u;
    const int aoff = lds_byte(wr * 64 + fr, fq * 8), boff = lds_byte(wc * 32 + fr, fq * 8);
#define PG8_SA(b, h) (((b) * 2 + (h)) * HTB)
#define PG8_SB(b, h) ((4 + (b) * 2 + (h)) * HTB)
#define PG8_STAGE(bufoff, gbase, voff) do { _Pragma("unroll") for (int _i = 0; _i < 2; ++_i) \
        __builtin_amdgcn_global_load_lds((const unsigned*)((const char*)(gbase) + (voff)[_i]), (LAS unsigned*)(lds + (bufoff) + ldsw + _i * 8192), 16, 0, 0); } while (0)
#define PG8_LDA(dst, b, h) do { _Pragma("unroll") for (int m = 0; m < 4; ++m) _Pragma("unroll") for (int k = 0; k < 2; ++k) dst[m][k] = *(const LAS bf16x8*)(lds + PG8_SA(b, h) + aoff + m * 2048 + k * 1024); } while (0)
#define PG8_LDB(dst, b, h) do { _Pragma("unroll") for (int n = 0; n < 2; ++n) _Pragma("unroll") for (int k = 0; k < 2; ++k) dst[n][k] = *(const LAS bf16x8*)(lds + PG8_SB(b, h) + boff + n * 2048 + k * 1024); } while (0)
#define PG8_MMA(ai, bj, At, Bt) do { __builtin_amdgcn_s_setprio(1); _Pragma("unroll") for (int m = 0; m < 4; ++m) _Pragma("unroll") for (int n = 0; n < 2; ++n) _Pragma("unroll") for (int k = 0; k < 2; ++k) \
        acc[ai][bj][m][n] = __builtin_amdgcn_mfma_f32_16x16x32_bf16(Bt[n][k], At[m][k], acc[ai][bj][m][n], 0, 0, 0); __builtin_amdgcn_s_setprio(0); } while (0)
#define PG8_WAIT_V(n) asm volatile("s_waitcnt vmcnt(" #n ")" ::: "memory")
#define PG8_WAIT_L(n) asm volatile("s_waitcnt lgkmcnt(" #n ")" ::: "memory")
#define PG8_BAR __builtin_amdgcn_s_barrier()
#define PG8_SCHED __builtin_amdgcn_sched_barrier(0)
#define PG8_ZERO() do { _Pragma("unroll") for (int a_ = 0; a_ < 2; ++a_) _Pragma("unroll") for (int b_ = 0; b_ < 2; ++b_) _Pragma("unroll") for (int m_ = 0; m_ < 4; ++m_) _Pragma("unroll") for (int n_ = 0; n_ < 2; ++n_) acc[a_][b_][m_][n_] = (f32x4){0.f, 0.f, 0.f, 0.f}; } while (0)
    Unit cur, nxt; int ui = 0;
    if (!S.next(0, cur)) return;
    f32x4 acc[2][2][4][2];
    PG8_ZERO();
    bf16x8 At[4][2], B0[2][2], B1[2][2];
    const char* cA = (const char*)g.A + (size_t)cur.pm * tstepA + (cur.pn >= g.asplit ? g.aoff : (size_t)0); const char* cB = (const char*)g.Bt + (size_t)cur.pn * tstepB;
    PG8_STAGE(PG8_SB(0, 0), cB, voffB); PG8_STAGE(PG8_SB(0, 1), cB + hstepB, voffB); PG8_STAGE(PG8_SA(0, 0), cA, voffA); PG8_STAGE(PG8_SA(0, 1), cA + hstepA, voffA);
    if (wr == 1) PG8_BAR;
    PG8_WAIT_V(2); PG8_BAR;
    PG8_STAGE(PG8_SB(1, 0), cB + kstep, voffB); PG8_STAGE(PG8_SA(1, 0), cA + kstep, voffA); PG8_STAGE(PG8_SB(1, 1), cB + hstepB + kstep, voffB);
    PG8_WAIT_V(6); PG8_BAR;
    for (;;) {
        const bool has_next = S.next(ui + 1, nxt);
        const char* nA = has_next ? (const char*)g.A + (size_t)nxt.pm * tstepA + (nxt.pn >= g.asplit ? g.aoff : (size_t)0) : cA; const char* nB = has_next ? (const char*)g.Bt + (size_t)nxt.pn * tstepB : cB;
        for (int t = 0; t < nt; t += 2) {
            const bool last = (t == nt - 2);
            const char* a1 = cA + (size_t)(t + 1) * kstep;
            const char* a2 = last ? nA : cA + (size_t)(t + 2) * kstep; const char* b2 = last ? nB : cB + (size_t)(t + 2) * kstep;
            const char* a3 = a2 + kstep; const char* b3 = b2 + kstep;
            PG8_LDB(B0, 0, 0); PG8_LDB(B1, 0, 1); PG8_SCHED; PG8_LDA(At, 0, 0); PG8_STAGE(PG8_SA(1, 1), a1 + hstepA, voffA);
            PG8_WAIT_V(8); PG8_WAIT_L(0); PG8_BAR; PG8_MMA(0, 0, At, B0); PG8_MMA(0, 1, At, B1); PG8_BAR; PG8_SCHED;
            PG8_LDA(At, 0, 1); PG8_STAGE(PG8_SB(0, 0), b2, voffB); PG8_STAGE(PG8_SB(0, 1), b2 + hstepB, voffB); PG8_STAGE(PG8_SA(0, 0), a2, voffA);
            PG8_WAIT_V(8); PG8_WAIT_L(0); PG8_BAR; PG8_MMA(1, 0, At, B0); PG8_MMA(1, 1, At, B1); PG8_BAR; PG8_SCHED;
            PG8_LDB(B0, 1, 0); PG8_LDB(B1, 1, 1); PG8_SCHED; PG8_LDA(At, 1, 0); PG8_STAGE(PG8_SA(0, 1), a2 + hstepA, voffA);
            PG8_WAIT_V(8); PG8_WAIT_L(0); PG8_BAR; PG8_MMA(0, 0, At, B0); PG8_MMA(0, 1, At, B1); PG8_BAR; PG8_SCHED;
            PG8_LDA(At, 1, 1); PG8_STAGE(PG8_SB(1, 0), b3, voffB); PG8_STAGE(PG8_SB(1, 1), b3 + hstepB, voffB); PG8_STAGE(PG8_SA(1, 0), a3, voffA);
            PG8_WAIT_V(8); PG8_WAIT_L(0); PG8_BAR; PG8_MMA(1, 0, At, B0); PG8_MMA(1, 1, At, B1); PG8_BAR; PG8_SCHED;
            if constexpr (Epi::SEG) { if (t + 2 == 16 || t + 2 == 24) { E.flush(acc, cur, (t + 2 == 16) ? 0 : 1, wr, wc, fr, fq); PG8_ZERO(); } }
        }
        if (wr == 0) PG8_BAR;
        if constexpr (Epi::SEG) E.flush(acc, cur, 2, wr, wc, fr, fq); else E(acc, cur, wr, wc, fr, fq);
        if (!has_next) break;
        PG8_ZERO();
        cur = nxt; cA = nA; cB = nB; ++ui;
        if (wr == 1) PG8_BAR;
    }
    PG8_WAIT_V(0);
    PG8_BAR;
#undef PG8_SA
#undef PG8_SB
#undef PG8_STAGE
#undef PG8_LDA
#undef PG8_LDB
#undef PG8_MMA
#undef PG8_WAIT_V
#undef PG8_WAIT_L
#undef PG8_BAR
#undef PG8_SCHED
#undef PG8_ZERO
}
}
using pg8::Unit;
typedef const f32x4 (&AccRef)[2][2][4][2];

struct Epi1 {
    static constexpr bool PERM = true, SEG = false;
    bf16_t *ocat, *kn, *vv, *qi, *ki, *u, *p, *gates; float* wi; const float* bgate; LAS unsigned char* stg;
    __device__ __forceinline__ void operator()(AccRef acc, const Unit& un, int wr, int wc, int fr, int fq) const {
        asm volatile("" : "+v"(fr), "+v"(fq));
        const int pn = un.pn, rowb = un.pm * 256 + wr * 64, lane = fq * 16 + fr;
        LAS unsigned char* sb = stg + (wr * 4 + wc) * 2304;
        if (pn == 7 && wc >= 1) {
            if (wc == 1 && fq == 0) {
                const float s = 0.35355339059327373f * 0.125f;
#pragma unroll
                for (int ai = 0; ai < 2; ++ai)
#pragma unroll
                    for (int m = 0; m < 4; ++m) { const size_t row = (size_t)(rowb + ai * 128 + m * 16 + fr);
                        *(f32x4*)(wi + row * 8) = acc[ai][0][m][0] * s; *(f32x4*)(wi + row * 8 + 4) = acc[ai][0][m][1] * s; }
            }
            return;
        }
        if (pn >= 12) {
            const int c0 = (pn - 12) * 256 + 64 * wc;
            f32x4 bz[2][2];
#pragma unroll
            for (int bj = 0; bj < 2; ++bj) { bz[bj][0] = *(const f32x4*)(bgate + c0 + 32 * bj + 8 * fq) * -1.4426950408889634f; bz[bj][1] = *(const f32x4*)(bgate + c0 + 32 * bj + 8 * fq + 4) * -1.4426950408889634f; }
            unsigned char* gb = (unsigned char*)gates + c0;
#pragma unroll
            for (int ai = 0; ai < 2; ++ai)
#pragma unroll
                for (int m = 0; m < 4; ++m) {
#pragma unroll
                    for (int bj = 0; bj < 2; ++bj) { uint2 q; unsigned w[2];
#pragma unroll
                        for (int n = 0; n < 2; ++n) { unsigned t = 0u;
#pragma unroll
                            for (int e = 0; e < 4; ++e) { const float ex_ = __builtin_amdgcn_exp2f(fmaf(acc[ai][bj][m][n][e], -1.4426950408889634f, bz[bj][n][e]));
                                t = __builtin_amdgcn_cvt_pk_u8_f32(__builtin_amdgcn_rcpf(fmaf(ex_, 1.f / 255.f, 1.f / 255.f)), e, t); }
                            w[n] = t; }
                        q.x = w[0]; q.y = w[1];
                        *(LAS u32x2*)(sb + fr * 80 + 32 * bj + 8 * fq) = (u32x2){q.x, q.y}; }
                    LDS_FENCE();
                    { const int r = lane >> 2, sg = lane & 3; const u32x4 v = *(const LAS u32x4*)(sb + r * 80 + sg * 16);
                      *(u32x4*)(gb + (size_t)(rowb + ai * 128 + m * 16 + r) * 6144 + sg * 16) = v; }
                    LDS_FENCE();
                }
            return;
        }
        bf16_t* base; int ld;
        if (pn < 4) { base = ocat + pn * 256 + 64 * wc; ld = 2048; }
        else if (pn == 4) { base = (wc < 2 ? kn : vv) + 64 * (wc & 1); ld = 128; }
        else if (pn < 7) { base = qi + (pn - 5) * 256 + 64 * wc; ld = 512; }
        else if (pn == 7) { base = ki; ld = 64; }
        else if (pn < 10) { base = u + (pn - 8) * 256 + 64 * wc; ld = 512; }
        else { base = p + (pn - 10) * 256 + 64 * wc; ld = 512; }
#pragma unroll
        for (int ai = 0; ai < 2; ++ai)
#pragma unroll
            for (int m = 0; m < 4; ++m) {
#pragma unroll
                for (int bj = 0; bj < 2; ++bj) { const uint4 pk_ = pack8(acc[ai][bj][m][0], acc[ai][bj][m][1]); *(LAS u32x4*)(sb + fr * 144 + 64 * bj + 16 * fq) = (u32x4){pk_.x, pk_.y, pk_.z, pk_.w}; }
                LDS_FENCE();
#pragma unroll
                for (int h = 0; h < 2; ++h) { const int r = h * 8 + (lane >> 3), sg = lane & 7; const u32x4 v = *(const LAS u32x4*)(sb + r * 144 + sg * 16);
                    *(u32x4*)(base + (size_t)(rowb + ai * 128 + m * 16 + r) * ld + sg * 8) = v; }
                LDS_FENCE();
            }
    }
};
struct EpiGluPool {
    static constexpr bool PERM = true, SEG = false;
    const bf16_t* y; const float* scale; bf16_t* ocat;
    __device__ __forceinline__ void operator()(AccRef acc, const Unit& un, int wr, int wc, int fr, int fq) const {
        asm volatile("" : "+v"(fr), "+v"(fq));
        const int row0 = un.pm * 256 + wr * 64 + fr; const bool glu = un.pn < 2;
#pragma unroll
        for (int bj = 0; bj < 2; ++bj) { const int col = (un.pn & 1) * 256 + 64 * wc + 32 * bj + 8 * fq;
            f32x4 s0 = {0.f, 0.f, 0.f, 0.f}, s1 = {0.f, 0.f, 0.f, 0.f};
            if (!glu) { s0 = *(const f32x4*)(scale + col); s1 = *(const f32x4*)(scale + col + 4); }
#pragma unroll
            for (int ai = 0; ai < 2; ++ai) {
                uint4 yq[4];
                if (glu) {
#pragma unroll
                    for (int m = 0; m < 4; ++m) yq[m] = *(const uint4*)(y + (size_t)(row0 + ai * 128 + m * 16) * 512 + col); }
#pragma unroll
                for (int m = 0; m < 4; ++m) { const size_t row = (size_t)(row0 + ai * 128 + m * 16);
                    f32x4 v0 = acc[ai][bj][m][0], v1 = acc[ai][bj][m][1];
                    if (glu) { float yv[8]; unpack8(yq[m], yv);
#pragma unroll
                        for (int e = 0; e < 4; ++e) { v0[e] = yv[e] * sigmoidf_(v0[e]); v1[e] = yv[4 + e] * sigmoidf_(v1[e]); }
                        *(uint4*)(ocat + row * 2048 + 1024 + col) = pack8(v0, v1);
                    } else *(uint4*)(ocat + row * 2048 + 1536 + col) = pack8(v0 * s0, v1 * s1); } } }
    }
};
struct EpiMerge {
    static constexpr bool PERM = true, SEG = true;
    const bf16_t* gates; bf16_t* merged; LAS unsigned char* stg;
    __device__ __forceinline__ void flush(AccRef acc, const Unit& un, int seg, int wr, int wc, int fr, int fq) const {
        asm volatile("" : "+v"(fr), "+v"(fq));
        const int rowb = un.pm * 256 + wr * 64, lane = fq * 16 + fr;
        const int colw = un.pn * 256 + 64 * wc;
        LAS unsigned char* sb = stg + (wr * 4 + wc) * 2304;
#pragma unroll
        for (int ai = 0; ai < 2; ++ai) {
            uint2 gq[2][4]; uint4 pq[2][4];
#pragma unroll
            for (int bj = 0; bj < 2; ++bj)
#pragma unroll
                for (int m = 0; m < 4; ++m) { const size_t row = (size_t)(rowb + ai * 128 + m * 16 + fr); const int col = colw + 32 * bj + 8 * fq;
                    gq[bj][m] = *(const uint2*)((const unsigned char*)gates + row * 6144 + seg * 2048 + col);
                    if (seg > 0) pq[bj][m] = *(const uint4*)(merged + row * 2048 + col); else pq[bj][m] = make_uint4(0u, 0u, 0u, 0u); }
#pragma unroll
            for (int m = 0; m < 4; ++m) {
#pragma unroll
                for (int bj = 0; bj < 2; ++bj) {
                    float gv[8], pv[8]; unpack8(pq[bj][m], pv);
#pragma unroll
                    for (int e = 0; e < 4; ++e) { gv[e] = (float)((gq[bj][m].x >> (8 * e)) & 0xffu) * (1.f / 255.f); gv[4 + e] = (float)((gq[bj][m].y >> (8 * e)) & 0xffu) * (1.f / 255.f); }
                    f32x4 v0 = acc[ai][bj][m][0], v1 = acc[ai][bj][m][1];
#pragma unroll
                    for (int e = 0; e < 4; ++e) { v0[e] = pv[e] + gv[e] * v0[e]; v1[e] = pv[4 + e] + gv[4 + e] * v1[e]; }
                    const uint4 pk_ = pack8(v0, v1); *(LAS u32x4*)(sb + fr * 144 + 64 * bj + 16 * fq) = (u32x4){pk_.x, pk_.y, pk_.z, pk_.w}; }
                LDS_FENCE();
#pragma unroll
                for (int h = 0; h < 2; ++h) { const int r = h * 8 + (lane >> 3), sg = lane & 7; const u32x4 v = *(const LAS u32x4*)(sb + r * 144 + sg * 16);
                    *(u32x4*)(merged + (size_t)(rowb + ai * 128 + m * 16 + r) * 2048 + colw + sg * 8) = v; }
                LDS_FENCE();
            }
        }
    }
};
struct EpiRes {
    static constexpr bool PERM = false, SEG = false;
    const float* xin; float* out; const float* gt;
    __device__ __forceinline__ void operator()(AccRef acc, const Unit& un, int wr, int wc, int fr, int fq) const {
        asm volatile("" : "+v"(fr), "+v"(fq));
        const int row0 = un.pm * 256 + wr * 64 + fr; const float* g = gt + (size_t)(un.pm >> 3) * 12288;
#pragma unroll
        for (int bj = 0; bj < 2; ++bj) { const int col = un.pn * 256 + bj * 128 + wc * 32 + 4 * fq;
            f32x4 gv[2], xv[2][2][4];
#pragma unroll
            for (int n = 0; n < 2; ++n) gv[n] = *(const f32x4*)(g + col + 16 * n);
#pragma unroll
            for (int n = 0; n < 2; ++n)
#pragma unroll
                for (int ai = 0; ai < 2; ++ai)
#pragma unroll
                    for (int m = 0; m < 4; ++m) xv[n][ai][m] = *(const f32x4*)(xin + (size_t)(row0 + ai * 128 + m * 16) * 2048 + col + 16 * n);
#pragma unroll
            for (int n = 0; n < 2; ++n)
#pragma unroll
                for (int ai = 0; ai < 2; ++ai)
#pragma unroll
                    for (int m = 0; m < 4; ++m) *(f32x4*)(out + (size_t)(row0 + ai * 128 + m * 16) * 2048 + col + 16 * n) = xv[n][ai][m] + gv[n] * acc[ai][bj][m][n]; }
    }
};
struct EpiUp {
    static constexpr bool PERM = true, SEG = false;
    bf16_t* act; float* SA; float* SB; const float* cw; const float* cb; LAS unsigned char* stg;
    __device__ __forceinline__ void operator()(AccRef acc, const Unit& un, int wr, int wc, int fr, int fq) const {
        asm volatile("" : "+v"(fr), "+v"(fq));
        const int lg = fq << 4, lane = lg | fr;
        const int src1 = lg | ((fr + 15) & 15), src2 = lg | ((fr + 14) & 15);
        const int ch0 = un.pn * 128 + wc * 32 + 8 * fq;
        LAS unsigned char* sb = stg + (wr * 4 + wc) * 2304;
        f32x4 w0[2], w1[2], w2[2], bb[2];
#pragma unroll
        for (int n = 0; n < 2; ++n) { w0[n] = *(const f32x4*)(cw + ch0 + 4 * n); w1[n] = *(const f32x4*)(cw + DFF + ch0 + 4 * n); w2[n] = *(const f32x4*)(cw + 2 * DFF + ch0 + 4 * n); bb[n] = *(const f32x4*)(cb + ch0 + 4 * n); }
#pragma unroll
        for (int ai = 0; ai < 2; ++ai) {
            const int rowb = un.pm * 256 + ai * 128 + wr * 64; const int blk = rowb >> 6;
#pragma unroll
            for (int m = 0; m < 4; ++m) {
                f32x4 res[2];
#pragma unroll
                for (int n = 0; n < 2; ++n)
#pragma unroll
                    for (int e = 0; e < 4; ++e) {
                        const float cur = acc[ai][0][m][n][e];
                        const float prv = (m > 0) ? acc[ai][0][m > 0 ? m - 1 : 0][n][e] : 0.f;
                        const float p1 = dpp_ror1((fr + 1 >= 16) ? prv : cur);
                        const float p2 = dpp_ror2((fr + 2 >= 16) ? prv : cur);
                        const float cv = bb[n][e] + w0[n][e] * p2 + w1[n][e] * p1 + w2[n][e] * cur;
                        res[n][e] = siluf_(cv) * acc[ai][1][m][n][e];
                    }
                if (m == 0 && fr < 2) {
                    float* sa = SA + ((size_t)(blk * 4 + 2 + fr)) * DFF + ch0; float* sbp = SB + ((size_t)(blk * 2 + fr)) * DFF + ch0;
                    *(f32x4*)sa = acc[ai][0][0][0]; *(f32x4*)(sa + 4) = acc[ai][0][0][1];
                    *(f32x4*)sbp = acc[ai][1][0][0]; *(f32x4*)(sbp + 4) = acc[ai][1][0][1];
                }
                if (m == 3 && fr >= 14) { float* sa = SA + ((size_t)(blk * 4 + (fr - 14))) * DFF + ch0; *(f32x4*)sa = acc[ai][0][3][0]; *(f32x4*)(sa + 4) = acc[ai][0][3][1]; }
                { const uint4 pk_ = pack8(res[0], res[1]); *(LAS u32x4*)(sb + fr * 80 + 16 * fq) = (u32x4){pk_.x, pk_.y, pk_.z, pk_.w}; }
                LDS_FENCE();
                { const int r = lane >> 2, sg = lane & 3; const u32x4 v = *(const LAS u32x4*)(sb + r * 80 + sg * 16);
                  if (!(m == 0 && r < 2)) *(u32x4*)(act + (size_t)(rowb + m * 16 + r) * DFF + un.pn * 128 + wc * 32 + sg * 8) = v; }
                LDS_FENCE();
            }
        }
    }
};

struct Args { const float* in[31]; float* out; unsigned char* ws; int ph_lo, ph_hi; };
enum { I_X = 0, I_C, I_POS, I_WADA, I_BADA, I_GN1, I_GN2, I_WIN, I_GQ, I_GK, I_ARE, I_AIM, I_BRE, I_BIM, I_CRE, I_CIM, I_DSKIP, I_LOGDT, I_WGLU, I_WPOOL, I_PSCALE, I_PA, I_PB, I_PC, I_WGATE, I_BGATE, I_WOUT, I_WUP, I_CONVW, I_CONVB, I_WDOWN };

__device__ __forceinline__ float wave_sum(float v) {
#pragma unroll
    for (int o = 32; o > 0; o >>= 1) v += __shfl_xor(v, o);
    return v;
}

__device__ __forceinline__ void phase_ada(const Args& a, unsigned char* lds, const int WV) {
    const int TI = fresh_tid(WV);
    const int tid = TI;
    float* cact = (float*)lds;
    float* mod = (float*)(a.ws + WS_MOD);
    for (int w = blockIdx.x; w < 256; w += gridDim.x) {
        for (int i = tid; i < 16 * 2048; i += 512) { const int b = i >> 11, k = i & 2047; const float v = a.in[I_C][i]; cact[k * 16 + b] = siluf_(v); }
        __syncthreads();
        const int l = w >> 7, n0 = (w & 127) * 96;
        float acc[16][4];
#pragma unroll
        for (int b = 0; b < 16; ++b)
#pragma unroll
            for (int j = 0; j < 4; ++j) acc[b][j] = 0.f;
        const int cg4 = tid % 24, ks = tid / 24;
        if (tid < 384) {
            const float* wp = a.in[I_WADA] + ((size_t)l * 2048 + ks * 128) * 12288 + n0 + cg4 * 4;
#pragma unroll 4
            for (int k = 0; k < 128; ++k) {
                const f32x4 wv = *(const f32x4*)(wp + (size_t)k * 12288);
                const f32x4* cp = (const f32x4*)(cact + (ks * 128 + k) * 16);
#pragma unroll
                for (int q = 0; q < 4; ++q) { const f32x4 cv = cp[q];
#pragma unroll
                    for (int e = 0; e < 4; ++e)
#pragma unroll
                        for (int j = 0; j < 4; ++j) acc[q * 4 + e][j] += cv[e] * wv[j]; }
            }
        }
        __syncthreads();
        float* part = (float*)lds;
        if (tid < 384) {
#pragma unroll
            for (int b = 0; b < 16; ++b)
#pragma unroll
                for (int j = 0; j < 4; ++j) part[(ks * 16 + b) * 96 + cg4 * 4 + j] = acc[b][j];
        }
        __syncthreads();
        for (int o = tid; o < 1536; o += 512) { const int b = o / 96, cc = o % 96; float s = 0.f;
#pragma unroll
            for (int k2 = 0; k2 < 16; ++k2) s += part[(k2 * 16 + b) * 96 + cc];
            mod[((size_t)l * 16 + b) * 12288 + n0 + cc] = s + a.in[I_BADA][l * 12288 + n0 + cc]; }
        __syncthreads();
    }
}

struct CvtJob { const float* src; bf16_t* dst; int ldS, cbase, cend, kbase, ldD, mode, r0, cs0, kd0; };
__device__ __forceinline__ CvtJob cvt_decode(const Args& a, int l, int t) {
    unsigned char* ws = a.ws; CvtJob J; int ncols, nkt, idx; J.mode = 0; J.r0 = 0; J.kd0 = 0; J.cs0 = 0;
    if (t < 960) { idx = t; J.src = a.in[I_WIN] + (size_t)l * DM * DIN; J.ldS = DIN; ncols = 1864; nkt = 32; J.dst = (bf16_t*)(ws + W_1CAT); J.ldD = 2048; J.mode = 2; }
    else if (t < 1472) { idx = t - 960; J.src = a.in[I_WIN] + (size_t)l * DM * DIN; J.ldS = DIN; J.cs0 = 1864; ncols = 1024; nkt = 32; J.dst = (bf16_t*)(ws + W_1CAT); J.ldD = 2048; J.r0 = 2048; J.mode = 2; }
    else if (t < 4544) { idx = t - 1472; const int gi = idx >> 10; idx &= 1023; J.src = a.in[I_WGATE] + ((size_t)l * 3 + gi) * DM * DM; J.ldS = DM; ncols = 2048; nkt = 32; J.dst = (bf16_t*)(ws + W_1CAT); J.ldD = 2048; J.r0 = 3072 + 2048 * gi; J.mode = 2; }
    else if (t < 5056) { idx = t - 4544; J.src = a.in[I_PA] + (size_t)l * 1024 * DM; J.ldS = DM; ncols = 2048; nkt = 16; J.dst = (bf16_t*)(ws + W_P); J.ldD = 2048; J.mode = 2; }
    else if (t < 5312) { idx = t - 5056; J.src = a.in[I_PB] + (size_t)l * 512 * DM; J.ldS = DM; ncols = 2048; nkt = 8; J.dst = (bf16_t*)(ws + W_P); J.ldD = 2048; J.kd0 = 1024; J.mode = 2; }
    else if (t < 5568) { idx = t - 5312; J.src = a.in[I_PC] + (size_t)l * 512 * DM; J.ldS = DM; ncols = 2048; nkt = 8; J.dst = (bf16_t*)(ws + W_P); J.ldD = 2048; J.kd0 = 1536; J.mode = 2; }
    else if (t < 6592) { idx = t - 5568; J.src = a.in[I_WOUT] + (size_t)l * DM * DM; J.ldS = DM; ncols = 2048; nkt = 32; J.dst = (bf16_t*)(ws + W_OUT); J.ldD = 2048; }
    else if (t < 12096) { idx = t - 6592; J.src = a.in[I_WUP] + (size_t)l * DM * 2 * DFF; J.ldS = 2 * DFF; ncols = 2 * DFF; nkt = 32; J.dst = (bf16_t*)(ws + W_UP); J.ldD = 2048; J.mode = 1; }
    else if (t < 14848) { idx = t - 12096; J.src = a.in[I_WDOWN] + (size_t)l * DFF * DM; J.ldS = DM; ncols = 2048; nkt = 86; J.dst = (bf16_t*)(ws + W_DOWN); J.ldD = DFF; }
    else { idx = t - 14848; J.src = a.in[I_WGLU] + (size_t)l * 512 * 512; J.ldS = 512; ncols = 512; nkt = 8; J.dst = (bf16_t*)(ws + W_GLU); J.ldD = 512; J.mode = 2; }
    const int tn = idx / nkt, tk = idx - tn * nkt;
    J.cbase = J.cs0 + tn * 64; J.cend = J.cs0 + ncols; J.kbase = tk * 64; return J;
}
__device__ __forceinline__ void phase_cvt(const Args& a, int l, unsigned char* lds, const int WV) {
    const int TI = fresh_tid(WV);
    float* T = (float*)lds;
    const int tid = TI, ty = tid >> 4, tx = tid & 15;
    for (int t4 = blockIdx.x * 8; t4 < 14912; t4 += gridDim.x * 8) {
        f32x4 v[8][2];
#pragma unroll
        for (int q = 0; q < 8; ++q) { const CvtJob J = cvt_decode(a, l, t4 + q);
#pragma unroll
            for (int ps = 0; ps < 2; ++ps) { const int k = ty + ps * 32, c = J.cbase + tx * 4;
                v[q][ps] = (f32x4){0.f, 0.f, 0.f, 0.f};
                if (c < J.cend) v[q][ps] = *(const f32x4*)(J.src + (size_t)(J.kbase + k) * J.ldS + c); } }
#pragma unroll
        for (int q = 0; q < 8; ++q)
#pragma unroll
            for (int ps = 0; ps < 2; ++ps) { float* tp = T + q * (64 * 65) + (ty + ps * 32) * 65 + tx * 4; tp[0] = v[q][ps][0]; tp[1] = v[q][ps][1]; tp[2] = v[q][ps][2]; tp[3] = v[q][ps][3]; }
        __syncthreads();
#pragma unroll
        for (int q = 0; q < 8; ++q) { const CvtJob J = cvt_decode(a, l, t4 + q);
            const int n = tid >> 3, kq = tid & 7, c = J.cbase + n;
            if (c < J.cend) {
                float f[8];
#pragma unroll
                for (int j = 0; j < 8; ++j) f[j] = T[q * (64 * 65) + (kq * 8 + j) * 65 + n];
                int row;
                if (J.mode == 0) row = J.r0 + (c - J.cs0);
                else if (J.mode == 2) { const int r_ = J.r0 + (c - J.cs0), ct = r_ & 255; row = (r_ & ~255) | (((ct >> 5) & 1) << 7) | ((ct >> 6) << 5) | (ct & 31); }
                else { const int bj = c >= DFF ? 1 : 0, ch = c - bj * DFF; row = (ch >> 7) * 256 + bj * 128 + (ch & 127); }
                uint4 o; o.x = pk2(f[0], f[1]); o.y = pk2(f[2], f[3]); o.z = pk2(f[4], f[5]); o.w = pk2(f[6], f[7]);
                *(uint4*)(J.dst + (size_t)row * J.ldD + J.kd0 + J.kbase + kq * 8) = o;
            } }
        __syncthreads();
    }
    bf16_t* wp = (bf16_t*)(a.ws + W_POOL); const float* wsrc = a.in[I_WPOOL] + (size_t)l * 4 * 128 * 128;
    for (int i = blockIdx.x * 512 + TI; i < 512 * 512; i += gridDim.x * 512) { const int n = i >> 9, k = i & 511, g = n >> 7;
        const float v = ((k >> 7) == g) ? wsrc[(g * 128 + (k & 127)) * 128 + (n & 127)] : 0.f;
        const int ct = n & 255, nr = (n & ~255) | (((ct >> 5) & 1) << 7) | ((ct >> 6) << 5) | (ct & 31); wp[nr * 512 + k] = (bf16_t)f2bf(v); }
}

__device__ __forceinline__ void phase_norm(const float* xin, const float* g, const float* modl, int shoff, int scoff, bf16_t* out, const int WV) {
    const int TI = fresh_tid(WV);
    const int lane = TI & 63, wave = TI >> 6;
    for (int r = blockIdx.x * 8 + wave; r < MROWS; r += gridDim.x * 8) {
        const f32x4* xp = (const f32x4*)(xin + (size_t)r * DM); f32x4 v[8]; float ssq = 0.f;
#pragma unroll
        for (int j = 0; j < 8; ++j) { v[j] = xp[j * 64 + lane]; ssq += v[j][0] * v[j][0] + v[j][1] * v[j][1] + v[j][2] * v[j][2] + v[j][3] * v[j][3]; }
        ssq = wave_sum(ssq);
        const float rinv = rsqrtf(ssq * (1.f / DM) + EPS);
        const float* mb = modl + (size_t)(r >> 11) * 12288;
#pragma unroll
        for (int j = 0; j < 8; ++j) { const int col = j * 256 + lane * 4;
            const f32x4 g4 = *(const f32x4*)(g + col), sc = *(const f32x4*)(mb + scoff + col), sh = *(const f32x4*)(mb + shoff + col);
            f32x4 y;
#pragma unroll
            for (int e = 0; e < 4; ++e) y[e] = (v[j][e] * rinv * g4[e]) * (1.f + sc[e]) + sh[e];
            uint2 o; o.x = pk2(y[0], y[1]); o.y = pk2(y[2], y[3]);
            *(uint2*)(out + (size_t)r * DM + col) = o; }
    }
}

__constant__ double kRevPerPos[24] = {0.15915494309189535, 0.0700865215877985, 0.03086376340470123, 0.013591370636193905, 0.005985185712713705, 0.002635675898667414, 0.001160663641240061, 0.0005111175045375439, 0.00022507907903927653, 9.911730936901935e-05, 4.364795279280289e-05, 1.9221100684944863e-05, 8.464330808241401e-06, 3.727408601915352e-06, 1.6414262627950345e-06, 7.228293068832865e-07, 0.15915494309189535, 0.03086376340470123, 0.005985185712713705, 0.001160663641240061, 0.00022507907903927653, 4.364795279280289e-05, 8.464330808241401e-06, 1.6414262627950345e-06};
__device__ __forceinline__ void rmsrope128(bf16_t* p, bool active, const float* g16, int sub, const float* cs) {
    float v[16];
    if (active) { unpack8(*(const uint4*)p, v); unpack8(*(const uint4*)(p + 8), v + 8); }
    else {
#pragma unroll
        for (int i = 0; i < 16; ++i) v[i] = 0.f; }
    float ssq = 0.f;
#pragma unroll
    for (int i = 0; i < 16; ++i) ssq += v[i] * v[i];
    ssq += __shfl_xor(ssq, 1); ssq += __shfl_xor(ssq, 2); ssq += __shfl_xor(ssq, 4);
    const float rinv = rsqrtf(ssq * (1.f / 128.f) + EPS);
#pragma unroll
    for (int i = 0; i < 16; ++i) v[i] = v[i] * rinv * g16[i];
#pragma unroll
    for (int i = 0; i < 16; ++i) { const float o = __shfl_xor(v[i], 1); const float c = cs[2 * i], s = cs[2 * i + 1];
        if (sub == 0) v[i] = v[i] * c - o * s; else if (sub == 1) v[i] = v[i] * c + o * s; }
    if (active) { uint4 o0, o1; o0.x = pk2(v[0], v[1]); o0.y = pk2(v[2], v[3]); o0.z = pk2(v[4], v[5]); o0.w = pk2(v[6], v[7]);
        o1.x = pk2(v[8], v[9]); o1.y = pk2(v[10], v[11]); o1.z = pk2(v[12], v[13]); o1.w = pk2(v[14], v[15]);
        *(uint4*)p = o0; *(uint4*)(p + 8) = o1; }
}
__device__ __forceinline__ void rope64(bf16_t* p, bool active, int sub, const float* cs) {
    float v[8];
    if (active) unpack8(*(const uint4*)p, v);
    else {
#pragma unroll
        for (int i = 0; i < 8; ++i) v[i] = 0.f; }
#pragma unroll
    for (int i = 0; i < 8; ++i) { const float o = __shfl_xor(v[i], 1); const float c = cs[2 * i], s = cs[2 * i + 1];
        if (sub == 0) v[i] = v[i] * c - o * s; else if (sub == 1) v[i] = v[i] * c + o * s; }
    if (active) { uint4 o0; o0.x = pk2(v[0], v[1]); o0.y = pk2(v[2], v[3]); o0.z = pk2(v[4], v[5]); o0.w = pk2(v[6], v[7]); *(uint4*)p = o0; }
}
__device__ __forceinline__ void phase_post(const Args& a, int l, unsigned char* lds, const int WV) {
    const int TI = fresh_tid(WV);
    const int lane = TI & 63, wave = TI >> 6;
    float* cs = (float*)lds + wave * 64;
    bf16_t* ocat = (bf16_t*)(a.ws + WS_OCAT); bf16_t* kn = (bf16_t*)(a.ws + WS_KN); bf16_t* qi = (bf16_t*)(a.ws + WS_QI); bf16_t* ki = (bf16_t*)(a.ws + WS_KI);
    const int* pos = (const int*)a.in[I_POS];
    const int sub = lane & 7, hd = lane >> 3;
    float gq[16], gk[16];
#pragma unroll
    for (int i = 0; i < 16; ++i) { gq[i] = a.in[I_GQ][l * 128 + sub * 16 + i]; gk[i] = a.in[I_GK][l * 128 + sub * 16 + i]; }
    for (int r = blockIdx.x * 8 + wave; r < MROWS; r += gridDim.x * 8) {
        const int ps = pos[r];
        if (lane < 24) {
            double rev = (double)ps * kRevPerPos[lane]; rev -= rint(rev); const float fr = (float)rev;
            cs[lane * 2] = __builtin_amdgcn_cosf(fr); cs[lane * 2 + 1] = __builtin_amdgcn_sinf(fr); }
        LDS_FENCE();
        rmsrope128(ocat + (size_t)r * 2048 + hd * 128 + sub * 16, true, gq, sub, cs);
        rmsrope128(kn + (size_t)r * 128 + sub * 16, lane < 8, gk, sub, cs);
        rope64(qi + (size_t)r * 512 + hd * 64 + sub * 8, true, sub, cs + 32);
        rope64(ki + (size_t)r * 64 + sub * 8, lane < 8, sub, cs + 32);
        LDS_FENCE();
    }
}

__device__ __forceinline__ void s5_unit(const Args& a, int l, int b, int g, unsigned char* lds, const int WV) {
    const int TI = fresh_tid(WV);
    const int lane = TI & 63, wave = __builtin_amdgcn_readfirstlane(TI >> 6), p = lane;
    float* E = (float*)lds;
    float* ust = (float*)(lds + 16384 + wave * 4096);
    bf16_t* sst = (bf16_t*)(lds + 49152 + wave * 4352);
    const bf16_t* U = (const bf16_t*)(a.ws + WS_U); bf16_t* Y = (bf16_t*)(a.ws + WS_Y);
    const int gp = (l * 32 + g) * 64 + p;
    const float are = a.in[I_ARE][gp], aim = a.in[I_AIM][gp], dt = expf(a.in[I_LOGDT][l * 32 + g]);
    const float mag = expf(are * dt);
    float ang = aim * dt; { const float n = rintf(ang * 0.15915494309189535f); ang = fmaf(-n, 6.28318548202514648f, ang); ang = fmaf(n, 1.7484555e-7f, ang); }
    const float lre = mag * cosf(ang), lim = mag * sinf(ang);
    float Bre[16], Bim[16];
    { const float nr = lre - 1.f, ni = lim, den = 1.f / (are * are + aim * aim); const float cr = (nr * are + ni * aim) * den, ci = (ni * are - nr * aim) * den;
#pragma unroll
        for (int j = 0; j < 16; ++j) { const float br = a.in[I_BRE][(size_t)gp * 16 + j], bi = a.in[I_BIM][(size_t)gp * 16 + j]; Bre[j] = cr * br - ci * bi; Bim[j] = cr * bi + ci * br; } }
    bf16x8 Cf[4];
    { const int i = lane & 15;
#pragma unroll
        for (int ks = 0; ks < 4; ++ks)
#pragma unroll
            for (int j = 0; j < 8; ++j) { const int k = ks * 32 + (lane >> 4) * 8 + j, pp = k >> 1; const size_t ci = ((size_t)(l * 32 + g) * 16 + i) * 64 + pp;
                const float v = (k & 1) ? -a.in[I_CIM][ci] : a.in[I_CRE][ci]; Cf[ks][j] = (short)f2bf(v); } }
    const float dsk = a.in[I_DSKIP][l * 512 + g * 16 + (lane & 15)];
    bf16_t* Bl = (bf16_t*)(lds + 83968);
    float* bus = (float*)(lds + 88064 + wave * 8448);
    if (wave == 0) {
#pragma unroll
        for (int q = 0; q < 2; ++q) { uint4 o_; o_.x = pk2(Bre[q * 8], Bre[q * 8 + 1]); o_.y = pk2(Bre[q * 8 + 2], Bre[q * 8 + 3]); o_.z = pk2(Bre[q * 8 + 4], Bre[q * 8 + 5]); o_.w = pk2(Bre[q * 8 + 6], Bre[q * 8 + 7]);
            *(uint4*)(Bl + p * 16 + q * 8) = o_;
            uint4 i_; i_.x = pk2(Bim[q * 8], Bim[q * 8 + 1]); i_.y = pk2(Bim[q * 8 + 2], Bim[q * 8 + 3]); i_.z = pk2(Bim[q * 8 + 4], Bim[q * 8 + 5]); i_.w = pk2(Bim[q * 8 + 6], Bim[q * 8 + 7]);
            *(uint4*)(Bl + (64 + p) * 16 + q * 8) = i_; }
    }
    __syncthreads();
    const int l15 = lane & 15, lg4 = lane >> 4;
    bf16x8 Bf[8];
#pragma unroll
    for (int nb = 0; nb < 8; ++nb) { u32x4 t_ = {0u, 0u, 0u, 0u}; if (lg4 < 2) t_ = *(const u32x4*)(Bl + (nb * 16 + l15) * 16 + lg4 * 8); Bf[nb] = __builtin_bit_cast(bf16x8, t_); }
#define S5_BU(t0_, sb_) do { u32x4 a_ = {0u, 0u, 0u, 0u}; if (lg4 < 2) a_ = *(const u32x4*)(U + (size_t)(b * 2048 + (t0_) + (sb_) * 16 + l15) * 512 + g * 16 + lg4 * 8); \
        const bf16x8 af_ = __builtin_bit_cast(bf16x8, a_); \
        _Pragma("unroll") for (int nb = 0; nb < 8; ++nb) { const f32x4 c_ = __builtin_amdgcn_mfma_f32_16x16x32_bf16(af_, Bf[nb], (f32x4){0.f, 0.f, 0.f, 0.f}, 0, 0, 0); \
            _Pragma("unroll") for (int r = 0; r < 4; ++r) bus[(lg4 * 4 + r) * 132 + nb * 16 + l15] = c_[r]; } \
        LDS_FENCE(); } while (0)
#define S5_STEP(tt_) do { const float br_ = bus[(tt_) * 132 + p], bi_ = bus[(tt_) * 132 + 64 + p]; \
        const float nre_ = lre * sre - lim * sim + br_, nim_ = lre * sim + lim * sre + bi_; sre = nre_; sim = nim_; } while (0)
#pragma unroll 1
    for (int cc = 0; cc < 4; ++cc) {
        const int chunk = wave * 4 + cc, t0 = chunk * 64;
        float sre = 0.f, sim = 0.f;
#pragma unroll 1
        for (int sb = 0; sb < 4; ++sb) {
            S5_BU(t0, sb);
#pragma unroll 4
            for (int tt = 0; tt < 16; ++tt) S5_STEP(tt);
            LDS_FENCE();
        }
        E[(chunk * 64 + p) * 2] = sre; E[(chunk * 64 + p) * 2 + 1] = sim;
    }
    __syncthreads();
    if (wave == 0) {
        float pr = lre, pi = lim;
#pragma unroll
        for (int q = 0; q < 6; ++q) { const float nr = pr * pr - pi * pi, pp_ = pr * pi, ni = pp_ + pp_; pr = nr; pi = ni; }
        float sr = 0.f, si = 0.f;
        for (int c = 0; c < 32; ++c) { const float er = E[(c * 64 + p) * 2], ei = E[(c * 64 + p) * 2 + 1]; E[(c * 64 + p) * 2] = sr; E[(c * 64 + p) * 2 + 1] = si;
            const float nr = pr * sr - pi * si + er, ni = pr * si + pi * sr + ei; sr = nr; si = ni; }
    }
    __syncthreads();
#pragma unroll 1
    for (int cc = 0; cc < 4; ++cc) {
        const int chunk = wave * 4 + cc, t0 = chunk * 64;
        { const bf16_t* up = U + (size_t)(b * 2048 + t0 + lane) * 512 + g * 16; const uint4 q0 = *(const uint4*)up, q1 = *(const uint4*)(up + 8);
            float f[16]; unpack8(q0, f); unpack8(q1, f + 8);
#pragma unroll
            for (int q = 0; q < 4; ++q) *(f32x4*)(ust + lane * 16 + q * 4) = (f32x4){f[q * 4], f[q * 4 + 1], f[q * 4 + 2], f[q * 4 + 3]}; }
        float sre = E[(chunk * 64 + p) * 2], sim = E[(chunk * 64 + p) * 2 + 1];
#pragma unroll 1
        for (int sb = 0; sb < 4; ++sb) {
            S5_BU(t0, sb);
#pragma unroll 4
            for (int tt = 0; tt < 16; ++tt) { S5_STEP(tt);
                *(unsigned*)(sst + tt * 136 + 2 * p) = pk2(sre, sim);
            }
            LDS_FENCE();
            f32x4 acc = {0.f, 0.f, 0.f, 0.f};
#pragma unroll
            for (int ks = 0; ks < 4; ++ks) { const bf16x8 af = *(const bf16x8*)(sst + (lane & 15) * 136 + ks * 32 + (lane >> 4) * 8);
                acc = __builtin_amdgcn_mfma_f32_16x16x32_bf16(af, Cf[ks], acc, 0, 0, 0); }
#pragma unroll
            for (int r = 0; r < 4; ++r) { const int t = sb * 16 + (lane >> 4) * 4 + r, i = lane & 15;
                const float y = gelu_tanh(acc[r] + dsk * ust[t * 16 + i]);
                Y[(size_t)(b * 2048 + t0 + t) * 512 + g * 16 + i] = (bf16_t)f2bf(y); }
            LDS_FENCE();
        }
    }
    __syncthreads();
#undef S5_STEP
#undef S5_BU
}

__device__ __forceinline__ void pool_unit(const Args& a, int b, int chunk, unsigned char* lds, const int WV) {
    const int TI = fresh_tid(WV);
    bf16_t* T = (bf16_t*)lds;
    const int t0 = chunk * 64;
    const bf16_t* P = (const bf16_t*)(a.ws + WS_P) + (size_t)b * 2048 * 512; bf16_t* O = (bf16_t*)(a.ws + WS_POOLED) + (size_t)b * 2048 * 512;
    __syncthreads();
    for (int i = TI; i < 80 * 64; i += 512) { const int r = i >> 6, c8 = i & 63, t = t0 - 16 + r;
        uint4 v = make_uint4(0u, 0u, 0u, 0u); if (t >= 0) v = *(const uint4*)(P + (size_t)t * 512 + c8 * 8);
        *(uint4*)(T + r * 512 + c8 * 8) = v; }
    __syncthreads();
    const int c = TI, w = 2 << (c >> 7);
    float s = 0.f;
    for (int k = 1; k <= w; ++k) s += bf1(T[(16 - k) * 512 + c]);
#pragma unroll 4
    for (int t = 0; t < 64; ++t) { const float pv = bf1(T[(16 + t) * 512 + c]); s += pv; s -= bf1(T[(16 + t - w) * 512 + c]);
        const int tt = t0 + t + 1; const float mean = s / (float)(tt < w ? tt : w); O[(size_t)(t0 + t) * 512 + c] = (bf16_t)f2bf(mean - pv); }
}

__device__ __forceinline__ unsigned sortkey(float x) { const unsigned u = __float_as_uint(x); return (u & 0x80000000u) ? ~u : (u | 0x80000000u); }
template <int NJ>
__device__ __forceinline__ void select256(const float* scq, int limit, unsigned short* sq, int lane) {
    const unsigned long long ltmask = (1ull << lane) - 1ull;
    unsigned key[NJ];
#pragma unroll
    for (int j = 0; j < NJ; ++j) { const int idx = j * 64 + lane; key[j] = (idx < limit) ? sortkey(scq[idx]) : 0u; }
    unsigned T = 0u;
    for (int bit = 31; bit >= 0; --bit) { const unsigned cand = T | (1u << bit); int cnt = 0;
#pragma unroll
        for (int j = 0; j < NJ; ++j) cnt += __popcll(__ballot(key[j] >= cand));
        if (cnt >= 256) { T = cand; if (cnt == 256) break; } }
    int cgt = 0;
#pragma unroll
    for (int j = 0; j < NJ; ++j) cgt += __popcll(__ballot(key[j] > T));
    const int need = 256 - cgt; int ob = 0, tb = 0;
#pragma unroll
    for (int j = 0; j < NJ; ++j) { const bool gt = key[j] > T, eq = key[j] == T; const unsigned long long me = __ballot(eq);
        const int pe = tb + __popcll(me & ltmask); const bool take = gt || (eq && pe < need); const unsigned long long mt = __ballot(take);
        if (take) sq[ob + __popcll(mt & ltmask)] = (unsigned short)(j * 64 + lane);
        ob += __popcll(mt); tb += __popcll(me); }
}
__device__ __forceinline__ void dsa_unit(const Args& a, int b, int tq, unsigned char* lds, const int WV, bf16_t* obase, const int ostride, const int parts) {
    const int TI = fresh_tid(WV);
    int tid = TI;
    int lane = tid & 63; const int wave = WV;
    float* sc = (float*)lds;
    unsigned short* sel = (unsigned short*)(lds + 131072);
    float* wis = (float*)(lds + 131072 + 8192);
    bf16_t* ocat = (bf16_t*)(a.ws + WS_OCAT); const bf16_t* Kn = (const bf16_t*)(a.ws + WS_KN); const bf16_t* V = (const bf16_t*)(a.ws + WS_V);
    const bf16_t* QI = (const bf16_t*)(a.ws + WS_QI); const bf16_t* KI = (const bf16_t*)(a.ws + WS_KI); const float* WI = (const float*)(a.ws + WS_WI);
    const int t0 = tq * 16, row0 = b * 2048 + t0, limit = ((t0 >> 6) + 1) << 6, nkt = limit >> 5, nsel = limit < 256 ? limit : 256;
    __syncthreads();
    if (tid < 128) wis[tid] = WI[(size_t)row0 * 8 + tid];
    __syncthreads();
    if (parts & 1)
    {
        const int g = lane >> 5, c32 = lane & 31;
        bf16x8 Af[4][4];
#pragma unroll
        for (int rb = 0; rb < 4; ++rb) { const int R = rb * 32 + c32; const bf16_t* qp = QI + (size_t)(row0 + (R >> 3)) * 512 + (R & 7) * 64 + g * 8;
#pragma unroll
            for (int s = 0; s < 4; ++s) Af[rb][s] = *(const bf16x8*)(qp + s * 16); }
        bf16x8 Bn[4];
        { const bf16_t* kp0 = KI + (size_t)(b * 2048 + wave * 32 + c32) * 64 + g * 8;
#pragma unroll
            for (int s = 0; s < 4; ++s) Bn[s] = *(const bf16x8*)(kp0 + s * 16); }
#pragma unroll 1
        for (int kt = wave; kt < nkt; kt += 8) {
            bf16x8 Bf[4];
#pragma unroll
            for (int s = 0; s < 4; ++s) Bf[s] = Bn[s];
            if (kt + 8 < nkt) { const bf16_t* kp = KI + (size_t)(b * 2048 + (kt + 8) * 32 + c32) * 64 + g * 8;
#pragma unroll
                for (int s = 0; s < 4; ++s) Bn[s] = *(const bf16x8*)(kp + s * 16); }
#pragma unroll
            for (int rb = 0; rb < 4; ++rb) {
                f32x16 acc;
#pragma unroll
                for (int i = 0; i < 16; ++i) acc[i] = 0.f;
#pragma unroll
                for (int s = 0; s < 4; ++s) acc = __builtin_amdgcn_mfma_f32_32x32x16_bf16(Af[rb][s], Bf[s], acc, 0, 0, 0);
#pragma unroll
                for (int j = 0; j < 4; ++j) { const int q = rb * 4 + j; const f32x4 w4 = *(const f32x4*)(wis + q * 8 + 4 * g);
                    float sp = fmaxf(acc[4 * j], 0.f) * w4[0] + fmaxf(acc[4 * j + 1], 0.f) * w4[1] + fmaxf(acc[4 * j + 2], 0.f) * w4[2] + fmaxf(acc[4 * j + 3], 0.f) * w4[3];
                    sp += __shfl_xor(sp, 32);
                    if (g == 0) sc[q * 2048 + kt * 32 + c32] = sp; }
            }
        }
    }
    __syncthreads();
    lane = fresh_tid(WV) & 63;
    for (int qq = 0; qq < 2; ++qq) {
        const int q = wave * 2 + qq; unsigned short* sq = sel + q * 256;
        if (limit <= 256 || !(parts & 2)) { for (int j = lane; j < nsel; j += 64) sq[j] = (unsigned short)j; }
        else if (limit <= 512) select256<8>(sc + q * 2048, limit, sq, lane);
        else if (limit <= 1024) select256<16>(sc + q * 2048, limit, sq, lane);
        else if (limit <= 1536) select256<24>(sc + q * 2048, limit, sq, lane);
        else select256<32>(sc + q * 2048, limit, sq, lane);
    }
    __syncthreads();
    lane = fresh_tid(WV) & 63;
    float* Pw = (float*)lds + wave * 2048;
    const int g4 = lane >> 4, hh = lane & 15;
#pragma unroll 1
    for (int qq = 0; qq < 2; ++qq) {
        const int q = wave * 2 + qq; const size_t row = (size_t)(row0 + q); const unsigned short* sq = sel + q * 256;
        bf16x8 Qf[4];
#pragma unroll
        for (int s = 0; s < 4; ++s) Qf[s] = *(const bf16x8*)(ocat + row * 2048 + (hh & 7) * 128 + g4 * 8 + s * 32);
        float lg[16][4];
#pragma unroll
        for (int kg = 0; kg < 4; ++kg) {
            if (kg * 64 < nsel) {
                bf16x8 kf[4][4];
#pragma unroll
                for (int k4 = 0; k4 < 4; ++k4) { const int idx = sq[(kg * 4 + k4) * 16 + hh]; const bf16_t* kp = Kn + (size_t)(b * 2048 + idx) * 128 + g4 * 8;
#pragma unroll
                    for (int s = 0; s < 4; ++s) kf[k4][s] = *(const bf16x8*)(kp + s * 32); }
#pragma unroll
                for (int k4 = 0; k4 < 4; ++k4) { f32x4 c = {0.f, 0.f, 0.f, 0.f};
#pragma unroll
                    for (int s = 0; s < 4; ++s) c = __builtin_amdgcn_mfma_f32_16x16x32_bf16(kf[k4][s], Qf[s], c, 0, 0, 0);
#pragma unroll
                    for (int r = 0; r < 4; ++r) lg[kg * 4 + k4][r] = c[r] * 0.08838834764831845f; }
            } else {
#pragma unroll
                for (int k4 = 0; k4 < 4; ++k4)
#pragma unroll
                    for (int r = 0; r < 4; ++r) lg[kg * 4 + k4][r] = -1e30f;
            }
        }
        float mx = -1e30f;
#pragma unroll
        for (int kb = 0; kb < 16; ++kb)
#pragma unroll
            for (int r = 0; r < 4; ++r) mx = fmaxf(mx, lg[kb][r]);
        mx = fmaxf(mx, __shfl_xor(mx, 16)); mx = fmaxf(mx, __shfl_xor(mx, 32));
        float sum = 0.f;
#pragma unroll
        for (int kb = 0; kb < 16; ++kb)
#pragma unroll
            for (int r = 0; r < 4; ++r) { const float e = (kb * 16 < nsel) ? __expf(lg[kb][r] - mx) : 0.f; lg[kb][r] = e; sum += e; }
        sum += __shfl_xor(sum, 16); sum += __shfl_xor(sum, 32);
        const float inv = 1.f / sum;
        bf16x8 Pa[8];
#pragma unroll
        for (int ks = 0; ks < 8; ++ks) {
            const unsigned a0 = pk2(lg[2 * ks][0] * inv, lg[2 * ks][1] * inv), a1 = pk2(lg[2 * ks][2] * inv, lg[2 * ks][3] * inv);
            const unsigned a2 = pk2(lg[2 * ks + 1][0] * inv, lg[2 * ks + 1][1] * inv), a3 = pk2(lg[2 * ks + 1][2] * inv, lg[2 * ks + 1][3] * inv);
            const u32x4 t_ = {a0, a1, a2, a3}; Pa[ks] = __builtin_bit_cast(bf16x8, t_); }
        bf16_t* Vs = (bf16_t*)(lds + wave * 10752);
        bf16_t* Os = Vs + 32 * 136;
        f32x4 oacc[8];
#pragma unroll
        for (int nb = 0; nb < 8; ++nb) oacc[nb] = (f32x4){0.f, 0.f, 0.f, 0.f};
        const bf16_t* Vb = V + (size_t)b * 2048 * 128 + hh * 8;
        u32x4 vq[8], vn[8];
#pragma unroll
        for (int jj = 0; jj < 8; ++jj) vn[jj] = (u32x4){0u, 0u, 0u, 0u};
#pragma unroll
        for (int jj = 0; jj < 8; ++jj) { const int idx = sq[jj * 4 + g4]; vq[jj] = *(const u32x4*)(Vb + (size_t)idx * 128); }
#define PV_BATCH(bt) do { if ((bt) * 32 < nsel) { \
            if (((bt) + 1) * 32 < nsel) { _Pragma("unroll") for (int jj = 0; jj < 8; ++jj) { const int idx = sq[((bt) + 1) * 32 + jj * 4 + g4]; vn[jj] = *(const u32x4*)(Vb + (size_t)idx * 128); } } \
            _Pragma("unroll") for (int jj = 0; jj < 8; ++jj) *(u32x4*)(Vs + (jj * 4 + g4) * 136 + hh * 8) = vq[jj]; \
            LDS_FENCE(); \
            _Pragma("unroll") for (int nb = 0; nb < 8; ++nb) { const bf16_t* vp = Vs + (4 * g4) * 136 + nb * 16 + hh; \
                const unsigned w0_ = (unsigned)vp[0 * 136] | ((unsigned)vp[1 * 136] << 16), w1_ = (unsigned)vp[2 * 136] | ((unsigned)vp[3 * 136] << 16); \
                const unsigned w2_ = (unsigned)vp[16 * 136] | ((unsigned)vp[17 * 136] << 16), w3_ = (unsigned)vp[18 * 136] | ((unsigned)vp[19 * 136] << 16); \
                const u32x4 t_ = {w0_, w1_, w2_, w3_}; \
                oacc[nb] = __builtin_amdgcn_mfma_f32_16x16x32_bf16(Pa[(bt)], __builtin_bit_cast(bf16x8, t_), oacc[nb], 0, 0, 0); } \
            LDS_FENCE(); \
            _Pragma("unroll") for (int jj = 0; jj < 8; ++jj) vq[jj] = vn[jj]; } } while (0)
        PV_BATCH(0); PV_BATCH(1); PV_BATCH(2); PV_BATCH(3); PV_BATCH(4); PV_BATCH(5); PV_BATCH(6); PV_BATCH(7);
#undef PV_BATCH
        if (g4 < 2) {
#pragma unroll
            for (int nb = 0; nb < 8; ++nb)
#pragma unroll
                for (int r = 0; r < 4; ++r) Os[(g4 * 4 + r) * 128 + nb * 16 + hh] = (bf16_t)f2bf(oacc[nb][r]);
        }
        LDS_FENCE();
#pragma unroll
        for (int h = 0; h < 2; ++h) { const uint4 ov = *(const uint4*)(Os + h * 512 + lane * 8); *(uint4*)(obase + row * ostride + h * 512 + lane * 8) = ov; }
        LDS_FENCE();
    }
}

__device__ __forceinline__ void phase_fix(const Args& a, int l, const int WV) {
    const int TI = fresh_tid(WV);
    const float* SA = (const float*)(a.ws + WS_SA); const float* SB = (const float*)(a.ws + WS_SB); bf16_t* act = (bf16_t*)(a.ws + WS_R2);
    const float* cw = a.in[I_CONVW] + (size_t)l * 3 * DFF; const float* cb = a.in[I_CONVB] + (size_t)l * DFF;
    const int total = 512 * 2 * DFF;
    for (int i = blockIdx.x * 512 + TI; i < total; i += gridDim.x * 512) {
        const int ch = i % DFF, rb = i / DFF, rr = rb & 1, blk = rb >> 1, r = blk * 64 + rr, t = r & 2047;
        const float a0 = SA[((size_t)blk * 4 + 2 + rr) * DFF + ch];
        float am1, am2;
        if (rr == 0) { am1 = (t >= 1) ? SA[((size_t)(blk - 1) * 4 + 1) * DFF + ch] : 0.f; am2 = (t >= 2) ? SA[((size_t)(blk - 1) * 4 + 0) * DFF + ch] : 0.f; }
        else { am1 = SA[((size_t)blk * 4 + 2) * DFF + ch]; am2 = (t >= 2) ? SA[((size_t)(blk - 1) * 4 + 1) * DFF + ch] : 0.f; }
        const float cv = cb[ch] + cw[ch] * am2 + cw[DFF + ch] * am1 + cw[2 * DFF + ch] * a0;
        act[(size_t)r * DFF + ch] = (bf16_t)f2bf(siluf_(cv) * SB[((size_t)blk * 2 + rr) * DFF + ch]);
    }
}

__device__ __forceinline__ void run_phase(const Args& a, int ph, unsigned char* lds, const int WV, const bool dummy) {
    unsigned char* ws = a.ws;
    LAS unsigned char* ldsl = (LAS unsigned char*)lds;
    const int G = gridDim.x, bx = blockIdx.x;
#ifndef DBG_NOADA
    if (ph == 0) { phase_ada(a, lds, WV); return; }
#else
    if (ph == 0) return;
#endif
    const int l = (ph - 1) / 10, sp = (ph - 1) % 10;
    const float* modl = (const float*)(ws + WS_MOD) + (size_t)l * 16 * 12288;
    const float* xin = (l == 0) ? a.in[I_X] : a.out;
#ifdef DBG_SP
    if (sp != DBG_SP) return;
#endif
    switch (sp) {
    case 0: phase_cvt(a, l, lds, WV); phase_norm(xin, a.in[I_GN1] + l * DM, modl, 0, 2048, (bf16_t*)(ws + WS_R1), WV); break;
    case 1: {
        pg8::Gemm g{(const bf16_t*)(ws + WS_R1), (const bf16_t*)(ws + W_1CAT), MROWS, N1, DM, DM, DM, 1 << 30, 0}; pg8::StaticOrder S; S.init(MROWS, N1, G, bx);
        Epi1 E{(bf16_t*)(ws + WS_OCAT), (bf16_t*)(ws + WS_KN), (bf16_t*)(ws + WS_V), (bf16_t*)(ws + WS_QI), (bf16_t*)(ws + WS_KI), (bf16_t*)(ws + WS_U), (bf16_t*)(ws + WS_P), (bf16_t*)(ws + WS_R2),
               (float*)(ws + WS_WI), a.in[I_BGATE] + (size_t)l * 3 * DM, ldsl + 131072};
        pg8::gemm_phase<Epi1, pg8::StaticOrder>(ldsl, g, S, E, WV); } break;
    case 2:
        if (!dummy) phase_post(a, l, lds, WV);
        __syncthreads();
        for (int u = bx; u < 512; u += G) s5_unit(a, l, u >> 5, u & 31, lds, WV);
        for (int u = bx; u < 512; u += G) pool_unit(a, u >> 5, u & 31, lds, WV);
        break;
    case 3: {
#ifndef DBG_NO_DSA
#ifdef DSA_PROBE
        for (int rep = 0; rep < 2; ++rep) { const bool dm = (rep == 0); const int parts = dm ? (DSA_PROBE) : 15;
#else
        { const bool dm = dummy; const int parts = 15;
#endif
            for (int u = bx; u < 2048; u += G) { const int w = u & 255, i = u >> 8, b = w & 15, s = w >> 4; const int tq = (i & 1) ? (i * 16 + 15 - s) : (i * 16 + s);
                dsa_unit(a, b, tq, lds, WV, dm ? (bf16_t*)(ws + WS_R1 + 64 * MiB) : (bf16_t*)(ws + WS_OCAT), dm ? 1024 : 2048, parts); }
        }
        __syncthreads();
#endif
#ifndef DBG_DSA_ONLY
        { pg8::Gemm g{(const bf16_t*)(ws + WS_Y), (const bf16_t*)(ws + W_GLU), MROWS, 1024, 512, 512, 512, 2, WS_POOLED - WS_Y}; pg8::StaticOrder S; S.init(MROWS, 1024, G, bx);
          EpiGluPool E{(const bf16_t*)(ws + WS_Y), a.in[I_PSCALE] + l * 512, (bf16_t*)(ws + WS_OCAT)}; pg8::gemm_phase<EpiGluPool, pg8::StaticOrder>(ldsl, g, S, E, WV); }
#endif
        } break;
    case 4: {
        pg8::Gemm g{(const bf16_t*)(ws + WS_OCAT), (const bf16_t*)(ws + W_P), MROWS, DM, DM, DM, DM, 1 << 30, 0}; pg8::StaticOrder S; S.init(MROWS, DM, G, bx);
        EpiMerge E{(const bf16_t*)(ws + WS_R2), (bf16_t*)(ws + WS_R1), ldsl + 131072}; pg8::gemm_phase<EpiMerge, pg8::StaticOrder>(ldsl, g, S, E, WV); } break;
    case 5: {
        pg8::Gemm g{(const bf16_t*)(ws + WS_R1), (const bf16_t*)(ws + W_OUT), MROWS, DM, DM, DM, DM, 1 << 30, 0}; pg8::StaticOrder S; S.init(MROWS, DM, G, bx);
        EpiRes E{xin, dummy ? (float*)(ws + WS_OCAT) : a.out, modl + 4096}; pg8::gemm_phase<EpiRes, pg8::StaticOrder>(ldsl, g, S, E, WV); } break;
    case 6: phase_norm(a.out, a.in[I_GN2] + l * DM, modl, 6144, 8192, (bf16_t*)(ws + WS_R1), WV); break;
    case 7: {
        pg8::Gemm g{(const bf16_t*)(ws + WS_R1), (const bf16_t*)(ws + W_UP), MROWS, 2 * DFF, DM, DM, DM, 1 << 30, 0}; pg8::StaticOrder S; S.init(MROWS, 2 * DFF, G, bx);
        EpiUp E{(bf16_t*)(ws + WS_R2), (float*)(ws + WS_SA), (float*)(ws + WS_SB), a.in[I_CONVW] + (size_t)l * 3 * DFF, a.in[I_CONVB] + (size_t)l * DFF, ldsl + 131072};
        pg8::gemm_phase<EpiUp, pg8::StaticOrder>(ldsl, g, S, E, WV); } break;
    case 8: phase_fix(a, l, WV); break;
    case 9: {
        pg8::Gemm g{(const bf16_t*)(ws + WS_R2), (const bf16_t*)(ws + W_DOWN), MROWS, DM, DFF, DFF, DFF, 1 << 30, 0}; pg8::StaticOrder S; S.init(MROWS, DM, G, bx);
        EpiRes E{a.out, dummy ? (float*)(ws + WS_OCAT) : a.out, modl + 10240}; pg8::gemm_phase<EpiRes, pg8::StaticOrder>(ldsl, g, S, E, WV); } break;
    }
}

#define XB_XCNT(j)  (256  + 64 * (j))
#define XB_XSUB(j)  (1280 + 64 * (j))
#define XB_XGEN(j)  (2304 + 64 * (j))
#define XB_TOP      3328
#define XB_TOPGEN   3392
#define XB_WORDS    3456
__device__ __forceinline__ unsigned xb_ld(unsigned* p)              { return __hip_atomic_load(p, __ATOMIC_RELAXED, __HIP_MEMORY_SCOPE_AGENT); }
__device__ __forceinline__ unsigned xb_add(unsigned* p, unsigned v) { return __hip_atomic_fetch_add(p, v, __ATOMIC_RELAXED, __HIP_MEMORY_SCOPE_AGENT); }
__device__ __forceinline__ unsigned xb_xcc_id() { return (unsigned)__builtin_amdgcn_s_getreg((3 << 11) | 20) & 0xFu; }
#define XB_SPIN(cond) do { unsigned _sp = 0; while (cond) { __builtin_amdgcn_s_sleep(1); if (++_sp > (1u << 22)) break; } } while (0)
__device__ __forceinline__ void grid_bar(unsigned* bar, volatile LAS unsigned* st, int wave_id) {
    asm volatile("s_waitcnt vmcnt(0) lgkmcnt(0)" ::: "memory");
    __syncthreads();
    if (wave_id == 0) {
        const int l = (int)__builtin_amdgcn_mbcnt_hi(~0u, __builtin_amdgcn_mbcnt_lo(~0u, 0u));
        if (l == 0) {
            const unsigned x = xb_xcc_id();
            unsigned nloc = st[0], nx = st[1];
            if (nloc == 0u) {
                const unsigned G = gridDim.x; unsigned sum, cnt, mine, sp = 0u;
                for (;;) { sum = 0u; cnt = 0u; mine = 0u;
#pragma unroll
                    for (unsigned j = 0; j < 16; ++j) { const unsigned c = xb_ld(&bar[XB_XCNT(j)]); sum += c; cnt += (c > 0u) ? 1u : 0u; mine = (j == x) ? c : mine; }
                    if (sum == G) break;
                    __builtin_amdgcn_s_sleep(1); if (++sp > (1u << 22)) break; }
                nloc = mine > 0u ? mine : 1u; nx = cnt > 0u ? cnt : 1u; st[0] = nloc; st[1] = nx;
            }
            const unsigned old = xb_add(&bar[XB_XSUB(x)], 1u);
            const unsigned gen = old / nloc;
            if (old + 1u == (gen + 1u) * nloc) {
                __builtin_amdgcn_fence(__ATOMIC_RELEASE, "agent");
                asm volatile("s_waitcnt vmcnt(0)" ::: "memory");
                const unsigned og = xb_add(&bar[XB_TOP], 1u);
                const unsigned tg = og / nx;
                if (og + 1u == (tg + 1u) * nx) xb_add(&bar[XB_TOPGEN], 1u);
                else XB_SPIN(xb_ld(&bar[XB_TOPGEN]) == tg);
                __builtin_amdgcn_fence(__ATOMIC_ACQUIRE, "agent");
                xb_add(&bar[XB_XGEN(x)], 1u);
                asm volatile("s_waitcnt vmcnt(0)" ::: "memory");
            } else {
                XB_SPIN(xb_ld(&bar[XB_XGEN(x)]) == gen);
                __builtin_amdgcn_fence(__ATOMIC_ACQUIRE, "agent");
                asm volatile("s_waitcnt vmcnt(0)" ::: "memory");
            }
        }
    }
    __syncthreads();
}

__global__ void __launch_bounds__(512, 2) mega_fwd(Args a) {
    extern __shared__ __attribute__((aligned(16))) unsigned char lds[];
    cg::grid_group grid = cg::this_grid();
    const int wave_id = __builtin_amdgcn_readfirstlane((int)(threadIdx.x >> 6));
    const int ph_lo = a.ph_lo, ph_hi = a.ph_hi;
    volatile LAS unsigned* xst = (volatile LAS unsigned*)((LAS unsigned char*)lds + 163776);
    if (threadIdx.x == 0) { xst[0] = 0u; xst[1] = 0u; (void)xb_add((unsigned*)(__attribute__((address_space(1))) unsigned*)a.ws + XB_XCNT(xb_xcc_id()), 1u); }
    __syncthreads();
    for (int ph = ph_lo; ph < ph_hi; ++ph) {
        const __attribute__((address_space(4))) Args* kp = (const __attribute__((address_space(4))) Args*)__builtin_amdgcn_kernarg_segment_ptr();
        asm volatile("" : "+s"(kp));
        Args la;
#pragma unroll
        for (int i = 0; i < 31; ++i) la.in[i] = (const float*)(const __attribute__((address_space(1))) float*)kp->in[i];
        la.ws = (unsigned char*)(__attribute__((address_space(1))) unsigned char*)kp->ws;
        la.out = (float*)(__attribute__((address_space(1))) float*)kp->out;
        la.ph_lo = ph_lo; la.ph_hi = ph_hi;
#ifdef REP_MASK
        if (ph > 0 && ((REP_MASK >> ((ph - 1) % 10)) & 1)) { run_phase(la, ph, lds, wave_id, true); grid.sync(); }
#endif
        run_phase(la, ph, lds, wave_id, false);
        if (ph + 1 < ph_hi) {
            if (ph_hi < 0) grid.sync();
            else grid_bar((unsigned*)la.ws, xst, wave_id);
        }
    }
}

extern "C" void kernel_launch(void* const* d_in, const int* in_sizes, int n_in, void* d_out, int out_size, void* d_ws, size_t ws_size, hipStream_t stream) {
    static int grid = 0;
    if (grid == 0) {
        int dev = 0, cus = 0, per_cu = 0;
        if (n_in != 31 || ws_size < WS_END) { fprintf(stderr, "kernel_launch: unexpected n_in %d / ws %zu\n", n_in, ws_size); grid = -1; return; }
        hipGetDevice(&dev); hipDeviceGetAttribute(&cus, hipDeviceAttributeMultiprocessorCount, dev);
        if (hipFuncSetAttribute((const void*)mega_fwd, hipFuncAttributeMaxDynamicSharedMemorySize, LDS_BYTES) != hipSuccess) { fprintf(stderr, "kernel_launch: hipFuncSetAttribute failed\n"); grid = -1; return; }
        if (hipOccupancyMaxActiveBlocksPerMultiprocessor(&per_cu, (const void*)mega_fwd, 512, LDS_BYTES) != hipSuccess || per_cu < 1) { fprintf(stderr, "kernel_launch: occupancy query says %d blocks/CU\n", per_cu); per_cu = 1; }
        (void)hipGetLastError();
        grid = cus > 0 ? cus : 256;
    }
    if (grid < 0) return;
    if (hipMemsetAsync(d_ws, 0, 16384, stream) != hipSuccess) { fprintf(stderr, "kernel_launch: memset of the barrier word failed\n"); return; }
    Args a{};
    for (int i = 0; i < 31; ++i) a.in[i] = (const float*)d_in[i];
    a.out = (float*)d_out; a.ws = (unsigned char*)d_ws;
#if MK_PER_PHASE
    for (int ph = 0; ph < NPHASE; ++ph) {
        a.ph_lo = ph; a.ph_hi = ph + 1;
        void* args[] = {&a};
        hipError_t e = hipLaunchCooperativeKernel((const void*)mega_fwd, dim3(grid), dim3(512), args, LDS_BYTES, stream);
        if (e != hipSuccess) { fprintf(stderr, "kernel_launch: launch of phase %d failed: %s\n", ph, hipGetErrorString(e)); break; }
    }
#else
    a.ph_lo = 0; a.ph_hi = NPHASE;
    void* args[] = {&a};
    hipError_t e = hipLaunchCooperativeKernel((const void*)mega_fwd, dim3(grid), dim3(512), args, LDS_BYTES, stream);
    if (e != hipSuccess) fprintf(stderr, "kernel_launch: cooperative launch failed: %s (grid %d)\n", hipGetErrorString(e), grid);
#endif
}
```

```cpp
#include <hip/hip_runtime.h>
#include <hip/hip_cooperative_groups.h>
#include <cstdio>
#include <cstdint>
namespace cg = cooperative_groups;

#ifndef MK_PER_PHASE
#define MK_PER_PHASE 0
#endif

typedef unsigned short bf16_t;
typedef short bf16x8 __attribute__((ext_vector_type(8)));
typedef float f32x4 __attribute__((ext_vector_type(4)));
typedef float f32x2 __attribute__((ext_vector_type(2)));
typedef float f32x16 __attribute__((ext_vector_type(16)));
typedef unsigned u32x4 __attribute__((ext_vector_type(4)));
typedef unsigned u32x2 __attribute__((ext_vector_type(2)));
#define LAS __attribute__((address_space(3)))

constexpr int BATCH = 16, SEQ = 2048, DM = 2048, MROWS = BATCH * SEQ, DIN = 2888, DFF = 5504;
constexpr int N1 = 9216;
constexpr float EPS = 1e-6f;
constexpr int NPHASE = 21;

constexpr size_t MiB = 1u << 20;
constexpr size_t WS_MOD = 1 * MiB;
constexpr size_t WS_WI = 3 * MiB;
constexpr size_t WS_W = 4 * MiB;
constexpr size_t W_1CAT = WS_W, W_P = WS_W + 36 * MiB, W_OUT = WS_W + 44 * MiB, W_UP = WS_W + 52 * MiB, W_DOWN = WS_W + 95 * MiB,
                 W_GLU = WS_W + 116 * MiB + MiB / 2, W_POOL = WS_W + 117 * MiB;
constexpr size_t WS_R1 = 122 * MiB;
constexpr size_t WS_Y = WS_R1, WS_POOLED = WS_R1 + 32 * MiB;
constexpr size_t WS_R2 = 250 * MiB;
constexpr size_t WS_OCAT = 634 * MiB;
constexpr size_t WS_SA = WS_OCAT, WS_SB = WS_OCAT + 44 * MiB;
constexpr size_t WS_KN = 762 * MiB, WS_V = 770 * MiB, WS_QI = 778 * MiB, WS_KI = 810 * MiB, WS_U = 814 * MiB, WS_P = 846 * MiB, WS_END = 878 * MiB;
constexpr int LDS_BYTES = 163840;

__device__ __forceinline__ unsigned f2bf(float f) { unsigned u = __float_as_uint(f); return (u + 0x7fffu + ((u >> 16) & 1u)) >> 16; }
__device__ __forceinline__ unsigned pk2(float lo, float hi) { unsigned r; asm("v_cvt_pk_bf16_f32 %0, %1, %2" : "=v"(r) : "v"(lo), "v"(hi)); return r; }
__device__ __forceinline__ float bflo(unsigned u) { return __uint_as_float(u << 16); }
__device__ __forceinline__ float bfhi(unsigned u) { return __uint_as_float(u & 0xffff0000u); }
__device__ __forceinline__ float bf1(bf16_t b) { return __uint_as_float(((unsigned)b) << 16); }
__device__ __forceinline__ float sigmoidf_(float x) { return __builtin_amdgcn_rcpf(1.f + __expf(-x)); }
__device__ __forceinline__ float siluf_(float x) { return x * __builtin_amdgcn_rcpf(1.f + __expf(-x)); }
__device__ __forceinline__ float dpp_ror1(float v) { return __builtin_bit_cast(float, __builtin_amdgcn_update_dpp(0, __builtin_bit_cast(int, v), 0x121, 0xf, 0xf, false)); }
__device__ __forceinline__ float dpp_ror2(float v) { return __builtin_bit_cast(float, __builtin_amdgcn_update_dpp(0, __builtin_bit_cast(int, v), 0x122, 0xf, 0xf, false)); }
__device__ __forceinline__ float gelu_tanh(float x) { const float z = 0.7978845608028654f * (x + 0.044715f * x * x * x); const float t = 1.f - 2.f * __builtin_amdgcn_rcpf(1.f + __expf(2.f * z)); return 0.5f * x * (1.f + t); }
__device__ __forceinline__ uint4 pack8(f32x4 a, f32x4 b) { uint4 r; r.x = pk2(a[0], a[1]); r.y = pk2(a[2], a[3]); r.z = pk2(b[0], b[1]); r.w = pk2(b[2], b[3]); return r; }
__device__ __forceinline__ void unpack8(uint4 v, float* f) { f[0] = bflo(v.x); f[1] = bfhi(v.x); f[2] = bflo(v.y); f[3] = bfhi(v.y); f[4] = bflo(v.z); f[5] = bfhi(v.z); f[6] = bflo(v.w); f[7] = bfhi(v.w); }
#define LDS_FENCE() asm volatile("s_waitcnt lgkmcnt(0)" ::: "memory")
__device__ __forceinline__ int fresh_tid(int wv) { int l = (int)__builtin_amdgcn_mbcnt_hi(~0u, __builtin_amdgcn_mbcnt_lo(~0u, 0u)); asm volatile("" : "+v"(l)); return (wv << 6) | l; }

namespace pg8 {
constexpr int BM = 256, BK = 64, HALF = 128, HTB = HALF * BK * 2, STAGE_BYTES = 8 * HTB, NXCD = 8, WGM = 4;
__host__ __device__ __forceinline__ int lds_byte(int r, int c) { const int st = (r >> 4) * 2 + (c >> 5), rr = r & 15, cc = c & 31, ob = rr * 64 + cc * 2; return st * 1024 + (ob ^ (((ob >> 9) & 1) << 5)); }
__host__ __device__ __forceinline__ void stage_rc(int b, int& R, int& C) { const int st = b / 1024, sb = b % 1024, swz = sb ^ (((sb >> 9) & 1) << 5); R = (st >> 1) * 16 + swz / 64; C = (st & 1) * 32 + (swz % 64) / 2; }
__host__ __device__ __forceinline__ int perm32(int rho) { const int n = rho >> 4, i = rho & 15; return 8 * (i >> 2) + 4 * n + (i & 3); }
struct Unit { int pm, pn; };
struct Gemm { const bf16_t* A; const bf16_t* Bt; int M, N, K, lda, ldb; int asplit; size_t aoff; };
struct StaticOrder {
    int nM, nN, nwg, G, c;
    __device__ void init(int M, int N, int G_, int c_) { nM = M / BM; nN = N / BM; nwg = nM * nN; G = G_; c = c_; }
    __device__ bool next(int i, Unit& u) const {
        const long L = (long)i * G + c; if (L >= nwg) return false;
        int wgid = (int)L; { const int q = nwg / NXCD, r = nwg % NXCD, xcd = wgid % NXCD, off = wgid / NXCD; wgid = (xcd < r ? xcd * (q + 1) : r * (q + 1) + (xcd - r) * q) + off; }
        const int nig = WGM * nN, gid = wgid / nig, fm = gid * WGM, gsz = (nM - fm) < WGM ? (nM - fm) : WGM;
        u.pm = fm + ((wgid % nig) % gsz); u.pn = (wgid % nig) / gsz; return true;
    }
};
template <class Epi, class Sched>
__device__ __forceinline__ void gemm_phase(LAS unsigned char* lds, const Gemm g, const Sched& S, const Epi& E, const int WV) {
    const int TI = fresh_tid(WV);
    const int tid = TI, wid = __builtin_amdgcn_readfirstlane(tid >> 6), lane = tid & 63, wr = wid >> 2, wc = wid & 3, fr = lane & 15, fq = lane >> 4;
    const int K = g.K, nt = K / BK;
    unsigned voffA[2], voffB[2];
#pragma unroll
    for (int i = 0; i < 2; ++i) { int R, C; stage_rc(tid * 16 + i * 8192, R, C); const int Rb = Epi::PERM ? ((R & ~31) + perm32(R & 31)) : R;
        voffA[i] = (unsigned)(R * g.lda + C) * 2u; voffB[i] = (unsigned)(Rb * g.ldb + C) * 2u; }
    const size_t kstep = (size_t)(BK * 2);
    const size_t hstepA = (size_t)HALF * g.lda * 2, hstepB = (size_t)HALF * g.ldb * 2;
    const size_t tstepA = 2 * hstepA, tstepB = 2 * hstepB;
    const unsigned ldsw = (unsigned)wid * 1024u;
    const int aoff = lds_byte(wr * 64 + fr, fq * 8), boff = lds_byte(wc * 32 + fr, fq * 8);
#define PG8_SA(b, h) (((b) * 2 + (h)) * HTB)
#define PG8_SB(b, h) ((4 + (b) * 2 + (h)) * HTB)
#define PG8_STAGE(bufoff, gbase, voff) do { _Pragma("unroll") for (int _i = 0; _i < 2; ++_i) \
        __builtin_amdgcn_global_load_lds((const unsigned*)((const char*)(gbase) + (voff)[_i]), (LAS unsigned*)(lds + (bufoff) + ldsw + _i * 8192), 16, 0, 0); } while (0)
#define PG8_LDA(dst, b, h) do { _Pragma("unroll") for (int m = 0; m < 4; ++m) _Pragma("unroll") for (int k = 0; k < 2; ++k) dst[m][k] = *(const LAS bf16x8*)(lds + PG8_SA(b, h) + aoff + m * 2048 + k * 1024); } while (0)
#define PG8_LDB(dst, b, h) do { _Pragma("unroll") for (int n = 0; n < 2; ++n) _Pragma("unroll") for (int k = 0; k < 2; ++k) dst[n][k] = *(const LAS bf16x8*)(lds + PG8_SB(b, h) + boff + n * 2048 + k * 1024); } while (0)
#define PG8_MMA(ai, bj, At, Bt) do { __builtin_amdgcn_s_setprio(1); _Pragma("unroll") for (int m = 0; m < 4; ++m) _Pragma("unroll") for (int n = 0; n < 2; ++n) _Pragma("unroll") for (int k = 0; k < 2; ++k) \
        acc[ai][bj][m][n] = __builtin_amdgcn_mfma_f32_16x16x32_bf16(Bt[n][k], At[m][k], acc[ai][bj][m][n], 0, 0, 0); __builtin_amdgcn_s_setprio(0); } while (0)
#define PG8_WAIT_V(n) asm volatile("s_waitcnt vmcnt(" #n ")" ::: "memory")
#define PG8_WAIT_L(n) asm volatile("s_waitcnt lgkmcnt(" #n ")" ::: "memory")
#define PG8_BAR __builtin_amdgcn_s_barrier()
#define PG8_SCHED __builtin_amdgcn_sched_barrier(0)
#define PG8_ZERO() do { _Pragma("unroll") for (int a_ = 0; a_ < 2; ++a_) _Pragma("unroll") for (int b_ = 0; b_ < 2; ++b_) _Pragma("unroll") for (int m_ = 0; m_ < 4; ++m_) _Pragma("unroll") for (int n_ = 0; n_ < 2; ++n_) acc[a_][b_][m_][n_] = (f32x4){0.f, 0.f, 0.f, 0.f}; } while (0)
    Unit cur, nxt; int ui = 0;
    if (!S.next(0, cur)) return;
    f32x4 acc[2][2][4][2];
    PG8_ZERO();
    bf16x8 At[4][2], B0[2][2], B1[2][2];
    const char* cA = (const char*)g.A + (size_t)cur.pm * tstepA + (cur.pn >= g.asplit ? g.aoff : (size_t)0); const char* cB = (const char*)g.Bt + (size_t)cur.pn * tstepB;
    PG8_STAGE(PG8_SB(0, 0), cB, voffB); PG8_STAGE(PG8_SB(0, 1), cB + hstepB, voffB); PG8_STAGE(PG8_SA(0, 0), cA, voffA); PG8_STAGE(PG8_SA(0, 1), cA + hstepA, voffA);
    if (wr == 1) PG8_BAR;
    PG8_WAIT_V(2); PG8_BAR;
    PG8_STAGE(PG8_SB(1, 0), cB + kstep, voffB); PG8_STAGE(PG8_SA(1, 0), cA + kstep, voffA); PG8_STAGE(PG8_SB(1, 1), cB + hstepB + kstep, voffB);
    PG8_WAIT_V(6); PG8_BAR;
    for (;;) {
        const bool has_next = S.next(ui + 1, nxt);
        const char* nA = has_next ? (const char*)g.A + (size_t)nxt.pm * tstepA + (nxt.pn >= g.asplit ? g.aoff : (size_t)0) : cA; const char* nB = has_next ? (const char*)g.Bt + (size_t)nxt.pn * tstepB : cB;
        for (int t = 0; t < nt; t += 2) {
            const bool last = (t == nt - 2);
            const char* a1 = cA + (size_t)(t + 1) * kstep;
            const char* a2 = last ? nA : cA + (size_t)(t + 2) * kstep; const char* b2 = last ? nB : cB + (size_t)(t + 2) * kstep;
            const char* a3 = a2 + kstep; const char* b3 = b2 + kstep;
            PG8_LDB(B0, 0, 0); PG8_LDB(B1, 0, 1); PG8_SCHED; PG8_LDA(At, 0, 0); PG8_STAGE(PG8_SA(1, 1), a1 + hstepA, voffA);
            PG8_WAIT_V(8); PG8_WAIT_L(0); PG8_BAR; PG8_MMA(0, 0, At, B0); PG8_MMA(0, 1, At, B1); PG8_BAR; PG8_SCHED;
            PG8_LDA(At, 0, 1); PG8_STAGE(PG8_SB(0, 0), b2, voffB); PG8_STAGE(PG8_SB(0, 1), b2 + hstepB, voffB); PG8_STAGE(PG8_SA(0, 0), a2, voffA);
            PG8_WAIT_V(8); PG8_WAIT_L(0); PG8_BAR; PG8_MMA(1, 0, At, B0); PG8_MMA(1, 1, At, B1); PG8_BAR; PG8_SCHED;
            PG8_LDB(B0, 1, 0); PG8_LDB(B1, 1, 1); PG8_SCHED; PG8_LDA(At, 1, 0); PG8_STAGE(PG8_SA(0, 1), a2 + hstepA, voffA);
            PG8_WAIT_V(8); PG8_WAIT_L(0); PG8_BAR; PG8_MMA(0, 0, At, B0); PG8_MMA(0, 1, At, B1); PG8_BAR; PG8_SCHED;
            PG8_LDA(At, 1, 1); PG8_STAGE(PG8_SB(1, 0), b3, voffB); PG8_STAGE(PG8_SB(1, 1), b3 + hstepB, voffB); PG8_STAGE(PG8_SA(1, 0), a3, voffA);
            PG8_WAIT_V(8); PG8_WAIT_L(0); PG8_BAR; PG8_MMA(1, 0, At, B0); PG8_MMA(1, 1, At, B1); PG8_BAR; PG8_SCHED;
            if constexpr (Epi::SEG) { if (t + 2 == 16 || t + 2 == 24) { E.flush(acc, cur, (t + 2 == 16) ? 0 : 1, wr, wc, fr, fq); PG8_ZERO(); } }
        }
        if (wr == 0) PG8_BAR;
        if constexpr (Epi::SEG) E.flush(acc, cur, 2, wr, wc, fr, fq); else E(acc, cur, wr, wc, fr, fq);
        if (!has_next) break;
        PG8_ZERO();
        cur = nxt; cA = nA; cB = nB; ++ui;
        if (wr == 1) PG8_BAR;
    }
    PG8_WAIT_V(0);
    PG8_BAR;
#undef PG8_SA
#undef PG8_SB
#undef PG8_STAGE
#undef PG8_LDA
#undef PG8_LDB
#undef PG8_MMA
#undef PG8_WAIT_V
#undef PG8_WAIT_L
#undef PG8_BAR
#undef PG8_SCHED
#undef PG8_ZERO
}
}
using pg8::Unit;
typedef const f32x4 (&AccRef)[2][2][4][2];

struct Epi1 {
    static constexpr bool PERM = true, SEG = false;
    bf16_t *ocat, *kn, *vv, *qi, *ki, *u, *p, *gates; float* wi; const float* bgate; LAS unsigned char* stg;
    __device__ __forceinline__ void operator()(AccRef acc, const Unit& un, int wr, int wc, int fr, int fq) const {
        asm volatile("" : "+v"(fr), "+v"(fq));
        const int pn = un.pn, rowb = un.pm * 256 + wr * 64, lane = fq * 16 + fr;
        LAS unsigned char* sb = stg + (wr * 4 + wc) * 2304;
        if (pn == 7 && wc >= 1) {
            if (wc == 1 && fq == 0) {
                const float s = 0.35355339059327373f * 0.125f;
#pragma unroll
                for (int ai = 0; ai < 2; ++ai)
#pragma unroll
                    for (int m = 0; m < 4; ++m) { const size_t row = (size_t)(rowb + ai * 128 + m * 16 + fr);
                        *(f32x4*)(wi + row * 8) = acc[ai][0][m][0] * s; *(f32x4*)(wi + row * 8 + 4) = acc[ai][0][m][1] * s; }
            }
            return;
        }
        if (pn >= 12) {
            const int c0 = (pn - 12) * 256 + 64 * wc;
            f32x4 bz[2][2];
#pragma unroll
            for (int bj = 0; bj < 2; ++bj) { bz[bj][0] = *(const f32x4*)(bgate + c0 + 32 * bj + 8 * fq) * -1.4426950408889634f; bz[bj][1] = *(const f32x4*)(bgate + c0 + 32 * bj + 8 * fq + 4) * -1.4426950408889634f; }
            unsigned char* gb = (unsigned char*)gates + c0;
#pragma unroll
            for (int ai = 0; ai < 2; ++ai)
#pragma unroll
                for (int m = 0; m < 4; ++m) {
#pragma unroll
                    for (int bj = 0; bj < 2; ++bj) { uint2 q; unsigned w[2];
#pragma unroll
                        for (int n = 0; n < 2; ++n) { unsigned t = 0u;
#pragma unroll
                            for (int e = 0; e < 4; ++e) { const float ex_ = __builtin_amdgcn_exp2f(fmaf(acc[ai][bj][m][n][e], -1.4426950408889634f, bz[bj][n][e]));
                                t = __builtin_amdgcn_cvt_pk_u8_f32(__builtin_amdgcn_rcpf(fmaf(ex_, 1.f / 255.f, 1.f / 255.f)), e, t); }
                            w[n] = t; }
                        q.x = w[0]; q.y = w[1];
                        *(LAS u32x2*)(sb + fr * 80 + 32 * bj + 8 * fq) = (u32x2){q.x, q.y}; }
                    LDS_FENCE();
                    { const int r = lane >> 2, sg = lane & 3; const u32x4 v = *(const LAS u32x4*)(sb + r * 80 + sg * 16);
                      *(u32x4*)(gb + (size_t)(rowb + ai * 128 + m * 16 + r) * 6144 + sg * 16) = v; }
                    LDS_FENCE();
                }
            return;
        }
        bf16_t* base; int ld;
        if (pn < 4) { base = ocat + pn * 256 + 64 * wc; ld = 2048; }
        else if (pn == 4) { base = (wc < 2 ? kn : vv) + 64 * (wc & 1); ld = 128; }
        else if (pn < 7) { base = qi + (pn - 5) * 256 + 64 * wc; ld = 512; }
        else if (pn == 7) { base = ki; ld = 64; }
        else if (pn < 10) { base = u + (pn - 8) * 256 + 64 * wc; ld = 512; }
        else { base = p + (pn - 10) * 256 + 64 * wc; ld = 512; }
#pragma unroll
        for (int ai = 0; ai < 2; ++ai)
#pragma unroll
            for (int m = 0; m < 4; ++m) {
#pragma unroll
                for (int bj = 0; bj < 2; ++bj) { const uint4 pk_ = pack8(acc[ai][bj][m][0], acc[ai][bj][m][1]); *(LAS u32x4*)(sb + fr * 144 + 64 * bj + 16 * fq) = (u32x4){pk_.x, pk_.y, pk_.z, pk_.w}; }
                LDS_FENCE();
#pragma unroll
                for (int h = 0; h < 2; ++h) { const int r = h * 8 + (lane >> 3), sg = lane & 7; const u32x4 v = *(const LAS u32x4*)(sb + r * 144 + sg * 16);
                    *(u32x4*)(base + (size_t)(rowb + ai * 128 + m * 16 + r) * ld + sg * 8) = v; }
                LDS_FENCE();
            }
    }
};
struct EpiGluPool {
    static constexpr bool PERM = true, SEG = false;
    const bf16_t* y; const float* scale; bf16_t* ocat;
    __device__ __forceinline__ void operator()(AccRef acc, const Unit& un, int wr, int wc, int fr, int fq) const {
        asm volatile("" : "+v"(fr), "+v"(fq));
        const int row0 = un.pm * 256 + wr * 64 + fr; const bool glu = un.pn < 2;
#pragma unroll
        for (int bj = 0; bj < 2; ++bj) { const int col = (un.pn & 1) * 256 + 64 * wc + 32 * bj + 8 * fq;
            f32x4 s0 = {0.f, 0.f, 0.f, 0.f}, s1 = {0.f, 0.f, 0.f, 0.f};
            if (!glu) { s0 = *(const f32x4*)(scale + col); s1 = *(const f32x4*)(scale + col + 4); }
#pragma unroll
            for (int ai = 0; ai < 2; ++ai) {
                uint4 yq[4];
                if (glu) {
#pragma unroll
                    for (int m = 0; m < 4; ++m) yq[m] = *(const uint4*)(y + (size_t)(row0 + ai * 128 + m * 16) * 512 + col); }
#pragma unroll
                for (int m = 0; m < 4; ++m) { const size_t row = (size_t)(row0 + ai * 128 + m * 16);
                    f32x4 v0 = acc[ai][bj][m][0], v1 = acc[ai][bj][m][1];
                    if (glu) { float yv[8]; unpack8(yq[m], yv);
#pragma unroll
                        for (int e = 0; e < 4; ++e) { v0[e] = yv[e] * sigmoidf_(v0[e]); v1[e] = yv[4 + e] * sigmoidf_(v1[e]); }
                        *(uint4*)(ocat + row * 2048 + 1024 + col) = pack8(v0, v1);
                    } else *(uint4*)(ocat + row * 2048 + 1536 + col) = pack8(v0 * s0, v1 * s1); } } }
    }
};
struct EpiMerge {
    static constexpr bool PERM = true, SEG = true;
    const bf16_t* gates; bf16_t* merged; LAS unsigned char* stg;
    __device__ __forceinline__ void flush(AccRef acc, const Unit& un, int seg, int wr, int wc, int fr, int fq) const {
        asm volatile("" : "+v"(fr), "+v"(fq));
        const int rowb = un.pm * 256 + wr * 64, lane = fq * 16 + fr;
        const int colw = un.pn * 256 + 64 * wc;
        LAS unsigned char* sb = stg + (wr * 4 + wc) * 2304;
#pragma unroll
        for (int ai = 0; ai < 2; ++ai) {
            uint2 gq[2][4]; uint4 pq[2][4];
#pragma unroll
            for (int bj = 0; bj < 2; ++bj)
#pragma unroll
                for (int m = 0; m < 4; ++m) { const size_t row = (size_t)(rowb + ai * 128 + m * 16 + fr); const int col = colw + 32 * bj + 8 * fq;
                    gq[bj][m] = *(const uint2*)((const unsigned char*)gates + row * 6144 + seg * 2048 + col);
                    if (seg > 0) pq[bj][m] = *(const uint4*)(merged + row * 2048 + col); else pq[bj][m] = make_uint4(0u, 0u, 0u, 0u); }
#pragma unroll
            for (int m = 0; m < 4; ++m) {
#pragma unroll
                for (int bj = 0; bj < 2; ++bj) {
                    float gv[8], pv[8]; unpack8(pq[bj][m], pv);
#pragma unroll
                    for (int e = 0; e < 4; ++e) { gv[e] = (float)((gq[bj][m].x >> (8 * e)) & 0xffu) * (1.f / 255.f); gv[4 + e] = (float)((gq[bj][m].y >> (8 * e)) & 0xffu) * (1.f / 255.f); }
                    f32x4 v0 = acc[ai][bj][m][0], v1 = acc[ai][bj][m][1];
#pragma unroll
                    for (int e = 0; e < 4; ++e) { v0[e] = pv[e] + gv[e] * v0[e]; v1[e] = pv[4 + e] + gv[4 + e] * v1[e]; }
                    const uint4 pk_ = pack8(v0, v1); *(LAS u32x4*)(sb + fr * 144 + 64 * bj + 16 * fq) = (u32x4){pk_.x, pk_.y, pk_.z, pk_.w}; }
                LDS_FENCE();
#pragma unroll
                for (int h = 0; h < 2; ++h) { const int r = h * 8 + (lane >> 3), sg = lane & 7; const u32x4 v = *(const LAS u32x4*)(sb + r * 144 + sg * 16);
                    *(u32x4*)(merged + (size_t)(rowb + ai * 128 + m * 16 + r) * 2048 + colw + sg * 8) = v; }
                LDS_FENCE();
            }
        }
    }
};
struct EpiRes {
    static constexpr bool PERM = false, SEG = false;
    const float* xin; float* out; const float* gt;
    __device__ __forceinline__ void operator()(AccRef acc, const Unit& un, int wr, int wc, int fr, int fq) const {
        asm volatile("" : "+v"(fr), "+v"(fq));
        const int row0 = un.pm * 256 + wr * 64 + fr; const float* g = gt + (size_t)(un.pm >> 3) * 12288;
#pragma unroll
        for (int bj = 0; bj < 2; ++bj) { const int col = un.pn * 256 + bj * 128 + wc * 32 + 4 * fq;
            f32x4 gv[2], xv[2][2][4];
#pragma unroll
            for (int n = 0; n < 2; ++n) gv[n] = *(const f32x4*)(g + col + 16 * n);
#pragma unroll
            for (int n = 0; n < 2; ++n)
#pragma unroll
                for (int ai = 0; ai < 2; ++ai)
#pragma unroll
                    for (int m = 0; m < 4; ++m) xv[n][ai][m] = *(const f32x4*)(xin + (size_t)(row0 + ai * 128 + m * 16) * 2048 + col + 16 * n);
#pragma unroll
            for (int n = 0; n < 2; ++n)
#pragma unroll
                for (int ai = 0; ai < 2; ++ai)
#pragma unroll
                    for (int m = 0; m < 4; ++m) *(f32x4*)(out + (size_t)(row0 + ai * 128 + m * 16) * 2048 + col + 16 * n) = xv[n][ai][m] + gv[n] * acc[ai][bj][m][n]; }
    }
};
struct EpiUp {
    static constexpr bool PERM = true, SEG = false;
    bf16_t* act; float* SA; float* SB; const float* cw; const float* cb; LAS unsigned char* stg;
    __device__ __forceinline__ void operator()(AccRef acc, const Unit& un, int wr, int wc, int fr, int fq) const {
        asm volatile("" : "+v"(fr), "+v"(fq));
        const int lg = fq << 4, lane = lg | fr;
        const int src1 = lg | ((fr + 15) & 15), src2 = lg | ((fr + 14) & 15);
        const int ch0 = un.pn * 128 + wc * 32 + 8 * fq;
        LAS unsigned char* sb = stg + (wr * 4 + wc) * 2304;
        f32x4 w0[2], w1[2], w2[2], bb[2];
#pragma unroll
        for (int n = 0; n < 2; ++n) { w0[n] = *(const f32x4*)(cw + ch0 + 4 * n); w1[n] = *(const f32x4*)(cw + DFF + ch0 + 4 * n); w2[n] = *(const f32x4*)(cw + 2 * DFF + ch0 + 4 * n); bb[n] = *(const f32x4*)(cb + ch0 + 4 * n); }
#pragma unroll
        for (int ai = 0; ai < 2; ++ai) {
            const int rowb = un.pm * 256 + ai * 128 + wr * 64; const int blk = rowb >> 6;
#pragma unroll
            for (int m = 0; m < 4; ++m) {
                f32x4 res[2];
#pragma unroll
                for (int n = 0; n < 2; ++n)
#pragma unroll
                    for (int e = 0; e < 4; ++e) {
                        const float cur = acc[ai][0][m][n][e];
                        const float prv = (m > 0) ? acc[ai][0][m > 0 ? m - 1 : 0][n][e] : 0.f;
                        const float p1 = dpp_ror1((fr + 1 >= 16) ? prv : cur);
                        const float p2 = dpp_ror2((fr + 2 >= 16) ? prv : cur);
                        const float cv = bb[n][e] + w0[n][e] * p2 + w1[n][e] * p1 + w2[n][e] * cur;
                        res[n][e] = siluf_(cv) * acc[ai][1][m][n][e];
                    }
                if (m == 0 && fr < 2) {
                    float* sa = SA + ((size_t)(blk * 4 + 2 + fr)) * DFF + ch0; float* sbp = SB + ((size_t)(blk * 2 + fr)) * DFF + ch0;
                    *(f32x4*)sa = acc[ai][0][0][0]; *(f32x4*)(sa + 4) = acc[ai][0][0][1];
                    *(f32x4*)sbp = acc[ai][1][0][0]; *(f32x4*)(sbp + 4) = acc[ai][1][0][1];
                }
                if (m == 3 && fr >= 14) { float* sa = SA + ((size_t)(blk * 4 + (fr - 14))) * DFF + ch0; *(f32x4*)sa = acc[ai][0][3][0]; *(f32x4*)(sa + 4) = acc[ai][0][3][1]; }
                { const uint4 pk_ = pack8(res[0], res[1]); *(LAS u32x4*)(sb + fr * 80 + 16 * fq) = (u32x4){pk_.x, pk_.y, pk_.z, pk_.w}; }
                LDS_FENCE();
                { const int r = lane >> 2, sg = lane & 3; const u32x4 v = *(const LAS u32x4*)(sb + r * 80 + sg * 16);
                  if (!(m == 0 && r < 2)) *(u32x4*)(act + (size_t)(rowb + m * 16 + r) * DFF + un.pn * 128 + wc * 32 + sg * 8) = v; }
                LDS_FENCE();
            }
        }
    }
};

struct Args { const float* in[31]; float* out; unsigned char* ws; int ph_lo, ph_hi; };
enum { I_X = 0, I_C, I_POS, I_WADA, I_BADA, I_GN1, I_GN2, I_WIN, I_GQ, I_GK, I_ARE, I_AIM, I_BRE, I_BIM, I_CRE, I_CIM, I_DSKIP, I_LOGDT, I_WGLU, I_WPOOL, I_PSCALE, I_PA, I_PB, I_PC, I_WGATE, I_BGATE, I_WOUT, I_WUP, I_CONVW, I_CONVB, I_WDOWN };

__device__ __forceinline__ float wave_sum(float v) {
#pragma unroll
    for (int o = 32; o > 0; o >>= 1) v += __shfl_xor(v, o);
    return v;
}

__device__ __forceinline__ void phase_ada(const Args& a, unsigned char* lds, const int WV) {
    const int TI = fresh_tid(WV);
    const int tid = TI;
    float* cact = (float*)lds;
    float* mod = (float*)(a.ws + WS_MOD);
    for (int w = blockIdx.x; w < 256; w += gridDim.x) {
        for (int i = tid; i < 16 * 2048; i += 512) { const int b = i >> 11, k = i & 2047; const float v = a.in[I_C][i]; cact[k * 16 + b] = siluf_(v); }
        __syncthreads();
        const int l = w >> 7, n0 = (w & 127) * 96;
        float acc[16][4];
#pragma unroll
        for (int b = 0; b < 16; ++b)
#pragma unroll
            for (int j = 0; j < 4; ++j) acc[b][j] = 0.f;
        const int cg4 = tid % 24, ks = tid / 24;
        if (tid < 384) {
            const float* wp = a.in[I_WADA] + ((size_t)l * 2048 + ks * 128) * 12288 + n0 + cg4 * 4;
#pragma unroll 4
            for (int k = 0; k < 128; ++k) {
                const f32x4 wv = *(const f32x4*)(wp + (size_t)k * 12288);
                const f32x4* cp = (const f32x4*)(cact + (ks * 128 + k) * 16);
#pragma unroll
                for (int q = 0; q < 4; ++q) { const f32x4 cv = cp[q];
#pragma unroll
                    for (int e = 0; e < 4; ++e)
#pragma unroll
                        for (int j = 0; j < 4; ++j) acc[q * 4 + e][j] += cv[e] * wv[j]; }
            }
        }
        __syncthreads();
        float* part = (float*)lds;
        if (tid < 384) {
#pragma unroll
            for (int b = 0; b < 16; ++b)
#pragma unroll
                for (int j = 0; j < 4; ++j) part[(ks * 16 + b) * 96 + cg4 * 4 + j] = acc[b][j];
        }
        __syncthreads();
        for (int o = tid; o < 1536; o += 512) { const int b = o / 96, cc = o % 96; float s = 0.f;
#pragma unroll
            for (int k2 = 0; k2 < 16; ++k2) s += part[(k2 * 16 + b) * 96 + cc];
            mod[((size_t)l * 16 + b) * 12288 + n0 + cc] = s + a.in[I_BADA][l * 12288 + n0 + cc]; }
        __syncthreads();
    }
}

struct CvtJob { const float* src; bf16_t* dst; int ldS, cbase, cend, kbase, ldD, mode, r0, cs0, kd0; };
__device__ __forceinline__ CvtJob cvt_decode(const Args& a, int l, int t) {
    unsigned char* ws = a.ws; CvtJob J; int ncols, nkt, idx; J.mode = 0; J.r0 = 0; J.kd0 = 0; J.cs0 = 0;
    if (t < 960) { idx = t; J.src = a.in[I_WIN] + (size_t)l * DM * DIN; J.ldS = DIN; ncols = 1864; nkt = 32; J.dst = (bf16_t*)(ws + W_1CAT); J.ldD = 2048; J.mode = 2; }
    else if (t < 1472) { idx = t - 960; J.src = a.in[I_WIN] + (size_t)l * DM * DIN; J.ldS = DIN; J.cs0 = 1864; ncols = 1024; nkt = 32; J.dst = (bf16_t*)(ws + W_1CAT); J.ldD = 2048; J.r0 = 2048; J.mode = 2; }
    else if (t < 4544) { idx = t - 1472; const int gi = idx >> 10; idx &= 1023; J.src = a.in[I_WGATE] + ((size_t)l * 3 + gi) * DM * DM; J.ldS = DM; ncols = 2048; nkt = 32; J.dst = (bf16_t*)(ws + W_1CAT); J.ldD = 2048; J.r0 = 3072 + 2048 * gi; J.mode = 2; }
    else if (t < 5056) { idx = t - 4544; J.src = a.in[I_PA] + (size_t)l * 1024 * DM; J.ldS = DM; ncols = 2048; nkt = 16; J.dst = (bf16_t*)(ws + W_P); J.ldD = 2048; J.mode = 2; }
    else if (t < 5312) { idx = t - 5056; J.src = a.in[I_PB] + (size_t)l * 512 * DM; J.ldS = DM; ncols = 2048; nkt = 8; J.dst = (bf16_t*)(ws + W_P); J.ldD = 2048; J.kd0 = 1024; J.mode = 2; }
    else if (t < 5568) { idx = t - 5312; J.src = a.in[I_PC] + (size_t)l * 512 * DM; J.ldS = DM; ncols = 2048; nkt = 8; J.dst = (bf16_t*)(ws + W_P); J.ldD = 2048; J.kd0 = 1536; J.mode = 2; }
    else if (t < 6592) { idx = t - 5568; J.src = a.in[I_WOUT] + (size_t)l * DM * DM; J.ldS = DM; ncols = 2048; nkt = 32; J.dst = (bf16_t*)(ws + W_OUT); J.ldD = 2048; }
    else if (t < 12096) { idx = t - 6592; J.src = a.in[I_WUP] + (size_t)l * DM * 2 * DFF; J.ldS = 2 * DFF; ncols = 2 * DFF; nkt = 32; J.dst = (bf16_t*)(ws + W_UP); J.ldD = 2048; J.mode = 1; }
    else if (t < 14848) { idx = t - 12096; J.src = a.in[I_WDOWN] + (size_t)l * DFF * DM; J.ldS = DM; ncols = 2048; nkt = 86; J.dst = (bf16_t*)(ws + W_DOWN); J.ldD = DFF; }
    else { idx = t - 14848; J.src = a.in[I_WGLU] + (size_t)l * 512 * 512; J.ldS = 512; ncols = 512; nkt = 8; J.dst = (bf16_t*)(ws + W_GLU); J.ldD = 512; J.mode = 2; }
    const int tn = idx / nkt, tk = idx - tn * nkt;
    J.cbase = J.cs0 + tn * 64; J.cend = J.cs0 + ncols; J.kbase = tk * 64; return J;
}
__device__ __forceinline__ void phase_cvt(const Args& a, int l, unsigned char* lds, const int WV) {
    const int TI = fresh_tid(WV);
    float* T = (float*)lds;
    const int tid = TI, ty = tid >> 4, tx = tid & 15;
    for (int t4 = blockIdx.x * 8; t4 < 14912; t4 += gridDim.x * 8) {
        f32x4 v[8][2];
#pragma unroll
        for (int q = 0; q < 8; ++q) { const CvtJob J = cvt_decode(a, l, t4 + q);
#pragma unroll
            for (int ps = 0; ps < 2; ++ps) { const int k = ty + ps * 32, c = J.cbase + tx * 4;
                v[q][ps] = (f32x4){0.f, 0.f, 0.f, 0.f};
                if (c < J.cend) v[q][ps] = *(const f32x4*)(J.src + (size_t)(J.kbase + k) * J.ldS + c); } }
#pragma unroll
        for (int q = 0; q < 8; ++q)
#pragma unroll
            for (int ps = 0; ps < 2; ++ps) { float* tp = T + q * (64 * 65) + (ty + ps * 32) * 65 + tx * 4; tp[0] = v[q][ps][0]; tp[1] = v[q][ps][1]; tp[2] = v[q][ps][2]; tp[3] = v[q][ps][3]; }
        __syncthreads();
#pragma unroll
        for (int q = 0; q < 8; ++q) { const CvtJob J = cvt_decode(a, l, t4 + q);
            const int n = tid >> 3, kq = tid & 7, c = J.cbase + n;
            if (c < J.cend) {
                float f[8];
#pragma unroll
                for (int j = 0; j < 8; ++j) f[j] = T[q * (64 * 65) + (kq * 8 + j) * 65 + n];
                int row;
                if (J.mode == 0) row = J.r0 + (c - J.cs0);
                else if (J.mode == 2) { const int r_ = J.r0 + (c - J.cs0), ct = r_ & 255; row = (r_ & ~255) | (((ct >> 5) & 1) << 7) | ((ct >> 6) << 5) | (ct & 31); }
                else { const int bj = c >= DFF ? 1 : 0, ch = c - bj * DFF; row = (ch >> 7) * 256 + bj * 128 + (ch & 127); }
                uint4 o; o.x = pk2(f[0], f[1]); o.y = pk2(f[2], f[3]); o.z = pk2(f[4], f[5]); o.w = pk2(f[6], f[7]);
                *(uint4*)(J.dst + (size_t)row * J.ldD + J.kd0 + J.kbase + kq * 8) = o;
            } }
        __syncthreads();
    }
    bf16_t* wp = (bf16_t*)(a.ws + W_POOL); const float* wsrc = a.in[I_WPOOL] + (size_t)l * 4 * 128 * 128;
    for (int i = blockIdx.x * 512 + TI; i < 512 * 512; i += gridDim.x * 512) { const int n = i >> 9, k = i & 511, g = n >> 7;
        const float v = ((k >> 7) == g) ? wsrc[(g * 128 + (k & 127)) * 128 + (n & 127)] : 0.f;
        const int ct = n & 255, nr = (n & ~255) | (((ct >> 5) & 1) << 7) | ((ct >> 6) << 5) | (ct & 31); wp[nr * 512 + k] = (bf16_t)f2bf(v); }
}

__device__ __forceinline__ void phase_norm(const float* xin, const float* g, const float* modl, int shoff, int scoff, bf16_t* out, const int WV) {
    const int TI = fresh_tid(WV);
    const int lane = TI & 63, wave = TI >> 6;
    for (int r = blockIdx.x * 8 + wave; r < MROWS; r += gridDim.x * 8) {
        const f32x4* xp = (const f32x4*)(xin + (size_t)r * DM); f32x4 v[8]; float ssq = 0.f;
#pragma unroll
        for (int j = 0; j < 8; ++j) { v[j] = xp[j * 64 + lane]; ssq += v[j][0] * v[j][0] + v[j][1] * v[j][1] + v[j][2] * v[j][2] + v[j][3] * v[j][3]; }
        ssq = wave_sum(ssq);
        const float rinv = rsqrtf(ssq * (1.f / DM) + EPS);
        const float* mb = modl + (size_t)(r >> 11) * 12288;
#pragma unroll
        for (int j = 0; j < 8; ++j) { const int col = j * 256 + lane * 4;
            const f32x4 g4 = *(const f32x4*)(g + col), sc = *(const f32x4*)(mb + scoff + col), sh = *(const f32x4*)(mb + shoff + col);
            f32x4 y;
#pragma unroll
            for (int e = 0; e < 4; ++e) y[e] = (v[j][e] * rinv * g4[e]) * (1.f + sc[e]) + sh[e];
            uint2 o; o.x = pk2(y[0], y[1]); o.y = pk2(y[2], y[3]);
            *(uint2*)(out + (size_t)r * DM + col) = o; }
    }
}

__constant__ double kRevPerPos[24] = {0.15915494309189535, 0.0700865215877985, 0.03086376340470123, 0.013591370636193905, 0.005985185712713705, 0.002635675898667414, 0.001160663641240061, 0.0005111175045375439, 0.00022507907903927653, 9.911730936901935e-05, 4.364795279280289e-05, 1.9221100684944863e-05, 8.464330808241401e-06, 3.727408601915352e-06, 1.6414262627950345e-06, 7.228293068832865e-07, 0.15915494309189535, 0.03086376340470123, 0.005985185712713705, 0.001160663641240061, 0.00022507907903927653, 4.364795279280289e-05, 8.464330808241401e-06, 1.6414262627950345e-06};
__device__ __forceinline__ void rmsrope128(bf16_t* p, bool active, const float* g16, int sub, const float* cs) {
    float v[16];
    if (active) { unpack8(*(const uint4*)p, v); unpack8(*(const uint4*)(p + 8), v + 8); }
    else {
#pragma unroll
        for (int i = 0; i < 16; ++i) v[i] = 0.f; }
    float ssq = 0.f;
#pragma unroll
    for (int i = 0; i < 16; ++i) ssq += v[i] * v[i];
    ssq += __shfl_xor(ssq, 1); ssq += __shfl_xor(ssq, 2); ssq += __shfl_xor(ssq, 4);
    const float rinv = rsqrtf(ssq * (1.f / 128.f) + EPS);
#pragma unroll
    for (int i = 0; i < 16; ++i) v[i] = v[i] * rinv * g16[i];
#pragma unroll
    for (int i = 0; i < 16; ++i) { const float o = __shfl_xor(v[i], 1); const float c = cs[2 * i], s = cs[2 * i + 1];
        if (sub == 0) v[i] = v[i] * c - o * s; else if (sub == 1) v[i] = v[i] * c + o * s; }
    if (active) { uint4 o0, o1; o0.x = pk2(v[0], v[1]); o0.y = pk2(v[2], v[3]); o0.z = pk2(v[4], v[5]); o0.w = pk2(v[6], v[7]);
        o1.x = pk2(v[8], v[9]); o1.y = pk2(v[10], v[11]); o1.z = pk2(v[12], v[13]); o1.w = pk2(v[14], v[15]);
        *(uint4*)p = o0; *(uint4*)(p + 8) = o1; }
}
__device__ __forceinline__ void rope64(bf16_t* p, bool active, int sub, const float* cs) {
    float v[8];
    if (active) unpack8(*(const uint4*)p, v);
    else {
#pragma unroll
        for (int i = 0; i < 8; ++i) v[i] = 0.f; }
#pragma unroll
    for (int i = 0; i < 8; ++i) { const float o = __shfl_xor(v[i], 1); const float c = cs[2 * i], s = cs[2 * i + 1];
        if (sub == 0) v[i] = v[i] * c - o * s; else if (sub == 1) v[i] = v[i] * c + o * s; }
    if (active) { uint4 o0; o0.x = pk2(v[0], v[1]); o0.y = pk2(v[2], v[3]); o0.z = pk2(v[4], v[5]); o0.w = pk2(v[6], v[7]); *(uint4*)p = o0; }
}
__device__ __forceinline__ void phase_post(const Args& a, int l, unsigned char* lds, const int WV) {
    const int TI = fresh_tid(WV);
    const int lane = TI & 63, wave = TI >> 6;
    float* cs = (float*)lds + wave * 64;
    bf16_t* ocat = (bf16_t*)(a.ws + WS_OCAT); bf16_t* kn = (bf16_t*)(a.ws + WS_KN); bf16_t* qi = (bf16_t*)(a.ws + WS_QI); bf16_t* ki = (bf16_t*)(a.ws + WS_KI);
    const int* pos = (const int*)a.in[I_POS];
    const int sub = lane & 7, hd = lane >> 3;
    float gq[16], gk[16];
#pragma unroll
    for (int i = 0; i < 16; ++i) { gq[i] = a.in[I_GQ][l * 128 + sub * 16 + i]; gk[i] = a.in[I_GK][l * 128 + sub * 16 + i]; }
    for (int r = blockIdx.x * 8 + wave; r < MROWS; r += gridDim.x * 8) {
        const int ps = pos[r];
        if (lane < 24) {
            double rev = (double)ps * kRevPerPos[lane]; rev -= rint(rev); const float fr = (float)rev;
            cs[lane * 2] = __builtin_amdgcn_cosf(fr); cs[lane * 2 + 1] = __builtin_amdgcn_sinf(fr); }
        LDS_FENCE();
        rmsrope128(ocat + (size_t)r * 2048 + hd * 128 + sub * 16, true, gq, sub, cs);
        rmsrope128(kn + (size_t)r * 128 + sub * 16, lane < 8, gk, sub, cs);
        rope64(qi + (size_t)r * 512 + hd * 64 + sub * 8, true, sub, cs + 32);
        rope64(ki + (size_t)r * 64 + sub * 8, lane < 8, sub, cs + 32);
        LDS_FENCE();
    }
}

__device__ __forceinline__ void s5_unit(const Args& a, int l, int b, int g, unsigned char* lds, const int WV) {
    const int TI = fresh_tid(WV);
    const int lane = TI & 63, wave = __builtin_amdgcn_readfirstlane(TI >> 6), p = lane;
    float* E = (float*)lds;
    float* ust = (float*)(lds + 16384 + wave * 4096);
    bf16_t* sst = (bf16_t*)(lds + 49152 + wave * 4352);
    const bf16_t* U = (const bf16_t*)(a.ws + WS_U); bf16_t* Y = (bf16_t*)(a.ws + WS_Y);
    const int gp = (l * 32 + g) * 64 + p;
    const float are = a.in[I_ARE][gp], aim = a.in[I_AIM][gp], dt = expf(a.in[I_LOGDT][l * 32 + g]);
    const float mag = expf(are * dt);
    float ang = aim * dt; { const float n = rintf(ang * 0.15915494309189535f); ang = fmaf(-n, 6.28318548202514648f, ang); ang = fmaf(n, 1.7484555e-7f, ang); }
    const float lre = mag * cosf(ang), lim = mag * sinf(ang);
    float Bre[16], Bim[16];
    { const float nr = lre - 1.f, ni = lim, den = 1.f / (are * are + aim * aim); const float cr = (nr * are + ni * aim) * den, ci = (ni * are - nr * aim) * den;
#pragma unroll
        for (int j = 0; j < 16; ++j) { const float br = a.in[I_BRE][(size_t)gp * 16 + j], bi = a.in[I_BIM][(size_t)gp * 16 + j]; Bre[j] = cr * br - ci * bi; Bim[j] = cr * bi + ci * br; } }
    bf16x8 Cf[4];
    { const int i = lane & 15;
#pragma unroll
        for (int ks = 0; ks < 4; ++ks)
#pragma unroll
            for (int j = 0; j < 8; ++j) { const int k = ks * 32 + (lane >> 4) * 8 + j, pp = k >> 1; const size_t ci = ((size_t)(l * 32 + g) * 16 + i) * 64 + pp;
                const float v = (k & 1) ? -a.in[I_CIM][ci] : a.in[I_CRE][ci]; Cf[ks][j] = (short)f2bf(v); } }
    const float dsk = a.in[I_DSKIP][l * 512 + g * 16 + (lane & 15)];
    bf16_t* Bl = (bf16_t*)(lds + 83968);
    float* bus = (float*)(lds + 88064 + wave * 8448);
    if (wave == 0) {
#pragma unroll
        for (int q = 0; q < 2; ++q) { uint4 o_; o_.x = pk2(Bre[q * 8], Bre[q * 8 + 1]); o_.y = pk2(Bre[q * 8 + 2], Bre[q * 8 + 3]); o_.z = pk2(Bre[q * 8 + 4], Bre[q * 8 + 5]); o_.w = pk2(Bre[q * 8 + 6], Bre[q * 8 + 7]);
            *(uint4*)(Bl + p * 16 + q * 8) = o_;
            uint4 i_; i_.x = pk2(Bim[q * 8], Bim[q * 8 + 1]); i_.y = pk2(Bim[q * 8 + 2], Bim[q * 8 + 3]); i_.z = pk2(Bim[q * 8 + 4], Bim[q * 8 + 5]); i_.w = pk2(Bim[q * 8 + 6], Bim[q * 8 + 7]);
            *(uint4*)(Bl + (64 + p) * 16 + q * 8) = i_; }
    }
    __syncthreads();
    const int l15 = lane & 15, lg4 = lane >> 4;
    bf16x8 Bf[8];
#pragma unroll
    for (int nb = 0; nb < 8; ++nb) { u32x4 t_ = {0u, 0u, 0u, 0u}; if (lg4 < 2) t_ = *(const u32x4*)(Bl + (nb * 16 + l15) * 16 + lg4 * 8); Bf[nb] = __builtin_bit_cast(bf16x8, t_); }
#define S5_BU(t0_, sb_) do { u32x4 a_ = {0u, 0u, 0u, 0u}; if (lg4 < 2) a_ = *(const u32x4*)(U + (size_t)(b * 2048 + (t0_) + (sb_) * 16 + l15) * 512 + g * 16 + lg4 * 8); \
        const bf16x8 af_ = __builtin_bit_cast(bf16x8, a_); \
        _Pragma("unroll") for (int nb = 0; nb < 8; ++nb) { const f32x4 c_ = __builtin_amdgcn_mfma_f32_16x16x32_bf16(af_, Bf[nb], (f32x4){0.f, 0.f, 0.f, 0.f}, 0, 0, 0); \
            _Pragma("unroll") for (int r = 0; r < 4; ++r) bus[(lg4 * 4 + r) * 132 + nb * 16 + l15] = c_[r]; } \
        LDS_FENCE(); } while (0)
#define S5_STEP(tt_) do { const float br_ = bus[(tt_) * 132 + p], bi_ = bus[(tt_) * 132 + 64 + p]; \
        const float nre_ = lre * sre - lim * sim + br_, nim_ = lre * sim + lim * sre + bi_; sre = nre_; sim = nim_; } while (0)
#pragma unroll 1
    for (int cc = 0; cc < 4; ++cc) {
        const int chunk = wave * 4 + cc, t0 = chunk * 64;
        float sre = 0.f, sim = 0.f;
#pragma unroll 1
        for (int sb = 0; sb < 4; ++sb) {
            S5_BU(t0, sb);
#pragma unroll 4
            for (int tt = 0; tt < 16; ++tt) S5_STEP(tt);
            LDS_FENCE();
        }
        E[(chunk * 64 + p) * 2] = sre; E[(chunk * 64 + p) * 2 + 1] = sim;
    }
    __syncthreads();
    if (wave == 0) {
        float pr = lre, pi = lim;
#pragma unroll
        for (int q = 0; q < 6; ++q) { const float nr = pr * pr - pi * pi, pp_ = pr * pi, ni = pp_ + pp_; pr = nr; pi = ni; }
        float sr = 0.f, si = 0.f;
        for (int c = 0; c < 32; ++c) { const float er = E[(c * 64 + p) * 2], ei = E[(c * 64 + p) * 2 + 1]; E[(c * 64 + p) * 2] = sr; E[(c * 64 + p) * 2 + 1] = si;
            const float nr = pr * sr - pi * si + er, ni = pr * si + pi * sr + ei; sr = nr; si = ni; }
    }
    __syncthreads();
#pragma unroll 1
    for (int cc = 0; cc < 4; ++cc) {
        const int chunk = wave * 4 + cc, t0 = chunk * 64;
        { const bf16_t* up = U + (size_t)(b * 2048 + t0 + lane) * 512 + g * 16; const uint4 q0 = *(const uint4*)up, q1 = *(const uint4*)(up + 8);
            float f[16]; unpack8(q0, f); unpack8(q1, f + 8);
#pragma unroll
            for (int q = 0; q < 4; ++q) *(f32x4*)(ust + lane * 16 + q * 4) = (f32x4){f[q * 4], f[q * 4 + 1], f[q * 4 + 2], f[q * 4 + 3]}; }
        float sre = E[(chunk * 64 + p) * 2], sim = E[(chunk * 64 + p) * 2 + 1];
#pragma unroll 1
        for (int sb = 0; sb < 4; ++sb) {
            S5_BU(t0, sb);
#pragma unroll 4
            for (int tt = 0; tt < 16; ++tt) { S5_STEP(tt);
                *(unsigned*)(sst + tt * 136 + 2 * p) = pk2(sre, sim);
            }
            LDS_FENCE();
            f32x4 acc = {0.f, 0.f, 0.f, 0.f};
#pragma unroll
            for (int ks = 0; ks < 4; ++ks) { const bf16x8 af = *(const bf16x8*)(sst + (lane & 15) * 136 + ks * 32 + (lane >> 4) * 8);
                acc = __builtin_amdgcn_mfma_f32_16x16x32_bf16(af, Cf[ks], acc, 0, 0, 0); }
#pragma unroll
            for (int r = 0; r < 4; ++r) { const int t = sb * 16 + (lane >> 4) * 4 + r, i = lane & 15;
                const float y = gelu_tanh(acc[r] + dsk * ust[t * 16 + i]);
                Y[(size_t)(b * 2048 + t0 + t) * 512 + g * 16 + i] = (bf16_t)f2bf(y); }
            LDS_FENCE();
        }
    }
    __syncthreads();
#undef S5_STEP
#undef S5_BU
}

__device__ __forceinline__ void pool_unit(const Args& a, int b, int chunk, unsigned char* lds, const int WV) {
    const int TI = fresh_tid(WV);
    bf16_t* T = (bf16_t*)lds;
    const int t0 = chunk * 64;
    const bf16_t* P = (const bf16_t*)(a.ws + WS_P) + (size_t)b * 2048 * 512; bf16_t* O = (bf16_t*)(a.ws + WS_POOLED) + (size_t)b * 2048 * 512;
    __syncthreads();
    for (int i = TI; i < 80 * 64; i += 512) { const int r = i >> 6, c8 = i & 63, t = t0 - 16 + r;
        uint4 v = make_uint4(0u, 0u, 0u, 0u); if (t >= 0) v = *(const uint4*)(P + (size_t)t * 512 + c8 * 8);
        *(uint4*)(T + r * 512 + c8 * 8) = v; }
    __syncthreads();
    const int c = TI, w = 2 << (c >> 7);
    float s = 0.f;
    for (int k = 1; k <= w; ++k) s += bf1(T[(16 - k) * 512 + c]);
#pragma unroll 4
    for (int t = 0; t < 64; ++t) { const float pv = bf1(T[(16 + t) * 512 + c]); s += pv; s -= bf1(T[(16 + t - w) * 512 + c]);
        const int tt = t0 + t + 1; const float mean = s / (float)(tt < w ? tt : w); O[(size_t)(t0 + t) * 512 + c] = (bf16_t)f2bf(mean - pv); }
}

__device__ __forceinline__ unsigned sortkey(float x) { const unsigned u = __float_as_uint(x); return (u & 0x80000000u) ? ~u : (u | 0x80000000u); }
template <int NJ>
__device__ __forceinline__ void select256(const float* scq, int limit, unsigned short* sq, int lane) {
    const unsigned long long ltmask = (1ull << lane) - 1ull;
    unsigned key[NJ];
#pragma unroll
    for (int j = 0; j < NJ; ++j) { const int idx = j * 64 + lane; key[j] = (idx < limit) ? sortkey(scq[idx]) : 0u; }
    unsigned T = 0u;
    for (int bit = 31; bit >= 0; --bit) { const unsigned cand = T | (1u << bit); int cnt = 0;
#pragma unroll
        for (int j = 0; j < NJ; ++j) cnt += __popcll(__ballot(key[j] >= cand));
        if (cnt >= 256) { T = cand; if (cnt == 256) break; } }
    int cgt = 0;
#pragma unroll
    for (int j = 0; j < NJ; ++j) cgt += __popcll(__ballot(key[j] > T));
    const int need = 256 - cgt; int ob = 0, tb = 0;
#pragma unroll
    for (int j = 0; j < NJ; ++j) { const bool gt = key[j] > T, eq = key[j] == T; const unsigned long long me = __ballot(eq);
        const int pe = tb + __popcll(me & ltmask); const bool take = gt || (eq && pe < need); const unsigned long long mt = __ballot(take);
        if (take) sq[ob + __popcll(mt & ltmask)] = (unsigned short)(j * 64 + lane);
        ob += __popcll(mt); tb += __popcll(me); }
}
__device__ __forceinline__ void dsa_unit(const Args& a, int b, int tq, unsigned char* lds, const int WV, bf16_t* obase, const int ostride, const int parts) {
    const int TI = fresh_tid(WV);
    int tid = TI;
    int lane = tid & 63; const int wave = WV;
    float* sc = (float*)lds;
    unsigned short* sel = (unsigned short*)(lds + 131072);
    float* wis = (float*)(lds + 131072 + 8192);
    bf16_t* ocat = (bf16_t*)(a.ws + WS_OCAT); const bf16_t* Kn = (const bf16_t*)(a.ws + WS_KN); const bf16_t* V = (const bf16_t*)(a.ws + WS_V);
    const bf16_t* QI = (const bf16_t*)(a.ws + WS_QI); const bf16_t* KI = (const bf16_t*)(a.ws + WS_KI); const float* WI = (const float*)(a.ws + WS_WI);
    const int t0 = tq * 16, row0 = b * 2048 + t0, limit = ((t0 >> 6) + 1) << 6, nkt = limit >> 5, nsel = limit < 256 ? limit : 256;
    __syncthreads();
    if (tid < 128) wis[tid] = WI[(size_t)row0 * 8 + tid];
    __syncthreads();
    if (parts & 1)
    {
        const int g = lane >> 5, c32 = lane & 31;
        bf16x8 Af[4][4];
#pragma unroll
        for (int rb = 0; rb < 4; ++rb) { const int R = rb * 32 + c32; const bf16_t* qp = QI + (size_t)(row0 + (R >> 3)) * 512 + (R & 7) * 64 + g * 8;
#pragma unroll
            for (int s = 0; s < 4; ++s) Af[rb][s] = *(const bf16x8*)(qp + s * 16); }
        bf16x8 Bn[4];
        { const bf16_t* kp0 = KI + (size_t)(b * 2048 + wave * 32 + c32) * 64 + g * 8;
#pragma unroll
            for (int s = 0; s < 4; ++s) Bn[s] = *(const bf16x8*)(kp0 + s * 16); }
#pragma unroll 1
        for (int kt = wave; kt < nkt; kt += 8) {
            bf16x8 Bf[4];
#pragma unroll
            for (int s = 0; s < 4; ++s) Bf[s] = Bn[s];
            if (kt + 8 < nkt) { const bf16_t* kp = KI + (size_t)(b * 2048 + (kt + 8) * 32 + c32) * 64 + g * 8;
#pragma unroll
                for (int s = 0; s < 4; ++s) Bn[s] = *(const bf16x8*)(kp + s * 16); }
#pragma unroll
            for (int rb = 0; rb < 4; ++rb) {
                f32x16 acc;
#pragma unroll
                for (int i = 0; i < 16; ++i) acc[i] = 0.f;
#pragma unroll
                for (int s = 0; s < 4; ++s) acc = __builtin_amdgcn_mfma_f32_32x32x16_bf16(Af[rb][s], Bf[s], acc, 0, 0, 0);
#pragma unroll
                for (int j = 0; j < 4; ++j) { const int q = rb * 4 + j; const f32x4 w4 = *(const f32x4*)(wis + q * 8 + 4 * g);
                    float sp = fmaxf(acc[4 * j], 0.f) * w4[0] + fmaxf(acc[4 * j + 1], 0.f) * w4[1] + fmaxf(acc[4 * j + 2], 0.f) * w4[2] + fmaxf(acc[4 * j + 3], 0.f) * w4[3];
                    sp += __shfl_xor(sp, 32);
                    if (g == 0) sc[q * 2048 + kt * 32 + c32] = sp; }
            }
        }
    }
    __syncthreads();
    lane = fresh_tid(WV) & 63;
    for (int qq = 0; qq < 2; ++qq) {
        const int q = wave * 2 + qq; unsigned short* sq = sel + q * 256;
        if (limit <= 256 || !(parts & 2)) { for (int j = lane; j < nsel; j += 64) sq[j] = (unsigned short)j; }
        else if (limit <= 512) select256<8>(sc + q * 2048, limit, sq, lane);
        else if (limit <= 1024) select256<16>(sc + q * 2048, limit, sq, lane);
        else if (limit <= 1536) select256<24>(sc + q * 2048, limit, sq, lane);
        else select256<32>(sc + q * 2048, limit, sq, lane);
    }
    __syncthreads();
    lane = fresh_tid(WV) & 63;
    float* Pw = (float*)lds + wave * 2048;
    const int g4 = lane >> 4, hh = lane & 15;
#pragma unroll 1
    for (int qq = 0; qq < 2; ++qq) {
        const int q = wave * 2 + qq; const size_t row = (size_t)(row0 + q); const unsigned short* sq = sel + q * 256;
        bf16x8 Qf[4];
#pragma unroll
        for (int s = 0; s < 4; ++s) Qf[s] = *(const bf16x8*)(ocat + row * 2048 + (hh & 7) * 128 + g4 * 8 + s * 32);
        float lg[16][4];
        { bf16_t* Ks = (bf16_t*)(lds + wave * 10752);
          const bf16_t* Kb = Kn + (size_t)b * 2048 * 128 + hh * 8;
          u32x4 kq[8], kn_[8];
#pragma unroll
          for (int jj = 0; jj < 8; ++jj) { kn_[jj] = (u32x4){0u, 0u, 0u, 0u}; const int idx = sq[jj * 4 + g4]; kq[jj] = *(const u32x4*)(Kb + (size_t)idx * 128); }
#define QK_BATCH(bt) do { if ((bt) * 32 < nsel) { \
            if (((bt) + 1) * 32 < nsel) { _Pragma("unroll") for (int jj = 0; jj < 8; ++jj) { const int idx = sq[((bt) + 1) * 32 + jj * 4 + g4]; kn_[jj] = *(const u32x4*)(Kb + (size_t)idx * 128); } } \
            _Pragma("unroll") for (int jj = 0; jj < 8; ++jj) *(u32x4*)(Ks + (jj * 4 + g4) * 136 + hh * 8) = kq[jj]; \
            LDS_FENCE(); \
            _Pragma("unroll") for (int kbl = 0; kbl < 2; ++kbl) { f32x4 c = {0.f, 0.f, 0.f, 0.f}; \
                _Pragma("unroll") for (int s = 0; s < 4; ++s) c = __builtin_amdgcn_mfma_f32_16x16x32_bf16(*(const bf16x8*)(Ks + (kbl * 16 + hh) * 136 + g4 * 8 + s * 32), Qf[s], c, 0, 0, 0); \
                _Pragma("unroll") for (int r = 0; r < 4; ++r) lg[2 * (bt) + kbl][r] = c[r] * 0.08838834764831845f; } \
            LDS_FENCE(); \
            _Pragma("unroll") for (int jj = 0; jj < 8; ++jj) kq[jj] = kn_[jj]; \
          } else { _Pragma("unroll") for (int kbl = 0; kbl < 2; ++kbl) _Pragma("unroll") for (int r = 0; r < 4; ++r) lg[2 * (bt) + kbl][r] = -1e30f; } } while (0)
          QK_BATCH(0); QK_BATCH(1); QK_BATCH(2); QK_BATCH(3); QK_BATCH(4); QK_BATCH(5); QK_BATCH(6); QK_BATCH(7);
#undef QK_BATCH
        }
        float mx = -1e30f;
#pragma unroll
        for (int kb = 0; kb < 16; ++kb)
#pragma unroll
            for (int r = 0; r < 4; ++r) mx = fmaxf(mx, lg[kb][r]);
        mx = fmaxf(mx, __shfl_xor(mx, 16)); mx = fmaxf(mx, __shfl_xor(mx, 32));
        float sum = 0.f;
#pragma unroll
        for (int kb = 0; kb < 16; ++kb)
#pragma unroll
            for (int r = 0; r < 4; ++r) { const float e = (kb * 16 < nsel) ? __expf(lg[kb][r] - mx) : 0.f; lg[kb][r] = e; sum += e; }
        sum += __shfl_xor(sum, 16); sum += __shfl_xor(sum, 32);
        const float inv = 1.f / sum;
        bf16x8 Pa[8];
#pragma unroll
        for (int ks = 0; ks < 8; ++ks) {
            const unsigned a0 = pk2(lg[2 * ks][0] * inv, lg[2 * ks][1] * inv), a1 = pk2(lg[2 * ks][2] * inv, lg[2 * ks][3] * inv);
            const unsigned a2 = pk2(lg[2 * ks + 1][0] * inv, lg[2 * ks + 1][1] * inv), a3 = pk2(lg[2 * ks + 1][2] * inv, lg[2 * ks + 1][3] * inv);
            const u32x4 t_ = {a0, a1, a2, a3}; Pa[ks] = __builtin_bit_cast(bf16x8, t_); }
        bf16_t* Vs = (bf16_t*)(lds + wave * 10752);
        bf16_t* Os = Vs + 32 * 136;
        f32x4 oacc[8];
#pragma unroll
        for (int nb = 0; nb < 8; ++nb) oacc[nb] = (f32x4){0.f, 0.f, 0.f, 0.f};
        const bf16_t* Vb = V + (size_t)b * 2048 * 128 + hh * 8;
        u32x4 vq[8], vn[8];
#pragma unroll
        for (int jj = 0; jj < 8; ++jj) vn[jj] = (u32x4){0u, 0u, 0u, 0u};
#pragma unroll
        for (int jj = 0; jj < 8; ++jj) { const int idx = sq[jj * 4 + g4]; vq[jj] = *(const u32x4*)(Vb + (size_t)idx * 128); }
#define PV_BATCH(bt) do { if ((bt) * 32 < nsel) { \
            if (((bt) + 1) * 32 < nsel) { _Pragma("unroll") for (int jj = 0; jj < 8; ++jj) { const int idx = sq[((bt) + 1) * 32 + jj * 4 + g4]; vn[jj] = *(const u32x4*)(Vb + (size_t)idx * 128); } } \
            _Pragma("unroll") for (int jj = 0; jj < 8; ++jj) *(u32x4*)(Vs + (jj * 4 + g4) * 136 + hh * 8) = vq[jj]; \
            LDS_FENCE(); \
            _Pragma("unroll") for (int nb = 0; nb < 8; ++nb) { const bf16_t* vp = Vs + (4 * g4) * 136 + nb * 16 + hh; \
                const unsigned w0_ = (unsigned)vp[0 * 136] | ((unsigned)vp[1 * 136] << 16), w1_ = (unsigned)vp[2 * 136] | ((unsigned)vp[3 * 136] << 16); \
                const unsigned w2_ = (unsigned)vp[16 * 136] | ((unsigned)vp[17 * 136] << 16), w3_ = (unsigned)vp[18 * 136] | ((unsigned)vp[19 * 136] << 16); \
                const u32x4 t_ = {w0_, w1_, w2_, w3_}; \
                oacc[nb] = __builtin_amdgcn_mfma_f32_16x16x32_bf16(Pa[(bt)], __builtin_bit_cast(bf16x8, t_), oacc[nb], 0, 0, 0); } \
            LDS_FENCE(); \
            _Pragma("unroll") for (int jj = 0; jj < 8; ++jj) vq[jj] = vn[jj]; } } while (0)
        PV_BATCH(0); PV_BATCH(1); PV_BATCH(2); PV_BATCH(3); PV_BATCH(4); PV_BATCH(5); PV_BATCH(6); PV_BATCH(7);
#undef PV_BATCH
        if (g4 < 2) {
#pragma unroll
            for (int nb = 0; nb < 8; ++nb)
#pragma unroll
                for (int r = 0; r < 4; ++r) Os[(g4 * 4 + r) * 128 + nb * 16 + hh] = (bf16_t)f2bf(oacc[nb][r]);
        }
        LDS_FENCE();
#pragma unroll
        for (int h = 0; h < 2; ++h) { const uint4 ov = *(const uint4*)(Os + h * 512 + lane * 8); *(uint4*)(obase + row * ostride + h * 512 + lane * 8) = ov; }
        LDS_FENCE();
    }
}

__device__ __forceinline__ void phase_fix(const Args& a, int l, const int WV) {
    const int TI = fresh_tid(WV);
    const float* SA = (const float*)(a.ws + WS_SA); const float* SB = (const float*)(a.ws + WS_SB); bf16_t* act = (bf16_t*)(a.ws + WS_R2);
    const float* cw = a.in[I_CONVW] + (size_t)l * 3 * DFF; const float* cb = a.in[I_CONVB] + (size_t)l * DFF;
    const int total = 512 * 2 * DFF;
    for (int i = blockIdx.x * 512 + TI; i < total; i += gridDim.x * 512) {
        const int ch = i % DFF, rb = i / DFF, rr = rb & 1, blk = rb >> 1, r = blk * 64 + rr, t = r & 2047;
        const float a0 = SA[((size_t)blk * 4 + 2 + rr) * DFF + ch];
        float am1, am2;
        if (rr == 0) { am1 = (t >= 1) ? SA[((size_t)(blk - 1) * 4 + 1) * DFF + ch] : 0.f; am2 = (t >= 2) ? SA[((size_t)(blk - 1) * 4 + 0) * DFF + ch] : 0.f; }
        else { am1 = SA[((size_t)blk * 4 + 2) * DFF + ch]; am2 = (t >= 2) ? SA[((size_t)(blk - 1) * 4 + 1) * DFF + ch] : 0.f; }
        const float cv = cb[ch] + cw[ch] * am2 + cw[DFF + ch] * am1 + cw[2 * DFF + ch] * a0;
        act[(size_t)r * DFF + ch] = (bf16_t)f2bf(siluf_(cv) * SB[((size_t)blk * 2 + rr) * DFF + ch]);
    }
}

__device__ __forceinline__ void run_phase(const Args& a, int ph, unsigned char* lds, const int WV, const bool dummy) {
    unsigned char* ws = a.ws;
    LAS unsigned char* ldsl = (LAS unsigned char*)lds;
    const int G = gridDim.x, bx = blockIdx.x;
#ifndef DBG_NOADA
    if (ph == 0) { phase_ada(a, lds, WV); return; }
#else
    if (ph == 0) return;
#endif
    const int l = (ph - 1) / 10, sp = (ph - 1) % 10;
    const float* modl = (const float*)(ws + WS_MOD) + (size_t)l * 16 * 12288;
    const float* xin = (l == 0) ? a.in[I_X] : a.out;
#ifdef DBG_SP
    if (sp != DBG_SP) return;
#endif
    switch (sp) {
    case 0: phase_cvt(a, l, lds, WV); phase_norm(xin, a.in[I_GN1] + l * DM, modl, 0, 2048, (bf16_t*)(ws + WS_R1), WV); break;
    case 1: {
        pg8::Gemm g{(const bf16_t*)(ws + WS_R1), (const bf16_t*)(ws + W_1CAT), MROWS, N1, DM, DM, DM, 1 << 30, 0}; pg8::StaticOrder S; S.init(MROWS, N1, G, bx);
        Epi1 E{(bf16_t*)(ws + WS_OCAT), (bf16_t*)(ws + WS_KN), (bf16_t*)(ws + WS_V), (bf16_t*)(ws + WS_QI), (bf16_t*)(ws + WS_KI), (bf16_t*)(ws + WS_U), (bf16_t*)(ws + WS_P), (bf16_t*)(ws + WS_R2),
               (float*)(ws + WS_WI), a.in[I_BGATE] + (size_t)l * 3 * DM, ldsl + 131072};
        pg8::gemm_phase<Epi1, pg8::StaticOrder>(ldsl, g, S, E, WV); } break;
    case 2:
        if (!dummy) phase_post(a, l, lds, WV);
        __syncthreads();
        for (int u = bx; u < 512; u += G) s5_unit(a, l, u >> 5, u & 31, lds, WV);
        for (int u = bx; u < 512; u += G) pool_unit(a, u >> 5, u & 31, lds, WV);
        break;
    case 3: {
#ifndef DBG_NO_DSA
#ifdef DSA_PROBE
        for (int rep = 0; rep < 2; ++rep) { const bool dm = (rep == 0); const int parts = dm ? (DSA_PROBE) : 15;
#else
        { const bool dm = dummy; const int parts = 15;
#endif
            for (int u = bx; u < 2048; u += G) { const int w = u & 255, i = u >> 8, b = w & 15, s = w >> 4; const int tq = (i & 1) ? (i * 16 + 15 - s) : (i * 16 + s);
                dsa_unit(a, b, tq, lds, WV, dm ? (bf16_t*)(ws + WS_R1 + 64 * MiB) : (bf16_t*)(ws + WS_OCAT), dm ? 1024 : 2048, parts); }
        }
        __syncthreads();
#endif
#ifndef DBG_DSA_ONLY
        { pg8::Gemm g{(const bf16_t*)(ws + WS_Y), (const bf16_t*)(ws + W_GLU), MROWS, 1024, 512, 512, 512, 2, WS_POOLED - WS_Y}; pg8::StaticOrder S; S.init(MROWS, 1024, G, bx);
          EpiGluPool E{(const bf16_t*)(ws + WS_Y), a.in[I_PSCALE] + l * 512, (bf16_t*)(ws + WS_OCAT)}; pg8::gemm_phase<EpiGluPool, pg8::StaticOrder>(ldsl, g, S, E, WV); }
#endif
        } break;
    case 4: {
        pg8::Gemm g{(const bf16_t*)(ws + WS_OCAT), (const bf16_t*)(ws + W_P), MROWS, DM, DM, DM, DM, 1 << 30, 0}; pg8::StaticOrder S; S.init(MROWS, DM, G, bx);
        EpiMerge E{(const bf16_t*)(ws + WS_R2), (bf16_t*)(ws + WS_R1), ldsl + 131072}; pg8::gemm_phase<EpiMerge, pg8::StaticOrder>(ldsl, g, S, E, WV); } break;
    case 5: {
        pg8::Gemm g{(const bf16_t*)(ws + WS_R1), (const bf16_t*)(ws + W_OUT), MROWS, DM, DM, DM, DM, 1 << 30, 0}; pg8::StaticOrder S; S.init(MROWS, DM, G, bx);
        EpiRes E{xin, dummy ? (float*)(ws + WS_OCAT) : a.out, modl + 4096}; pg8::gemm_phase<EpiRes, pg8::StaticOrder>(ldsl, g, S, E, WV); } break;
    case 6: phase_norm(a.out, a.in[I_GN2] + l * DM, modl, 6144, 8192, (bf16_t*)(ws + WS_R1), WV); break;
    case 7: {
        pg8::Gemm g{(const bf16_t*)(ws + WS_R1), (const bf16_t*)(ws + W_UP), MROWS, 2 * DFF, DM, DM, DM, 1 << 30, 0}; pg8::StaticOrder S; S.init(MROWS, 2 * DFF, G, bx);
        EpiUp E{(bf16_t*)(ws + WS_R2), (float*)(ws + WS_SA), (float*)(ws + WS_SB), a.in[I_CONVW] + (size_t)l * 3 * DFF, a.in[I_CONVB] + (size_t)l * DFF, ldsl + 131072};
        pg8::gemm_phase<EpiUp, pg8::StaticOrder>(ldsl, g, S, E, WV); } break;
    case 8: phase_fix(a, l, WV); break;
    case 9: {
        pg8::Gemm g{(const bf16_t*)(ws + WS_R2), (const bf16_t*)(ws + W_DOWN), MROWS, DM, DFF, DFF, DFF, 1 << 30, 0}; pg8::StaticOrder S; S.init(MROWS, DM, G, bx);
        EpiRes E{a.out, dummy ? (float*)(ws + WS_OCAT) : a.out, modl + 10240}; pg8::gemm_phase<EpiRes, pg8::StaticOrder>(ldsl, g, S, E, WV); } break;
    }
}

#define XB_XCNT(j)  (256  + 64 * (j))
#define XB_XSUB(j)  (1280 + 64 * (j))
#define XB_XGEN(j)  (2304 + 64 * (j))
#define XB_TOP      3328
#define XB_TOPGEN   3392
#define XB_WORDS    3456
__device__ __forceinline__ unsigned xb_ld(unsigned* p)              { return __hip_atomic_load(p, __ATOMIC_RELAXED, __HIP_MEMORY_SCOPE_AGENT); }
__device__ __forceinline__ unsigned xb_add(unsigned* p, unsigned v) { return __hip_atomic_fetch_add(p, v, __ATOMIC_RELAXED, __HIP_MEMORY_SCOPE_AGENT); }
__device__ __forceinline__ unsigned xb_xcc_id() { return (unsigned)__builtin_amdgcn_s_getreg((3 << 11) | 20) & 0xFu; }
#define XB_SPIN(cond) do { unsigned _sp = 0; while (cond) { __builtin_amdgcn_s_sleep(1); if (++_sp > (1u << 22)) break; } } while (0)
__device__ __forceinline__ void grid_bar(unsigned* bar, volatile LAS unsigned* st, int wave_id) {
    asm volatile("s_waitcnt vmcnt(0) lgkmcnt(0)" ::: "memory");
    __syncthreads();
    if (wave_id == 0) {
        const int l = (int)__builtin_amdgcn_mbcnt_hi(~0u, __builtin_amdgcn_mbcnt_lo(~0u, 0u));
        if (l == 0) {
            const unsigned x = xb_xcc_id();
            unsigned nloc = st[0], nx = st[1];
            if (nloc == 0u) {
                const unsigned G = gridDim.x; unsigned sum, cnt, mine, sp = 0u;
                for (;;) { sum = 0u; cnt = 0u; mine = 0u;
#pragma unroll
                    for (unsigned j = 0; j < 16; ++j) { const unsigned c = xb_ld(&bar[XB_XCNT(j)]); sum += c; cnt += (c > 0u) ? 1u : 0u; mine = (j == x) ? c : mine; }
                    if (sum == G) break;
                    __builtin_amdgcn_s_sleep(1); if (++sp > (1u << 22)) break; }
                nloc = mine > 0u ? mine : 1u; nx = cnt > 0u ? cnt : 1u; st[0] = nloc; st[1] = nx;
            }
            const unsigned old = xb_add(&bar[XB_XSUB(x)], 1u);
            const unsigned gen = old / nloc;
            if (old + 1u == (gen + 1u) * nloc) {
                __builtin_amdgcn_fence(__ATOMIC_RELEASE, "agent");
                asm volatile("s_waitcnt vmcnt(0)" ::: "memory");
                const unsigned og = xb_add(&bar[XB_TOP], 1u);
                const unsigned tg = og / nx;
                if (og + 1u == (tg + 1u) * nx) xb_add(&bar[XB_TOPGEN], 1u);
                else XB_SPIN(xb_ld(&bar[XB_TOPGEN]) == tg);
                __builtin_amdgcn_fence(__ATOMIC_ACQUIRE, "agent");
                xb_add(&bar[XB_XGEN(x)], 1u);
                asm volatile("s_waitcnt vmcnt(0)" ::: "memory");
            } else {
                XB_SPIN(xb_ld(&bar[XB_XGEN(x)]) == gen);
                __builtin_amdgcn_fence(__ATOMIC_ACQUIRE, "agent");
                asm volatile("s_waitcnt vmcnt(0)" ::: "memory");
            }
        }
    }
    __syncthreads();
}

__global__ void __launch_bounds__(512, 2) mega_fwd(Args a) {
    extern __shared__ __attribute__((aligned(16))) unsigned char lds[];
    cg::grid_group grid = cg::this_grid();
    const int wave_id = __builtin_amdgcn_readfirstlane((int)(threadIdx.x >> 6));
    const int ph_lo = a.ph_lo, ph_hi = a.ph_hi;
    volatile LAS unsigned* xst = (volatile LAS unsigned*)((LAS unsigned char*)lds + 163776);
    if (threadIdx.x == 0) { xst[0] = 0u; xst[1] = 0u; (void)xb_add((unsigned*)(__attribute__((address_space(1))) unsigned*)a.ws + XB_XCNT(xb_xcc_id()), 1u); }
    __syncthreads();
    for (int ph = ph_lo; ph < ph_hi; ++ph) {
        const __attribute__((address_space(4))) Args* kp = (const __attribute__((address_space(4))) Args*)__builtin_amdgcn_kernarg_segment_ptr();
        asm volatile("" : "+s"(kp));
        Args la;
#pragma unroll
        for (int i = 0; i < 31; ++i) la.in[i] = (const float*)(const __attribute__((address_space(1))) float*)kp->in[i];
        la.ws = (unsigned char*)(__attribute__((address_space(1))) unsigned char*)kp->ws;
        la.out = (float*)(__attribute__((address_space(1))) float*)kp->out;
        la.ph_lo = ph_lo; la.ph_hi = ph_hi;
#ifdef REP_MASK
        if (ph > 0 && ((REP_MASK >> ((ph - 1) % 10)) & 1)) { run_phase(la, ph, lds, wave_id, true); grid.sync(); }
#endif
        run_phase(la, ph, lds, wave_id, false);
        if (ph + 1 < ph_hi) {
            if (ph_hi < 0) grid.sync();
            else grid_bar((unsigned*)la.ws, xst, wave_id);
        }
    }
}

extern "C" void kernel_launch(void* const* d_in, const int* in_sizes, int n_in, void* d_out, int out_size, void* d_ws, size_t ws_size, hipStream_t stream) {
    static int grid = 0;
    if (grid == 0) {
        int dev = 0, cus = 0, per_cu = 0;
        if (n_in != 31 || ws_size < WS_END) { fprintf(stderr, "kernel_launch: unexpected n_in %d / ws %zu\n", n_in, ws_size); grid = -1; return; }
        hipGetDevice(&dev); hipDeviceGetAttribute(&cus, hipDeviceAttributeMultiprocessorCount, dev);
        if (hipFuncSetAttribute((const void*)mega_fwd, hipFuncAttributeMaxDynamicSharedMemorySize, LDS_BYTES) != hipSuccess) { fprintf(stderr, "kernel_launch: hipFuncSetAttribute failed\n"); grid = -1; return; }
        if (hipOccupancyMaxActiveBlocksPerMultiprocessor(&per_cu, (const void*)mega_fwd, 512, LDS_BYTES) != hipSuccess || per_cu < 1) { fprintf(stderr, "kernel_launch: occupancy query says %d blocks/CU\n", per_cu); per_cu = 1; }
        (void)hipGetLastError();
        grid = cus > 0 ? cus : 256;
    }
    if (grid < 0) return;
    if (hipMemsetAsync(d_ws, 0, 16384, stream) != hipSuccess) { fprintf(stderr, "kernel_launch: memset of the barrier word failed\n"); return; }
    Args a{};
    for (int i = 0; i < 31; ++i) a.in[i] = (const float*)d_in[i];
    a.out = (float*)d_out; a.ws = (unsigned char*)d_ws;
#if MK_PER_PHASE
    for (int ph = 0; ph < NPHASE; ++ph) {
        a.ph_lo = ph; a.ph_hi = ph + 1;
        void* args[] = {&a};
        hipError_t e = hipLaunchCooperativeKernel((const void*)mega_fwd, dim3(grid), dim3(512), args, LDS_BYTES, stream);
        if (e != hipSuccess) { fprintf(stderr, "kernel_launch: launch of phase %d failed: %s\n", ph, hipGetErrorString(e)); break; }
    }
#else
    a.ph_lo = 0; a.ph_hi = NPHASE;
    void* args[] = {&a};
    hipError_t e = hipLaunchCooperativeKernel((const void*)mega_fwd, dim3(grid), dim3(512), args, LDS_BYTES, stream);
    if (e != hipSuccess) fprintf(stderr, "kernel_launch: cooperative launch failed: %s (grid %d)\n", hipGetErrorString(e), grid);
#endif
}
```

```cpp
#include <hip/hip_runtime.h>
#include <hip/hip_cooperative_groups.h>
#include <cstdio>
#include <cstdint>
namespace cg = cooperative_groups;

#ifndef MK_PER_PHASE
#define MK_PER_PHASE 0
#endif

typedef unsigned short bf16_t;
typedef short bf16x8 __attribute__((ext_vector_type(8)));
typedef float f32x4 __attribute__((ext_vector_type(4)));
typedef float f32x2 __attribute__((ext_vector_type(2)));
typedef float f32x16 __attribute__((ext_vector_type(16)));
typedef unsigned u32x4 __attribute__((ext_vector_type(4)));
typedef unsigned u32x2 __attribute__((ext_vector_type(2)));
#define LAS __attribute__((address_space(3)))

constexpr int BATCH = 16, SEQ = 2048, DM = 2048, MROWS = BATCH * SEQ, DIN = 2888, DFF = 5504;
constexpr int N1 = 9216;
constexpr float EPS = 1e-6f;
constexpr int NPHASE = 21;

constexpr size_t MiB = 1u << 20;
constexpr size_t WS_MOD = 1 * MiB;
constexpr size_t WS_WI = 3 * MiB;
constexpr size_t WS_W = 4 * MiB;
constexpr size_t W_1CAT = WS_W, W_P = WS_W + 36 * MiB, W_OUT = WS_W + 44 * MiB, W_UP = WS_W + 52 * MiB, W_DOWN = WS_W + 95 * MiB,
                 W_GLU = WS_W + 116 * MiB + MiB / 2, W_POOL = WS_W + 117 * MiB;
constexpr size_t WS_R1 = 122 * MiB;
constexpr size_t WS_Y = WS_R1, WS_POOLED = WS_R1 + 32 * MiB;
constexpr size_t WS_R2 = 250 * MiB;
constexpr size_t WS_OCAT = 634 * MiB;
constexpr size_t WS_SA = WS_OCAT, WS_SB = WS_OCAT + 44 * MiB;
constexpr size_t WS_KN = 762 * MiB, WS_V = 770 * MiB, WS_QI = 778 * MiB, WS_KI = 810 * MiB, WS_U = 814 * MiB, WS_P = 846 * MiB, WS_END = 878 * MiB;
constexpr int LDS_BYTES = 163840;

__device__ __forceinline__ unsigned f2bf(float f) { unsigned u = __float_as_uint(f); return (u + 0x7fffu + ((u >> 16) & 1u)) >> 16; }
__device__ __forceinline__ unsigned pk2(float lo, float hi) { unsigned r; asm("v_cvt_pk_bf16_f32 %0, %1, %2" : "=v"(r) : "v"(lo), "v"(hi)); return r; }
__device__ __forceinline__ float bflo(unsigned u) { return __uint_as_float(u << 16); }
__device__ __forceinline__ float bfhi(unsigned u) { return __uint_as_float(u & 0xffff0000u); }
__device__ __forceinline__ float bf1(bf16_t b) { return __uint_as_float(((unsigned)b) << 16); }
__device__ __forceinline__ float sigmoidf_(float x) { return __builtin_amdgcn_rcpf(1.f + __expf(-x)); }
__device__ __forceinline__ float siluf_(float x) { return x * __builtin_amdgcn_rcpf(1.f + __expf(-x)); }
__device__ __forceinline__ float dpp_ror1(float v) { return __builtin_bit_cast(float, __builtin_amdgcn_update_dpp(0, __builtin_bit_cast(int, v), 0x121, 0xf, 0xf, false)); }
__device__ __forceinline__ float dpp_ror2(float v) { return __builtin_bit_cast(float, __builtin_amdgcn_update_dpp(0, __builtin_bit_cast(int, v), 0x122, 0xf, 0xf, false)); }
__device__ __forceinline__ float gelu_tanh(float x) { const float z = 0.7978845608028654f * (x + 0.044715f * x * x * x); const float t = 1.f - 2.f * __builtin_amdgcn_rcpf(1.f + __expf(2.f * z)); return 0.5f * x * (1.f + t); }
__device__ __forceinline__ uint4 pack8(f32x4 a, f32x4 b) { uint4 r; r.x = pk2(a[0], a[1]); r.y = pk2(a[2], a[3]); r.z = pk2(b[0], b[1]); r.w = pk2(b[2], b[3]); return r; }
__device__ __forceinline__ void unpack8(uint4 v, float* f) { f[0] = bflo(v.x); f[1] = bfhi(v.x); f[2] = bflo(v.y); f[3] = bfhi(v.y); f[4] = bflo(v.z); f[5] = bfhi(v.z); f[6] = bflo(v.w); f[7] = bfhi(v.w); }
#define LDS_FENCE() asm volatile("s_waitcnt lgkmcnt(0)" ::: "memory")
__device__ __forceinline__ int fresh_tid(int wv) { int l = (int)__builtin_amdgcn_mbcnt_hi(~0u, __builtin_amdgcn_mbcnt_lo(~0u, 0u)); asm volatile("" : "+v"(l)); return (wv << 6) | l; }

namespace pg8 {
constexpr int BM = 256, BK = 64, HALF = 128, HTB = HALF * BK * 2, STAGE_BYTES = 8 * HTB, NXCD = 8, WGM = 4;
__host__ __device__ __forceinline__ int lds_byte(int r, int c) { const int st = (r >> 4) * 2 + (c >> 5), rr = r & 15, cc = c & 31, ob = rr * 64 + cc * 2; return st * 1024 + (ob ^ (((ob >> 9) & 1) << 5)); }
__host__ __device__ __forceinline__ void stage_rc(int b, int& R, int& C) { const int st = b / 1024, sb = b % 1024, swz = sb ^ (((sb >> 9) & 1) << 5); R = (st >> 1) * 16 + swz / 64; C = (st & 1) * 32 + (swz % 64) / 2; }
__host__ __device__ __forceinline__ int perm32(int rho) { const int n = rho >> 4, i = rho & 15; return 8 * (i >> 2) + 4 * n + (i & 3); }
struct Unit { int pm, pn; };
struct Gemm { const bf16_t* A; const bf16_t* Bt; int M, N, K, lda, ldb; int asplit; size_t aoff; };
struct StaticOrder {
    int nM, nN, nwg, G, c;
    __device__ void init(int M, int N, int G_, int c_) { nM = M / BM; nN = N / BM; nwg = nM * nN; G = G_; c = c_; }
    __device__ bool next(int i, Unit& u) const {
        const long L = (long)i * G + c; if (L >= nwg) return false;
        int wgid = (int)L; { const int q = nwg / NXCD, r = nwg % NXCD, xcd = wgid % NXCD, off = wgid / NXCD; wgid = (xcd < r ? xcd * (q + 1) : r * (q + 1) + (xcd - r) * q) + off; }
        const int nig = WGM * nN, gid = wgid / nig, fm = gid * WGM, gsz = (nM - fm) < WGM ? (nM - fm) : WGM;
        u.pm = fm + ((wgid % nig) % gsz); u.pn = (wgid % nig) / gsz; return true;
    }
};
template <class Epi, class Sched>
__device__ __forceinline__ void gemm_phase(LAS unsigned char* lds, const Gemm g, const Sched& S, const Epi& E, const int WV) {
    const int TI = fresh_tid(WV);
    const int tid = TI, wid = __builtin_amdgcn_readfirstlane(tid >> 6), lane = tid & 63, wr = wid >> 2, wc = wid & 3, fr = lane & 15, fq = lane >> 4;
    const int K = g.K, nt = K / BK;
    unsigned voffA[2], voffB[2];
#pragma unroll
    for (int i = 0; i < 2; ++i) { int R, C; stage_rc(tid * 16 + i * 8192, R, C); const int Rb = Epi::PERM ? ((R & ~31) + perm32(R & 31)) : R;
        voffA[i] = (unsigned)(R * g.lda + C) * 2u; voffB[i] = (unsigned)(Rb * g.ldb + C) * 2u; }
    const size_t kstep = (size_t)(BK * 2);
    const size_t hstepA = (size_t)HALF * g.lda * 2, hstepB = (size_t)HALF * g.ldb * 2;
    const size_t tstepA = 2 * hstepA, tstepB = 2 * hstepB;
    const unsigned ldsw = (unsigned)wid * 1024u;
    const int aoff = lds_byte(wr * 64 + fr, fq * 8), boff = lds_byte(wc * 32 + fr, fq * 8);
#define PG8_SA(b, h) (((b) * 2 + (h)) * HTB)
#define PG8_SB(b, h) ((4 + (b) * 2 + (h)) * HTB)
#define PG8_STAGE(bufoff, gbase, voff) do { _Pragma("unroll") for (int _i = 0; _i < 2; ++_i) \
        __builtin_amdgcn_global_load_lds((const unsigned*)((const char*)(gbase) + (voff)[_i]), (LAS unsigned*)(lds + (bufoff) + ldsw + _i * 8192), 16, 0, 0); } while (0)
#define PG8_LDA(dst, b, h) do { _Pragma("unroll") for (int m = 0; m < 4; ++m) _Pragma("unroll") for (int k = 0; k < 2; ++k) dst[m][k] = *(const LAS bf16x8*)(lds + PG8_SA(b, h) + aoff + m * 2048 + k * 1024); } while (0)
#define PG8_LDB(dst, b, h) do { _Pragma("unroll") for (int n = 0; n < 2; ++n) _Pragma("unroll") for (int k = 0; k < 2; ++k) dst[n][k] = *(const LAS bf16x8*)(lds + PG8_SB(b, h) + boff + n * 2048 + k * 1024); } while (0)
#define PG8_MMA(ai, bj, At, Bt) do { __builtin_amdgcn_s_setprio(1); _Pragma("unroll") for (int m = 0; m < 4; ++m) _Pragma("unroll") for (int n = 0; n < 2; ++n) _Pragma("unroll") for (int k = 0; k < 2; ++k) \
        acc[ai][bj][m][n] = __builtin_amdgcn_mfma_f32_16x16x32_bf16(Bt[n][k], At[m][k], acc[ai][bj][m][n], 0, 0, 0); __builtin_amdgcn_s_setprio(0); } while (0)
#define PG8_WAIT_V(n) asm volatile("s_waitcnt vmcnt(" #n ")" ::: "memory")
#define PG8_WAIT_L(n) asm volatile("s_waitcnt lgkmcnt(" #n ")" ::: "memory")
#define PG8_BAR __builtin_amdgcn_s_barrier()
#define PG8_SCHED __builtin_amdgcn_sched_barrier(0)
#define PG8_ZERO() do { _Pragma("unroll") for (int a_ = 0; a_ < 2; ++a_) _Pragma("unroll") for (int b_ = 0; b_ < 2; ++b_) _Pragma("unroll") for (int m_ = 0; m_ < 4; ++m_) _Pragma("unroll") for (int n_ = 0; n_ < 2; ++n_) acc[a_][b_][m_][n_] = (f32x4){0.f, 0.f, 0.f, 0.f}; } while (0)
    Unit cur, nxt; int ui = 0;
    if (!S.next(0, cur)) return;
    f32x4 acc[2][2][4][2];
    PG8_ZERO();
    bf16x8 At[4][2], B0[2][2], B1[2][2];
    const char* cA = (const char*)g.A + (size_t)cur.pm * tstepA + (cur.pn >= g.asplit ? g.aoff : (size_t)0); const char* cB = (const char*)g.Bt + (size_t)cur.pn * tstepB;
    PG8_STAGE(PG8_SB(0, 0), cB, voffB); PG8_STAGE(PG8_SB(0, 1), cB + hstepB, voffB); PG8_STAGE(PG8_SA(0, 0), cA, voffA); PG8_STAGE(PG8_SA(0, 1), cA + hstepA, voffA);
    if (wr == 1) PG8_BAR;
    PG8_WAIT_V(2); PG8_BAR;
    PG8_STAGE(PG8_SB(1, 0), cB + kstep, voffB); PG8_STAGE(PG8_SA(1, 0), cA + kstep, voffA); PG8_STAGE(PG8_SB(1, 1), cB + hstepB + kstep, voffB);
    PG8_WAIT_V(6); PG8_BAR;
    for (;;) {
        const bool has_next = S.next(ui + 1, nxt);
        const char* nA = has_next ? (const char*)g.A + (size_t)nxt.pm * tstepA + (nxt.pn >= g.asplit ? g.aoff : (size_t)0) : cA; const char* nB = has_next ? (const char*)g.Bt + (size_t)nxt.pn * tstepB : cB;
        for (int t = 0; t < nt; t += 2) {
            const bool last = (t == nt - 2);
            const char* a1 = cA + (size_t)(t + 1) * kstep;
            const char* a2 = last ? nA : cA + (size_t)(t + 2) * kstep; const char* b2 = last ? nB : cB + (size_t)(t + 2) * kstep;
            const char* a3 = a2 + kstep; const char* b3 = b2 + kstep;
            PG8_LDB(B0, 0, 0); PG8_LDB(B1, 0, 1); PG8_SCHED; PG8_LDA(At, 0, 0); PG8_STAGE(PG8_SA(1, 1), a1 + hstepA, voffA);
            PG8_WAIT_V(8); PG8_WAIT_L(0); PG8_BAR; PG8_MMA(0, 0, At, B0); PG8_MMA(0, 1, At, B1); PG8_BAR; PG8_SCHED;
            PG8_LDA(At, 0, 1); PG8_STAGE(PG8_SB(0, 0), b2, voffB); PG8_STAGE(PG8_SB(0, 1), b2 + hstepB, voffB); PG8_STAGE(PG8_SA(0, 0), a2, voffA);
            PG8_WAIT_V(8); PG8_WAIT_L(0); PG8_BAR; PG8_MMA(1, 0, At, B0); PG8_MMA(1, 1, At, B1); PG8_BAR; PG8_SCHED;
            PG8_LDB(B0, 1, 0); PG8_LDB(B1, 1, 1); PG8_SCHED; PG8_LDA(At, 1, 0); PG8_STAGE(PG8_SA(0, 1), a2 + hstepA, voffA);
            PG8_WAIT_V(8); PG8_WAIT_L(0); PG8_BAR; PG8_MMA(0, 0, At, B0); PG8_MMA(0, 1, At, B1); PG8_BAR; PG8_SCHED;
            PG8_LDA(At, 1, 1); PG8_STAGE(PG8_SB(1, 0), b3, voffB); PG8_STAGE(PG8_SB(1, 1), b3 + hstepB, voffB); PG8_STAGE(PG8_SA(1, 0), a3, voffA);
            PG8_WAIT_V(8); PG8_WAIT_L(0); PG8_BAR; PG8_MMA(1, 0, At, B0); PG8_MMA(1, 1, At, B1); PG8_BAR; PG8_SCHED;
            if constexpr (Epi::SEG) { if (t + 2 == 16 || t + 2 == 24) { E.flush(acc, cur, (t + 2 == 16) ? 0 : 1, wr, wc, fr, fq); PG8_ZERO(); } }
        }
        if (wr == 0) PG8_BAR;
        if constexpr (Epi::SEG) E.flush(acc, cur, 2, wr, wc, fr, fq); else E(acc, cur, wr, wc, fr, fq);
        if (!has_next) break;
        PG8_ZERO();
        cur = nxt; cA = nA; cB = nB; ++ui;
        if (wr == 1) PG8_BAR;
    }
    PG8_WAIT_V(0);
    PG8_BAR;
#undef PG8_SA
#undef PG8_SB
#undef PG8_STAGE
#undef PG8_LDA
#undef PG8_LDB
#undef PG8_MMA
#undef PG8_WAIT_V
#undef PG8_WAIT_L
#undef PG8_BAR
#undef PG8_SCHED
#undef PG8_ZERO
}
}
using pg8::Unit;
typedef const f32x4 (&AccRef)[2][2][4][2];

struct Epi1 {
    static constexpr bool PERM = true, SEG = false;
    bf16_t *ocat, *kn, *vv, *qi, *ki, *u, *p, *gates; float* wi; const float* bgate; LAS unsigned char* stg;
    __device__ __forceinline__ void operator()(AccRef acc, const Unit& un, int wr, int wc, int fr, int fq) const {
        asm volatile("" : "+v"(fr), "+v"(fq));
        const int pn = un.pn, rowb = un.pm * 256 + wr * 64, lane = fq * 16 + fr;
        LAS unsigned char* sb = stg + (wr * 4 + wc) * 2304;
        if (pn == 7 && wc >= 1) {
            if (wc == 1 && fq == 0) {
                const float s = 0.35355339059327373f * 0.125f;
#pragma unroll
                for (int ai = 0; ai < 2; ++ai)
#pragma unroll
                    for (int m = 0; m < 4; ++m) { const size_t row = (size_t)(rowb + ai * 128 + m * 16 + fr);
                        *(f32x4*)(wi + row * 8) = acc[ai][0][m][0] * s; *(f32x4*)(wi + row * 8 + 4) = acc[ai][0][m][1] * s; }
            }
            return;
        }
        if (pn >= 12) {
            const int c0 = (pn - 12) * 256 + 64 * wc;
            f32x4 bz[2][2];
#pragma unroll
            for (int bj = 0; bj < 2; ++bj) { bz[bj][0] = *(const f32x4*)(bgate + c0 + 32 * bj + 8 * fq) * -1.4426950408889634f; bz[bj][1] = *(const f32x4*)(bgate + c0 + 32 * bj + 8 * fq + 4) * -1.4426950408889634f; }
            unsigned char* gb = (unsigned char*)gates + c0;
#pragma unroll
            for (int ai = 0; ai < 2; ++ai)
#pragma unroll
                for (int m = 0; m < 4; ++m) {
#pragma unroll
                    for (int bj = 0; bj < 2; ++bj) { uint2 q; unsigned w[2];
#pragma unroll
                        for (int n = 0; n < 2; ++n) { unsigned t = 0u;
#pragma unroll
                            for (int e = 0; e < 4; ++e) { const float ex_ = __builtin_amdgcn_exp2f(fmaf(acc[ai][bj][m][n][e], -1.4426950408889634f, bz[bj][n][e]));
                                t = __builtin_amdgcn_cvt_pk_u8_f32(__builtin_amdgcn_rcpf(fmaf(ex_, 1.f / 255.f, 1.f / 255.f)), e, t); }
                            w[n] = t; }
                        q.x = w[0]; q.y = w[1];
                        *(LAS u32x2*)(sb + fr * 80 + 32 * bj + 8 * fq) = (u32x2){q.x, q.y}; }
                    LDS_FENCE();
                    { const int r = lane >> 2, sg = lane & 3; const u32x4 v = *(const LAS u32x4*)(sb + r * 80 + sg * 16);
                      *(u32x4*)(gb + (size_t)(rowb + ai * 128 + m * 16 + r) * 6144 + sg * 16) = v; }
                    LDS_FENCE();
                }
            return;
        }
        bf16_t* base; int ld;
        if (pn < 4) { base = ocat + pn * 256 + 64 * wc; ld = 2048; }
        else if (pn == 4) { base = (wc < 2 ? kn : vv) + 64 * (wc & 1); ld = 128; }
        else if (pn < 7) { base = qi + (pn - 5) * 256 + 64 * wc; ld = 512; }
        else if (pn == 7) { base = ki; ld = 64; }
        else if (pn < 10) { base = u + (pn - 8) * 256 + 64 * wc; ld = 512; }
        else { base = p + (pn - 10) * 256 + 64 * wc; ld = 512; }
#pragma unroll
        for (int ai = 0; ai < 2; ++ai)
#pragma unroll
            for (int m = 0; m < 4; ++m) {
#pragma unroll
                for (int bj = 0; bj < 2; ++bj) { const uint4 pk_ = pack8(acc[ai][bj][m][0], acc[ai][bj][m][1]); *(LAS u32x4*)(sb + fr * 144 + 64 * bj + 16 * fq) = (u32x4){pk_.x, pk_.y, pk_.z, pk_.w}; }
                LDS_FENCE();
#pragma unroll
                for (int h = 0; h < 2; ++h) { const int r = h * 8 + (lane >> 3), sg = lane & 7; const u32x4 v = *(const LAS u32x4*)(sb + r * 144 + sg * 16);
                    *(u32x4*)(base + (size_t)(rowb + ai * 128 + m * 16 + r) * ld + sg * 8) = v; }
                LDS_FENCE();
            }
    }
};
struct EpiGluPool {
    static constexpr bool PERM = true, SEG = false;
    const bf16_t* y; const float* scale; bf16_t* ocat;
    __device__ __forceinline__ void operator()(AccRef acc, const Unit& un, int wr, int wc, int fr, int fq) const {
        asm volatile("" : "+v"(fr), "+v"(fq));
        const int row0 = un.pm * 256 + wr * 64 + fr; const bool glu = un.pn < 2;
#pragma unroll
        for (int bj = 0; bj < 2; ++bj) { const int col = (un.pn & 1) * 256 + 64 * wc + 32 * bj + 8 * fq;
            f32x4 s0 = {0.f, 0.f, 0.f, 0.f}, s1 = {0.f, 0.f, 0.f, 0.f};
            if (!glu) { s0 = *(const f32x4*)(scale + col); s1 = *(const f32x4*)(scale + col + 4); }
#pragma unroll
            for (int ai = 0; ai < 2; ++ai) {
                uint4 yq[4];
                if (glu) {
#pragma unroll
                    for (int m = 0; m < 4; ++m) yq[m] = *(const uint4*)(y + (size_t)(row0 + ai * 128 + m * 16) * 512 + col); }
#pragma unroll
                for (int m = 0; m < 4; ++m) { const size_t row = (size_t)(row0 + ai * 128 + m * 16);
                    f32x4 v0 = acc[ai][bj][m][0], v1 = acc[ai][bj][m][1];
                    if (glu) { float yv[8]; unpack8(yq[m], yv);
#pragma unroll
                        for (int e = 0; e < 4; ++e) { v0[e] = yv[e] * sigmoidf_(v0[e]); v1[e] = yv[4 + e] * sigmoidf_(v1[e]); }
                        *(uint4*)(ocat + row * 2048 + 1024 + col) = pack8(v0, v1);
                    } else *(uint4*)(ocat + row * 2048 + 1536 + col) = pack8(v0 * s0, v1 * s1); } } }
    }
};
struct EpiMerge {
    static constexpr bool PERM = true, SEG = true;
    const bf16_t* gates; bf16_t* merged; LAS unsigned char* stg;
    __device__ __forceinline__ void flush(AccRef acc, const Unit& un, int seg, int wr, int wc, int fr, int fq) const {
        asm volatile("" : "+v"(fr), "+v"(fq));
        const int rowb = un.pm * 256 + wr * 64, lane = fq * 16 + fr;
        const int colw = un.pn * 256 + 64 * wc;
        LAS unsigned char* sb = stg + (wr * 4 + wc) * 2304;
#pragma unroll
        for (int ai = 0; ai < 2; ++ai) {
            uint2 gq[2][4]; uint4 pq[2][4];
#pragma unroll
            for (int bj = 0; bj < 2; ++bj)
#pragma unroll
                for (int m = 0; m < 4; ++m) { const size_t row = (size_t)(rowb + ai * 128 + m * 16 + fr); const int col = colw + 32 * bj + 8 * fq;
                    gq[bj][m] = *(const uint2*)((const unsigned char*)gates + row * 6144 + seg * 2048 + col);
                    if (seg > 0) pq[bj][m] = *(const uint4*)(merged + row * 2048 + col); else pq[bj][m] = make_uint4(0u, 0u, 0u, 0u); }
#pragma unroll
            for (int m = 0; m < 4; ++m) {
#pragma unroll
                for (int bj = 0; bj < 2; ++bj) {
                    float gv[8], pv[8]; unpack8(pq[bj][m], pv);
#pragma unroll
                    for (int e = 0; e < 4; ++e) { gv[e] = (float)((gq[bj][m].x >> (8 * e)) & 0xffu) * (1.f / 255.f); gv[4 + e] = (float)((gq[bj][m].y >> (8 * e)) & 0xffu) * (1.f / 255.f); }
                    f32x4 v0 = acc[ai][bj][m][0], v1 = acc[ai][bj][m][1];
#pragma unroll
                    for (int e = 0; e < 4; ++e) { v0[e] = pv[e] + gv[e] * v0[e]; v1[e] = pv[4 + e] + gv[4 + e] * v1[e]; }
                    const uint4 pk_ = pack8(v0, v1); *(LAS u32x4*)(sb + fr * 144 + 64 * bj + 16 * fq) = (u32x4){pk_.x, pk_.y, pk_.z, pk_.w}; }
                LDS_FENCE();
#pragma unroll
                for (int h = 0; h < 2; ++h) { const int r = h * 8 + (lane >> 3), sg = lane & 7; const u32x4 v = *(const LAS u32x4*)(sb + r * 144 + sg * 16);
                    *(u32x4*)(merged + (size_t)(rowb + ai * 128 + m * 16 + r) * 2048 + colw + sg * 8) = v; }
                LDS_FENCE();
            }
        }
    }
};
struct EpiRes {
    static constexpr bool PERM = false, SEG = false;
    const float* xin; float* out; const float* gt;
    __device__ __forceinline__ void operator()(AccRef acc, const Unit& un, int wr, int wc, int fr, int fq) const {
        asm volatile("" : "+v"(fr), "+v"(fq));
        const int row0 = un.pm * 256 + wr * 64 + fr; const float* g = gt + (size_t)(un.pm >> 3) * 12288;
#pragma unroll
        for (int bj = 0; bj < 2; ++bj) { const int col = un.pn * 256 + bj * 128 + wc * 32 + 4 * fq;
            f32x4 gv[2], xv[2][2][4];
#pragma unroll
            for (int n = 0; n < 2; ++n) gv[n] = *(const f32x4*)(g + col + 16 * n);
#pragma unroll
            for (int n = 0; n < 2; ++n)
#pragma unroll
                for (int ai = 0; ai < 2; ++ai)
#pragma unroll
                    for (int m = 0; m < 4; ++m) xv[n][ai][m] = *(const f32x4*)(xin + (size_t)(row0 + ai * 128 + m * 16) * 2048 + col + 16 * n);
#pragma unroll
            for (int n = 0; n < 2; ++n)
#pragma unroll
                for (int ai = 0; ai < 2; ++ai)
#pragma unroll
                    for (int m = 0; m < 4; ++m) *(f32x4*)(out + (size_t)(row0 + ai * 128 + m * 16) * 2048 + col + 16 * n) = xv[n][ai][m] + gv[n] * acc[ai][bj][m][n]; }
    }
};
struct EpiUp {
    static constexpr bool PERM = true, SEG = false;
    bf16_t* act; float* SA; float* SB; const float* cw; const float* cb; LAS unsigned char* stg;
    __device__ __forceinline__ void operator()(AccRef acc, const Unit& un, int wr, int wc, int fr, int fq) const {
        asm volatile("" : "+v"(fr), "+v"(fq));
        const int lg = fq << 4, lane = lg | fr;
        const int src1 = lg | ((fr + 15) & 15), src2 = lg | ((fr + 14) & 15);
        const int ch0 = un.pn * 128 + wc * 32 + 8 * fq;
        LAS unsigned char* sb = stg + (wr * 4 + wc) * 2304;
        f32x4 w0[2], w1[2], w2[2], bb[2];
#pragma unroll
        for (int n = 0; n < 2; ++n) { w0[n] = *(const f32x4*)(cw + ch0 + 4 * n); w1[n] = *(const f32x4*)(cw + DFF + ch0 + 4 * n); w2[n] = *(const f32x4*)(cw + 2 * DFF + ch0 + 4 * n); bb[n] = *(const f32x4*)(cb + ch0 + 4 * n); }
#pragma unroll
        for (int ai = 0; ai < 2; ++ai) {
            const int rowb = un.pm * 256 + ai * 128 + wr * 64; const int blk = rowb >> 6;
#pragma unroll
            for (int m = 0; m < 4; ++m) {
                f32x4 res[2];
#pragma unroll
                for (int n = 0; n < 2; ++n)
#pragma unroll
                    for (int e = 0; e < 4; ++e) {
                        const float cur = acc[ai][0][m][n][e];
                        const float prv = (m > 0) ? acc[ai][0][m > 0 ? m - 1 : 0][n][e] : 0.f;
                        const float p1 = dpp_ror1((fr + 1 >= 16) ? prv : cur);
                        const float p2 = dpp_ror2((fr + 2 >= 16) ? prv : cur);
                        const float cv = bb[n][e] + w0[n][e] * p2 + w1[n][e] * p1 + w2[n][e] * cur;
                        res[n][e] = siluf_(cv) * acc[ai][1][m][n][e];
                    }
                if (m == 0 && fr < 2) {
                    float* sa = SA + ((size_t)(blk * 4 + 2 + fr)) * DFF + ch0; float* sbp = SB + ((size_t)(blk * 2 + fr)) * DFF + ch0;
                    *(f32x4*)sa = acc[ai][0][0][0]; *(f32x4*)(sa + 4) = acc[ai][0][0][1];
                    *(f32x4*)sbp = acc[ai][1][0][0]; *(f32x4*)(sbp + 4) = acc[ai][1][0][1];
                }
                if (m == 3 && fr >= 14) { float* sa = SA + ((size_t)(blk * 4 + (fr - 14))) * DFF + ch0; *(f32x4*)sa = acc[ai][0][3][0]; *(f32x4*)(sa + 4) = acc[ai][0][3][1]; }
                { const uint4 pk_ = pack8(res[0], res[1]); *(LAS u32x4*)(sb + fr * 80 + 16 * fq) = (u32x4){pk_.x, pk_.y, pk_.z, pk_.w}; }
                LDS_FENCE();
                { const int r = lane >> 2, sg = lane & 3; const u32x4 v = *(const LAS u32x4*)(sb + r * 80 + sg * 16);
                  if (!(m == 0 && r < 2)) *(u32x4*)(act + (size_t)(rowb + m * 16 + r) * DFF + un.pn * 128 + wc * 32 + sg * 8) = v; }
                LDS_FENCE();
            }
        }
    }
};

struct Args { const float* in[31]; float* out; unsigned char* ws; int ph_lo, ph_hi; };
enum { I_X = 0, I_C, I_POS, I_WADA, I_BADA, I_GN1, I_GN2, I_WIN, I_GQ, I_GK, I_ARE, I_AIM, I_BRE, I_BIM, I_CRE, I_CIM, I_DSKIP, I_LOGDT, I_WGLU, I_WPOOL, I_PSCALE, I_PA, I_PB, I_PC, I_WGATE, I_BGATE, I_WOUT, I_WUP, I_CONVW, I_CONVB, I_WDOWN };

__device__ __forceinline__ float wave_sum(float v) {
#pragma unroll
    for (int o = 32; o > 0; o >>= 1) v += __shfl_xor(v, o);
    return v;
}

__device__ __forceinline__ void phase_ada(const Args& a, unsigned char* lds, const int WV) {
    const int TI = fresh_tid(WV);
    const int tid = TI;
    float* cact = (float*)lds;
    float* mod = (float*)(a.ws + WS_MOD);
    for (int w = blockIdx.x; w < 256; w += gridDim.x) {
        for (int i = tid; i < 16 * 2048; i += 512) { const int b = i >> 11, k = i & 2047; const float v = a.in[I_C][i]; cact[k * 16 + b] = siluf_(v); }
        __syncthreads();
        const int l = w >> 7, n0 = (w & 127) * 96;
        float acc[16][4];
#pragma unroll
        for (int b = 0; b < 16; ++b)
#pragma unroll
            for (int j = 0; j < 4; ++j) acc[b][j] = 0.f;
        const int cg4 = tid % 24, ks = tid / 24;
        if (tid < 384) {
            const float* wp = a.in[I_WADA] + ((size_t)l * 2048 + ks * 128) * 12288 + n0 + cg4 * 4;
#pragma unroll 4
            for (int k = 0; k < 128; ++k) {
                const f32x4 wv = *(const f32x4*)(wp + (size_t)k * 12288);
                const f32x4* cp = (const f32x4*)(cact + (ks * 128 + k) * 16);
#pragma unroll
                for (int q = 0; q < 4; ++q) { const f32x4 cv = cp[q];
#pragma unroll
                    for (int e = 0; e < 4; ++e)
#pragma unroll
                        for (int j = 0; j < 4; ++j) acc[q * 4 + e][j] += cv[e] * wv[j]; }
            }
        }
        __syncthreads();
        float* part = (float*)lds;
        if (tid < 384) {
#pragma unroll
            for (int b = 0; b < 16; ++b)
#pragma unroll
                for (int j = 0; j < 4; ++j) part[(ks * 16 + b) * 96 + cg4 * 4 + j] = acc[b][j];
        }
        __syncthreads();
        for (int o = tid; o < 1536; o += 512) { const int b = o / 96, cc = o % 96; float s = 0.f;
#pragma unroll
            for (int k2 = 0; k2 < 16; ++k2) s += part[(k2 * 16 + b) * 96 + cc];
            mod[((size_t)l * 16 + b) * 12288 + n0 + cc] = s + a.in[I_BADA][l * 12288 + n0 + cc]; }
        __syncthreads();
    }
}

struct CvtJob { const float* src; bf16_t* dst; int ldS, cbase, cend, kbase, ldD, mode, r0, cs0, kd0; };
__device__ __forceinline__ CvtJob cvt_decode(const Args& a, int l, int t) {
    unsigned char* ws = a.ws; CvtJob J; int ncols, nkt, idx; J.mode = 0; J.r0 = 0; J.kd0 = 0; J.cs0 = 0;
    if (t < 960) { idx = t; J.src = a.in[I_WIN] + (size_t)l * DM * DIN; J.ldS = DIN; ncols = 1864; nkt = 32; J.dst = (bf16_t*)(ws + W_1CAT); J.ldD = 2048; J.mode = 2; }
    else if (t < 1472) { idx = t - 960; J.src = a.in[I_WIN] + (size_t)l * DM * DIN; J.ldS = DIN; J.cs0 = 1864; ncols = 1024; nkt = 32; J.dst = (bf16_t*)(ws + W_1CAT); J.ldD = 2048; J.r0 = 2048; J.mode = 2; }
    else if (t < 4544) { idx = t - 1472; const int gi = idx >> 10; idx &= 1023; J.src = a.in[I_WGATE] + ((size_t)l * 3 + gi) * DM * DM; J.ldS = DM; ncols = 2048; nkt = 32; J.dst = (bf16_t*)(ws + W_1CAT); J.ldD = 2048; J.r0 = 3072 + 2048 * gi; J.mode = 2; }
    else if (t < 5056) { idx = t - 4544; J.src = a.in[I_PA] + (size_t)l * 1024 * DM; J.ldS = DM; ncols = 2048; nkt = 16; J.dst = (bf16_t*)(ws + W_P); J.ldD = 2048; J.mode = 2; }
    else if (t < 5312) { idx = t - 5056; J.src = a.in[I_PB] + (size_t)l * 512 * DM; J.ldS = DM; ncols = 2048; nkt = 8; J.dst = (bf16_t*)(ws + W_P); J.ldD = 2048; J.kd0 = 1024; J.mode = 2; }
    else if (t < 5568) { idx = t - 5312; J.src = a.in[I_PC] + (size_t)l * 512 * DM; J.ldS = DM; ncols = 2048; nkt = 8; J.dst = (bf16_t*)(ws + W_P); J.ldD = 2048; J.kd0 = 1536; J.mode = 2; }
    else if (t < 6592) { idx = t - 5568; J.src = a.in[I_WOUT] + (size_t)l * DM * DM; J.ldS = DM; ncols = 2048; nkt = 32; J.dst = (bf16_t*)(ws + W_OUT); J.ldD = 2048; }
    else if (t < 12096) { idx = t - 6592; J.src = a.in[I_WUP] + (size_t)l * DM * 2 * DFF; J.ldS = 2 * DFF; ncols = 2 * DFF; nkt = 32; J.dst = (bf16_t*)(ws + W_UP); J.ldD = 2048; J.mode = 1; }
    else if (t < 14848) { idx = t - 12096; J.src = a.in[I_WDOWN] + (size_t)l * DFF * DM; J.ldS = DM; ncols = 2048; nkt = 86; J.dst = (bf16_t*)(ws + W_DOWN); J.ldD = DFF; }
    else { idx = t - 14848; J.src = a.in[I_WGLU] + (size_t)l * 512 * 512; J.ldS = 512; ncols = 512; nkt = 8; J.dst = (bf16_t*)(ws + W_GLU); J.ldD = 512; J.mode = 2; }
    const int tn = idx / nkt, tk = idx - tn * nkt;
    J.cbase = J.cs0 + tn * 64; J.cend = J.cs0 + ncols; J.kbase = tk * 64; return J;
}
__device__ __forceinline__ void phase_cvt(const Args& a, int l, unsigned char* lds, const int WV) {
    const int TI = fresh_tid(WV);
    float* T = (float*)lds;
    const int tid = TI, ty = tid >> 4, tx = tid & 15;
    for (int t4 = blockIdx.x * 8; t4 < 14912; t4 += gridDim.x * 8) {
        f32x4 v[8][2];
#pragma unroll
        for (int q = 0; q < 8; ++q) { const CvtJob J = cvt_decode(a, l, t4 + q);
#pragma unroll
            for (int ps = 0; ps < 2; ++ps) { const int k = ty + ps * 32, c = J.cbase + tx * 4;
                v[q][ps] = (f32x4){0.f, 0.f, 0.f, 0.f};
                if (c < J.cend) v[q][ps] = *(const f32x4*)(J.src + (size_t)(J.kbase + k) * J.ldS + c); } }
#pragma unroll
        for (int q = 0; q < 8; ++q)
#pragma unroll
            for (int ps = 0; ps < 2; ++ps) { float* tp = T + q * (64 * 65) + (ty + ps * 32) * 65 + tx * 4; tp[0] = v[q][ps][0]; tp[1] = v[q][ps][1]; tp[2] = v[q][ps][2]; tp[3] = v[q][ps][3]; }
        __syncthreads();
#pragma unroll
        for (int q = 0; q < 8; ++q) { const CvtJob J = cvt_decode(a, l, t4 + q);
            const int n = tid >> 3, kq = tid & 7, c = J.cbase + n;
            if (c < J.cend) {
                float f[8];
#pragma unroll
                for (int j = 0; j < 8; ++j) f[j] = T[q * (64 * 65) + (kq * 8 + j) * 65 + n];
                int row;
                if (J.mode == 0) row = J.r0 + (c - J.cs0);
                else if (J.mode == 2) { const int r_ = J.r0 + (c - J.cs0), ct = r_ & 255; row = (r_ & ~255) | (((ct >> 5) & 1) << 7) | ((ct >> 6) << 5) | (ct & 31); }
                else { const int bj = c >= DFF ? 1 : 0, ch = c - bj * DFF; row = (ch >> 7) * 256 + bj * 128 + (ch & 127); }
                uint4 o; o.x = pk2(f[0], f[1]); o.y = pk2(f[2], f[3]); o.z = pk2(f[4], f[5]); o.w = pk2(f[6], f[7]);
                *(uint4*)(J.dst + (size_t)row * J.ldD + J.kd0 + J.kbase + kq * 8) = o;
            } }
        __syncthreads();
    }
    bf16_t* wp = (bf16_t*)(a.ws + W_POOL); const float* wsrc = a.in[I_WPOOL] + (size_t)l * 4 * 128 * 128;
    for (int i = blockIdx.x * 512 + TI; i < 512 * 512; i += gridDim.x * 512) { const int n = i >> 9, k = i & 511, g = n >> 7;
        const float v = ((k >> 7) == g) ? wsrc[(g * 128 + (k & 127)) * 128 + (n & 127)] : 0.f;
        const int ct = n & 255, nr = (n & ~255) | (((ct >> 5) & 1) << 7) | ((ct >> 6) << 5) | (ct & 31); wp[nr * 512 + k] = (bf16_t)f2bf(v); }
}

__device__ __forceinline__ void phase_norm(const float* xin, const float* g, const float* modl, int shoff, int scoff, bf16_t* out, const int WV) {
    const int TI = fresh_tid(WV);
    const int lane = TI & 63, wave = TI >> 6;
    for (int r = blockIdx.x * 8 + wave; r < MROWS; r += gridDim.x * 8) {
        const f32x4* xp = (const f32x4*)(xin + (size_t)r * DM); f32x4 v[8]; float ssq = 0.f;
#pragma unroll
        for (int j = 0; j < 8; ++j) { v[j] = xp[j * 64 + lane]; ssq += v[j][0] * v[j][0] + v[j][1] * v[j][1] + v[j][2] * v[j][2] + v[j][3] * v[j][3]; }
        ssq = wave_sum(ssq);
        const float rinv = rsqrtf(ssq * (1.f / DM) + EPS);
        const float* mb = modl + (size_t)(r >> 11) * 12288;
#pragma unroll
        for (int j = 0; j < 8; ++j) { const int col = j * 256 + lane * 4;
            const f32x4 g4 = *(const f32x4*)(g + col), sc = *(const f32x4*)(mb + scoff + col), sh = *(const f32x4*)(mb + shoff + col);
            f32x4 y;
#pragma unroll
            for (int e = 0; e < 4; ++e) y[e] = (v[j][e] * rinv * g4[e]) * (1.f + sc[e]) + sh[e];
            uint2 o; o.x = pk2(y[0], y[1]); o.y = pk2(y[2], y[3]);
            *(uint2*)(out + (size_t)r * DM + col) = o; }
    }
}

__constant__ double kRevPerPos[24] = {0.15915494309189535, 0.0700865215877985, 0.03086376340470123, 0.013591370636193905, 0.005985185712713705, 0.002635675898667414, 0.001160663641240061, 0.0005111175045375439, 0.00022507907903927653, 9.911730936901935e-05, 4.364795279280289e-05, 1.9221100684944863e-05, 8.464330808241401e-06, 3.727408601915352e-06, 1.6414262627950345e-06, 7.228293068832865e-07, 0.15915494309189535, 0.03086376340470123, 0.005985185712713705, 0.001160663641240061, 0.00022507907903927653, 4.364795279280289e-05, 8.464330808241401e-06, 1.6414262627950345e-06};
__device__ __forceinline__ void rmsrope128(bf16_t* p, bool active, const float* g16, int sub, const float* cs) {
    float v[16];
    if (active) { unpack8(*(const uint4*)p, v); unpack8(*(const uint4*)(p + 8), v + 8); }
    else {
#pragma unroll
        for (int i = 0; i < 16; ++i) v[i] = 0.f; }
    float ssq = 0.f;
#pragma unroll
    for (int i = 0; i < 16; ++i) ssq += v[i] * v[i];
    ssq += __shfl_xor(ssq, 1); ssq += __shfl_xor(ssq, 2); ssq += __shfl_xor(ssq, 4);
    const float rinv = rsqrtf(ssq * (1.f / 128.f) + EPS);
#pragma unroll
    for (int i = 0; i < 16; ++i) v[i] = v[i] * rinv * g16[i];
#pragma unroll
    for (int i = 0; i < 16; ++i) { const float o = __shfl_xor(v[i], 1); const float c = cs[2 * i], s = cs[2 * i + 1];
        if (sub == 0) v[i] = v[i] * c - o * s; else if (sub == 1) v[i] = v[i] * c + o * s; }
    if (active) { uint4 o0, o1; o0.x = pk2(v[0], v[1]); o0.y = pk2(v[2], v[3]); o0.z = pk2(v[4], v[5]); o0.w = pk2(v[6], v[7]);
        o1.x = pk2(v[8], v[9]); o1.y = pk2(v[10], v[11]); o1.z = pk2(v[12], v[13]); o1.w = pk2(v[14], v[15]);
        *(uint4*)p = o0; *(uint4*)(p + 8) = o1; }
}
__device__ __forceinline__ void rope64(bf16_t* p, bool active, int sub, const float* cs) {
    float v[8];
    if (active) unpack8(*(const uint4*)p, v);
    else {
#pragma unroll
        for (int i = 0; i < 8; ++i) v[i] = 0.f; }
#pragma unroll
    for (int i = 0; i < 8; ++i) { const float o = __shfl_xor(v[i], 1); const float c = cs[2 * i], s = cs[2 * i + 1];
        if (sub == 0) v[i] = v[i] * c - o * s; else if (sub == 1) v[i] = v[i] * c + o * s; }
    if (active) { uint4 o0; o0.x = pk2(v[0], v[1]); o0.y = pk2(v[2], v[3]); o0.z = pk2(v[4], v[5]); o0.w = pk2(v[6], v[7]); *(uint4*)p = o0; }
}
__device__ __forceinline__ void phase_post(const Args& a, int l, unsigned char* lds, const int WV) {
    const int TI = fresh_tid(WV);
    const int lane = TI & 63, wave = TI >> 6;
    float* cs = (float*)lds + wave * 64;
    bf16_t* ocat = (bf16_t*)(a.ws + WS_OCAT); bf16_t* kn = (bf16_t*)(a.ws + WS_KN); bf16_t* qi = (bf16_t*)(a.ws + WS_QI); bf16_t* ki = (bf16_t*)(a.ws + WS_KI);
    const int* pos = (const int*)a.in[I_POS];
    const int sub = lane & 7, hd = lane >> 3;
    float gq[16], gk[16];
#pragma unroll
    for (int i = 0; i < 16; ++i) { gq[i] = a.in[I_GQ][l * 128 + sub * 16 + i]; gk[i] = a.in[I_GK][l * 128 + sub * 16 + i]; }
    for (int r = blockIdx.x * 8 + wave; r < MROWS; r += gridDim.x * 8) {
        const int ps = pos[r];
        if (lane < 24) {
            double rev = (double)ps * kRevPerPos[lane]; rev -= rint(rev); const float fr = (float)rev;
            cs[lane * 2] = __builtin_amdgcn_cosf(fr); cs[lane * 2 + 1] = __builtin_amdgcn_sinf(fr); }
        LDS_FENCE();
        rmsrope128(ocat + (size_t)r * 2048 + hd * 128 + sub * 16, true, gq, sub, cs);
        rmsrope128(kn + (size_t)r * 128 + sub * 16, lane < 8, gk, sub, cs);
        rope64(qi + (size_t)r * 512 + hd * 64 + sub * 8, true, sub, cs + 32);
        rope64(ki + (size_t)r * 64 + sub * 8, lane < 8, sub, cs + 32);
        LDS_FENCE();
    }
}

__device__ __forceinline__ void s5_unit(const Args& a, int l, int b, int g, unsigned char* lds, const int WV) {
    const int TI = fresh_tid(WV);
    const int lane = TI & 63, wave = __builtin_amdgcn_readfirstlane(TI >> 6), p = lane;
    float* E = (float*)lds;
    float* ust = (float*)(lds + 16384 + wave * 4096);
    bf16_t* sst = (bf16_t*)(lds + 49152 + wave * 4352);
    const bf16_t* U = (const bf16_t*)(a.ws + WS_U); bf16_t* Y = (bf16_t*)(a.ws + WS_Y);
    const int gp = (l * 32 + g) * 64 + p;
    const float are = a.in[I_ARE][gp], aim = a.in[I_AIM][gp], dt = expf(a.in[I_LOGDT][l * 32 + g]);
    const float mag = expf(are * dt);
    float ang = aim * dt; { const float n = rintf(ang * 0.15915494309189535f); ang = fmaf(-n, 6.28318548202514648f, ang); ang = fmaf(n, 1.7484555e-7f, ang); }
    const float lre = mag * cosf(ang), lim = mag * sinf(ang);
    float Bre[16], Bim[16];
    { const float nr = lre - 1.f, ni = lim, den = 1.f / (are * are + aim * aim); const float cr = (nr * are + ni * aim) * den, ci = (ni * are - nr * aim) * den;
#pragma unroll
        for (int j = 0; j < 16; ++j) { const float br = a.in[I_BRE][(size_t)gp * 16 + j], bi = a.in[I_BIM][(size_t)gp * 16 + j]; Bre[j] = cr * br - ci * bi; Bim[j] = cr * bi + ci * br; } }
    bf16x8 Cf[4];
    { const int i = lane & 15;
#pragma unroll
        for (int ks = 0; ks < 4; ++ks)
#pragma unroll
            for (int j = 0; j < 8; ++j) { const int k = ks * 32 + (lane >> 4) * 8 + j, pp = k >> 1; const size_t ci = ((size_t)(l * 32 + g) * 16 + i) * 64 + pp;
                const float v = (k & 1) ? -a.in[I_CIM][ci] : a.in[I_CRE][ci]; Cf[ks][j] = (short)f2bf(v); } }
    const float dsk = a.in[I_DSKIP][l * 512 + g * 16 + (lane & 15)];
    bf16_t* Bl = (bf16_t*)(lds + 83968);
    float* bus = (float*)(lds + 88064 + wave * 8448);
    if (wave == 0) {
#pragma unroll
        for (int q = 0; q < 2; ++q) { uint4 o_; o_.x = pk2(Bre[q * 8], Bre[q * 8 + 1]); o_.y = pk2(Bre[q * 8 + 2], Bre[q * 8 + 3]); o_.z = pk2(Bre[q * 8 + 4], Bre[q * 8 + 5]); o_.w = pk2(Bre[q * 8 + 6], Bre[q * 8 + 7]);
            *(uint4*)(Bl + p * 16 + q * 8) = o_;
            uint4 i_; i_.x = pk2(Bim[q * 8], Bim[q * 8 + 1]); i_.y = pk2(Bim[q * 8 + 2], Bim[q * 8 + 3]); i_.z = pk2(Bim[q * 8 + 4], Bim[q * 8 + 5]); i_.w = pk2(Bim[q * 8 + 6], Bim[q * 8 + 7]);
            *(uint4*)(Bl + (64 + p) * 16 + q * 8) = i_; }
    }
    __syncthreads();
    const int l15 = lane & 15, lg4 = lane >> 4;
    bf16x8 Bf[8];
#pragma unroll
    for (int nb = 0; nb < 8; ++nb) { u32x4 t_ = {0u, 0u, 0u, 0u}; if (lg4 < 2) t_ = *(const u32x4*)(Bl + (nb * 16 + l15) * 16 + lg4 * 8); Bf[nb] = __builtin_bit_cast(bf16x8, t_); }
#define S5_BU(t0_, sb_) do { u32x4 a_ = {0u, 0u, 0u, 0u}; if (lg4 < 2) a_ = *(const u32x4*)(U + (size_t)(b * 2048 + (t0_) + (sb_) * 16 + l15) * 512 + g * 16 + lg4 * 8); \
        const bf16x8 af_ = __builtin_bit_cast(bf16x8, a_); \
        _Pragma("unroll") for (int nb = 0; nb < 8; ++nb) { const f32x4 c_ = __builtin_amdgcn_mfma_f32_16x16x32_bf16(af_, Bf[nb], (f32x4){0.f, 0.f, 0.f, 0.f}, 0, 0, 0); \
            _Pragma("unroll") for (int r = 0; r < 4; ++r) bus[(lg4 * 4 + r) * 132 + nb * 16 + l15] = c_[r]; } \
        LDS_FENCE(); } while (0)
#define S5_STEP(tt_) do { const float br_ = bus[(tt_) * 132 + p], bi_ = bus[(tt_) * 132 + 64 + p]; \
        const float nre_ = lre * sre - lim * sim + br_, nim_ = lre * sim + lim * sre + bi_; sre = nre_; sim = nim_; } while (0)
#pragma unroll 1
    for (int cc = 0; cc < 4; ++cc) {
        const int chunk = wave * 4 + cc, t0 = chunk * 64;
        float sre = 0.f, sim = 0.f;
#pragma unroll 1
        for (int sb = 0; sb < 4; ++sb) {
            S5_BU(t0, sb);
#pragma unroll 4
            for (int tt = 0; tt < 16; ++tt) S5_STEP(tt);
            LDS_FENCE();
        }
        E[(chunk * 64 + p) * 2] = sre; E[(chunk * 64 + p) * 2 + 1] = sim;
    }
    __syncthreads();
    if (wave == 0) {
        float pr = lre, pi = lim;
#pragma unroll
        for (int q = 0; q < 6; ++q) { const float nr = pr * pr - pi * pi, pp_ = pr * pi, ni = pp_ + pp_; pr = nr; pi = ni; }
        float sr = 0.f, si = 0.f;
        for (int c = 0; c < 32; ++c) { const float er = E[(c * 64 + p) * 2], ei = E[(c * 64 + p) * 2 + 1]; E[(c * 64 + p) * 2] = sr; E[(c * 64 + p) * 2 + 1] = si;
            const float nr = pr * sr - pi * si + er, ni = pr * si + pi * sr + ei; sr = nr; si = ni; }
    }
    __syncthreads();
#pragma unroll 1
    for (int cc = 0; cc < 4; ++cc) {
        const int chunk = wave * 4 + cc, t0 = chunk * 64;
        { const bf16_t* up = U + (size_t)(b * 2048 + t0 + lane) * 512 + g * 16; const uint4 q0 = *(const uint4*)up, q1 = *(const uint4*)(up + 8);
            float f[16]; unpack8(q0, f); unpack8(q1, f + 8);
#pragma unroll
            for (int q = 0; q < 4; ++q) *(f32x4*)(ust + lane * 16 + q * 4) = (f32x4){f[q * 4], f[q * 4 + 1], f[q * 4 + 2], f[q * 4 + 3]}; }
        float sre = E[(chunk * 64 + p) * 2], sim = E[(chunk * 64 + p) * 2 + 1];
#pragma unroll 1
        for (int sb = 0; sb < 4; ++sb) {
            S5_BU(t0, sb);
#pragma unroll 4
            for (int tt = 0; tt < 16; ++tt) { S5_STEP(tt);
                *(unsigned*)(sst + tt * 136 + 2 * p) = pk2(sre, sim);
            }
            LDS_FENCE();
            f32x4 acc = {0.f, 0.f, 0.f, 0.f};
#pragma unroll
            for (int ks = 0; ks < 4; ++ks) { const bf16x8 af = *(const bf16x8*)(sst + (lane & 15) * 136 + ks * 32 + (lane >> 4) * 8);
                acc = __builtin_amdgcn_mfma_f32_16x16x32_bf16(af, Cf[ks], acc, 0, 0, 0); }
#pragma unroll
            for (int r = 0; r < 4; ++r) { const int t = sb * 16 + (lane >> 4) * 4 + r, i = lane & 15;
                const float y = gelu_tanh(acc[r] + dsk * ust[t * 16 + i]);
                Y[(size_t)(b * 2048 + t0 + t) * 512 + g * 16 + i] = (bf16_t)f2bf(y); }
            LDS_FENCE();
        }
    }
    __syncthreads();
#undef S5_STEP
#undef S5_BU
}

__device__ __forceinline__ void pool_unit(const Args& a, int b, int chunk, unsigned char* lds, const int WV) {
    const int TI = fresh_tid(WV);
    bf16_t* T = (bf16_t*)lds;
    const int t0 = chunk * 64;
    const bf16_t* P = (const bf16_t*)(a.ws + WS_P) + (size_t)b * 2048 * 512; bf16_t* O = (bf16_t*)(a.ws + WS_POOLED) + (size_t)b * 2048 * 512;
    __syncthreads();
    for (int i = TI; i < 80 * 64; i += 512) { const int r = i >> 6, c8 = i & 63, t = t0 - 16 + r;
        uint4 v = make_uint4(0u, 0u, 0u, 0u); if (t >= 0) v = *(const uint4*)(P + (size_t)t * 512 + c8 * 8);
        *(uint4*)(T + r * 512 + c8 * 8) = v; }
    __syncthreads();
    const int c = TI, w = 2 << (c >> 7);
    float s = 0.f;
    for (int k = 1; k <= w; ++k) s += bf1(T[(16 - k) * 512 + c]);
#pragma unroll 4
    for (int t = 0; t < 64; ++t) { const float pv = bf1(T[(16 + t) * 512 + c]); s += pv; s -= bf1(T[(16 + t - w) * 512 + c]);
        const int tt = t0 + t + 1; const float mean = s / (float)(tt < w ? tt : w); O[(size_t)(t0 + t) * 512 + c] = (bf16_t)f2bf(mean - pv); }
}

__device__ __forceinline__ unsigned sortkey(float x) { const unsigned u = __float_as_uint(x); return (u & 0x80000000u) ? ~u : (u | 0x80000000u); }
template <int NJ>
__device__ __forceinline__ void select256(const float* scq, int limit, unsigned short* sq, int lane) {
    const unsigned long long ltmask = (1ull << lane) - 1ull;
    unsigned key[NJ];
#pragma unroll
    for (int j = 0; j < NJ; ++j) { const int idx = j * 64 + lane; key[j] = (idx < limit) ? sortkey(scq[idx]) : 0u; }
    unsigned T = 0u;
    for (int bit = 31; bit >= 0; --bit) { const unsigned cand = T | (1u << bit); int cnt = 0;
#pragma unroll
        for (int j = 0; j < NJ; ++j) cnt += __popcll(__ballot(key[j] >= cand));
        if (cnt >= 256) { T = cand; if (cnt == 256) break; } }
    int cgt = 0;
#pragma unroll
    for (int j = 0; j < NJ; ++j) cgt += __popcll(__ballot(key[j] > T));
    const int need = 256 - cgt; int ob = 0, tb = 0;
#pragma unroll
    for (int j = 0; j < NJ; ++j) { const bool gt = key[j] > T, eq = key[j] == T; const unsigned long long me = __ballot(eq);
        const int pe = tb + __popcll(me & ltmask); const bool take = gt || (eq && pe < need); const unsigned long long mt = __ballot(take);
        if (take) sq[ob + __popcll(mt & ltmask)] = (unsigned short)(j * 64 + lane);
        ob += __popcll(mt); tb += __popcll(me); }
}
__device__ __forceinline__ void dsa_unit(const Args& a, int b, int tq, unsigned char* lds, const int WV, bf16_t* obase, const int ostride, const int parts) {
    const int TI = fresh_tid(WV);
    int tid = TI;
    int lane = tid & 63; const int wave = WV;
    float* sc = (float*)lds;
    unsigned short* sel = (unsigned short*)(lds + 131072);
    float* wis = (float*)(lds + 131072 + 8192);
    bf16_t* ocat = (bf16_t*)(a.ws + WS_OCAT); const bf16_t* Kn = (const bf16_t*)(a.ws + WS_KN); const bf16_t* V = (const bf16_t*)(a.ws + WS_V);
    const bf16_t* QI = (const bf16_t*)(a.ws + WS_QI); const bf16_t* KI = (const bf16_t*)(a.ws + WS_KI); const float* WI = (const float*)(a.ws + WS_WI);
    const int t0 = tq * 16, row0 = b * 2048 + t0, limit = ((t0 >> 6) + 1) << 6, nkt = limit >> 5, nsel = limit < 256 ? limit : 256;
    const int g = lane >> 5, c32 = lane & 31;
        bf16x8 Af[4][4];
#pragma unroll
        for (int rb = 0; rb < 4; ++rb) { const int R = rb * 32 + c32; const bf16_t* qp = QI + (size_t)(row0 + (R >> 3)) * 512 + (R & 7) * 64 + g * 8;
#pragma unroll
            for (int s = 0; s < 4; ++s) Af[rb][s] = *(const bf16x8*)(qp + s * 16); }
        bf16x8 Bn[4];
        { const bf16_t* kp0 = KI + (size_t)(b * 2048 + wave * 32 + c32) * 64 + g * 8;
#pragma unroll
            for (int s = 0; s < 4; ++s) Bn[s] = *(const bf16x8*)(kp0 + s * 16); }
    __syncthreads();
    if (tid < 128) wis[tid] = WI[(size_t)row0 * 8 + tid];
    __syncthreads();
    if (parts & 1)
    {
#pragma unroll 1
        for (int kt = wave; kt < nkt; kt += 8) {
            bf16x8 Bf[4];
#pragma unroll
            for (int s = 0; s < 4; ++s) Bf[s] = Bn[s];
            if (kt + 8 < nkt) { const bf16_t* kp = KI + (size_t)(b * 2048 + (kt + 8) * 32 + c32) * 64 + g * 8;
#pragma unroll
                for (int s = 0; s < 4; ++s) Bn[s] = *(const bf16x8*)(kp + s * 16); }
#pragma unroll
            for (int rb = 0; rb < 4; ++rb) {
                f32x16 acc;
#pragma unroll
                for (int i = 0; i < 16; ++i) acc[i] = 0.f;
#pragma unroll
                for (int s = 0; s < 4; ++s) acc = __builtin_amdgcn_mfma_f32_32x32x16_bf16(Af[rb][s], Bf[s], acc, 0, 0, 0);
#pragma unroll
                for (int j = 0; j < 4; ++j) { const int q = rb * 4 + j; const f32x4 w4 = *(const f32x4*)(wis + q * 8 + 4 * g);
                    float sp = fmaxf(acc[4 * j], 0.f) * w4[0] + fmaxf(acc[4 * j + 1], 0.f) * w4[1] + fmaxf(acc[4 * j + 2], 0.f) * w4[2] + fmaxf(acc[4 * j + 3], 0.f) * w4[3];
                    sp += __shfl_xor(sp, 32);
                    if (g == 0) sc[q * 2048 + kt * 32 + c32] = sp; }
            }
        }
    }
    __syncthreads();
    lane = fresh_tid(WV) & 63;
    for (int qq = 0; qq < 2; ++qq) {
        const int q = wave * 2 + qq; unsigned short* sq = sel + q * 256;
        if (limit <= 256 || !(parts & 2)) { for (int j = lane; j < nsel; j += 64) sq[j] = (unsigned short)j; }
        else if (limit <= 512) select256<8>(sc + q * 2048, limit, sq, lane);
        else if (limit <= 1024) select256<16>(sc + q * 2048, limit, sq, lane);
        else if (limit <= 1536) select256<24>(sc + q * 2048, limit, sq, lane);
        else select256<32>(sc + q * 2048, limit, sq, lane);
    }
    __syncthreads();
    lane = fresh_tid(WV) & 63;
    float* Pw = (float*)lds + wave * 2048;
    const int g4 = lane >> 4, hh = lane & 15;
#pragma unroll 1
    for (int qq = 0; qq < 2; ++qq) {
        const int q = wave * 2 + qq; const size_t row = (size_t)(row0 + q); const unsigned short* sq = sel + q * 256;
        bf16x8 Qf[4];
#pragma unroll
        for (int s = 0; s < 4; ++s) Qf[s] = *(const bf16x8*)(ocat + row * 2048 + (hh & 7) * 128 + g4 * 8 + s * 32);
        float lg[16][4];
        { bf16_t* Ks = (bf16_t*)(lds + wave * 10752);
          const bf16_t* Kb = Kn + (size_t)b * 2048 * 128 + hh * 8;
          u32x4 kq[8], kn_[8];
#pragma unroll
          for (int jj = 0; jj < 8; ++jj) { kn_[jj] = (u32x4){0u, 0u, 0u, 0u}; const int idx = sq[jj * 4 + g4]; kq[jj] = *(const u32x4*)(Kb + (size_t)idx * 128); }
#define QK_BATCH(bt) do { if ((bt) * 32 < nsel) { \
            if (((bt) + 1) * 32 < nsel) { _Pragma("unroll") for (int jj = 0; jj < 8; ++jj) { const int idx = sq[((bt) + 1) * 32 + jj * 4 + g4]; kn_[jj] = *(const u32x4*)(Kb + (size_t)idx * 128); } } \
            _Pragma("unroll") for (int jj = 0; jj < 8; ++jj) *(u32x4*)(Ks + (jj * 4 + g4) * 136 + hh * 8) = kq[jj]; \
            LDS_FENCE(); \
            _Pragma("unroll") for (int kbl = 0; kbl < 2; ++kbl) { f32x4 c = {0.f, 0.f, 0.f, 0.f}; \
                _Pragma("unroll") for (int s = 0; s < 4; ++s) c = __builtin_amdgcn_mfma_f32_16x16x32_bf16(*(const bf16x8*)(Ks + (kbl * 16 + hh) * 136 + g4 * 8 + s * 32), Qf[s], c, 0, 0, 0); \
                _Pragma("unroll") for (int r = 0; r < 4; ++r) lg[2 * (bt) + kbl][r] = c[r] * 0.08838834764831845f; } \
            LDS_FENCE(); \
            _Pragma("unroll") for (int jj = 0; jj < 8; ++jj) kq[jj] = kn_[jj]; \
          } else { _Pragma("unroll") for (int kbl = 0; kbl < 2; ++kbl) _Pragma("unroll") for (int r = 0; r < 4; ++r) lg[2 * (bt) + kbl][r] = -1e30f; } } while (0)
          QK_BATCH(0); QK_BATCH(1); QK_BATCH(2); QK_BATCH(3); QK_BATCH(4); QK_BATCH(5); QK_BATCH(6); QK_BATCH(7);
#undef QK_BATCH
        }
        float mx = -1e30f;
#pragma unroll
        for (int kb = 0; kb < 16; ++kb)
#pragma unroll
            for (int r = 0; r < 4; ++r) mx = fmaxf(mx, lg[kb][r]);
        mx = fmaxf(mx, __shfl_xor(mx, 16)); mx = fmaxf(mx, __shfl_xor(mx, 32));
        float sum = 0.f;
#pragma unroll
        for (int kb = 0; kb < 16; ++kb)
#pragma unroll
            for (int r = 0; r < 4; ++r) { const float e = (kb * 16 < nsel) ? __expf(lg[kb][r] - mx) : 0.f; lg[kb][r] = e; sum += e; }
        sum += __shfl_xor(sum, 16); sum += __shfl_xor(sum, 32);
        const float inv = 1.f / sum;
        bf16x8 Pa[8];
#pragma unroll
        for (int ks = 0; ks < 8; ++ks) {
            const unsigned a0 = pk2(lg[2 * ks][0] * inv, lg[2 * ks][1] * inv), a1 = pk2(lg[2 * ks][2] * inv, lg[2 * ks][3] * inv);
            const unsigned a2 = pk2(lg[2 * ks + 1][0] * inv, lg[2 * ks + 1][1] * inv), a3 = pk2(lg[2 * ks + 1][2] * inv, lg[2 * ks + 1][3] * inv);
            const u32x4 t_ = {a0, a1, a2, a3}; Pa[ks] = __builtin_bit_cast(bf16x8, t_); }
        bf16_t* Vs = (bf16_t*)(lds + wave * 10752);
        bf16_t* Os = Vs + 32 * 136;
        f32x4 oacc[8];
#pragma unroll
        for (int nb = 0; nb < 8; ++nb) oacc[nb] = (f32x4){0.f, 0.f, 0.f, 0.f};
        const bf16_t* Vb = V + (size_t)b * 2048 * 128 + hh * 8;
        u32x4 vq[8], vn[8];
#pragma unroll
        for (int jj = 0; jj < 8; ++jj) vn[jj] = (u32x4){0u, 0u, 0u, 0u};
#pragma unroll
        for (int jj = 0; jj < 8; ++jj) { const int idx = sq[jj * 4 + g4]; vq[jj] = *(const u32x4*)(Vb + (size_t)idx * 128); }
#define PV_BATCH(bt) do { if ((bt) * 32 < nsel) { \
            if (((bt) + 1) * 32 < nsel) { _Pragma("unroll") for (int jj = 0; jj < 8; ++jj) { const int idx = sq[((bt) + 1) * 32 + jj * 4 + g4]; vn[jj] = *(const u32x4*)(Vb + (size_t)idx * 128); } } \
            _Pragma("unroll") for (int jj = 0; jj < 8; ++jj) *(u32x4*)(Vs + (jj * 4 + g4) * 136 + hh * 8) = vq[jj]; \
            LDS_FENCE(); \
            _Pragma("unroll") for (int nb = 0; nb < 8; ++nb) { const bf16_t* vp = Vs + (4 * g4) * 136 + nb * 16 + hh; \
                const unsigned w0_ = (unsigned)vp[0 * 136] | ((unsigned)vp[1 * 136] << 16), w1_ = (unsigned)vp[2 * 136] | ((unsigned)vp[3 * 136] << 16); \
                const unsigned w2_ = (unsigned)vp[16 * 136] | ((unsigned)vp[17 * 136] << 16), w3_ = (unsigned)vp[18 * 136] | ((unsigned)vp[19 * 136] << 16); \
                const u32x4 t_ = {w0_, w1_, w2_, w3_}; \
                oacc[nb] = __builtin_amdgcn_mfma_f32_16x16x32_bf16(Pa[(bt)], __builtin_bit_cast(bf16x8, t_), oacc[nb], 0, 0, 0); } \
            LDS_FENCE(); \
            _Pragma("unroll") for (int jj = 0; jj < 8; ++jj) vq[jj] = vn[jj]; } } while (0)
        PV_BATCH(0); PV_BATCH(1); PV_BATCH(2); PV_BATCH(3); PV_BATCH(4); PV_BATCH(5); PV_BATCH(6); PV_BATCH(7);
#undef PV_BATCH
        if (g4 < 2) {
#pragma unroll
            for (int nb = 0; nb < 8; ++nb)
#pragma unroll
                for (int r = 0; r < 4; ++r) Os[(g4 * 4 + r) * 128 + nb * 16 + hh] = (bf16_t)f2bf(oacc[nb][r]);
        }
        LDS_FENCE();
#pragma unroll
        for (int h = 0; h < 2; ++h) { const uint4 ov = *(const uint4*)(Os + h * 512 + lane * 8); *(uint4*)(obase + row * ostride + h * 512 + lane * 8) = ov; }
        LDS_FENCE();
    }
}

__device__ __forceinline__ void phase_fix(const Args& a, int l, const int WV) {
    const int TI = fresh_tid(WV);
    const float* SA = (const float*)(a.ws + WS_SA); const float* SB = (const float*)(a.ws + WS_SB); bf16_t* act = (bf16_t*)(a.ws + WS_R2);
    const float* cw = a.in[I_CONVW] + (size_t)l * 3 * DFF; const float* cb = a.in[I_CONVB] + (size_t)l * DFF;
    const int total = 512 * 2 * DFF;
    for (int i = blockIdx.x * 512 + TI; i < total; i += gridDim.x * 512) {
        const int ch = i % DFF, rb = i / DFF, rr = rb & 1, blk = rb >> 1, r = blk * 64 + rr, t = r & 2047;
        const float a0 = SA[((size_t)blk * 4 + 2 + rr) * DFF + ch];
        float am1, am2;
        if (rr == 0) { am1 = (t >= 1) ? SA[((size_t)(blk - 1) * 4 + 1) * DFF + ch] : 0.f; am2 = (t >= 2) ? SA[((size_t)(blk - 1) * 4 + 0) * DFF + ch] : 0.f; }
        else { am1 = SA[((size_t)blk * 4 + 2) * DFF + ch]; am2 = (t >= 2) ? SA[((size_t)(blk - 1) * 4 + 1) * DFF + ch] : 0.f; }
        const float cv = cb[ch] + cw[ch] * am2 + cw[DFF + ch] * am1 + cw[2 * DFF + ch] * a0;
        act[(size_t)r * DFF + ch] = (bf16_t)f2bf(siluf_(cv) * SB[((size_t)blk * 2 + rr) * DFF + ch]);
    }
}

__device__ __forceinline__ void run_phase(const Args& a, int ph, unsigned char* lds, const int WV, const bool dummy) {
    unsigned char* ws = a.ws;
    LAS unsigned char* ldsl = (LAS unsigned char*)lds;
    const int G = gridDim.x, bx = blockIdx.x;
#ifndef DBG_NOADA
    if (ph == 0) { phase_ada(a, lds, WV); return; }
#else
    if (ph == 0) return;
#endif
    const int l = (ph - 1) / 10, sp = (ph - 1) % 10;
    const float* modl = (const float*)(ws + WS_MOD) + (size_t)l * 16 * 12288;
    const float* xin = (l == 0) ? a.in[I_X] : a.out;
#ifdef DBG_SP
    if (sp != DBG_SP) return;
#endif
    switch (sp) {
    case 0: phase_cvt(a, l, lds, WV); phase_norm(xin, a.in[I_GN1] + l * DM, modl, 0, 2048, (bf16_t*)(ws + WS_R1), WV); break;
    case 1: {
        pg8::Gemm g{(const bf16_t*)(ws + WS_R1), (const bf16_t*)(ws + W_1CAT), MROWS, N1, DM, DM, DM, 1 << 30, 0}; pg8::StaticOrder S; S.init(MROWS, N1, G, bx);
        Epi1 E{(bf16_t*)(ws + WS_OCAT), (bf16_t*)(ws + WS_KN), (bf16_t*)(ws + WS_V), (bf16_t*)(ws + WS_QI), (bf16_t*)(ws + WS_KI), (bf16_t*)(ws + WS_U), (bf16_t*)(ws + WS_P), (bf16_t*)(ws + WS_R2),
               (float*)(ws + WS_WI), a.in[I_BGATE] + (size_t)l * 3 * DM, ldsl + 131072};
        pg8::gemm_phase<Epi1, pg8::StaticOrder>(ldsl, g, S, E, WV); } break;
    case 2:
        if (!dummy) phase_post(a, l, lds, WV);
        __syncthreads();
        for (int u = bx; u < 512; u += G) s5_unit(a, l, u >> 5, u & 31, lds, WV);
        for (int u = bx; u < 512; u += G) pool_unit(a, u >> 5, u & 31, lds, WV);
        break;
    case 3: {
#ifndef DBG_NO_DSA
#ifdef DSA_PROBE
        for (int rep = 0; rep < 2; ++rep) { const bool dm = (rep == 0); const int parts = dm ? (DSA_PROBE) : 15;
#else
        { const bool dm = dummy; const int parts = 15;
#endif
            for (int u = bx; u < 2048; u += G) { const int w = u & 255, i = u >> 8, b = w & 15, s = w >> 4; const int tq = (i & 1) ? (i * 16 + 15 - s) : (i * 16 + s);
                dsa_unit(a, b, tq, lds, WV, dm ? (bf16_t*)(ws + WS_R1 + 64 * MiB) : (bf16_t*)(ws + WS_OCAT), dm ? 1024 : 2048, parts); }
        }
        __syncthreads();
#endif
#ifndef DBG_DSA_ONLY
        { pg8::Gemm g{(const bf16_t*)(ws + WS_Y), (const bf16_t*)(ws + W_GLU), MROWS, 1024, 512, 512, 512, 2, WS_POOLED - WS_Y}; pg8::StaticOrder S; S.init(MROWS, 1024, G, bx);
          EpiGluPool E{(const bf16_t*)(ws + WS_Y), a.in[I_PSCALE] + l * 512, (bf16_t*)(ws + WS_OCAT)}; pg8::gemm_phase<EpiGluPool, pg8::StaticOrder>(ldsl, g, S, E, WV); }
#endif
        } break;
    case 4: {
        pg8::Gemm g{(const bf16_t*)(ws + WS_OCAT), (const bf16_t*)(ws + W_P), MROWS, DM, DM, DM, DM, 1 << 30, 0}; pg8::StaticOrder S; S.init(MROWS, DM, G, bx);
        EpiMerge E{(const bf16_t*)(ws + WS_R2), (bf16_t*)(ws + WS_R1), ldsl + 131072}; pg8::gemm_phase<EpiMerge, pg8::StaticOrder>(ldsl, g, S, E, WV); } break;
    case 5: {
        pg8::Gemm g{(const bf16_t*)(ws + WS_R1), (const bf16_t*)(ws + W_OUT), MROWS, DM, DM, DM, DM, 1 << 30, 0}; pg8::StaticOrder S; S.init(MROWS, DM, G, bx);
        EpiRes E{xin, dummy ? (float*)(ws + WS_OCAT) : a.out, modl + 4096}; pg8::gemm_phase<EpiRes, pg8::StaticOrder>(ldsl, g, S, E, WV); } break;
    case 6: phase_norm(a.out, a.in[I_GN2] + l * DM, modl, 6144, 8192, (bf16_t*)(ws + WS_R1), WV); break;
    case 7: {
        pg8::Gemm g{(const bf16_t*)(ws + WS_R1), (const bf16_t*)(ws + W_UP), MROWS, 2 * DFF, DM, DM, DM, 1 << 30, 0}; pg8::StaticOrder S; S.init(MROWS, 2 * DFF, G, bx);
        EpiUp E{(bf16_t*)(ws + WS_R2), (float*)(ws + WS_SA), (float*)(ws + WS_SB), a.in[I_CONVW] + (size_t)l * 3 * DFF, a.in[I_CONVB] + (size_t)l * DFF, ldsl + 131072};
        pg8::gemm_phase<EpiUp, pg8::StaticOrder>(ldsl, g, S, E, WV); } break;
    case 8: phase_fix(a, l, WV); break;
    case 9: {
        pg8::Gemm g{(const bf16_t*)(ws + WS_R2), (const bf16_t*)(ws + W_DOWN), MROWS, DM, DFF, DFF, DFF, 1 << 30, 0}; pg8::StaticOrder S; S.init(MROWS, DM, G, bx);
        EpiRes E{a.out, dummy ? (float*)(ws + WS_OCAT) : a.out, modl + 10240}; pg8::gemm_phase<EpiRes, pg8::StaticOrder>(ldsl, g, S, E, WV); } break;
    }
}

#define XB_XCNT(j)  (256  + 64 * (j))
#define XB_XSUB(j)  (1280 + 64 * (j))
#define XB_XGEN(j)  (2304 + 64 * (j))
#define XB_TOP      3328
#define XB_TOPGEN   3392
#define XB_WORDS    3456
__device__ __forceinline__ unsigned xb_ld(unsigned* p)              { return __hip_atomic_load(p, __ATOMIC_RELAXED, __HIP_MEMORY_SCOPE_AGENT); }
__device__ __forceinline__ unsigned xb_add(unsigned* p, unsigned v) { return __hip_atomic_fetch_add(p, v, __ATOMIC_RELAXED, __HIP_MEMORY_SCOPE_AGENT); }
__device__ __forceinline__ unsigned xb_xcc_id() { return (unsigned)__builtin_amdgcn_s_getreg((3 << 11) | 20) & 0xFu; }
#define XB_SPIN(cond) do { unsigned _sp = 0; while (cond) { __builtin_amdgcn_s_sleep(1); if (++_sp > (1u << 22)) break; } } while (0)
__device__ __forceinline__ void grid_bar(unsigned* bar, volatile LAS unsigned* st, int wave_id) {
    asm volatile("s_waitcnt vmcnt(0) lgkmcnt(0)" ::: "memory");
    __syncthreads();
    if (wave_id == 0) {
        const int l = (int)__builtin_amdgcn_mbcnt_hi(~0u, __builtin_amdgcn_mbcnt_lo(~0u, 0u));
        if (l == 0) {
            const unsigned x = xb_xcc_id();
            unsigned nloc = st[0], nx = st[1];
            if (nloc == 0u) {
                const unsigned G = gridDim.x; unsigned sum, cnt, mine, sp = 0u;
                for (;;) { sum = 0u; cnt = 0u; mine = 0u;
#pragma unroll
                    for (unsigned j = 0; j < 16; ++j) { const unsigned c = xb_ld(&bar[XB_XCNT(j)]); sum += c; cnt += (c > 0u) ? 1u : 0u; mine = (j == x) ? c : mine; }
                    if (sum == G) break;
                    __builtin_amdgcn_s_sleep(1); if (++sp > (1u << 22)) break; }
                nloc = mine > 0u ? mine : 1u; nx = cnt > 0u ? cnt : 1u; st[0] = nloc; st[1] = nx;
            }
            const unsigned old = xb_add(&bar[XB_XSUB(x)], 1u);
            const unsigned gen = old / nloc;
            if (old + 1u == (gen + 1u) * nloc) {
                __builtin_amdgcn_fence(__ATOMIC_RELEASE, "agent");
                asm volatile("s_waitcnt vmcnt(0)" ::: "memory");
                const unsigned og = xb_add(&bar[XB_TOP], 1u);
                const unsigned tg = og / nx;
                if (og + 1u == (tg + 1u) * nx) xb_add(&bar[XB_TOPGEN], 1u);
                else XB_SPIN(xb_ld(&bar[XB_TOPGEN]) == tg);
                __builtin_amdgcn_fence(__ATOMIC_ACQUIRE, "agent");
                xb_add(&bar[XB_XGEN(x)], 1u);
                asm volatile("s_waitcnt vmcnt(0)" ::: "memory");
            } else {
                XB_SPIN(xb_ld(&bar[XB_XGEN(x)]) == gen);
                __builtin_amdgcn_fence(__ATOMIC_ACQUIRE, "agent");
                asm volatile("s_waitcnt vmcnt(0)" ::: "memory");
            }
        }
    }
    __syncthreads();
}

__global__ void __launch_bounds__(512, 2) mega_fwd(Args a) {
    extern __shared__ __attribute__((aligned(16))) unsigned char lds[];
    cg::grid_group grid = cg::this_grid();
    const int wave_id = __builtin_amdgcn_readfirstlane((int)(threadIdx.x >> 6));
    const int ph_lo = a.ph_lo, ph_hi = a.ph_hi;
    volatile LAS unsigned* xst = (volatile LAS unsigned*)((LAS unsigned char*)lds + 163776);
    if (threadIdx.x == 0) { xst[0] = 0u; xst[1] = 0u; (void)xb_add((unsigned*)(__attribute__((address_space(1))) unsigned*)a.ws + XB_XCNT(xb_xcc_id()), 1u); }
    __syncthreads();
    for (int ph = ph_lo; ph < ph_hi; ++ph) {
        const __attribute__((address_space(4))) Args* kp = (const __attribute__((address_space(4))) Args*)__builtin_amdgcn_kernarg_segment_ptr();
        asm volatile("" : "+s"(kp));
        Args la;
#pragma unroll
        for (int i = 0; i < 31; ++i) la.in[i] = (const float*)(const __attribute__((address_space(1))) float*)kp->in[i];
        la.ws = (unsigned char*)(__attribute__((address_space(1))) unsigned char*)kp->ws;
        la.out = (float*)(__attribute__((address_space(1))) float*)kp->out;
        la.ph_lo = ph_lo; la.ph_hi = ph_hi;
#ifdef REP_MASK
        if (ph > 0 && ((REP_MASK >> ((ph - 1) % 10)) & 1)) { run_phase(la, ph, lds, wave_id, true); grid.sync(); }
#endif
        run_phase(la, ph, lds, wave_id, false);
        if (ph + 1 < ph_hi) {
            if (ph_hi < 0) grid.sync();
            else grid_bar((unsigned*)la.ws, xst, wave_id);
        }
    }
}

extern "C" void kernel_launch(void* const* d_in, const int* in_sizes, int n_in, void* d_out, int out_size, void* d_ws, size_t ws_size, hipStream_t stream) {
    static int grid = 0;
    if (grid == 0) {
        int dev = 0, cus = 0, per_cu = 0;
        if (n_in != 31 || ws_size < WS_END) { fprintf(stderr, "kernel_launch: unexpected n_in %d / ws %zu\n", n_in, ws_size); grid = -1; return; }
        hipGetDevice(&dev); hipDeviceGetAttribute(&cus, hipDeviceAttributeMultiprocessorCount, dev);
        if (hipFuncSetAttribute((const void*)mega_fwd, hipFuncAttributeMaxDynamicSharedMemorySize, LDS_BYTES) != hipSuccess) { fprintf(stderr, "kernel_launch: hipFuncSetAttribute failed\n"); grid = -1; return; }
        if (hipOccupancyMaxActiveBlocksPerMultiprocessor(&per_cu, (const void*)mega_fwd, 512, LDS_BYTES) != hipSuccess || per_cu < 1) { fprintf(stderr, "kernel_launch: occupancy query says %d blocks/CU\n", per_cu); per_cu = 1; }
        (void)hipGetLastError();
        grid = cus > 0 ? cus : 256;
    }
    if (grid < 0) return;
    if (hipMemsetAsync(d_ws, 0, 16384, stream) != hipSuccess) { fprintf(stderr, "kernel_launch: memset of the barrier word failed\n"); return; }
    Args a{};
    for (int i = 0; i < 31; ++i) a.in[i] = (const float*)d_in[i];
    a.out = (float*)d_out; a.ws = (unsigned char*)d_ws;
#if MK_PER_PHASE
    for (int ph = 0; ph < NPHASE; ++ph) {
        a.ph_lo = ph; a.ph_hi = ph + 1;
        void* args[] = {&a};
        hipError_t e = hipLaunchCooperativeKernel((const void*)mega_fwd, dim3(grid), dim3(512), args, LDS_BYTES, stream);
        if (e != hipSuccess) { fprintf(stderr, "kernel_launch: launch of phase %d failed: %s\n", ph, hipGetErrorString(e)); break; }
    }
#else
    a.ph_lo = 0; a.ph_hi = NPHASE;
    void* args[] = {&a};
    hipError_t e = hipLaunchCooperativeKernel((const void*)mega_fwd, dim3(grid), dim3(512), args, LDS_BYTES, stream);
    if (e != hipSuccess) fprintf(stderr, "kernel_launch: cooperative launch failed: %s (grid %d)\n", hipGetErrorString(e), grid);
#endif
}
```

```cpp
#include <hip/hip_runtime.h>
#include <hip/hip_cooperative_groups.h>
#include <cstdio>
#include <cstdint>
namespace cg = cooperative_groups;

#ifndef MK_PER_PHASE
#define MK_PER_PHASE 0
#endif

typedef unsigned short bf16_t;
typedef short bf16x8 __attribute__((ext_vector_type(8)));
typedef float f32x4 __attribute__((ext_vector_type(4)));
typedef float f32x2 __attribute__((ext_vector_type(2)));
typedef float f32x16 __attribute__((ext_vector_type(16)));
typedef unsigned u32x4 __attribute__((ext_vector_type(4)));
typedef unsigned u32x2 __attribute__((ext_vector_type(2)));
#define LAS __attribute__((address_space(3)))

constexpr int BATCH = 16, SEQ = 2048, DM = 2048, MROWS = BATCH * SEQ, DIN = 2888, DFF = 5504;
constexpr int N1 = 9216;
constexpr float EPS = 1e-6f;
constexpr int NPHASE = 21;

constexpr size_t MiB = 1u << 20;
constexpr size_t WS_MOD = 1 * MiB;
constexpr size_t WS_WI = 3 * MiB;
constexpr size_t WS_W = 4 * MiB;
constexpr size_t W_1CAT = WS_W, W_P = WS_W + 36 * MiB, W_OUT = WS_W + 44 * MiB, W_UP = WS_W + 52 * MiB, W_DOWN = WS_W + 95 * MiB,
                 W_GLU = WS_W + 116 * MiB + MiB / 2, W_POOL = WS_W + 117 * MiB;
constexpr size_t WS_R1 = 122 * MiB;
constexpr size_t WS_Y = WS_R1, WS_POOLED = WS_R1 + 32 * MiB;
constexpr size_t WS_R2 = 250 * MiB;
constexpr size_t WS_OCAT = 634 * MiB;
constexpr size_t WS_SA = WS_OCAT, WS_SB = WS_OCAT + 44 * MiB;
constexpr size_t WS_KN = 762 * MiB, WS_V = 770 * MiB, WS_QI = 778 * MiB, WS_KI = 810 * MiB, WS_U = 814 * MiB, WS_P = 846 * MiB, WS_END = 878 * MiB;
constexpr int LDS_BYTES = 163840;

__device__ __forceinline__ unsigned f2bf(float f) { unsigned u = __float_as_uint(f); return (u + 0x7fffu + ((u >> 16) & 1u)) >> 16; }
__device__ __forceinline__ unsigned pk2(float lo, float hi) { unsigned r; asm("v_cvt_pk_bf16_f32 %0, %1, %2" : "=v"(r) : "v"(lo), "v"(hi)); return r; }
__device__ __forceinline__ float bflo(unsigned u) { return __uint_as_float(u << 16); }
__device__ __forceinline__ float bfhi(unsigned u) { return __uint_as_float(u & 0xffff0000u); }
__device__ __forceinline__ float bf1(bf16_t b) { return __uint_as_float(((unsigned)b) << 16); }
__device__ __forceinline__ float sigmoidf_(float x) { return __builtin_amdgcn_rcpf(1.f + __expf(-x)); }
__device__ __forceinline__ float siluf_(float x) { return x * __builtin_amdgcn_rcpf(1.f + __expf(-x)); }
__device__ __forceinline__ float dpp_ror1(float v) { return __builtin_bit_cast(float, __builtin_amdgcn_update_dpp(0, __builtin_bit_cast(int, v), 0x121, 0xf, 0xf, false)); }
__device__ __forceinline__ float dpp_ror2(float v) { return __builtin_bit_cast(float, __builtin_amdgcn_update_dpp(0, __builtin_bit_cast(int, v), 0x122, 0xf, 0xf, false)); }
__device__ __forceinline__ float gelu_tanh(float x) { const float z = 0.7978845608028654f * (x + 0.044715f * x * x * x); const float t = 1.f - 2.f * __builtin_amdgcn_rcpf(1.f + __expf(2.f * z)); return 0.5f * x * (1.f + t); }
__device__ __forceinline__ uint4 pack8(f32x4 a, f32x4 b) { uint4 r; r.x = pk2(a[0], a[1]); r.y = pk2(a[2], a[3]); r.z = pk2(b[0], b[1]); r.w = pk2(b[2], b[3]); return r; }
__device__ __forceinline__ void unpack8(uint4 v, float* f) { f[0] = bflo(v.x); f[1] = bfhi(v.x); f[2] = bflo(v.y); f[3] = bfhi(v.y); f[4] = bflo(v.z); f[5] = bfhi(v.z); f[6] = bflo(v.w); f[7] = bfhi(v.w); }
#define LDS_FENCE() asm volatile("s_waitcnt lgkmcnt(0)" ::: "memory")
__device__ __forceinline__ int fresh_tid(int wv) { int l = (int)__builtin_amdgcn_mbcnt_hi(~0u, __builtin_amdgcn_mbcnt_lo(~0u, 0u)); asm volatile("" : "+v"(l)); return (wv << 6) | l; }

namespace pg8 {
constexpr int BM = 256, BK = 64, HALF = 128, HTB = HALF * BK * 2, STAGE_BYTES = 8 * HTB, NXCD = 8, WGM = 4;
__host__ __device__ __forceinline__ int lds_byte(int r, int c) { const int st = (r >> 4) * 2 + (c >> 5), rr = r & 15, cc = c & 31, ob = rr * 64 + cc * 2; return st * 1024 + (ob ^ (((ob >> 9) & 1) << 5)); }
__host__ __device__ __forceinline__ void stage_rc(int b, int& R, int& C) { const int st = b / 1024, sb = b % 1024, swz = sb ^ (((sb >> 9) & 1) << 5); R = (st >> 1) * 16 + swz / 64; C = (st & 1) * 32 + (swz % 64) / 2; }
__host__ __device__ __forceinline__ int perm32(int rho) { const int n = rho >> 4, i = rho & 15; return 8 * (i >> 2) + 4 * n + (i & 3); }
struct Unit { int pm, pn; };
struct Gemm { const bf16_t* A; const bf16_t* Bt; int M, N, K, lda, ldb; int asplit; size_t aoff; };
struct StaticOrder {
    int nM, nN, nwg, G, c;
    __device__ void init(int M, int N, int G_, int c_) { nM = M / BM; nN = N / BM; nwg = nM * nN; G = G_; c = c_; }
    __device__ bool next(int i, Unit& u) const {
        const long L = (long)i * G + c; if (L >= nwg) return false;
        int wgid = (int)L; { const int q = nwg / NXCD, r = nwg % NXCD, xcd = wgid % NXCD, off = wgid / NXCD; wgid = (xcd < r ? xcd * (q + 1) : r * (q + 1) + (xcd - r) * q) + off; }
        const int nig = WGM * nN, gid = wgid / nig, fm = gid * WGM, gsz = (nM - fm) < WGM ? (nM - fm) : WGM;
        u.pm = fm + ((wgid % nig) % gsz); u.pn = (wgid % nig) / gsz; return true;
    }
};
template <class Epi, class Sched>
__device__ __forceinline__ void gemm_phase(LAS unsigned char* lds, const Gemm g, const Sched& S, const Epi& E, const int WV) {
    const int TI = fresh_tid(WV);
    const int tid = TI, wid = __builtin_amdgcn_readfirstlane(tid >> 6), lane = tid & 63, wr = wid >> 2, wc = wid & 3, fr = lane & 15, fq = lane >> 4;
    const int K = g.K, nt = K / BK;
    unsigned voffA[2], voffB[2];
#pragma unroll
    for (int i = 0; i < 2; ++i) { int R, C; stage_rc(tid * 16 + i * 8192, R, C); const int Rb = Epi::PERM ? ((R & ~31) + perm32(R & 31)) : R;
        voffA[i] = (unsigned)(R * g.lda + C) * 2u; voffB[i] = (unsigned)(Rb * g.ldb + C) * 2u; }
    const size_t kstep = (size_t)(BK * 2);
    const size_t hstepA = (size_t)HALF * g.lda * 2, hstepB = (size_t)HALF * g.ldb * 2;
    const size_t tstepA = 2 * hstepA, tstepB = 2 * hstepB;
    const unsigned ldsw = (unsigned)wid * 1024u;
    const int aoff = lds_byte(wr * 64 + fr, fq * 8), boff = lds_byte(wc * 32 + fr, fq * 8);
#define PG8_SA(b, h) (((b) * 2 + (h)) * HTB)
#define PG8_SB(b, h) ((4 + (b) * 2 + (h)) * HTB)
#define PG8_STAGE(bufoff, gbase, voff) do { _Pragma("unroll") for (int _i = 0; _i < 2; ++_i) \
        __builtin_amdgcn_global_load_lds((const unsigned*)((const char*)(gbase) + (voff)[_i]), (LAS unsigned*)(lds + (bufoff) + ldsw + _i * 8192), 16, 0, 0); } while (0)
#define PG8_LDA(dst, b, h) do { _Pragma("unroll") for (int m = 0; m < 4; ++m) _Pragma("unroll") for (int k = 0; k < 2; ++k) dst[m][k] = *(const LAS bf16x8*)(lds + PG8_SA(b, h) + aoff + m * 2048 + k * 1024); } while (0)
#define PG8_LDB(dst, b, h) do { _Pragma("unroll") for (int n = 0; n < 2; ++n) _Pragma("unroll") for (int k = 0; k < 2; ++k) dst[n][k] = *(const LAS bf16x8*)(lds + PG8_SB(b, h) + boff + n * 2048 + k * 1024); } while (0)
#define PG8_MMA(ai, bj, At, Bt) do { __builtin_amdgcn_s_setprio(1); _Pragma("unroll") for (int m = 0; m < 4; ++m) _Pragma("unroll") for (int n = 0; n < 2; ++n) _Pragma("unroll") for (int k = 0; k < 2; ++k) \
        acc[ai][bj][m][n] = __builtin_amdgcn_mfma_f32_16x16x32_bf16(Bt[n][k], At[m][k], acc[ai][bj][m][n], 0, 0, 0); __builtin_amdgcn_s_setprio(0); } while (0)
#define PG8_WAIT_V(n) asm volatile("s_waitcnt vmcnt(" #n ")" ::: "memory")
#define PG8_WAIT_L(n) asm volatile("s_waitcnt lgkmcnt(" #n ")" ::: "memory")
#define PG8_BAR __builtin_amdgcn_s_barrier()
#define PG8_SCHED __builtin_amdgcn_sched_barrier(0)
#define PG8_ZERO() do { _Pragma("unroll") for (int a_ = 0; a_ < 2; ++a_) _Pragma("unroll") for (int b_ = 0; b_ < 2; ++b_) _Pragma("unroll") for (int m_ = 0; m_ < 4; ++m_) _Pragma("unroll") for (int n_ = 0; n_ < 2; ++n_) acc[a_][b_][m_][n_] = (f32x4){0.f, 0.f, 0.f, 0.f}; } while (0)
    Unit cur, nxt; int ui = 0;
    if (!S.next(0, cur)) return;
    if constexpr (Epi::PREF) E.prefetch(cur, wr, wc, lane);
    f32x4 acc[2][2][4][2];
    PG8_ZERO();
    bf16x8 At[4][2], B0[2][2], B1[2][2];
    const char* cA = (const char*)g.A + (size_t)cur.pm * tstepA + (cur.pn >= g.asplit ? g.aoff : (size_t)0); const char* cB = (const char*)g.Bt + (size_t)cur.pn * tstepB;
    PG8_STAGE(PG8_SB(0, 0), cB, voffB); PG8_STAGE(PG8_SB(0, 1), cB + hstepB, voffB); PG8_STAGE(PG8_SA(0, 0), cA, voffA); PG8_STAGE(PG8_SA(0, 1), cA + hstepA, voffA);
    if (wr == 1) PG8_BAR;
    PG8_WAIT_V(2); PG8_BAR;
    PG8_STAGE(PG8_SB(1, 0), cB + kstep, voffB); PG8_STAGE(PG8_SA(1, 0), cA + kstep, voffA); PG8_STAGE(PG8_SB(1, 1), cB + hstepB + kstep, voffB);
    PG8_WAIT_V(6); PG8_BAR;
    for (;;) {
        const bool has_next = S.next(ui + 1, nxt);
        const char* nA = has_next ? (const char*)g.A + (size_t)nxt.pm * tstepA + (nxt.pn >= g.asplit ? g.aoff : (size_t)0) : cA; const char* nB = has_next ? (const char*)g.Bt + (size_t)nxt.pn * tstepB : cB;
        for (int t = 0; t < nt; t += 2) {
            const bool last = (t == nt - 2);
            const char* a1 = cA + (size_t)(t + 1) * kstep;
            const char* a2 = last ? nA : cA + (size_t)(t + 2) * kstep; const char* b2 = last ? nB : cB + (size_t)(t + 2) * kstep;
            const char* a3 = a2 + kstep; const char* b3 = b2 + kstep;
            PG8_LDB(B0, 0, 0); PG8_LDB(B1, 0, 1); PG8_SCHED; PG8_LDA(At, 0, 0); PG8_STAGE(PG8_SA(1, 1), a1 + hstepA, voffA);
            PG8_WAIT_V(8); PG8_WAIT_L(0); PG8_BAR; PG8_MMA(0, 0, At, B0); PG8_MMA(0, 1, At, B1); PG8_BAR; PG8_SCHED;
            PG8_LDA(At, 0, 1); PG8_STAGE(PG8_SB(0, 0), b2, voffB); PG8_STAGE(PG8_SB(0, 1), b2 + hstepB, voffB); PG8_STAGE(PG8_SA(0, 0), a2, voffA);
            PG8_WAIT_V(8); PG8_WAIT_L(0); PG8_BAR; PG8_MMA(1, 0, At, B0); PG8_MMA(1, 1, At, B1); PG8_BAR; PG8_SCHED;
            PG8_LDB(B0, 1, 0); PG8_LDB(B1, 1, 1); PG8_SCHED; PG8_LDA(At, 1, 0); PG8_STAGE(PG8_SA(0, 1), a2 + hstepA, voffA);
            PG8_WAIT_V(8); PG8_WAIT_L(0); PG8_BAR; PG8_MMA(0, 0, At, B0); PG8_MMA(0, 1, At, B1); PG8_BAR; PG8_SCHED;
            PG8_LDA(At, 1, 1); PG8_STAGE(PG8_SB(1, 0), b3, voffB); PG8_STAGE(PG8_SB(1, 1), b3 + hstepB, voffB); PG8_STAGE(PG8_SA(1, 0), a3, voffA);
            PG8_WAIT_V(8); PG8_WAIT_L(0); PG8_BAR; PG8_MMA(1, 0, At, B0); PG8_MMA(1, 1, At, B1); PG8_BAR; PG8_SCHED;
            if constexpr (Epi::SEG) { if (t + 2 == 16 || t + 2 == 24) { E.flush(acc, cur, (t + 2 == 16) ? 0 : 1, wr, wc, fr, fq); PG8_ZERO(); } }
        }
        if (wr == 0) PG8_BAR;
        if constexpr (Epi::SEG) E.flush(acc, cur, 2, wr, wc, fr, fq); else E(acc, cur, wr, wc, fr, fq);
        if (!has_next) break;
        if constexpr (Epi::PREF) E.prefetch(nxt, wr, wc, lane);
        PG8_ZERO();
        cur = nxt; cA = nA; cB = nB; ++ui;
        if (wr == 1) PG8_BAR;
    }
    PG8_WAIT_V(0);
    PG8_BAR;
#undef PG8_SA
#undef PG8_SB
#undef PG8_STAGE
#undef PG8_LDA
#undef PG8_LDB
#undef PG8_MMA
#undef PG8_WAIT_V
#undef PG8_WAIT_L
#undef PG8_BAR
#undef PG8_SCHED
#undef PG8_ZERO
}
}
using pg8::Unit;
typedef const f32x4 (&AccRef)[2][2][4][2];

struct Epi1 {
    static constexpr bool PERM = true, SEG = false, PREF = true;
    bf16_t *ocat, *kn, *vv, *qi, *ki, *u, *p, *gates; float* wi; const float* bgate; LAS unsigned char* stg;
    __device__ __forceinline__ void prefetch(const Unit& un, int wr, int wc, int lane) const {
        if (un.pn >= 12) __builtin_amdgcn_global_load_lds((const unsigned*)(bgate + (un.pn - 12) * 256 + 64 * wc + lane), (LAS unsigned*)(stg + (wr * 4 + wc) * 2304 + 2048), 4, 0, 0);
    }
    __device__ __forceinline__ void operator()(AccRef acc, const Unit& un, int wr, int wc, int fr, int fq) const {
        asm volatile("" : "+v"(fr), "+v"(fq));
        const int pn = un.pn, rowb = un.pm * 256 + wr * 64, lane = fq * 16 + fr;
        LAS unsigned char* sb = stg + (wr * 4 + wc) * 2304;
        if (pn == 7 && wc >= 1) {
            if (wc == 1 && fq == 0) {
                const float s = 0.35355339059327373f * 0.125f;
#pragma unroll
                for (int ai = 0; ai < 2; ++ai)
#pragma unroll
                    for (int m = 0; m < 4; ++m) { const size_t row = (size_t)(rowb + ai * 128 + m * 16 + fr);
                        *(f32x4*)(wi + row * 8) = acc[ai][0][m][0] * s; *(f32x4*)(wi + row * 8 + 4) = acc[ai][0][m][1] * s; }
            }
            return;
        }
        if (pn >= 12) {
            const int c0 = (pn - 12) * 256 + 64 * wc;
            f32x4 bz[2][2];
#pragma unroll
            for (int bj = 0; bj < 2; ++bj) { const LAS float* bp_ = (const LAS float*)(sb + 2048) + 32 * bj + 8 * fq;
                bz[bj][0] = *(const LAS f32x4*)bp_ * -1.4426950408889634f; bz[bj][1] = *(const LAS f32x4*)(bp_ + 4) * -1.4426950408889634f; }
            unsigned char* gb = (unsigned char*)gates + c0;
#pragma unroll
            for (int ai = 0; ai < 2; ++ai)
#pragma unroll
                for (int m = 0; m < 4; ++m) {
#pragma unroll
                    for (int bj = 0; bj < 2; ++bj) { uint2 q; unsigned w[2];
#pragma unroll
                        for (int n = 0; n < 2; ++n) { unsigned t = 0u;
#pragma unroll
                            for (int e = 0; e < 4; ++e) { const float ex_ = __builtin_amdgcn_exp2f(fmaf(acc[ai][bj][m][n][e], -1.4426950408889634f, bz[bj][n][e]));
                                t = __builtin_amdgcn_cvt_pk_u8_f32(__builtin_amdgcn_rcpf(fmaf(ex_, 1.f / 255.f, 1.f / 255.f)), e, t); }
                            w[n] = t; }
                        q.x = w[0]; q.y = w[1];
                        *(LAS u32x2*)(sb + fr * 80 + 32 * bj + 8 * fq) = (u32x2){q.x, q.y}; }
                    LDS_FENCE();
                    { const int r = lane >> 2, sg = lane & 3; const u32x4 v = *(const LAS u32x4*)(sb + r * 80 + sg * 16);
                      *(u32x4*)(gb + (size_t)(rowb + ai * 128 + m * 16 + r) * 6144 + sg * 16) = v; }
                    LDS_FENCE();
                }
            return;
        }
        bf16_t* base; int ld;
        if (pn < 4) { base = ocat + pn * 256 + 64 * wc; ld = 2048; }
        else if (pn == 4) { base = (wc < 2 ? kn : vv) + 64 * (wc & 1); ld = 128; }
        else if (pn < 7) { base = qi + (pn - 5) * 256 + 64 * wc; ld = 512; }
        else if (pn == 7) { base = ki; ld = 64; }
        else if (pn < 10) { base = u + (pn - 8) * 256 + 64 * wc; ld = 512; }
        else { base = p + (pn - 10) * 256 + 64 * wc; ld = 512; }
#pragma unroll
        for (int ai = 0; ai < 2; ++ai)
#pragma unroll
            for (int m = 0; m < 4; ++m) {
#pragma unroll
                for (int bj = 0; bj < 2; ++bj) { const uint4 pk_ = pack8(acc[ai][bj][m][0], acc[ai][bj][m][1]); *(LAS u32x4*)(sb + fr * 144 + 64 * bj + 16 * fq) = (u32x4){pk_.x, pk_.y, pk_.z, pk_.w}; }
                LDS_FENCE();
#pragma unroll
                for (int h = 0; h < 2; ++h) { const int r = h * 8 + (lane >> 3), sg = lane & 7; const u32x4 v = *(const LAS u32x4*)(sb + r * 144 + sg * 16);
                    *(u32x4*)(base + (size_t)(rowb + ai * 128 + m * 16 + r) * ld + sg * 8) = v; }
                LDS_FENCE();
            }
    }
};
struct EpiGluPool {
    static constexpr bool PERM = true, SEG = false, PREF = false;
    const bf16_t* y; const float* scale; bf16_t* ocat;
    __device__ __forceinline__ void operator()(AccRef acc, const Unit& un, int wr, int wc, int fr, int fq) const {
        asm volatile("" : "+v"(fr), "+v"(fq));
        const int row0 = un.pm * 256 + wr * 64 + fr; const bool glu = un.pn < 2;
#pragma unroll
        for (int bj = 0; bj < 2; ++bj) { const int col = (un.pn & 1) * 256 + 64 * wc + 32 * bj + 8 * fq;
            f32x4 s0 = {0.f, 0.f, 0.f, 0.f}, s1 = {0.f, 0.f, 0.f, 0.f};
            if (!glu) { s0 = *(const f32x4*)(scale + col); s1 = *(const f32x4*)(scale + col + 4); }
#pragma unroll
            for (int ai = 0; ai < 2; ++ai) {
                uint4 yq[4];
                if (glu) {
#pragma unroll
                    for (int m = 0; m < 4; ++m) yq[m] = *(const uint4*)(y + (size_t)(row0 + ai * 128 + m * 16) * 512 + col); }
#pragma unroll
                for (int m = 0; m < 4; ++m) { const size_t row = (size_t)(row0 + ai * 128 + m * 16);
                    f32x4 v0 = acc[ai][bj][m][0], v1 = acc[ai][bj][m][1];
                    if (glu) { float yv[8]; unpack8(yq[m], yv);
#pragma unroll
                        for (int e = 0; e < 4; ++e) { v0[e] = yv[e] * sigmoidf_(v0[e]); v1[e] = yv[4 + e] * sigmoidf_(v1[e]); }
                        *(uint4*)(ocat + row * 2048 + 1024 + col) = pack8(v0, v1);
                    } else *(uint4*)(ocat + row * 2048 + 1536 + col) = pack8(v0 * s0, v1 * s1); } } }
    }
};
struct EpiMerge {
    static constexpr bool PERM = true, SEG = true, PREF = false;
    const bf16_t* gates; bf16_t* merged; LAS unsigned char* stg;
    __device__ __forceinline__ void flush(AccRef acc, const Unit& un, int seg, int wr, int wc, int fr, int fq) const {
        asm volatile("" : "+v"(fr), "+v"(fq));
        const int rowb = un.pm * 256 + wr * 64, lane = fq * 16 + fr;
        const int colw = un.pn * 256 + 64 * wc;
        LAS unsigned char* sb = stg + (wr * 4 + wc) * 2304;
#pragma unroll
        for (int ai = 0; ai < 2; ++ai) {
            uint2 gq[2][4]; uint4 pq[2][4];
#pragma unroll
            for (int bj = 0; bj < 2; ++bj)
#pragma unroll
                for (int m = 0; m < 4; ++m) { const size_t row = (size_t)(rowb + ai * 128 + m * 16 + fr); const int col = colw + 32 * bj + 8 * fq;
                    gq[bj][m] = *(const uint2*)((const unsigned char*)gates + row * 6144 + seg * 2048 + col);
                    if (seg > 0) pq[bj][m] = *(const uint4*)(merged + row * 2048 + col); else pq[bj][m] = make_uint4(0u, 0u, 0u, 0u); }
#pragma unroll
            for (int m = 0; m < 4; ++m) {
#pragma unroll
                for (int bj = 0; bj < 2; ++bj) {
                    float gv[8], pv[8]; unpack8(pq[bj][m], pv);
#pragma unroll
                    for (int e = 0; e < 4; ++e) { gv[e] = (float)((gq[bj][m].x >> (8 * e)) & 0xffu) * (1.f / 255.f); gv[4 + e] = (float)((gq[bj][m].y >> (8 * e)) & 0xffu) * (1.f / 255.f); }
                    f32x4 v0 = acc[ai][bj][m][0], v1 = acc[ai][bj][m][1];
#pragma unroll
                    for (int e = 0; e < 4; ++e) { v0[e] = pv[e] + gv[e] * v0[e]; v1[e] = pv[4 + e] + gv[4 + e] * v1[e]; }
                    const uint4 pk_ = pack8(v0, v1); *(LAS u32x4*)(sb + fr * 144 + 64 * bj + 16 * fq) = (u32x4){pk_.x, pk_.y, pk_.z, pk_.w}; }
                LDS_FENCE();
#pragma unroll
                for (int h = 0; h < 2; ++h) { const int r = h * 8 + (lane >> 3), sg = lane & 7; const u32x4 v = *(const LAS u32x4*)(sb + r * 144 + sg * 16);
                    *(u32x4*)(merged + (size_t)(rowb + ai * 128 + m * 16 + r) * 2048 + colw + sg * 8) = v; }
                LDS_FENCE();
            }
        }
    }
};
struct EpiRes {
    static constexpr bool PERM = false, SEG = false, PREF = false;
    const float* xin; float* out; const float* gt;
    __device__ __forceinline__ void operator()(AccRef acc, const Unit& un, int wr, int wc, int fr, int fq) const {
        asm volatile("" : "+v"(fr), "+v"(fq));
        const int row0 = un.pm * 256 + wr * 64 + fr; const float* g = gt + (size_t)(un.pm >> 3) * 12288;
#pragma unroll
        for (int bj = 0; bj < 2; ++bj) { const int col = un.pn * 256 + bj * 128 + wc * 32 + 4 * fq;
            f32x4 gv[2], xv[2][2][4];
#pragma unroll
            for (int n = 0; n < 2; ++n) gv[n] = *(const f32x4*)(g + col + 16 * n);
#pragma unroll
            for (int n = 0; n < 2; ++n)
#pragma unroll
                for (int ai = 0; ai < 2; ++ai)
#pragma unroll
                    for (int m = 0; m < 4; ++m) xv[n][ai][m] = *(const f32x4*)(xin + (size_t)(row0 + ai * 128 + m * 16) * 2048 + col + 16 * n);
#pragma unroll
            for (int n = 0; n < 2; ++n)
#pragma unroll
                for (int ai = 0; ai < 2; ++ai)
#pragma unroll
                    for (int m = 0; m < 4; ++m) *(f32x4*)(out + (size_t)(row0 + ai * 128 + m * 16) * 2048 + col + 16 * n) = xv[n][ai][m] + gv[n] * acc[ai][bj][m][n]; }
    }
};
struct EpiUp {
    static constexpr bool PERM = true, SEG = false, PREF = true;
    bf16_t* act; float* SA; float* SB; const float* cw; const float* cb; LAS unsigned char* stg;
    __device__ __forceinline__ void prefetch(const Unit& un, int wr, int wc, int lane) const {
        LAS unsigned char* sb = stg + (wr * 4 + wc) * 2304; const int ch = un.pn * 128 + wc * 32 + (lane & 31);
        const float* s0 = (lane < 32) ? cw + ch : cw + DFF + ch; const float* s1 = (lane < 32) ? cw + 2 * DFF + ch : cb + ch;
        __builtin_amdgcn_global_load_lds((const unsigned*)s0, (LAS unsigned*)(sb + 1536), 4, 0, 0);
        __builtin_amdgcn_global_load_lds((const unsigned*)s1, (LAS unsigned*)(sb + 1536 + 256), 4, 0, 0);
    }
    __device__ __forceinline__ void operator()(AccRef acc, const Unit& un, int wr, int wc, int fr, int fq) const {
        asm volatile("" : "+v"(fr), "+v"(fq));
        const int lg = fq << 4, lane = lg | fr;
        const int src1 = lg | ((fr + 15) & 15), src2 = lg | ((fr + 14) & 15);
        const int ch0 = un.pn * 128 + wc * 32 + 8 * fq;
        LAS unsigned char* sb = stg + (wr * 4 + wc) * 2304;
        f32x4 w0[2], w1[2], w2[2], bb[2];
#pragma unroll
        for (int n = 0; n < 2; ++n) { const LAS float* wp_ = (const LAS float*)(sb + 1536) + 8 * fq + 4 * n;
            w0[n] = *(const LAS f32x4*)wp_; w1[n] = *(const LAS f32x4*)(wp_ + 32); w2[n] = *(const LAS f32x4*)(wp_ + 64); bb[n] = *(const LAS f32x4*)(wp_ + 96); }
#pragma unroll
        for (int ai = 0; ai < 2; ++ai) {
            const int rowb = un.pm * 256 + ai * 128 + wr * 64; const int blk = rowb >> 6;
#pragma unroll
            for (int m = 0; m < 4; ++m) {
                f32x4 res[2];
#pragma unroll
                for (int n = 0; n < 2; ++n)
#pragma unroll
                    for (int e = 0; e < 4; ++e) {
                        const float cur = acc[ai][0][m][n][e];
                        const float prv = (m > 0) ? acc[ai][0][m > 0 ? m - 1 : 0][n][e] : 0.f;
                        const float p1 = dpp_ror1((fr + 1 >= 16) ? prv : cur);
                        const float p2 = dpp_ror2((fr + 2 >= 16) ? prv : cur);
                        const float cv = bb[n][e] + w0[n][e] * p2 + w1[n][e] * p1 + w2[n][e] * cur;
                        res[n][e] = siluf_(cv) * acc[ai][1][m][n][e];
                    }
                if (m == 0 && fr < 2) {
                    float* sa = SA + ((size_t)(blk * 4 + 2 + fr)) * DFF + ch0; float* sbp = SB + ((size_t)(blk * 2 + fr)) * DFF + ch0;
                    *(f32x4*)sa = acc[ai][0][0][0]; *(f32x4*)(sa + 4) = acc[ai][0][0][1];
                    *(f32x4*)sbp = acc[ai][1][0][0]; *(f32x4*)(sbp + 4) = acc[ai][1][0][1];
                }
                if (m == 3 && fr >= 14) { float* sa = SA + ((size_t)(blk * 4 + (fr - 14))) * DFF + ch0; *(f32x4*)sa = acc[ai][0][3][0]; *(f32x4*)(sa + 4) = acc[ai][0][3][1]; }
                { const uint4 pk_ = pack8(res[0], res[1]); *(LAS u32x4*)(sb + fr * 80 + 16 * fq) = (u32x4){pk_.x, pk_.y, pk_.z, pk_.w}; }
                LDS_FENCE();
                { const int r = lane >> 2, sg = lane & 3; const u32x4 v = *(const LAS u32x4*)(sb + r * 80 + sg * 16);
                  if (!(m == 0 && r < 2)) *(u32x4*)(act + (size_t)(rowb + m * 16 + r) * DFF + un.pn * 128 + wc * 32 + sg * 8) = v; }
                LDS_FENCE();
            }
        }
    }
};

struct Args { const float* in[31]; float* out; unsigned char* ws; int ph_lo, ph_hi; };
enum { I_X = 0, I_C, I_POS, I_WADA, I_BADA, I_GN1, I_GN2, I_WIN, I_GQ, I_GK, I_ARE, I_AIM, I_BRE, I_BIM, I_CRE, I_CIM, I_DSKIP, I_LOGDT, I_WGLU, I_WPOOL, I_PSCALE, I_PA, I_PB, I_PC, I_WGATE, I_BGATE, I_WOUT, I_WUP, I_CONVW, I_CONVB, I_WDOWN };

__device__ __forceinline__ float wave_sum(float v) {
#pragma unroll
    for (int o = 32; o > 0; o >>= 1) v += __shfl_xor(v, o);
    return v;
}

__device__ __forceinline__ void phase_ada(const Args& a, unsigned char* lds, const int WV) {
    const int TI = fresh_tid(WV);
    const int tid = TI;
    float* cact = (float*)lds;
    float* mod = (float*)(a.ws + WS_MOD);
    for (int w = blockIdx.x; w < 256; w += gridDim.x) {
        for (int i = tid; i < 16 * 2048; i += 512) { const int b = i >> 11, k = i & 2047; const float v = a.in[I_C][i]; cact[k * 16 + b] = siluf_(v); }
        __syncthreads();
        const int l = w >> 7, n0 = (w & 127) * 96;
        float acc[16][4];
#pragma unroll
        for (int b = 0; b < 16; ++b)
#pragma unroll
            for (int j = 0; j < 4; ++j) acc[b][j] = 0.f;
        const int cg4 = tid % 24, ks = tid / 24;
        if (tid < 384) {
            const float* wp = a.in[I_WADA] + ((size_t)l * 2048 + ks * 128) * 12288 + n0 + cg4 * 4;
#pragma unroll 4
            for (int k = 0; k < 128; ++k) {
                const f32x4 wv = *(const f32x4*)(wp + (size_t)k * 12288);
                const f32x4* cp = (const f32x4*)(cact + (ks * 128 + k) * 16);
#pragma unroll
                for (int q = 0; q < 4; ++q) { const f32x4 cv = cp[q];
#pragma unroll
                    for (int e = 0; e < 4; ++e)
#pragma unroll
                        for (int j = 0; j < 4; ++j) acc[q * 4 + e][j] += cv[e] * wv[j]; }
            }
        }
        __syncthreads();
        float* part = (float*)lds;
        if (tid < 384) {
#pragma unroll
            for (int b = 0; b < 16; ++b)
#pragma unroll
                for (int j = 0; j < 4; ++j) part[(ks * 16 + b) * 96 + cg4 * 4 + j] = acc[b][j];
        }
        __syncthreads();
        for (int o = tid; o < 1536; o += 512) { const int b = o / 96, cc = o % 96; float s = 0.f;
#pragma unroll
            for (int k2 = 0; k2 < 16; ++k2) s += part[(k2 * 16 + b) * 96 + cc];
            mod[((size_t)l * 16 + b) * 12288 + n0 + cc] = s + a.in[I_BADA][l * 12288 + n0 + cc]; }
        __syncthreads();
    }
}

struct CvtJob { const float* src; bf16_t* dst; int ldS, cbase, cend, kbase, ldD, mode, r0, cs0, kd0; };
__device__ __forceinline__ CvtJob cvt_decode(const Args& a, int l, int t) {
    unsigned char* ws = a.ws; CvtJob J; int ncols, nkt, idx; J.mode = 0; J.r0 = 0; J.kd0 = 0; J.cs0 = 0;
    if (t < 960) { idx = t; J.src = a.in[I_WIN] + (size_t)l * DM * DIN; J.ldS = DIN; ncols = 1864; nkt = 32; J.dst = (bf16_t*)(ws + W_1CAT); J.ldD = 2048; J.mode = 2; }
    else if (t < 1472) { idx = t - 960; J.src = a.in[I_WIN] + (size_t)l * DM * DIN; J.ldS = DIN; J.cs0 = 1864; ncols = 1024; nkt = 32; J.dst = (bf16_t*)(ws + W_1CAT); J.ldD = 2048; J.r0 = 2048; J.mode = 2; }
    else if (t < 4544) { idx = t - 1472; const int gi = idx >> 10; idx &= 1023; J.src = a.in[I_WGATE] + ((size_t)l * 3 + gi) * DM * DM; J.ldS = DM; ncols = 2048; nkt = 32; J.dst = (bf16_t*)(ws + W_1CAT); J.ldD = 2048; J.r0 = 3072 + 2048 * gi; J.mode = 2; }
    else if (t < 5056) { idx = t - 4544; J.src = a.in[I_PA] + (size_t)l * 1024 * DM; J.ldS = DM; ncols = 2048; nkt = 16; J.dst = (bf16_t*)(ws + W_P); J.ldD = 2048; J.mode = 2; }
    else if (t < 5312) { idx = t - 5056; J.src = a.in[I_PB] + (size_t)l * 512 * DM; J.ldS = DM; ncols = 2048; nkt = 8; J.dst = (bf16_t*)(ws + W_P); J.ldD = 2048; J.kd0 = 1024; J.mode = 2; }
    else if (t < 5568) { idx = t - 5312; J.src = a.in[I_PC] + (size_t)l * 512 * DM; J.ldS = DM; ncols = 2048; nkt = 8; J.dst = (bf16_t*)(ws + W_P); J.ldD = 2048; J.kd0 = 1536; J.mode = 2; }
    else if (t < 6592) { idx = t - 5568; J.src = a.in[I_WOUT] + (size_t)l * DM * DM; J.ldS = DM; ncols = 2048; nkt = 32; J.dst = (bf16_t*)(ws + W_OUT); J.ldD = 2048; }
    else if (t < 12096) { idx = t - 6592; J.src = a.in[I_WUP] + (size_t)l * DM * 2 * DFF; J.ldS = 2 * DFF; ncols = 2 * DFF; nkt = 32; J.dst = (bf16_t*)(ws + W_UP); J.ldD = 2048; J.mode = 1; }
    else if (t < 14848) { idx = t - 12096; J.src = a.in[I_WDOWN] + (size_t)l * DFF * DM; J.ldS = DM; ncols = 2048; nkt = 86; J.dst = (bf16_t*)(ws + W_DOWN); J.ldD = DFF; }
    else { idx = t - 14848; J.src = a.in[I_WGLU] + (size_t)l * 512 * 512; J.ldS = 512; ncols = 512; nkt = 8; J.dst = (bf16_t*)(ws + W_GLU); J.ldD = 512; J.mode = 2; }
    const int tn = idx / nkt, tk = idx - tn * nkt;
    J.cbase = J.cs0 + tn * 64; J.cend = J.cs0 + ncols; J.kbase = tk * 64; return J;
}
__device__ __forceinline__ void phase_cvt(const Args& a, int l, unsigned char* lds, const int WV) {
    const int TI = fresh_tid(WV);
    float* T = (float*)lds;
    const int tid = TI, ty = tid >> 4, tx = tid & 15;
    for (int t4 = blockIdx.x * 8; t4 < 14912; t4 += gridDim.x * 8) {
        f32x4 v[8][2];
#pragma unroll
        for (int q = 0; q < 8; ++q) { const CvtJob J = cvt_decode(a, l, t4 + q);
#pragma unroll
            for (int ps = 0; ps < 2; ++ps) { const int k = ty + ps * 32, c = J.cbase + tx * 4;
                v[q][ps] = (f32x4){0.f, 0.f, 0.f, 0.f};
                if (c < J.cend) v[q][ps] = *(const f32x4*)(J.src + (size_t)(J.kbase + k) * J.ldS + c); } }
#pragma unroll
        for (int q = 0; q < 8; ++q)
#pragma unroll
            for (int ps = 0; ps < 2; ++ps) { float* tp = T + q * (64 * 65) + (ty + ps * 32) * 65 + tx * 4; tp[0] = v[q][ps][0]; tp[1] = v[q][ps][1]; tp[2] = v[q][ps][2]; tp[3] = v[q][ps][3]; }
        __syncthreads();
#pragma unroll
        for (int q = 0; q < 8; ++q) { const CvtJob J = cvt_decode(a, l, t4 + q);
            const int n = tid >> 3, kq = tid & 7, c = J.cbase + n;
            if (c < J.cend) {
                float f[8];
#pragma unroll
                for (int j = 0; j < 8; ++j) f[j] = T[q * (64 * 65) + (kq * 8 + j) * 65 + n];
                int row;
                if (J.mode == 0) row = J.r0 + (c - J.cs0);
                else if (J.mode == 2) { const int r_ = J.r0 + (c - J.cs0), ct = r_ & 255; row = (r_ & ~255) | (((ct >> 5) & 1) << 7) | ((ct >> 6) << 5) | (ct & 31); }
                else { const int bj = c >= DFF ? 1 : 0, ch = c - bj * DFF; row = (ch >> 7) * 256 + bj * 128 + (ch & 127); }
                uint4 o; o.x = pk2(f[0], f[1]); o.y = pk2(f[2], f[3]); o.z = pk2(f[4], f[5]); o.w = pk2(f[6], f[7]);
                *(uint4*)(J.dst + (size_t)row * J.ldD + J.kd0 + J.kbase + kq * 8) = o;
            } }
        __syncthreads();
    }
    bf16_t* wp = (bf16_t*)(a.ws + W_POOL); const float* wsrc = a.in[I_WPOOL] + (size_t)l * 4 * 128 * 128;
    for (int i = blockIdx.x * 512 + TI; i < 512 * 512; i += gridDim.x * 512) { const int n = i >> 9, k = i & 511, g = n >> 7;
        const float v = ((k >> 7) == g) ? wsrc[(g * 128 + (k & 127)) * 128 + (n & 127)] : 0.f;
        const int ct = n & 255, nr = (n & ~255) | (((ct >> 5) & 1) << 7) | ((ct >> 6) << 5) | (ct & 31); wp[nr * 512 + k] = (bf16_t)f2bf(v); }
}

__device__ __forceinline__ void phase_norm(const float* xin, const float* g, const float* modl, int shoff, int scoff, bf16_t* out, const int WV) {
    const int TI = fresh_tid(WV);
    const int lane = TI & 63, wave = TI >> 6;
    for (int r = blockIdx.x * 8 + wave; r < MROWS; r += gridDim.x * 8) {
        const f32x4* xp = (const f32x4*)(xin + (size_t)r * DM); f32x4 v[8]; float ssq = 0.f;
#pragma unroll
        for (int j = 0; j < 8; ++j) { v[j] = xp[j * 64 + lane]; ssq += v[j][0] * v[j][0] + v[j][1] * v[j][1] + v[j][2] * v[j][2] + v[j][3] * v[j][3]; }
        ssq = wave_sum(ssq);
        const float rinv = rsqrtf(ssq * (1.f / DM) + EPS);
        const float* mb = modl + (size_t)(r >> 11) * 12288;
#pragma unroll
        for (int j = 0; j < 8; ++j) { const int col = j * 256 + lane * 4;
            const f32x4 g4 = *(const f32x4*)(g + col), sc = *(const f32x4*)(mb + scoff + col), sh = *(const f32x4*)(mb + shoff + col);
            f32x4 y;
#pragma unroll
            for (int e = 0; e < 4; ++e) y[e] = (v[j][e] * rinv * g4[e]) * (1.f + sc[e]) + sh[e];
            uint2 o; o.x = pk2(y[0], y[1]); o.y = pk2(y[2], y[3]);
            *(uint2*)(out + (size_t)r * DM + col) = o; }
    }
}

__constant__ double kRevPerPos[24] = {0.15915494309189535, 0.0700865215877985, 0.03086376340470123, 0.013591370636193905, 0.005985185712713705, 0.002635675898667414, 0.001160663641240061, 0.0005111175045375439, 0.00022507907903927653, 9.911730936901935e-05, 4.364795279280289e-05, 1.9221100684944863e-05, 8.464330808241401e-06, 3.727408601915352e-06, 1.6414262627950345e-06, 7.228293068832865e-07, 0.15915494309189535, 0.03086376340470123, 0.005985185712713705, 0.001160663641240061, 0.00022507907903927653, 4.364795279280289e-05, 8.464330808241401e-06, 1.6414262627950345e-06};
__device__ __forceinline__ void rmsrope128(bf16_t* p, bool active, const float* g16, int sub, const float* cs) {
    float v[16];
    if (active) { unpack8(*(const uint4*)p, v); unpack8(*(const uint4*)(p + 8), v + 8); }
    else {
#pragma unroll
        for (int i = 0; i < 16; ++i) v[i] = 0.f; }
    float ssq = 0.f;
#pragma unroll
    for (int i = 0; i < 16; ++i) ssq += v[i] * v[i];
    ssq += __shfl_xor(ssq, 1); ssq += __shfl_xor(ssq, 2); ssq += __shfl_xor(ssq, 4);
    const float rinv = rsqrtf(ssq * (1.f / 128.f) + EPS);
#pragma unroll
    for (int i = 0; i < 16; ++i) v[i] = v[i] * rinv * g16[i];
#pragma unroll
    for (int i = 0; i < 16; ++i) { const float o = __shfl_xor(v[i], 1); const float c = cs[2 * i], s = cs[2 * i + 1];
        if (sub == 0) v[i] = v[i] * c - o * s; else if (sub == 1) v[i] = v[i] * c + o * s; }
    if (active) { uint4 o0, o1; o0.x = pk2(v[0], v[1]); o0.y = pk2(v[2], v[3]); o0.z = pk2(v[4], v[5]); o0.w = pk2(v[6], v[7]);
        o1.x = pk2(v[8], v[9]); o1.y = pk2(v[10], v[11]); o1.z = pk2(v[12], v[13]); o1.w = pk2(v[14], v[15]);
        *(uint4*)p = o0; *(uint4*)(p + 8) = o1; }
}
__device__ __forceinline__ void rope64(bf16_t* p, bool active, int sub, const float* cs) {
    float v[8];
    if (active) unpack8(*(const uint4*)p, v);
    else {
#pragma unroll
        for (int i = 0; i < 8; ++i) v[i] = 0.f; }
#pragma unroll
    for (int i = 0; i < 8; ++i) { const float o = __shfl_xor(v[i], 1); const float c = cs[2 * i], s = cs[2 * i + 1];
        if (sub == 0) v[i] = v[i] * c - o * s; else if (sub == 1) v[i] = v[i] * c + o * s; }
    if (active) { uint4 o0; o0.x = pk2(v[0], v[1]); o0.y = pk2(v[2], v[3]); o0.z = pk2(v[4], v[5]); o0.w = pk2(v[6], v[7]); *(uint4*)p = o0; }
}
__device__ __forceinline__ void phase_post(const Args& a, int l, unsigned char* lds, const int WV) {
    const int TI = fresh_tid(WV);
    const int lane = TI & 63, wave = TI >> 6;
    float* cs = (float*)lds + wave * 64;
    bf16_t* ocat = (bf16_t*)(a.ws + WS_OCAT); bf16_t* kn = (bf16_t*)(a.ws + WS_KN); bf16_t* qi = (bf16_t*)(a.ws + WS_QI); bf16_t* ki = (bf16_t*)(a.ws + WS_KI);
    const int* pos = (const int*)a.in[I_POS];
    const int sub = lane & 7, hd = lane >> 3;
    float gq[16], gk[16];
#pragma unroll
    for (int i = 0; i < 16; ++i) { gq[i] = a.in[I_GQ][l * 128 + sub * 16 + i]; gk[i] = a.in[I_GK][l * 128 + sub * 16 + i]; }
    for (int r = blockIdx.x * 8 + wave; r < MROWS; r += gridDim.x * 8) {
        const int ps = pos[r];
        if (lane < 24) {
            double rev = (double)ps * kRevPerPos[lane]; rev -= rint(rev); const float fr = (float)rev;
            cs[lane * 2] = __builtin_amdgcn_cosf(fr); cs[lane * 2 + 1] = __builtin_amdgcn_sinf(fr); }
        LDS_FENCE();
        rmsrope128(ocat + (size_t)r * 2048 + hd * 128 + sub * 16, true, gq, sub, cs);
        rmsrope128(kn + (size_t)r * 128 + sub * 16, lane < 8, gk, sub, cs);
        rope64(qi + (size_t)r * 512 + hd * 64 + sub * 8, true, sub, cs + 32);
        rope64(ki + (size_t)r * 64 + sub * 8, lane < 8, sub, cs + 32);
        LDS_FENCE();
    }
}

__device__ __forceinline__ void s5_unit(const Args& a, int l, int b, int g, unsigned char* lds, const int WV) {
    const int TI = fresh_tid(WV);
    const int lane = TI & 63, wave = __builtin_amdgcn_readfirstlane(TI >> 6), p = lane;
    float* E = (float*)lds;
    float* ust = (float*)(lds + 16384 + wave * 4096);
    bf16_t* sst = (bf16_t*)(lds + 49152 + wave * 4352);
    const bf16_t* U = (const bf16_t*)(a.ws + WS_U); bf16_t* Y = (bf16_t*)(a.ws + WS_Y);
    const int gp = (l * 32 + g) * 64 + p;
    const float are = a.in[I_ARE][gp], aim = a.in[I_AIM][gp], dt = expf(a.in[I_LOGDT][l * 32 + g]);
    const float mag = expf(are * dt);
    float ang = aim * dt; { const float n = rintf(ang * 0.15915494309189535f); ang = fmaf(-n, 6.28318548202514648f, ang); ang = fmaf(n, 1.7484555e-7f, ang); }
    const float lre = mag * cosf(ang), lim = mag * sinf(ang);
    float Bre[16], Bim[16];
    { const float nr = lre - 1.f, ni = lim, den = 1.f / (are * are + aim * aim); const float cr = (nr * are + ni * aim) * den, ci = (ni * are - nr * aim) * den;
#pragma unroll
        for (int j = 0; j < 16; ++j) { const float br = a.in[I_BRE][(size_t)gp * 16 + j], bi = a.in[I_BIM][(size_t)gp * 16 + j]; Bre[j] = cr * br - ci * bi; Bim[j] = cr * bi + ci * br; } }
    bf16x8 Cf[4];
    { const int i = lane & 15;
#pragma unroll
        for (int ks = 0; ks < 4; ++ks)
#pragma unroll
            for (int j = 0; j < 8; ++j) { const int k = ks * 32 + (lane >> 4) * 8 + j, pp = k >> 1; const size_t ci = ((size_t)(l * 32 + g) * 16 + i) * 64 + pp;
                const float v = (k & 1) ? -a.in[I_CIM][ci] : a.in[I_CRE][ci]; Cf[ks][j] = (short)f2bf(v); } }
    const float dsk = a.in[I_DSKIP][l * 512 + g * 16 + (lane & 15)];
    bf16_t* Bl = (bf16_t*)(lds + 83968);
    float* bus = (float*)(lds + 88064 + wave * 8448);
    if (wave == 0) {
#pragma unroll
        for (int q = 0; q < 2; ++q) { uint4 o_; o_.x = pk2(Bre[q * 8], Bre[q * 8 + 1]); o_.y = pk2(Bre[q * 8 + 2], Bre[q * 8 + 3]); o_.z = pk2(Bre[q * 8 + 4], Bre[q * 8 + 5]); o_.w = pk2(Bre[q * 8 + 6], Bre[q * 8 + 7]);
            *(uint4*)(Bl + p * 16 + q * 8) = o_;
            uint4 i_; i_.x = pk2(Bim[q * 8], Bim[q * 8 + 1]); i_.y = pk2(Bim[q * 8 + 2], Bim[q * 8 + 3]); i_.z = pk2(Bim[q * 8 + 4], Bim[q * 8 + 5]); i_.w = pk2(Bim[q * 8 + 6], Bim[q * 8 + 7]);
            *(uint4*)(Bl + (64 + p) * 16 + q * 8) = i_; }
    }
    __syncthreads();
    const int l15 = lane & 15, lg4 = lane >> 4;
    bf16x8 Bf[8];
#pragma unroll
    for (int nb = 0; nb < 8; ++nb) { u32x4 t_ = {0u, 0u, 0u, 0u}; if (lg4 < 2) t_ = *(const u32x4*)(Bl + (nb * 16 + l15) * 16 + lg4 * 8); Bf[nb] = __builtin_bit_cast(bf16x8, t_); }
#define S5_BU(t0_, sb_) do { u32x4 a_ = {0u, 0u, 0u, 0u}; if (lg4 < 2) a_ = *(const u32x4*)(U + (size_t)(b * 2048 + (t0_) + (sb_) * 16 + l15) * 512 + g * 16 + lg4 * 8); \
        const bf16x8 af_ = __builtin_bit_cast(bf16x8, a_); \
        _Pragma("unroll") for (int nb = 0; nb < 8; ++nb) { const f32x4 c_ = __builtin_amdgcn_mfma_f32_16x16x32_bf16(af_, Bf[nb], (f32x4){0.f, 0.f, 0.f, 0.f}, 0, 0, 0); \
            _Pragma("unroll") for (int r = 0; r < 4; ++r) bus[(lg4 * 4 + r) * 132 + nb * 16 + l15] = c_[r]; } \
        LDS_FENCE(); } while (0)
#define S5_STEP(tt_) do { const float br_ = bus[(tt_) * 132 + p], bi_ = bus[(tt_) * 132 + 64 + p]; \
        const float nre_ = lre * sre - lim * sim + br_, nim_ = lre * sim + lim * sre + bi_; sre = nre_; sim = nim_; } while (0)
#pragma unroll 1
    for (int cc = 0; cc < 4; ++cc) {
        const int chunk = wave * 4 + cc, t0 = chunk * 64;
        float sre = 0.f, sim = 0.f;
#pragma unroll 1
        for (int sb = 0; sb < 4; ++sb) {
            S5_BU(t0, sb);
#pragma unroll 4
            for (int tt = 0; tt < 16; ++tt) S5_STEP(tt);
            LDS_FENCE();
        }
        E[(chunk * 64 + p) * 2] = sre; E[(chunk * 64 + p) * 2 + 1] = sim;
    }
    __syncthreads();
    if (wave == 0) {
        float pr = lre, pi = lim;
#pragma unroll
        for (int q = 0; q < 6; ++q) { const float nr = pr * pr - pi * pi, pp_ = pr * pi, ni = pp_ + pp_; pr = nr; pi = ni; }
        float sr = 0.f, si = 0.f;
        for (int c = 0; c < 32; ++c) { const float er = E[(c * 64 + p) * 2], ei = E[(c * 64 + p) * 2 + 1]; E[(c * 64 + p) * 2] = sr; E[(c * 64 + p) * 2 + 1] = si;
            const float nr = pr * sr - pi * si + er, ni = pr * si + pi * sr + ei; sr = nr; si = ni; }
    }
    __syncthreads();
#pragma unroll 1
    for (int cc = 0; cc < 4; ++cc) {
        const int chunk = wave * 4 + cc, t0 = chunk * 64;
        { const bf16_t* up = U + (size_t)(b * 2048 + t0 + lane) * 512 + g * 16; const uint4 q0 = *(const uint4*)up, q1 = *(const uint4*)(up + 8);
            float f[16]; unpack8(q0, f); unpack8(q1, f + 8);
#pragma unroll
            for (int q = 0; q < 4; ++q) *(f32x4*)(ust + lane * 16 + q * 4) = (f32x4){f[q * 4], f[q * 4 + 1], f[q * 4 + 2], f[q * 4 + 3]}; }
        float sre = E[(chunk * 64 + p) * 2], sim = E[(chunk * 64 + p) * 2 + 1];
#pragma unroll 1
        for (int sb = 0; sb < 4; ++sb) {
            S5_BU(t0, sb);
#pragma unroll 4
            for (int tt = 0; tt < 16; ++tt) { S5_STEP(tt);
                *(unsigned*)(sst + tt * 136 + 2 * p) = pk2(sre, sim);
            }
            LDS_FENCE();
            f32x4 acc = {0.f, 0.f, 0.f, 0.f};
#pragma unroll
            for (int ks = 0; ks < 4; ++ks) { const bf16x8 af = *(const bf16x8*)(sst + (lane & 15) * 136 + ks * 32 + (lane >> 4) * 8);
                acc = __builtin_amdgcn_mfma_f32_16x16x32_bf16(af, Cf[ks], acc, 0, 0, 0); }
#pragma unroll
            for (int r = 0; r < 4; ++r) { const int t = sb * 16 + (lane >> 4) * 4 + r, i = lane & 15;
                const float y = gelu_tanh(acc[r] + dsk * ust[t * 16 + i]);
                Y[(size_t)(b * 2048 + t0 + t) * 512 + g * 16 + i] = (bf16_t)f2bf(y); }
            LDS_FENCE();
        }
    }
    __syncthreads();
#undef S5_STEP
#undef S5_BU
}

__device__ __forceinline__ void pool_unit(const Args& a, int b, int chunk, unsigned char* lds, const int WV) {
    const int TI = fresh_tid(WV);
    bf16_t* T = (bf16_t*)lds;
    const int t0 = chunk * 64;
    const bf16_t* P = (const bf16_t*)(a.ws + WS_P) + (size_t)b * 2048 * 512; bf16_t* O = (bf16_t*)(a.ws + WS_POOLED) + (size_t)b * 2048 * 512;
    __syncthreads();
    for (int i = TI; i < 80 * 64; i += 512) { const int r = i >> 6, c8 = i & 63, t = t0 - 16 + r;
        uint4 v = make_uint4(0u, 0u, 0u, 0u); if (t >= 0) v = *(const uint4*)(P + (size_t)t * 512 + c8 * 8);
        *(uint4*)(T + r * 512 + c8 * 8) = v; }
    __syncthreads();
    const int c = TI, w = 2 << (c >> 7);
    float s = 0.f;
    for (int k = 1; k <= w; ++k) s += bf1(T[(16 - k) * 512 + c]);
#pragma unroll 4
    for (int t = 0; t < 64; ++t) { const float pv = bf1(T[(16 + t) * 512 + c]); s += pv; s -= bf1(T[(16 + t - w) * 512 + c]);
        const int tt = t0 + t + 1; const float mean = s / (float)(tt < w ? tt : w); O[(size_t)(t0 + t) * 512 + c] = (bf16_t)f2bf(mean - pv); }
}

__device__ __forceinline__ unsigned sortkey(float x) { const unsigned u = __float_as_uint(x); return (u & 0x80000000u) ? ~u : (u | 0x80000000u); }
template <int NJ>
__device__ __forceinline__ void select256(const float* scq, int limit, unsigned short* sq, int lane) {
    const unsigned long long ltmask = (1ull << lane) - 1ull;
    unsigned key[NJ];
#pragma unroll
    for (int j = 0; j < NJ; ++j) { const int idx = j * 64 + lane; key[j] = (idx < limit) ? sortkey(scq[idx]) : 0u; }
    unsigned T = 0u;
    for (int bit = 31; bit >= 0; --bit) { const unsigned cand = T | (1u << bit); int cnt = 0;
#pragma unroll
        for (int j = 0; j < NJ; ++j) cnt += __popcll(__ballot(key[j] >= cand));
        if (cnt >= 256) { T = cand; if (cnt == 256) break; } }
    int cgt = 0;
#pragma unroll
    for (int j = 0; j < NJ; ++j) cgt += __popcll(__ballot(key[j] > T));
    const int need = 256 - cgt; int ob = 0, tb = 0;
#pragma unroll
    for (int j = 0; j < NJ; ++j) { const bool gt = key[j] > T, eq = key[j] == T; const unsigned long long me = __ballot(eq);
        const int pe = tb + __popcll(me & ltmask); const bool take = gt || (eq && pe < need); const unsigned long long mt = __ballot(take);
        if (take) sq[ob + __popcll(mt & ltmask)] = (unsigned short)(j * 64 + lane);
        ob += __popcll(mt); tb += __popcll(me); }
}
__device__ __forceinline__ void dsa_unit(const Args& a, int b, int tq, unsigned char* lds, const int WV, bf16_t* obase, const int ostride, const int parts) {
    const int TI = fresh_tid(WV);
    int tid = TI;
    int lane = tid & 63; const int wave = WV;
    float* sc = (float*)lds;
    unsigned short* sel = (unsigned short*)(lds + 131072);
    float* wis = (float*)(lds + 131072 + 8192);
    bf16_t* ocat = (bf16_t*)(a.ws + WS_OCAT); const bf16_t* Kn = (const bf16_t*)(a.ws + WS_KN); const bf16_t* V = (const bf16_t*)(a.ws + WS_V);
    const bf16_t* QI = (const bf16_t*)(a.ws + WS_QI); const bf16_t* KI = (const bf16_t*)(a.ws + WS_KI); const float* WI = (const float*)(a.ws + WS_WI);
    const int t0 = tq * 16, row0 = b * 2048 + t0, limit = ((t0 >> 6) + 1) << 6, nkt = limit >> 5, nsel = limit < 256 ? limit : 256;
    const int g = lane >> 5, c32 = lane & 31;
        bf16x8 Af[4][4];
#pragma unroll
        for (int rb = 0; rb < 4; ++rb) { const int R = rb * 32 + c32; const bf16_t* qp = QI + (size_t)(row0 + (R >> 3)) * 512 + (R & 7) * 64 + g * 8;
#pragma unroll
            for (int s = 0; s < 4; ++s) Af[rb][s] = *(const bf16x8*)(qp + s * 16); }
        bf16x8 Bn[4];
        { const bf16_t* kp0 = KI + (size_t)(b * 2048 + wave * 32 + c32) * 64 + g * 8;
#pragma unroll
            for (int s = 0; s < 4; ++s) Bn[s] = *(const bf16x8*)(kp0 + s * 16); }
    __syncthreads();
    if (tid < 128) wis[tid] = WI[(size_t)row0 * 8 + tid];
    __syncthreads();
    if (parts & 1)
    {
#pragma unroll 1
        for (int kt = wave; kt < nkt; kt += 8) {
            bf16x8 Bf[4];
#pragma unroll
            for (int s = 0; s < 4; ++s) Bf[s] = Bn[s];
            if (kt + 8 < nkt) { const bf16_t* kp = KI + (size_t)(b * 2048 + (kt + 8) * 32 + c32) * 64 + g * 8;
#pragma unroll
                for (int s = 0; s < 4; ++s) Bn[s] = *(const bf16x8*)(kp + s * 16); }
#pragma unroll
            for (int rb = 0; rb < 4; ++rb) {
                f32x16 acc;
#pragma unroll
                for (int i = 0; i < 16; ++i) acc[i] = 0.f;
#pragma unroll
                for (int s = 0; s < 4; ++s) acc = __builtin_amdgcn_mfma_f32_32x32x16_bf16(Af[rb][s], Bf[s], acc, 0, 0, 0);
#pragma unroll
                for (int j = 0; j < 4; ++j) { const int q = rb * 4 + j; const f32x4 w4 = *(const f32x4*)(wis + q * 8 + 4 * g);
                    float sp = fmaxf(acc[4 * j], 0.f) * w4[0] + fmaxf(acc[4 * j + 1], 0.f) * w4[1] + fmaxf(acc[4 * j + 2], 0.f) * w4[2] + fmaxf(acc[4 * j + 3], 0.f) * w4[3];
                    sp += __shfl_xor(sp, 32);
                    if (g == 0) sc[q * 2048 + kt * 32 + c32] = sp; }
            }
        }
    }
    __syncthreads();
    lane = fresh_tid(WV) & 63;
    for (int qq = 0; qq < 2; ++qq) {
        const int q = wave * 2 + qq; unsigned short* sq = sel + q * 256;
        if (limit <= 256 || !(parts & 2)) { for (int j = lane; j < nsel; j += 64) sq[j] = (unsigned short)j; }
        else if (limit <= 512) select256<8>(sc + q * 2048, limit, sq, lane);
        else if (limit <= 1024) select256<16>(sc + q * 2048, limit, sq, lane);
        else if (limit <= 1536) select256<24>(sc + q * 2048, limit, sq, lane);
        else select256<32>(sc + q * 2048, limit, sq, lane);
    }
    __syncthreads();
    lane = fresh_tid(WV) & 63;
    float* Pw = (float*)lds + wave * 2048;
    const int g4 = lane >> 4, hh = lane & 15;
#pragma unroll 1
    for (int qq = 0; qq < 2; ++qq) {
        const int q = wave * 2 + qq; const size_t row = (size_t)(row0 + q); const unsigned short* sq = sel + q * 256;
        bf16x8 Qf[4];
#pragma unroll
        for (int s = 0; s < 4; ++s) Qf[s] = *(const bf16x8*)(ocat + row * 2048 + (hh & 7) * 128 + g4 * 8 + s * 32);
        float lg[16][4];
        { bf16_t* Ks = (bf16_t*)(lds + wave * 10752);
          const bf16_t* Kb = Kn + (size_t)b * 2048 * 128 + hh * 8;
          u32x4 kq[8], kn_[8];
#pragma unroll
          for (int jj = 0; jj < 8; ++jj) { kn_[jj] = (u32x4){0u, 0u, 0u, 0u}; const int idx = sq[jj * 4 + g4]; kq[jj] = *(const u32x4*)(Kb + (size_t)idx * 128); }
#define QK_BATCH(bt) do { if ((bt) * 32 < nsel) { \
            if (((bt) + 1) * 32 < nsel) { _Pragma("unroll") for (int jj = 0; jj < 8; ++jj) { const int idx = sq[((bt) + 1) * 32 + jj * 4 + g4]; kn_[jj] = *(const u32x4*)(Kb + (size_t)idx * 128); } } \
            _Pragma("unroll") for (int jj = 0; jj < 8; ++jj) *(u32x4*)(Ks + (jj * 4 + g4) * 136 + hh * 8) = kq[jj]; \
            LDS_FENCE(); \
            _Pragma("unroll") for (int kbl = 0; kbl < 2; ++kbl) { f32x4 c = {0.f, 0.f, 0.f, 0.f}; \
                _Pragma("unroll") for (int s = 0; s < 4; ++s) c = __builtin_amdgcn_mfma_f32_16x16x32_bf16(*(const bf16x8*)(Ks + (kbl * 16 + hh) * 136 + g4 * 8 + s * 32), Qf[s], c, 0, 0, 0); \
                _Pragma("unroll") for (int r = 0; r < 4; ++r) lg[2 * (bt) + kbl][r] = c[r] * 0.08838834764831845f; } \
            LDS_FENCE(); \
            _Pragma("unroll") for (int jj = 0; jj < 8; ++jj) kq[jj] = kn_[jj]; \
          } else { _Pragma("unroll") for (int kbl = 0; kbl < 2; ++kbl) _Pragma("unroll") for (int r = 0; r < 4; ++r) lg[2 * (bt) + kbl][r] = -1e30f; } } while (0)
          QK_BATCH(0); QK_BATCH(1); QK_BATCH(2); QK_BATCH(3); QK_BATCH(4); QK_BATCH(5); QK_BATCH(6); QK_BATCH(7);
#undef QK_BATCH
        }
        float mx = -1e30f;
#pragma unroll
        for (int kb = 0; kb < 16; ++kb)
#pragma unroll
            for (int r = 0; r < 4; ++r) mx = fmaxf(mx, lg[kb][r]);
        mx = fmaxf(mx, __shfl_xor(mx, 16)); mx = fmaxf(mx, __shfl_xor(mx, 32));
        float sum = 0.f;
#pragma unroll
        for (int kb = 0; kb < 16; ++kb)
#pragma unroll
            for (int r = 0; r < 4; ++r) { const float e = (kb * 16 < nsel) ? __expf(lg[kb][r] - mx) : 0.f; lg[kb][r] = e; sum += e; }
        sum += __shfl_xor(sum, 16); sum += __shfl_xor(sum, 32);
        const float inv = 1.f / sum;
        bf16x8 Pa[8];
#pragma unroll
        for (int ks = 0; ks < 8; ++ks) {
            const unsigned a0 = pk2(lg[2 * ks][0] * inv, lg[2 * ks][1] * inv), a1 = pk2(lg[2 * ks][2] * inv, lg[2 * ks][3] * inv);
            const unsigned a2 = pk2(lg[2 * ks + 1][0] * inv, lg[2 * ks + 1][1] * inv), a3 = pk2(lg[2 * ks + 1][2] * inv, lg[2 * ks + 1][3] * inv);
            const u32x4 t_ = {a0, a1, a2, a3}; Pa[ks] = __builtin_bit_cast(bf16x8, t_); }
        bf16_t* Vs = (bf16_t*)(lds + wave * 10752);
        bf16_t* Os = Vs + 32 * 136;
        f32x4 oacc[8];
#pragma unroll
        for (int nb = 0; nb < 8; ++nb) oacc[nb] = (f32x4){0.f, 0.f, 0.f, 0.f};
        const bf16_t* Vb = V + (size_t)b * 2048 * 128 + hh * 8;
        u32x4 vq[8], vn[8];
#pragma unroll
        for (int jj = 0; jj < 8; ++jj) vn[jj] = (u32x4){0u, 0u, 0u, 0u};
#pragma unroll
        for (int jj = 0; jj < 8; ++jj) { const int idx = sq[jj * 4 + g4]; vq[jj] = *(const u32x4*)(Vb + (size_t)idx * 128); }
#define PV_BATCH(bt) do { if ((bt) * 32 < nsel) { \
            if (((bt) + 1) * 32 < nsel) { _Pragma("unroll") for (int jj = 0; jj < 8; ++jj) { const int idx = sq[((bt) + 1) * 32 + jj * 4 + g4]; vn[jj] = *(const u32x4*)(Vb + (size_t)idx * 128); } } \
            _Pragma("unroll") for (int jj = 0; jj < 8; ++jj) *(u32x4*)(Vs + (jj * 4 + g4) * 136 + hh * 8) = vq[jj]; \
            LDS_FENCE(); \
            _Pragma("unroll") for (int nb = 0; nb < 8; ++nb) { const bf16_t* vp = Vs + (4 * g4) * 136 + nb * 16 + hh; \
                const unsigned w0_ = (unsigned)vp[0 * 136] | ((unsigned)vp[1 * 136] << 16), w1_ = (unsigned)vp[2 * 136] | ((unsigned)vp[3 * 136] << 16); \
                const unsigned w2_ = (unsigned)vp[16 * 136] | ((unsigned)vp[17 * 136] << 16), w3_ = (unsigned)vp[18 * 136] | ((unsigned)vp[19 * 136] << 16); \
                const u32x4 t_ = {w0_, w1_, w2_, w3_}; \
                oacc[nb] = __builtin_amdgcn_mfma_f32_16x16x32_bf16(Pa[(bt)], __builtin_bit_cast(bf16x8, t_), oacc[nb], 0, 0, 0); } \
            LDS_FENCE(); \
            _Pragma("unroll") for (int jj = 0; jj < 8; ++jj) vq[jj] = vn[jj]; } } while (0)
        PV_BATCH(0); PV_BATCH(1); PV_BATCH(2); PV_BATCH(3); PV_BATCH(4); PV_BATCH(5); PV_BATCH(6); PV_BATCH(7);
#undef PV_BATCH
        if (g4 < 2) {
#pragma unroll
            for (int nb = 0; nb < 8; ++nb)
#pragma unroll
                for (int r = 0; r < 4; ++r) Os[(g4 * 4 + r) * 128 + nb * 16 + hh] = (bf16_t)f2bf(oacc[nb][r]);
        }
        LDS_FENCE();
#pragma unroll
        for (int h = 0; h < 2; ++h) { const uint4 ov = *(const uint4*)(Os + h * 512 + lane * 8); *(uint4*)(obase + row * ostride + h * 512 + lane * 8) = ov; }
        LDS_FENCE();
    }
}

__device__ __forceinline__ void phase_fix(const Args& a, int l, const int WV) {
    const int TI = fresh_tid(WV);
    const float* SA = (const float*)(a.ws + WS_SA); const float* SB = (const float*)(a.ws + WS_SB); bf16_t* act = (bf16_t*)(a.ws + WS_R2);
    const float* cw = a.in[I_CONVW] + (size_t)l * 3 * DFF; const float* cb = a.in[I_CONVB] + (size_t)l * DFF;
    const int total = 512 * 2 * DFF;
    for (int i = blockIdx.x * 512 + TI; i < total; i += gridDim.x * 512) {
        const int ch = i % DFF, rb = i / DFF, rr = rb & 1, blk = rb >> 1, r = blk * 64 + rr, t = r & 2047;
        const float a0 = SA[((size_t)blk * 4 + 2 + rr) * DFF + ch];
        float am1, am2;
        if (rr == 0) { am1 = (t >= 1) ? SA[((size_t)(blk - 1) * 4 + 1) * DFF + ch] : 0.f; am2 = (t >= 2) ? SA[((size_t)(blk - 1) * 4 + 0) * DFF + ch] : 0.f; }
        else { am1 = SA[((size_t)blk * 4 + 2) * DFF + ch]; am2 = (t >= 2) ? SA[((size_t)(blk - 1) * 4 + 1) * DFF + ch] : 0.f; }
        const float cv = cb[ch] + cw[ch] * am2 + cw[DFF + ch] * am1 + cw[2 * DFF + ch] * a0;
        act[(size_t)r * DFF + ch] = (bf16_t)f2bf(siluf_(cv) * SB[((size_t)blk * 2 + rr) * DFF + ch]);
    }
}

__device__ __forceinline__ void run_phase(const Args& a, int ph, unsigned char* lds, const int WV, const bool dummy) {
    unsigned char* ws = a.ws;
    LAS unsigned char* ldsl = (LAS unsigned char*)lds;
    const int G = gridDim.x, bx = blockIdx.x;
#ifndef DBG_NOADA
    if (ph == 0) { phase_ada(a, lds, WV); return; }
#else
    if (ph == 0) return;
#endif
    const int l = (ph - 1) / 10, sp = (ph - 1) % 10;
    const float* modl = (const float*)(ws + WS_MOD) + (size_t)l * 16 * 12288;
    const float* xin = (l == 0) ? a.in[I_X] : a.out;
#ifdef DBG_SP
    if (sp != DBG_SP) return;
#endif
    switch (sp) {
    case 0: phase_cvt(a, l, lds, WV); phase_norm(xin, a.in[I_GN1] + l * DM, modl, 0, 2048, (bf16_t*)(ws + WS_R1), WV); break;
    case 1: {
        pg8::Gemm g{(const bf16_t*)(ws + WS_R1), (const bf16_t*)(ws + W_1CAT), MROWS, N1, DM, DM, DM, 1 << 30, 0}; pg8::StaticOrder S; S.init(MROWS, N1, G, bx);
        Epi1 E{(bf16_t*)(ws + WS_OCAT), (bf16_t*)(ws + WS_KN), (bf16_t*)(ws + WS_V), (bf16_t*)(ws + WS_QI), (bf16_t*)(ws + WS_KI), (bf16_t*)(ws + WS_U), (bf16_t*)(ws + WS_P), (bf16_t*)(ws + WS_R2),
               (float*)(ws + WS_WI), a.in[I_BGATE] + (size_t)l * 3 * DM, ldsl + 131072};
        pg8::gemm_phase<Epi1, pg8::StaticOrder>(ldsl, g, S, E, WV); } break;
    case 2:
        if (!dummy) phase_post(a, l, lds, WV);
        __syncthreads();
        for (int u = bx; u < 512; u += G) s5_unit(a, l, u >> 5, u & 31, lds, WV);
        for (int u = bx; u < 512; u += G) pool_unit(a, u >> 5, u & 31, lds, WV);
        break;
    case 3: {
#ifndef DBG_NO_DSA
#ifdef DSA_PROBE
        for (int rep = 0; rep < 2; ++rep) { const bool dm = (rep == 0); const int parts = dm ? (DSA_PROBE) : 15;
#else
        { const bool dm = dummy; const int parts = 15;
#endif
            for (int u = bx; u < 2048; u += G) { const int w = u & 255, i = u >> 8, b = w & 15, s = w >> 4; const int tq = (i & 1) ? (i * 16 + 15 - s) : (i * 16 + s);
                dsa_unit(a, b, tq, lds, WV, dm ? (bf16_t*)(ws + WS_R1 + 64 * MiB) : (bf16_t*)(ws + WS_OCAT), dm ? 1024 : 2048, parts); }
        }
        __syncthreads();
#endif
#ifndef DBG_DSA_ONLY
        { pg8::Gemm g{(const bf16_t*)(ws + WS_Y), (const bf16_t*)(ws + W_GLU), MROWS, 1024, 512, 512, 512, 2, WS_POOLED - WS_Y}; pg8::StaticOrder S; S.init(MROWS, 1024, G, bx);
          EpiGluPool E{(const bf16_t*)(ws + WS_Y), a.in[I_PSCALE] + l * 512, (bf16_t*)(ws + WS_OCAT)}; pg8::gemm_phase<EpiGluPool, pg8::StaticOrder>(ldsl, g, S, E, WV); }
#endif
        } break;
    case 4: {
        pg8::Gemm g{(const bf16_t*)(ws + WS_OCAT), (const bf16_t*)(ws + W_P), MROWS, DM, DM, DM, DM, 1 << 30, 0}; pg8::StaticOrder S; S.init(MROWS, DM, G, bx);
        EpiMerge E{(const bf16_t*)(ws + WS_R2), (bf16_t*)(ws + WS_R1), ldsl + 131072}; pg8::gemm_phase<EpiMerge, pg8::StaticOrder>(ldsl, g, S, E, WV); } break;
    case 5: {
        pg8::Gemm g{(const bf16_t*)(ws + WS_R1), (const bf16_t*)(ws + W_OUT), MROWS, DM, DM, DM, DM, 1 << 30, 0}; pg8::StaticOrder S; S.init(MROWS, DM, G, bx);
        EpiRes E{xin, dummy ? (float*)(ws + WS_OCAT) : a.out, modl + 4096}; pg8::gemm_phase<EpiRes, pg8::StaticOrder>(ldsl, g, S, E, WV); } break;
    case 6: phase_norm(a.out, a.in[I_GN2] + l * DM, modl, 6144, 8192, (bf16_t*)(ws + WS_R1), WV); break;
    case 7: {
        pg8::Gemm g{(const bf16_t*)(ws + WS_R1), (const bf16_t*)(ws + W_UP), MROWS, 2 * DFF, DM, DM, DM, 1 << 30, 0}; pg8::StaticOrder S; S.init(MROWS, 2 * DFF, G, bx);
        EpiUp E{(bf16_t*)(ws + WS_R2), (float*)(ws + WS_SA), (float*)(ws + WS_SB), a.in[I_CONVW] + (size_t)l * 3 * DFF, a.in[I_CONVB] + (size_t)l * DFF, ldsl + 131072};
        pg8::gemm_phase<EpiUp, pg8::StaticOrder>(ldsl, g, S, E, WV); } break;
    case 8: phase_fix(a, l, WV); break;
    case 9: {
        pg8::Gemm g{(const bf16_t*)(ws + WS_R2), (const bf16_t*)(ws + W_DOWN), MROWS, DM, DFF, DFF, DFF, 1 << 30, 0}; pg8::StaticOrder S; S.init(MROWS, DM, G, bx);
        EpiRes E{a.out, dummy ? (float*)(ws + WS_OCAT) : a.out, modl + 10240}; pg8::gemm_phase<EpiRes, pg8::StaticOrder>(ldsl, g, S, E, WV); } break;
    }
}

#define XB_XCNT(j)  (256  + 64 * (j))
#define XB_XSUB(j)  (1280 + 64 * (j))
#define XB_XGEN(j)  (2304 + 64 * (j))
#define XB_TOP      3328
#define XB_TOPGEN   3392
#define XB_WORDS    3456
__device__ __forceinline__ unsigned xb_ld(unsigned* p)              { return __hip_atomic_load(p, __ATOMIC_RELAXED, __HIP_MEMORY_SCOPE_AGENT); }
__device__ __forceinline__ unsigned xb_add(unsigned* p, unsigned v) { return __hip_atomic_fetch_add(p, v, __ATOMIC_RELAXED, __HIP_MEMORY_SCOPE_AGENT); }
__device__ __forceinline__ unsigned xb_xcc_id() { return (unsigned)__builtin_amdgcn_s_getreg((3 << 11) | 20) & 0xFu; }
#define XB_SPIN(cond) do { unsigned _sp = 0; while (cond) { __builtin_amdgcn_s_sleep(1); if (++_sp > (1u << 22)) break; } } while (0)
__device__ __forceinline__ void grid_bar(unsigned* bar, volatile LAS unsigned* st, int wave_id) {
    asm volatile("s_waitcnt vmcnt(0) lgkmcnt(0)" ::: "memory");
    __syncthreads();
    if (wave_id == 0) {
        const int l = (int)__builtin_amdgcn_mbcnt_hi(~0u, __builtin_amdgcn_mbcnt_lo(~0u, 0u));
        if (l == 0) {
            const unsigned x = xb_xcc_id();
            unsigned nloc = st[0], nx = st[1];
            if (nloc == 0u) {
                const unsigned G = gridDim.x; unsigned sum, cnt, mine, sp = 0u;
                for (;;) { sum = 0u; cnt = 0u; mine = 0u;
#pragma unroll
                    for (unsigned j = 0; j < 16; ++j) { const unsigned c = xb_ld(&bar[XB_XCNT(j)]); sum += c; cnt += (c > 0u) ? 1u : 0u; mine = (j == x) ? c : mine; }
                    if (sum == G) break;
                    __builtin_amdgcn_s_sleep(1); if (++sp > (1u << 22)) break; }
                nloc = mine > 0u ? mine : 1u; nx = cnt > 0u ? cnt : 1u; st[0] = nloc; st[1] = nx;
            }
            const unsigned old = xb_add(&bar[XB_XSUB(x)], 1u);
            const unsigned gen = old / nloc;
            if (old + 1u == (gen + 1u) * nloc) {
                __builtin_amdgcn_fence(__ATOMIC_RELEASE, "agent");
                asm volatile("s_waitcnt vmcnt(0)" ::: "memory");
                const unsigned og = xb_add(&bar[XB_TOP], 1u);
                const unsigned tg = og / nx;
                if (og + 1u == (tg + 1u) * nx) xb_add(&bar[XB_TOPGEN], 1u);
                else XB_SPIN(xb_ld(&bar[XB_TOPGEN]) == tg);
                __builtin_amdgcn_fence(__ATOMIC_ACQUIRE, "agent");
                xb_add(&bar[XB_XGEN(x)], 1u);
                asm volatile("s_waitcnt vmcnt(0)" ::: "memory");
            } else {
                XB_SPIN(xb_ld(&bar[XB_XGEN(x)]) == gen);
                __builtin_amdgcn_fence(__ATOMIC_ACQUIRE, "agent");
                asm volatile("s_waitcnt vmcnt(0)" ::: "memory");
            }
        }
    }
    __syncthreads();
}

__global__ void __launch_bounds__(512, 2) mega_fwd(Args a) {
    extern __shared__ __attribute__((aligned(16))) unsigned char lds[];
    cg::grid_group grid = cg::this_grid();
    const int wave_id = __builtin_amdgcn_readfirstlane((int)(threadIdx.x >> 6));
    const int ph_lo = a.ph_lo, ph_hi = a.ph_hi;
    volatile LAS unsigned* xst = (volatile LAS unsigned*)((LAS unsigned char*)lds + 163776);
    if (threadIdx.x == 0) { xst[0] = 0u; xst[1] = 0u; (void)xb_add((unsigned*)(__attribute__((address_space(1))) unsigned*)a.ws + XB_XCNT(xb_xcc_id()), 1u); }
    __syncthreads();
    for (int ph = ph_lo; ph < ph_hi; ++ph) {
        const __attribute__((address_space(4))) Args* kp = (const __attribute__((address_space(4))) Args*)__builtin_amdgcn_kernarg_segment_ptr();
        asm volatile("" : "+s"(kp));
        Args la;
#pragma unroll
        for (int i = 0; i < 31; ++i) la.in[i] = (const float*)(const __attribute__((address_space(1))) float*)kp->in[i];
        la.ws = (unsigned char*)(__attribute__((address_space(1))) unsigned char*)kp->ws;
        la.out = (float*)(__attribute__((address_space(1))) float*)kp->out;
        la.ph_lo = ph_lo; la.ph_hi = ph_hi;
#ifdef REP_MASK
        if (ph > 0 && ((REP_MASK >> ((ph - 1) % 10)) & 1)) { run_phase(la, ph, lds, wave_id, true); grid.sync(); }
#endif
        run_phase(la, ph, lds, wave_id, false);
        if (ph + 1 < ph_hi) {
            if (ph_hi < 0) grid.sync();
            else grid_bar((unsigned*)la.ws, xst, wave_id);
        }
    }
}

extern "C" void kernel_launch(void* const* d_in, const int* in_sizes, int n_in, void* d_out, int out_size, void* d_ws, size_t ws_size, hipStream_t stream) {
    static int grid = 0;
    if (grid == 0) {
        int dev = 0, cus = 0, per_cu = 0;
        if (n_in != 31 || ws_size < WS_END) { fprintf(stderr, "kernel_launch: unexpected n_in %d / ws %zu\n", n_in, ws_size); grid = -1; return; }
        hipGetDevice(&dev); hipDeviceGetAttribute(&cus, hipDeviceAttributeMultiprocessorCount, dev);
        if (hipFuncSetAttribute((const void*)mega_fwd, hipFuncAttributeMaxDynamicSharedMemorySize, LDS_BYTES) != hipSuccess) { fprintf(stderr, "kernel_launch: hipFuncSetAttribute failed\n"); grid = -1; return; }
        if (hipOccupancyMaxActiveBlocksPerMultiprocessor(&per_cu, (const void*)mega_fwd, 512, LDS_BYTES) != hipSuccess || per_cu < 1) { fprintf(stderr, "kernel_launch: occupancy query says %d blocks/CU\n", per_cu); per_cu = 1; }
        (void)hipGetLastError();
        grid = cus > 0 ? cus : 256;
    }
    if (grid < 0) return;
    if (hipMemsetAsync(d_ws, 0, 16384, stream) != hipSuccess) { fprintf(stderr, "kernel_launch: memset of the barrier word failed\n"); return; }
    Args a{};
    for (int i = 0; i < 31; ++i) a.in[i] = (const float*)d_in[i];
    a.out = (float*)d_out; a.ws = (unsigned char*)d_ws;
#if MK_PER_PHASE
    for (int ph = 0; ph < NPHASE; ++ph) {
        a.ph_lo = ph; a.ph_hi = ph + 1;
        void* args[] = {&a};
        hipError_t e = hipLaunchCooperativeKernel((const void*)mega_fwd, dim3(grid), dim3(512), args, LDS_BYTES, stream);
        if (e != hipSuccess) { fprintf(stderr, "kernel_launch: launch of phase %d failed: %s\n", ph, hipGetErrorString(e)); break; }
    }
#else
    a.ph_lo = 0; a.ph_hi = NPHASE;
    void* args[] = {&a};
    hipError_t e = hipLaunchCooperativeKernel((const void*)mega_fwd, dim3(grid), dim3(512), args, LDS_BYTES, stream);
    if (e != hipSuccess) fprintf(stderr, "kernel_launch: cooperative launch failed: %s (grid %d)\n", hipGetErrorString(e), grid);
#endif
}
```
